# Optimizing an MI355X kernel written in HIP

```python
import math
import jax, jax.numpy as jnp
from jax import lax
import numpy as np

D_MODEL = 1024
BATCH = 4
SEQ = 8192
DEPTH = 2

GRID_W = 64
CTX_LEN = 256
N_EVEN = (DEPTH + 1) // 2
N_ODD = DEPTH // 2
ALPHA = (2.0 * DEPTH) ** 0.25
BETA = (8.0 * DEPTH) ** -0.25
LN_EPS = 1e-5
GN_EPS = 1e-6
ROPE_BASE = 10000.0
RET_DK = 64
RET_DV = 128
S5_CH = D_MODEL // 4
RET_HEADS = (D_MODEL - S5_CH) // RET_DV
RET_QK_W = RET_HEADS * RET_DK
RET_V_W = RET_HEADS * RET_DV
RET_CHUNK = 128
S5_GROUP_SIZE = 16
S5_GROUPS = S5_CH // S5_GROUP_SIZE
S5_STATE = 64
EVEN_SPLITS = (RET_QK_W, 2 * RET_QK_W, 2 * RET_QK_W + RET_V_W, 2 * RET_QK_W + 2 * RET_V_W)
EVEN_IN_W = 2 * RET_QK_W + 2 * RET_V_W + S5_CH
EVEN_OUT_W = RET_V_W + S5_CH
DIFF_HEADS = 8
DIFF_DH = D_MODEL // (2 * DIFF_HEADS)
Q_BLOCK = 128
N_EXPERTS = 16
N_EXPERT_GROUPS = 4
EXPERTS_PER_GROUP = N_EXPERTS // N_EXPERT_GROUPS
TOP_K = 2
D_FF = D_MODEL
MOE_BLOCK = 256

kernel_name = "hybrid_retention_s5_diffattn_moe_dit"


def _layer_norm(x, g):
    xf = x.astype(jnp.float32)
    mu = xf.mean(-1, keepdims=True)
    var = jnp.mean(jnp.square(xf - mu), -1, keepdims=True)
    return ((xf - mu) * lax.rsqrt(var + LN_EPS) * g.astype(jnp.float32)).astype(x.dtype)


def _modulate(x, shift, scale):
    return x * (1 + scale) + shift


def _rope_cos_sin(pos, dim):
    inv = ROPE_BASE ** (-jnp.arange(0, dim, 2, dtype=jnp.float32) / dim)
    ang = pos.astype(jnp.float32)[:, None] * inv[None, :]
    return jnp.cos(ang), jnp.sin(ang)


def _apply_rope(x, cos, sin):
    half = x.shape[-1] // 2
    x1, x2 = x[..., :half], x[..., half:]
    cos = cos.astype(x.dtype)
    sin = sin.astype(x.dtype)
    return jnp.concatenate([x1 * cos - x2 * sin, x1 * sin + x2 * cos], -1)


def _axial_rope(x, rows, cols):
    half = x.shape[-1] // 2
    cr, sr = _rope_cos_sin(rows, half)
    cc, sc = _rope_cos_sin(cols, half)
    return jnp.concatenate([_apply_rope(x[..., :half], cr, sr),
                            _apply_rope(x[..., half:], cc, sc)], -1)


def _retention_chunkwise(q, k, v, log_gamma, s0, strict):
    bsz, nh, L, dk = q.shape
    dv = v.shape[-1]
    nc = L // RET_CHUNK
    qc = q.reshape(bsz, nh, nc, RET_CHUNK, dk)
    kc = k.reshape(bsz, nh, nc, RET_CHUNK, dk)
    vc = v.reshape(bsz, nh, nc, RET_CHUNK, dv)
    idx = jnp.arange(RET_CHUNK, dtype=jnp.float32)
    diff = idx[:, None] - idx[None, :]
    mask = diff > 0 if strict else diff >= 0
    intra_decay = jnp.where(mask, jnp.exp(log_gamma[:, None, None] * jnp.maximum(diff, 0.0)), 0.0)
    scores = jnp.einsum('bhcid,bhcjd->bhcij', qc, kc) * intra_decay[None, :, None]
    o_intra = jnp.einsum('bhcij,bhcje->bhcie', scores, vc)
    k_decay = jnp.exp(log_gamma[:, None] * (RET_CHUNK - 1.0 - idx)[None])
    chunk_states = jnp.einsum('bhcjd,bhcje->cbhde', kc * k_decay[None, :, None, :, None], vc)
    gamma_chunk = jnp.exp(log_gamma * RET_CHUNK)[None, :, None, None]

    def step(s, r):
        return gamma_chunk * s + r, s

    s_final, s_prev = lax.scan(step, s0, chunk_states)
    q_decay = jnp.exp(log_gamma[:, None] * (idx + 1.0)[None])
    o_inter = jnp.einsum('bhcid,cbhde->bhcie', qc * q_decay[None, :, None, :, None], s_prev)
    return (o_intra + o_inter).reshape(bsz, nh, L, dv), s_final


def _bidir_retention(q_lat, k_lat, v_lat, q_ctx, k_ctx, v_ctx, log_gammas):
    bsz, nh, _, dk = q_lat.shape
    zeros = jnp.zeros((bsz, nh, dk, v_lat.shape[-1]), jnp.float32)
    flip = lambda t: jnp.flip(t, axis=2)
    oc_f, sc_f = _retention_chunkwise(q_ctx, k_ctx, v_ctx, log_gammas[0], zeros, False)
    ol_f, _ = _retention_chunkwise(q_lat, k_lat, v_lat, log_gammas[0], sc_f, False)
    oc_b, sc_b = _retention_chunkwise(flip(q_ctx), flip(k_ctx), flip(v_ctx), log_gammas[1], zeros, True)
    ol_b, _ = _retention_chunkwise(flip(q_lat), flip(k_lat), flip(v_lat), log_gammas[1], sc_b, True)
    return ol_f + flip(ol_b), oc_f + flip(oc_b)


def _head_group_norm(o):
    mu = o.mean(-1, keepdims=True)
    var = jnp.mean(jnp.square(o - mu), -1, keepdims=True)
    return (o - mu) * lax.rsqrt(var + GN_EPS)


def _ssm_combine(e_i, e_j):
    a_i, b_i = e_i
    a_j, b_j = e_j
    return a_j * a_i, a_j * b_i + b_j


def _s5_scan(u, lam_bar, b_bar, c_mat, h0):
    bu = jnp.einsum('blgp,gnp->blgn', u.astype(jnp.complex64), b_bar)
    if h0 is not None:
        bu = bu.at[:, 0].add(lam_bar[None] * h0)
    a = jnp.broadcast_to(lam_bar[None, None], (1,) + bu.shape[1:])
    _, h = lax.associative_scan(_ssm_combine, (a, bu), axis=1)
    y = jnp.einsum('blgn,gpn->blgp', h, c_mat).real
    return y, h[:, -1]


def _bidir_s5(u_lat, u_ctx, lam_re, lam_im, log_dt, b_re, b_im, c_re, c_im, d_skip):
    f32 = jnp.float32
    flip = lambda t: jnp.flip(t, axis=1)
    d = d_skip.astype(f32)
    y_lat = d * u_lat
    y_ctx = d * u_ctx
    for direction in range(2):
        lam = lax.complex(lam_re[direction].astype(f32), lam_im[direction].astype(f32))
        dt = jnp.exp(log_dt[direction].astype(f32))[:, None]
        lam_bar = jnp.exp(lam * dt)
        b_bar = ((lam_bar - 1.0) / lam)[..., None] * lax.complex(b_re[direction].astype(f32), b_im[direction].astype(f32))
        c_mat = lax.complex(c_re[direction].astype(f32), c_im[direction].astype(f32))
        uc, ul = (u_ctx, u_lat) if direction == 0 else (flip(u_ctx), flip(u_lat))
        yc, hc = _s5_scan(uc, lam_bar, b_bar, c_mat, None)
        yl, _ = _s5_scan(ul, lam_bar, b_bar, c_mat, hc)
        if direction == 1:
            yc, yl = flip(yc), flip(yl)
        y_lat = y_lat + yl
        y_ctx = y_ctx + yc
    return y_lat, y_ctx


def _even_mixer(h_lat, h_ctx, w_in, decay_logit, lam_re, lam_im, log_dt, b_re, b_im,
                c_re, c_im, d_skip, w_glu, w_out):
    dtype = h_lat.dtype
    L = h_lat.shape[1]
    cos, sin = _rope_cos_sin(jnp.arange(L), RET_DK)

    def heads(t, dh):
        return t.reshape(t.shape[0], t.shape[1], RET_HEADS, dh).transpose(0, 2, 1, 3).astype(jnp.float32)

    def project(h):
        q, k, v, g, u = jnp.split(h @ w_in, EVEN_SPLITS, axis=-1)
        u = u.reshape(u.shape[0], u.shape[1], S5_GROUPS, S5_GROUP_SIZE).astype(jnp.float32)
        return heads(q, RET_DK), heads(k, RET_DK) * RET_DK ** -0.5, heads(v, RET_DV), g, u

    q_l, k_l, v_l, g_l, u_l = project(h_lat)
    q_l = _apply_rope(q_l, cos, sin)
    k_l = _apply_rope(k_l, cos, sin)
    q_c, k_c, v_c, g_c, u_c = project(h_ctx)
    log_gammas = jax.nn.log_sigmoid(decay_logit.astype(jnp.float32))
    r_lat, r_ctx = _bidir_retention(q_l, k_l, v_l, q_c, k_c, v_c, log_gammas)
    s_lat, s_ctx = _bidir_s5(u_l, u_c, lam_re, lam_im, log_dt, b_re, b_im, c_re, c_im, d_skip)

    def merge(r, g, s):
        bsz, n = g.shape[:2]
        r = _head_group_norm(r).transpose(0, 2, 1, 3).reshape(bsz, n, RET_V_W).astype(dtype) * jax.nn.silu(g)
        z = jax.nn.gelu(s.reshape(bsz, n, S5_CH)).astype(dtype) @ w_glu
        za, zb = jnp.split(z, 2, axis=-1)
        return jnp.concatenate([r, za * jax.nn.sigmoid(zb)], -1) @ w_out

    return merge(r_lat, g_l, s_lat), merge(r_ctx, g_c, s_ctx)


def _diff_attend(q1, q2, k1, k2, v, lam):
    s1 = jnp.einsum('bhqd,bhkd->bhqk', q1, k1).astype(jnp.float32)
    s2 = jnp.einsum('bhqd,bhkd->bhqk', q2, k2).astype(jnp.float32)
    a = jax.nn.softmax(s1, axis=-1) - lam * jax.nn.softmax(s2, axis=-1)
    return jnp.einsum('bhqk,bhkd->bhqd', a.astype(v.dtype), v)


def _odd_mixer(h_lat, h_ctx, w_in, diff_lambda, subln_g, w_out, lambda_init, need_ctx):
    dtype = h_lat.dtype
    bsz, L, _ = h_lat.shape
    n_rows = L // GRID_W
    rows = jnp.repeat(jnp.arange(n_rows), GRID_W)
    cols = jnp.arange(n_rows * GRID_W) % GRID_W
    scale = DIFF_DH ** -0.5

    def qk_heads(t):
        return t.reshape(t.shape[0], t.shape[1], DIFF_HEADS, 2, DIFF_DH).transpose(3, 0, 2, 1, 4)

    def v_heads(t):
        return t.reshape(t.shape[0], t.shape[1], DIFF_HEADS, 2 * DIFF_DH).transpose(0, 2, 1, 3)

    def head_out(o):
        of = o.astype(jnp.float32)
        of = of * lax.rsqrt(jnp.mean(jnp.square(of), -1, keepdims=True) + GN_EPS)
        of = of * subln_g.astype(jnp.float32) * (1.0 - lambda_init)
        n = o.shape[2]
        return of.transpose(0, 2, 1, 3).reshape(o.shape[0], n, D_MODEL).astype(dtype) @ w_out

    q, k, v = jnp.split(h_lat @ w_in, 3, axis=-1)
    q_l = _axial_rope(qk_heads(q), rows, cols) * scale
    k_l = _axial_rope(qk_heads(k), rows, cols)
    k_cx, v_cx = jnp.split(h_ctx @ w_in[:, D_MODEL:], 2, axis=-1)
    k_c = qk_heads(k_cx)
    v_c = v_heads(v_cx)
    k_all = jnp.concatenate([k_l, k_c], axis=3)
    v_all = jnp.concatenate([v_heads(v), v_c], axis=2)
    lf = diff_lambda.astype(jnp.float32)
    lam = jnp.exp(jnp.sum(lf[0] * lf[1])) - jnp.exp(jnp.sum(lf[2] * lf[3])) + lambda_init
    nb = L // Q_BLOCK
    q_blocks = q_l.reshape(2, bsz, DIFF_HEADS, nb, Q_BLOCK, DIFF_DH).transpose(3, 0, 1, 2, 4, 5)
    o = lax.map(lambda qb: _diff_attend(qb[0], qb[1], k_all[0], k_all[1], v_all, lam), q_blocks)
    o = o.transpose(1, 2, 0, 3, 4).reshape(bsz, DIFF_HEADS, L, 2 * DIFF_DH)
    o_lat = head_out(o)
    o_ctx = None
    if need_ctx:
        q_c = qk_heads(h_ctx @ w_in[:, :D_MODEL]) * scale
        o_ctx = head_out(_diff_attend(q_c[0], q_c[1], k_c[0], k_c[1], v_c, lam))
    return o_lat, o_ctx


def _moe(h, router_w, router_bias, w_gate, w_up, w_down):
    n_tok, d = h.shape
    scores = jax.nn.sigmoid((h @ router_w).astype(jnp.float32))
    biased = scores + router_bias.astype(jnp.float32)
    group_score = lax.top_k(biased.reshape(n_tok, N_EXPERT_GROUPS, EXPERTS_PER_GROUP), 2)[0].sum(-1)
    group_sel = jnp.argmax(group_score, axis=-1)
    in_group = (jnp.arange(N_EXPERTS) // EXPERTS_PER_GROUP)[None, :] == group_sel[:, None]
    _, expert_idx = lax.top_k(jnp.where(in_group, biased, -jnp.inf), TOP_K)
    gate = jnp.take_along_axis(scores, expert_idx, axis=-1)
    gate = gate / gate.sum(-1, keepdims=True)

    n_assign = n_tok * TOP_K
    e_flat = expert_idx.reshape(-1)
    order = jnp.argsort(e_flat)
    e_sorted = e_flat[order]
    counts = jnp.bincount(e_flat, length=N_EXPERTS)
    starts = jnp.cumsum(counts) - counts
    padded = (counts + MOE_BLOCK - 1) // MOE_BLOCK * MOE_BLOCK
    pad_end = jnp.cumsum(padded)
    pad_start = pad_end - padded
    dest_sorted = (pad_start[e_sorted] + jnp.arange(n_assign) - starts[e_sorted]).astype(jnp.int32)
    dest = jnp.zeros((n_assign,), jnp.int32).at[order].set(dest_sorted)
    n_blocks = -(-(n_assign + N_EXPERTS * (MOE_BLOCK - 1)) // MOE_BLOCK)
    buf = jnp.zeros((n_blocks * MOE_BLOCK, d), h.dtype).at[dest].set(jnp.repeat(h, TOP_K, axis=0))
    block_expert = jnp.minimum(
        jnp.searchsorted(pad_end, jnp.arange(n_blocks) * MOE_BLOCK, side='right'), N_EXPERTS - 1)

    def expert_block(args):
        xb, e = args
        return (jax.nn.silu(xb @ w_gate[e]) * (xb @ w_up[e])) @ w_down[e]

    out = lax.map(expert_block, (buf.reshape(n_blocks, MOE_BLOCK, d), block_expert)).reshape(-1, d)
    y = out[dest].reshape(n_tok, TOP_K, d)
    return jnp.einsum('nkd,nk->nd', y, gate.astype(h.dtype))


def setup_inputs(seed: int = 0) -> dict:
    key = jax.random.key(seed)
    ks = jax.random.split(key, 32)
    f32 = jnp.float32

    def nrm(i, shape, scale):
        return jax.random.normal(ks[i], shape, f32) * scale

    g0 = 1.0 - 2.0 ** (-5.0 - np.arange(RET_HEADS))
    logit0 = jnp.asarray(np.log(g0 / (1.0 - g0)), f32)
    lam_im = jnp.broadcast_to(jnp.pi * jnp.arange(S5_STATE, dtype=f32), (N_EVEN, 2, S5_GROUPS, S5_STATE))
    b_scale = (2.0 * S5_GROUP_SIZE) ** -0.5
    c_scale = (2.0 * S5_STATE) ** -0.5
    return {
        "x": nrm(0, (BATCH, SEQ, D_MODEL), 1.0),
        "c": nrm(1, (BATCH, D_MODEL), 1.0),
        "ctx": nrm(2, (BATCH, CTX_LEN, D_MODEL), 1.0),
        "c_ctx": nrm(3, (D_MODEL,), 1.0),
        "ada_w": nrm(4, (DEPTH, D_MODEL, 6 * D_MODEL), 0.5 * D_MODEL ** -0.5),
        "ada_b": nrm(5, (DEPTH, 6 * D_MODEL), 0.02),
        "ln_g": 1.0 + nrm(6, (DEPTH, 2, D_MODEL), 0.02),
        "w_in_ab": nrm(7, (N_EVEN, D_MODEL, EVEN_IN_W), D_MODEL ** -0.5),
        "ret_decay_logit": logit0 + nrm(8, (N_EVEN, 2, RET_HEADS), 0.05),
        "s5_lam_re": -0.5 + nrm(9, (N_EVEN, 2, S5_GROUPS, S5_STATE), 0.01),
        "s5_lam_im": lam_im,
        "s5_log_dt": jax.random.uniform(ks[10], (N_EVEN, 2, S5_GROUPS), f32,
                                        math.log(1e-3), math.log(1e-1)),
        "s5_b_re": nrm(11, (N_EVEN, 2, S5_GROUPS, S5_STATE, S5_GROUP_SIZE), b_scale),
        "s5_b_im": nrm(12, (N_EVEN, 2, S5_GROUPS, S5_STATE, S5_GROUP_SIZE), b_scale),
        "s5_c_re": nrm(13, (N_EVEN, 2, S5_GROUPS, S5_GROUP_SIZE, S5_STATE), c_scale),
        "s5_c_im": nrm(14, (N_EVEN, 2, S5_GROUPS, S5_GROUP_SIZE, S5_STATE), c_scale),
        "s5_d": nrm(15, (N_EVEN, S5_GROUPS, S5_GROUP_SIZE), 1.0),
        "s5_w_glu": nrm(16, (N_EVEN, S5_CH, 2 * S5_CH), S5_CH ** -0.5),
        "w_out_ab": nrm(17, (N_EVEN, EVEN_OUT_W, D_MODEL), BETA * EVEN_OUT_W ** -0.5),
        "w_in_c": nrm(18, (N_ODD, D_MODEL, 3 * D_MODEL), D_MODEL ** -0.5),
        "diff_lambda": nrm(19, (N_ODD, 4, DIFF_DH), 0.1),
        "diff_subln_g": 1.0 + nrm(20, (N_ODD, 2 * DIFF_DH), 0.02),
        "w_out_c": nrm(21, (N_ODD, D_MODEL, D_MODEL), BETA * D_MODEL ** -0.5),
        "router_w": nrm(22, (D_MODEL, N_EXPERTS), D_MODEL ** -0.5),
        "router_bias": nrm(23, (N_EXPERTS,), 0.01),
        "exp_w_gate": nrm(24, (DEPTH, N_EXPERTS, D_MODEL, D_FF), D_MODEL ** -0.5),
        "exp_w_up": nrm(25, (DEPTH, N_EXPERTS, D_MODEL, D_FF), D_MODEL ** -0.5),
        "exp_w_down": nrm(26, (DEPTH, N_EXPERTS, D_FF, D_MODEL), BETA * D_FF ** -0.5),
    }


def reference(x, c, ctx, c_ctx, ada_w, ada_b, ln_g, w_in_ab, ret_decay_logit, s5_lam_re,
              s5_lam_im, s5_log_dt, s5_b_re, s5_b_im, s5_c_re, s5_c_im, s5_d, s5_w_glu,
              w_out_ab, w_in_c, diff_lambda, diff_subln_g, w_out_c, router_w, router_bias,
              exp_w_gate, exp_w_up, exp_w_down):
    bsz, L, d = x.shape
    x_lat, x_ctx = x, ctx
    c_all = jnp.concatenate([c, c_ctx[None].astype(c.dtype)], axis=0)
    for i in range(DEPTH):
        last = i == DEPTH - 1
        mod = jax.nn.silu(c_all) @ ada_w[i] + ada_b[i]
        sh1, sc1, g1, sh2, sc2, g2 = jnp.split(mod[:bsz, None, :], 6, axis=-1)
        csh1, csc1, cg1, csh2, csc2, cg2 = jnp.split(mod[bsz:, None, :], 6, axis=-1)
        h_lat = _modulate(x_lat, sh1, sc1)
        h_ctx = _modulate(x_ctx, csh1, csc1)
        j = i // 2
        if i % 2 == 0:
            o_lat, o_ctx = _even_mixer(h_lat, h_ctx, w_in_ab[j], ret_decay_logit[j], s5_lam_re[j],
                                       s5_lam_im[j], s5_log_dt[j], s5_b_re[j], s5_b_im[j],
                                       s5_c_re[j], s5_c_im[j], s5_d[j], s5_w_glu[j], w_out_ab[j])
        else:
            lambda_init = 0.8 - 0.6 * math.exp(-0.3 * i)
            o_lat, o_ctx = _odd_mixer(h_lat, h_ctx, w_in_c[j], diff_lambda[j], diff_subln_g[j],
                                      w_out_c[j], lambda_init, not last)
        x_lat = _layer_norm(ALPHA * x_lat + g1 * o_lat, ln_g[i, 0])
        h_lat = _modulate(x_lat, sh2, sc2)
        if last:
            y_lat = _moe(h_lat.reshape(-1, d), router_w, router_bias, exp_w_gate[i],
                         exp_w_up[i], exp_w_down[i]).reshape(h_lat.shape)
        else:
            x_ctx = _layer_norm(ALPHA * x_ctx + cg1 * o_ctx, ln_g[i, 0])
            h_ctx = _modulate(x_ctx, csh2, csc2)
            tokens = jnp.concatenate([h_lat.reshape(-1, d), h_ctx.reshape(-1, d)], axis=0)
            y_all = _moe(tokens, router_w, router_bias, exp_w_gate[i], exp_w_up[i], exp_w_down[i])
            y_lat = y_all[:bsz * L].reshape(h_lat.shape)
            y_ctx = y_all[bsz * L:].reshape(h_ctx.shape)
            x_ctx = _layer_norm(ALPHA * x_ctx + cg2 * y_ctx, ln_g[i, 1])
        x_lat = _layer_norm(ALPHA * x_lat + g2 * y_lat, ln_g[i, 1])
    return x_lat
```

```cpp
#include <hip/hip_runtime.h>
#include <cstdio>
#include <cstdint>

#define LAS __attribute__((address_space(3)))
#define GAS __attribute__((address_space(1)))
typedef unsigned short bf16;
typedef short bf16x8 __attribute__((ext_vector_type(8)));
typedef short s16x4 __attribute__((ext_vector_type(4)));
typedef float f32x4 __attribute__((ext_vector_type(4)));
typedef float f32x2 __attribute__((ext_vector_type(2)));
typedef float f32x16 __attribute__((ext_vector_type(16)));
typedef unsigned u32x4 __attribute__((ext_vector_type(4)));
typedef unsigned u32x2 __attribute__((ext_vector_type(2)));

constexpr int DM = 1024, NBATCH = 4, SEQ = 8192, CTXL = 256;
constexpr int NLAT = NBATCH * SEQ, NCTX = NBATCH * CTXL, NTOK = NLAT + NCTX;
constexpr int RH = 6, RDK = 64, RDV = 128, RC = 128, RNCH = 66;
constexpr int S5G = 16, S5P = 16, S5N = 64, S5T = 32, S5ROWS = 1280;
constexpr int NEXP = 16, NB0 = 280, NB1 = 272;
constexpr float ALPHA = 1.4142135623730951f;
constexpr float LN_EPS = 1e-5f, GN_EPS = 1e-6f;
constexpr float LAMBDA_INIT = 0.35550906759096926f;
constexpr int NWAVES = 8, NTHREADS = 512;

constexpr size_t MiB = 1u << 20, KiB = 1024;
constexpr size_t WS_CTL = 0, CTL_BYTES = 1 * MiB;
constexpr size_t WS_MOD = 1 * MiB;
constexpr size_t WS_SCAL = 1 * MiB + 256 * KiB;
constexpr size_t WS_LAMP = 1 * MiB + 320 * KiB;
constexpr size_t WS_COEF = 1 * MiB + 896 * KiB;
constexpr size_t WS_ROPE0C = 2 * MiB, WS_ROPE0S = 3 * MiB;
constexpr size_t WS_ROPE1 = 4 * MiB;
constexpr size_t WS_S5K = 4 * MiB + 64 * KiB;
constexpr size_t WS_XC = 6 * MiB;
constexpr size_t WS_CNT = 10 * MiB;
constexpr size_t WS_ROUTE = 10 * MiB + 64 * KiB;
constexpr size_t WS_BT1 = 12 * MiB;
constexpr size_t WS_BT2 = 16 * MiB;
constexpr size_t WS_WIN0 = 28 * MiB;
constexpr size_t WS_WGLU = 33 * MiB;
constexpr size_t WS_WOUT0 = 34 * MiB;
constexpr size_t WS_WIN1 = 36 * MiB;
constexpr size_t WS_WOUT1 = 42 * MiB;
constexpr size_t WS_EXP = 44 * MiB;
constexpr size_t EXP_STRIDE = 6 * MiB, EXP_DN = 4 * MiB;
constexpr size_t WS_ARENA = 236 * MiB;
constexpr size_t AR(double mib) { return WS_ARENA + (size_t)(mib * 1048576.0); }
constexpr size_t A_QK = AR(0), A_V = AR(49.5), A_G = AR(99), A_UA = AR(148.5), A_TT = AR(178.5), A_EO = AR(228), A_H0 = AR(248), A_MRG = AR(248), A_SG = AR(314);
constexpr size_t A_O = AR(140), A_H2 = AR(206), A_BUF = AR(0), A_HID = AR(140), A_Y = AR(0), A_H0P = AR(140);
constexpr size_t B_Q = AR(0), B_K = AR(64), B_V = AR(206), B_STASH = AR(272), B_AO = AR(140), B_O = AR(0), B_H2 = AR(64), B_BUF = AR(140), B_HID = AR(0), B_Y = AR(140);
constexpr size_t WS_END = AR(331);

constexpr int STAGE_BYTES_LDS = 131072;
constexpr int MISC_OFF = 131072;
constexpr int LDS_BYTES = 147456;

__device__ __forceinline__ unsigned f2bf(float f) { unsigned u = __float_as_uint(f); return (u + 0x7fffu + ((u >> 16) & 1u)) >> 16; }
__device__ __forceinline__ float bf2f(unsigned b) { return __uint_as_float(b << 16); }
__device__ __forceinline__ float bflo(unsigned w) { return __uint_as_float(w << 16); }
__device__ __forceinline__ float bfhi(unsigned w) { return __uint_as_float(w & 0xffff0000u); }
__device__ __forceinline__ unsigned cvt_pk_bf16(float lo, float hi) { unsigned r; asm volatile("v_cvt_pk_bf16_f32 %0, %1, %2" : "=v"(r) : "v"(lo), "v"(hi)); return r; }
__device__ __forceinline__ float wave_sum(float v) {
#pragma unroll
    for (int o = 1; o < 64; o <<= 1) v += __shfl_xor(v, o);
    return v;
}
__device__ __forceinline__ float fast_sigmoid(float x) { return __builtin_amdgcn_rcpf(1.f + __expf(-x)); }
__device__ __forceinline__ float fast_silu(float x) { return x * fast_sigmoid(x); }
__device__ __forceinline__ float gelu_tanh(float x) { const float z = 0.7978845608028654f * (x + 0.044715f * x * x * x); const float t = 1.f - 2.f * __builtin_amdgcn_rcpf(__expf(2.f * z) + 1.f); return 0.5f * x * (1.f + t); }
__device__ __forceinline__ void sincos_rev(double rev, float& s, float& c) { const double fr = rev - rint(rev); const float y = (float)(fr * 6.283185307179586); s = sinf(y); c = cosf(y); }
__device__ __forceinline__ f32x2 cmul(f32x2 a, f32x2 b) { return (f32x2){a.x * b.x - a.y * b.y, a.x * b.y + a.y * b.x}; }

#define XB_TMO      128
#define XB_XCNT(j)  (256  + 64 * (j))
#define XB_XSUB(j)  (1280 + 64 * (j))
#define XB_XGEN(j)  (2304 + 64 * (j))
#define XB_TOP      3328
#define XB_TOPGEN   3392
#define XCD_BAR_WORDS 3456
#define XB_SPIN_CAP (1u << 22)
__device__ __forceinline__ unsigned xb_ld(unsigned* p)              { return __hip_atomic_load(p, __ATOMIC_RELAXED, __HIP_MEMORY_SCOPE_AGENT); }
__device__ __forceinline__ unsigned xb_add(unsigned* p, unsigned v) { return __hip_atomic_fetch_add(p, v, __ATOMIC_RELAXED, __HIP_MEMORY_SCOPE_AGENT); }
__device__ __forceinline__ unsigned xb_xcc_id() { return (unsigned)__builtin_amdgcn_s_getreg((3 << 11) | 20) & 0xFu; }
#define XB_SPIN(cond, bar) do { unsigned _sp = 0; while (cond) { __builtin_amdgcn_s_sleep(1); \
    if ((++_sp & 255u) == 0u) { if (xb_ld(&(bar)[XB_TMO])) break; if (_sp > XB_SPIN_CAP) { atomicAdd(&(bar)[XB_TMO], 1u); break; } } } } while (0)
struct XcdBarrier { unsigned* bar; unsigned x; volatile LAS unsigned* st; };
__device__ __forceinline__ XcdBarrier xcd_barrier_post(unsigned* bar, volatile LAS unsigned* st) {
    XcdBarrier b; b.bar = bar; b.x = xb_xcc_id(); b.st = st;
    if (threadIdx.x == 0) (void)xb_add(&bar[XB_XCNT(b.x)], 1u);
    return b;
}
__device__ __forceinline__ void xcd_barrier_complete(unsigned* bar, unsigned x, unsigned& nloc, unsigned& nx) {
    const unsigned G = gridDim.x * gridDim.y * gridDim.z;
    unsigned sum, cnt, mine, sp = 0u;
    for (;;) {
        sum = 0u; cnt = 0u; mine = 0u;
#pragma unroll
        for (unsigned j = 0; j < 16; ++j) { const unsigned c = xb_ld(&bar[XB_XCNT(j)]); sum += c; cnt += (c > 0u) ? 1u : 0u; mine = (j == x) ? c : mine; }
        if (sum == G) break;
        __builtin_amdgcn_s_sleep(1);
        if ((++sp & 255u) == 0u) { if (xb_ld(&bar[XB_TMO])) break; if (sp > XB_SPIN_CAP) { atomicAdd(&bar[XB_TMO], 1u); break; } }
    }
    nloc = mine > 0u ? mine : 1u; nx = cnt > 0u ? cnt : 1u;
}
__device__ __forceinline__ void xcd_barrier(const XcdBarrier& b) {
    asm volatile("s_waitcnt vmcnt(0)" ::: "memory");
    __syncthreads();
    if (threadIdx.x == 0) {
        unsigned* bar = b.bar;
        __builtin_amdgcn_s_waitcnt(0);
        unsigned nloc = b.st[0], nx = b.st[1];
        if (nloc == 0u) { xcd_barrier_complete(bar, b.x, nloc, nx); b.st[0] = nloc; b.st[1] = nx; }
        const unsigned old = xb_add(&bar[XB_XSUB(b.x)], 1u);
        const unsigned gen = old / nloc;
        if (old + 1u == (gen + 1u) * nloc) {
            __builtin_amdgcn_fence(__ATOMIC_RELEASE, "agent");
            asm volatile("s_waitcnt vmcnt(0)" ::: "memory");
            const unsigned og = xb_add(&bar[XB_TOP], 1u);
            const unsigned tg = og / nx;
            if (og + 1u == (tg + 1u) * nx) xb_add(&bar[XB_TOPGEN], 1u);
            else XB_SPIN(xb_ld(&bar[XB_TOPGEN]) == tg, bar);
            __builtin_amdgcn_fence(__ATOMIC_ACQUIRE, "agent");
            xb_add(&bar[XB_XGEN(b.x)], 1u);
            asm volatile("s_waitcnt vmcnt(0)" ::: "memory");
        } else {
            XB_SPIN(xb_ld(&bar[XB_XGEN(b.x)]) == gen, bar);
            __builtin_amdgcn_fence(__ATOMIC_ACQUIRE, "agent");
            asm volatile("s_waitcnt vmcnt(0)" ::: "memory");
        }
    }
    __syncthreads();
}

namespace pg8 {
constexpr int BM = 256, BK = 64, HALF = 128, HTB = HALF * BK * 2, NXCD = 8, WGM = 8;
__host__ __device__ __forceinline__ int lds_byte(int r, int c) { const int st = (r >> 4) * 2 + (c >> 5), rr = r & 15, cc = c & 31, ob = rr * 64 + cc * 2; return st * 1024 + (ob ^ (((ob >> 9) & 1) << 5)); }
__host__ __device__ __forceinline__ void stage_rc(int b, int& R, int& C) { const int st = b / 1024, sb = b % 1024, swz = sb ^ (((sb >> 9) & 1) << 5); R = (st >> 1) * 16 + swz / 64; C = (st & 1) * 32 + (swz % 64) / 2; }
__host__ __device__ __forceinline__ int perm32(int rho) { const int n = rho >> 4, i = rho & 15; return 8 * (i >> 2) + 4 * n + (i & 3); }

struct Unit { int pm, pn, z; long aoff, boff; };
struct Gemm { const bf16* A; const bf16* Bt; int K, lda, ldb; };

struct GridOrder {
    int nM, nN, nwg, G, c; long tA, tB;
    __device__ void init(int nM_, int nN_, int G_, int c_, int lda, int ldb) { nM = nM_; nN = nN_; nwg = nM * nN; G = G_; c = c_; tA = (long)BM * lda * 2; tB = (long)BM * ldb * 2; }
    __device__ __forceinline__ bool tile(long L, int& pm, int& pn) const {
        if (L >= nwg) return false;
        int wgid = (int)L; { const int q = nwg / NXCD, r = nwg % NXCD, xcd = wgid % NXCD, off = wgid / NXCD; wgid = (xcd < r ? xcd * (q + 1) : r * (q + 1) + (xcd - r) * q) + off; }
        const int nig = WGM * nN, gid = wgid / nig, fm = gid * WGM, gsz = (nM - fm) < WGM ? (nM - fm) : WGM;
        pm = fm + ((wgid % nig) % gsz); pn = (wgid % nig) / gsz; return true;
    }
    __device__ __forceinline__ bool next(int i, Unit& u) const {
        if (!tile((long)i * G + c, u.pm, u.pn)) return false;
        u.z = 0; u.aoff = u.pm * tA; u.boff = u.pn * tB; return true;
    }
};
struct BatchOrder {
    int nZ, nM, nN, G, c; long tA, tB, zA, zB;
    __device__ __forceinline__ bool next(int i, Unit& u) const {
        const long L = (long)i * G + c; if (L >= (long)nZ * nM * nN) return false;
        const int per = nM * nN; u.z = (int)(L / per); const int r = (int)(L % per); u.pm = r / nN; u.pn = r % nN;
        u.aoff = u.z * zA + u.pm * tA; u.boff = u.z * zB + u.pn * tB; return true;
    }
};
struct ExpertOrder {
    GridOrder g; const LAS unsigned* pend; long eB;
    __device__ __forceinline__ bool next(int i, Unit& u) const {
        if (!g.tile((long)i * g.G + g.c, u.pm, u.pn)) return false;
        int e = 0;
#pragma unroll
        for (int k = 0; k < 15; ++k) e += ((unsigned)u.pm >= pend[k]) ? 1 : 0;
        u.z = e; u.aoff = u.pm * g.tA; u.boff = e * eB + u.pn * g.tB; return true;
    }
};
struct InProj1Order {
    GridOrder g;
    __device__ __forceinline__ bool next(int i, Unit& u) const {
        const long L = (long)i * g.G + g.c;
        if (L < g.nwg) { g.tile(L, u.pm, u.pn); }
        else { const long Lc = L - g.nwg; if (Lc >= 32) return false; u.pm = 128 + (int)(Lc >> 3); u.pn = 4 + (int)(Lc & 7); }
        u.z = 0; u.aoff = u.pm * g.tA; u.boff = u.pn * g.tB; return true;
    }
};

template <class Epi, class Sched>
__device__ __forceinline__ void gemm_phase(LAS unsigned char* lds, const Gemm g, const Sched& S, const Epi& E) {
    const int tid = threadIdx.x, wid = __builtin_amdgcn_readfirstlane(tid >> 6), lane = tid & 63, wr = wid >> 2, wc = wid & 3, fr = lane & 15, fq = lane >> 4;
    const int K = g.K, nt = K / BK;
    unsigned voffA[2], voffB[2];
#pragma unroll
    for (int i = 0; i < 2; ++i) { int R, C; stage_rc(tid * 16 + i * 8192, R, C); const int Rb = Epi::PERM ? ((R & ~31) + perm32(R & 31)) : R;
        voffA[i] = (unsigned)(R * g.lda + C) * 2u; voffB[i] = (unsigned)(Rb * g.ldb + C) * 2u; }
    const size_t kstep = (size_t)(BK * 2);
    const size_t hstepA = (size_t)HALF * g.lda * 2, hstepB = (size_t)HALF * g.ldb * 2;
    const unsigned ldsw = (unsigned)wid * 1024u;
    const int aoff = lds_byte(wr * 64 + fr, fq * 8), boff = lds_byte(wc * 32 + fr, fq * 8);
#define PG8_SA(b, h) (((b) * 2 + (h)) * HTB)
#define PG8_SB(b, h) ((4 + (b) * 2 + (h)) * HTB)
#define PG8_STAGE(bufoff, gbase, voff) do { _Pragma("unroll") for (int _i = 0; _i < 2; ++_i) \
        __builtin_amdgcn_global_load_lds((const unsigned*)((const char*)(gbase) + (voff)[_i]), (LAS unsigned*)(lds + (bufoff) + ldsw + _i * 8192), 16, 0, 0); } while (0)
#define PG8_LDA(dst, b, h) do { _Pragma("unroll") for (int m = 0; m < 4; ++m) _Pragma("unroll") for (int k = 0; k < 2; ++k) dst[m][k] = *(const LAS bf16x8*)(lds + PG8_SA(b, h) + aoff + m * 2048 + k * 1024); } while (0)
#define PG8_LDB(dst, b, h) do { _Pragma("unroll") for (int n = 0; n < 2; ++n) _Pragma("unroll") for (int k = 0; k < 2; ++k) dst[n][k] = *(const LAS bf16x8*)(lds + PG8_SB(b, h) + boff + n * 2048 + k * 1024); } while (0)
#define PG8_MMA(ai, bj, At, Bt) do { __builtin_amdgcn_s_setprio(1); _Pragma("unroll") for (int m = 0; m < 4; ++m) _Pragma("unroll") for (int n = 0; n < 2; ++n) _Pragma("unroll") for (int k = 0; k < 2; ++k) \
        acc[ai][bj][m][n] = __builtin_amdgcn_mfma_f32_16x16x32_bf16(Bt[n][k], At[m][k], acc[ai][bj][m][n], 0, 0, 0); __builtin_amdgcn_s_setprio(0); } while (0)
#define PG8_WAIT_V(n) asm volatile("s_waitcnt vmcnt(" #n ")" ::: "memory")
#define PG8_WAIT_L(n) asm volatile("s_waitcnt lgkmcnt(" #n ")" ::: "memory")
#define PG8_BAR __builtin_amdgcn_s_barrier()
#define PG8_SCHED __builtin_amdgcn_sched_barrier(0)
    Unit cur, nxt; int ui = 0;
    if (!S.next(0, cur)) return;
    f32x4 acc[2][2][4][2];
#pragma unroll
    for (int a = 0; a < 2; ++a)
#pragma unroll
        for (int b = 0; b < 2; ++b)
#pragma unroll
            for (int m = 0; m < 4; ++m)
#pragma unroll
                for (int n = 0; n < 2; ++n) acc[a][b][m][n] = (f32x4){0.f, 0.f, 0.f, 0.f};
    bf16x8 At[4][2], B0[2][2], B1[2][2];
    const char* cA = (const char*)g.A + cur.aoff; const char* cB = (const char*)g.Bt + cur.boff;
    PG8_STAGE(PG8_SB(0, 0), cB, voffB); PG8_STAGE(PG8_SB(0, 1), cB + hstepB, voffB); PG8_STAGE(PG8_SA(0, 0), cA, voffA); PG8_STAGE(PG8_SA(0, 1), cA + hstepA, voffA);
    if (wr == 1) PG8_BAR;
    PG8_WAIT_V(2); PG8_BAR;
    PG8_STAGE(PG8_SB(1, 0), cB + kstep, voffB); PG8_STAGE(PG8_SA(1, 0), cA + kstep, voffA); PG8_STAGE(PG8_SB(1, 1), cB + hstepB + kstep, voffB);
    PG8_WAIT_V(6); PG8_BAR;
    for (;;) {
        const bool has_next = S.next(ui + 1, nxt);
        const char* nA = has_next ? (const char*)g.A + nxt.aoff : cA; const char* nB = has_next ? (const char*)g.Bt + nxt.boff : cB;
        for (int t = 0; t < nt; t += 2) {
            const bool last = (t == nt - 2);
            const char* a1 = cA + (size_t)(t + 1) * kstep;
            const char* a2 = last ? nA : cA + (size_t)(t + 2) * kstep; const char* b2 = last ? nB : cB + (size_t)(t + 2) * kstep;
            const char* a3 = a2 + kstep; const char* b3 = b2 + kstep;
            PG8_LDB(B0, 0, 0); PG8_LDB(B1, 0, 1); PG8_SCHED; PG8_LDA(At, 0, 0); PG8_STAGE(PG8_SA(1, 1), a1 + hstepA, voffA);
            PG8_WAIT_V(8); PG8_WAIT_L(0); PG8_BAR; PG8_MMA(0, 0, At, B0); PG8_MMA(0, 1, At, B1); PG8_BAR; PG8_SCHED;
            PG8_LDA(At, 0, 1); PG8_STAGE(PG8_SB(0, 0), b2, voffB); PG8_STAGE(PG8_SB(0, 1), b2 + hstepB, voffB); PG8_STAGE(PG8_SA(0, 0), a2, voffA);
            PG8_WAIT_V(8); PG8_WAIT_L(0); PG8_BAR; PG8_MMA(1, 0, At, B0); PG8_MMA(1, 1, At, B1); PG8_BAR; PG8_SCHED;
            PG8_LDB(B0, 1, 0); PG8_LDB(B1, 1, 1); PG8_SCHED; PG8_LDA(At, 1, 0); PG8_STAGE(PG8_SA(0, 1), a2 + hstepA, voffA);
            PG8_WAIT_V(8); PG8_WAIT_L(0); PG8_BAR; PG8_MMA(0, 0, At, B0); PG8_MMA(0, 1, At, B1); PG8_BAR; PG8_SCHED;
            PG8_LDA(At, 1, 1); PG8_STAGE(PG8_SB(1, 0), b3, voffB); PG8_STAGE(PG8_SB(1, 1), b3 + hstepB, voffB); PG8_STAGE(PG8_SA(1, 0), a3, voffA);
            PG8_WAIT_V(8); PG8_WAIT_L(0); PG8_BAR; PG8_MMA(1, 0, At, B0); PG8_MMA(1, 1, At, B1); PG8_BAR; PG8_SCHED;
        }
        if (wr == 0) PG8_BAR;
        E(acc, cur, wr, wc, fr, fq);
        if (!has_next) break;
#pragma unroll
        for (int a = 0; a < 2; ++a)
#pragma unroll
            for (int b = 0; b < 2; ++b)
#pragma unroll
                for (int m = 0; m < 4; ++m)
#pragma unroll
                    for (int n = 0; n < 2; ++n) acc[a][b][m][n] = (f32x4){0.f, 0.f, 0.f, 0.f};
        cur = nxt; cA = nA; cB = nB; ++ui;
        if (wr == 1) PG8_BAR;
    }
    PG8_WAIT_V(0);
    PG8_BAR;
#undef PG8_SA
#undef PG8_SB
#undef PG8_STAGE
#undef PG8_LDA
#undef PG8_LDB
#undef PG8_MMA
#undef PG8_WAIT_V
#undef PG8_WAIT_L
#undef PG8_BAR
#undef PG8_SCHED
}
}
namespace pg8 {
__device__ __forceinline__ u32x4 pack8(const f32x4 a, const f32x4 b) { u32x4 w; w.x = cvt_pk_bf16(a[0], a[1]); w.y = cvt_pk_bf16(a[2], a[3]); w.z = cvt_pk_bf16(b[0], b[1]); w.w = cvt_pk_bf16(b[2], b[3]); return w; }
typedef const f32x4 (&AccRef)[2][2][4][2];

struct EpiPlain {
    static constexpr bool PERM = true;
    bf16* O; int ldc;
    __device__ __forceinline__ void operator()(AccRef acc, const Unit& u, int wr, int wc, int fr, int fq) const {
        const int row0 = u.pm * BM + wr * 64 + fr, col0 = u.pn * BM + wc * 32 + 8 * fq;
#pragma unroll
        for (int ai = 0; ai < 2; ++ai)
#pragma unroll
            for (int m = 0; m < 4; ++m) { bf16* rowp = O + (size_t)(row0 + ai * HALF + m * 16) * ldc + col0;
#pragma unroll
                for (int bj = 0; bj < 2; ++bj) *(u32x4*)(rowp + bj * HALF) = pack8(acc[ai][bj][m][0], acc[ai][bj][m][1]); }
    }
};
struct EpiInProj0 {
    static constexpr bool PERM = true;
    bf16 *QK, *V, *G, *UA; const float *rc, *rs;
    __device__ __forceinline__ void operator()(AccRef acc, const Unit& u, int wr, int wc, int fr, int fq) const {
        const int row0 = u.pm * BM + wr * 64 + fr, pn = u.pn;
        if (pn < 3) {
            const int H = 4 * pn + wc;
#pragma unroll
            for (int ai = 0; ai < 2; ++ai)
#pragma unroll
                for (int m = 0; m < 4; ++m) {
                    const int row = row0 + ai * HALF + m * 16;
                    f32x4 c0 = (f32x4){1.f, 1.f, 1.f, 1.f}, c1 = c0, s0 = (f32x4){0.f, 0.f, 0.f, 0.f}, s1 = s0;
                    if (row < NLAT) { const int pos = row & (SEQ - 1); const float* pc = rc + pos * 32 + 8 * fq; const float* ps = rs + pos * 32 + 8 * fq;
                        c0 = *(const f32x4*)pc; c1 = *(const f32x4*)(pc + 4); s0 = *(const f32x4*)ps; s1 = *(const f32x4*)(ps + 4); }
                    const f32x4 a0 = acc[ai][0][m][0], a1 = acc[ai][0][m][1], b0 = acc[ai][1][m][0], b1 = acc[ai][1][m][1];
                    const f32x4 y10 = a0 * c0 - b0 * s0, y11 = a1 * c1 - b1 * s1, y20 = a0 * s0 + b0 * c0, y21 = a1 * s1 + b1 * c1;
                    bf16* rp = QK + (size_t)row * 768 + H * 64 + 8 * fq;
                    *(u32x4*)rp = pack8(y10, y11); *(u32x4*)(rp + 32) = pack8(y20, y21);
                }
        } else if (pn < 9) {
            bf16* base = pn < 6 ? V : G; const int colt = (pn < 6 ? pn - 3 : pn - 6) * BM + wc * 32 + 8 * fq;
#pragma unroll
            for (int ai = 0; ai < 2; ++ai)
#pragma unroll
                for (int m = 0; m < 4; ++m) { bf16* rowp = base + (size_t)(row0 + ai * HALF + m * 16) * 768 + colt;
#pragma unroll
                    for (int bj = 0; bj < 2; ++bj) *(u32x4*)(rowp + bj * HALF) = pack8(acc[ai][bj][m][0], acc[ai][bj][m][1]); }
        } else {
#pragma unroll
            for (int ai = 0; ai < 2; ++ai)
#pragma unroll
                for (int m = 0; m < 4; ++m) { const int row = row0 + ai * HALF + m * 16;
#pragma unroll
                    for (int bj = 0; bj < 2; ++bj) { const int c = bj * HALF + wc * 32 + 8 * fq, g = c >> 4, p0 = c & 15;
                        *(u32x4*)(UA + ((size_t)g * S5ROWS + (row >> 5)) * 768 + (row & 31) * 16 + p0) = pack8(acc[ai][bj][m][0], acc[ai][bj][m][1]); } }
        }
    }
};
struct EpiS5E {
    static constexpr bool PERM = false;
    float* EO;
    __device__ __forceinline__ void operator()(AccRef acc, const Unit& u, int wr, int wc, int fr, int fq) const {
        const int row0 = u.pm * BM + wr * 64 + fr, col0 = wc * 32 + 4 * fq;
#pragma unroll
        for (int ai = 0; ai < 2; ++ai)
#pragma unroll
            for (int m = 0; m < 4; ++m) { float* rowp = EO + ((size_t)u.z * S5ROWS + row0 + ai * HALF + m * 16) * 256 + col0;
#pragma unroll
                for (int bj = 0; bj < 2; ++bj)
#pragma unroll
                    for (int n = 0; n < 2; ++n) *(f32x4*)(rowp + bj * HALF + n * 16) = acc[ai][bj][m][n]; }
    }
};
struct EpiS5Y {
    static constexpr bool PERM = true;
    bf16* SG;
    __device__ __forceinline__ void operator()(AccRef acc, const Unit& u, int wr, int wc, int fr, int fq) const {
        const int row0 = u.pm * BM + wr * 64 + fr;
#pragma unroll
        for (int ai = 0; ai < 2; ++ai)
#pragma unroll
            for (int m = 0; m < 4; ++m) { const int cr = row0 + ai * HALF + m * 16;
                if (cr < NTOK / S5T) {
#pragma unroll
                    for (int bj = 0; bj < 2; ++bj) { const int cn0 = u.pn * BM + bj * HALF + wc * 32 + 8 * fq, i = cn0 >> 4, p0 = cn0 & 15;
                        f32x4 v0 = acc[ai][bj][m][0], v1 = acc[ai][bj][m][1];
#pragma unroll
                        for (int j = 0; j < 4; ++j) { v0[j] = gelu_tanh(v0[j]); v1[j] = gelu_tanh(v1[j]); }
                        *(u32x4*)(SG + (size_t)(cr * S5T + i) * 256 + u.z * 16 + p0) = pack8(v0, v1); } } }
    }
};
struct EpiGlu {
    static constexpr bool PERM = true;
    bf16* MRG;
    __device__ __forceinline__ void operator()(AccRef acc, const Unit& u, int wr, int wc, int fr, int fq) const {
        const int row0 = u.pm * BM + wr * 64 + fr, col0 = 768 + u.pn * HALF + wc * 32 + 8 * fq;
#pragma unroll
        for (int ai = 0; ai < 2; ++ai)
#pragma unroll
            for (int m = 0; m < 4; ++m) { f32x4 v0, v1;
#pragma unroll
                for (int j = 0; j < 4; ++j) { v0[j] = acc[ai][0][m][0][j] * fast_sigmoid(acc[ai][1][m][0][j]); v1[j] = acc[ai][0][m][1][j] * fast_sigmoid(acc[ai][1][m][1][j]); }
                *(u32x4*)(MRG + (size_t)(row0 + ai * HALF + m * 16) * 1024 + col0) = pack8(v0, v1); }
    }
};
struct EpiSwiGlu {
    static constexpr bool PERM = true;
    bf16* HID;
    __device__ __forceinline__ void operator()(AccRef acc, const Unit& u, int wr, int wc, int fr, int fq) const {
        const int row0 = u.pm * BM + wr * 64 + fr, col0 = u.pn * HALF + wc * 32 + 8 * fq;
#pragma unroll
        for (int ai = 0; ai < 2; ++ai)
#pragma unroll
            for (int m = 0; m < 4; ++m) { f32x4 v0, v1;
#pragma unroll
                for (int j = 0; j < 4; ++j) { v0[j] = fast_silu(acc[ai][0][m][0][j]) * acc[ai][1][m][0][j]; v1[j] = fast_silu(acc[ai][0][m][1][j]) * acc[ai][1][m][1][j]; }
                *(u32x4*)(HID + (size_t)(row0 + ai * HALF + m * 16) * 1024 + col0) = pack8(v0, v1); }
    }
};
struct EpiInProj1 {
    static constexpr bool PERM = true;
    bf16 *Q, *Kb, *Vb; const float* rope;
    __device__ __forceinline__ void operator()(AccRef acc, const Unit& u, int wr, int wc, int fr, int fq) const {
        const int row0 = u.pm * BM + wr * 64 + fr, pn = u.pn;
#pragma unroll
        for (int ai = 0; ai < 2; ++ai)
#pragma unroll
            for (int m = 0; m < 4; ++m) {
                const int row = row0 + ai * HALF + m * 16;
                const bool lat = row < NLAT;
                const int b = lat ? (row >> 13) : ((row - NLAT) >> 8), t = lat ? (row & (SEQ - 1)) : ((row - NLAT) & 255);
                const size_t krow = (size_t)b * (SEQ + CTXL) + (lat ? t : SEQ + t);
                if (pn < 8) {
                    const int sh = 4 * (pn & 3) + wc;
                    f32x4 c0 = (f32x4){1.f, 1.f, 1.f, 1.f}, c1 = c0, s0 = (f32x4){0.f, 0.f, 0.f, 0.f}, s1 = s0;
                    if (lat) { const int pos = (fq < 2) ? (t >> 6) : (t & 63); const float* pc = rope + pos * 16 + 8 * (fq & 1);
                        c0 = *(const f32x4*)pc; c1 = *(const f32x4*)(pc + 4); s0 = *(const f32x4*)(pc + 2048); s1 = *(const f32x4*)(pc + 2048 + 4); }
                    const f32x4 a0 = acc[ai][0][m][0], a1 = acc[ai][0][m][1], b0 = acc[ai][1][m][0], b1 = acc[ai][1][m][1];
                    const f32x4 y10 = a0 * c0 - b0 * s0, y11 = a1 * c1 - b1 * s1, y20 = a0 * s0 + b0 * c0, y21 = a1 * s1 + b1 * c1;
                    const int dim = (fq < 2 ? 0 : 32) + 8 * (fq & 1);
                    bf16* rp = (pn < 4) ? (Q + (size_t)row * 1024) : (Kb + krow * 1024);
                    rp += sh * 64 + dim;
                    if (pn >= 4 || lat) { *(u32x4*)rp = pack8(y10, y11); *(u32x4*)(rp + 16) = pack8(y20, y21); }
                } else {
                    bf16* rp = Vb + krow * 1024 + (pn - 8) * BM + wc * 32 + 8 * fq;
#pragma unroll
                    for (int bj = 0; bj < 2; ++bj) *(u32x4*)(rp + bj * HALF) = pack8(acc[ai][bj][m][0], acc[ai][bj][m][1]);
                }
            }
    }
};
}
enum InIdx { I_X = 0, I_C, I_CTX, I_CCTX, I_ADAW, I_ADAB, I_LNG, I_WINAB, I_DECAY, I_LAMRE, I_LAMIM, I_LOGDT, I_BRE, I_BIM, I_CRE, I_CIM, I_S5D, I_WGLU,
             I_WOUTAB, I_WINC, I_DLAM, I_SUBLN, I_WOUTC, I_RW, I_RB, I_EG, I_EU, I_ED, N_IN };
struct Params { const float* in[N_IN]; float* out; unsigned char* ws; int ph_lo, ph_hi; };
#if defined(__HIP_DEVICE_COMPILE__)
#define CAS __attribute__((address_space(4)))
#else
#define CAS
#endif
typedef const CAS Params& PR;

struct Frame {
    LAS unsigned char* lds; int tid, lane, wave, G, bid, vcu;
};
#define WSP(T, off) ((T*)(p.ws + (off)))

__device__ __forceinline__ void p0_gemv_item(PR p, Frame& F, int item) {
    LAS float* sc = (LAS float*)F.lds;
    LAS float* red = (LAS float*)(F.lds + 20480);
    const float* c = p.in[I_C]; const float* cctx = p.in[I_CCTX];
    for (int i = F.tid; i < 5120; i += NTHREADS) { const int r = i >> 10, k = i & 1023; const float v = r < 4 ? c[r * 1024 + k] : cctx[k]; sc[i] = v / (1.f + expf(-v)); }
    __syncthreads();
    const int l = item / 96, cb = item % 96, jj = F.tid & 63, kp = F.tid >> 6;
    const float* W = p.in[I_ADAW] + (size_t)l * 1024 * 6144 + cb * 64 + jj;
    float a0 = 0.f, a1 = 0.f, a2 = 0.f, a3 = 0.f, a4 = 0.f;
#pragma unroll 16
    for (int k = kp * 128; k < kp * 128 + 128; ++k) { const float w = W[(size_t)k * 6144]; a0 += sc[k] * w; a1 += sc[1024 + k] * w; a2 += sc[2048 + k] * w; a3 += sc[3072 + k] * w; a4 += sc[4096 + k] * w; }
    red[(kp * 5 + 0) * 64 + jj] = a0; red[(kp * 5 + 1) * 64 + jj] = a1; red[(kp * 5 + 2) * 64 + jj] = a2; red[(kp * 5 + 3) * 64 + jj] = a3; red[(kp * 5 + 4) * 64 + jj] = a4;
    __syncthreads();
    if (F.tid < 320) { const int r = F.tid >> 6, j = F.tid & 63; float s = 0.f;
#pragma unroll
        for (int q = 0; q < 8; ++q) s += red[(q * 5 + r) * 64 + j];
        WSP(float, WS_MOD)[(l * 5 + r) * 6144 + cb * 64 + j] = s + p.in[I_ADAB][l * 6144 + cb * 64 + j]; }
    __syncthreads();
}
__device__ __forceinline__ void p0_s5_item(PR p, Frame& F, int item) {
    const int g = item >> 1, dir = item & 1;
    LAS f32x2* lamp = (LAS f32x2*)F.lds;
    LAS f32x2* coef = lamp + 64 * 33;
    const float dt = expf(p.in[I_LOGDT][dir * 16 + g]);
    for (int i = F.tid; i < 64 * 33; i += NTHREADS) { const int n = i / 33, tau = i % 33;
        const float re = p.in[I_LAMRE][(dir * 16 + g) * 64 + n], im = p.in[I_LAMIM][(dir * 16 + g) * 64 + n];
        const float mag = expf(re * dt * (float)tau); float s, c; sincos_rev((double)im * (double)dt * (double)tau * 0.15915494309189535, s, c);
        const f32x2 v = (f32x2){mag * c, mag * s}; lamp[i] = v; WSP(f32x2, WS_LAMP)[((g * 2 + dir) * 64 + n) * 33 + tau] = v; }
    __syncthreads();
    if (F.tid < 64) { const int n = F.tid; const float re = p.in[I_LAMRE][(dir * 16 + g) * 64 + n], im = p.in[I_LAMIM][(dir * 16 + g) * 64 + n];
        const f32x2 lb = lamp[n * 33 + 1]; const float a = lb.x - 1.f, b = lb.y, den = re * re + im * im;
        const f32x2 v = (f32x2){(a * re + b * im) / den, (b * re - a * im) / den}; coef[n] = v; WSP(f32x2, WS_COEF)[(g * 2 + dir) * 64 + n] = v; }
    __syncthreads();
    const float* bre = p.in[I_BRE] + (size_t)(dir * 16 + g) * 64 * 16; const float* bim = p.in[I_BIM] + (size_t)(dir * 16 + g) * 64 * 16;
    const float* cre = p.in[I_CRE] + (size_t)(dir * 16 + g) * 16 * 64; const float* cim = p.in[I_CIM] + (size_t)(dir * 16 + g) * 16 * 64;
    for (int idx = F.tid; idx < 32 * 256; idx += NTHREADS) { const int tau = idx >> 8, pp = (idx >> 4) & 15, q = idx & 15; float acc = 0.f;
        for (int n = 0; n < 64; ++n) { const f32x2 w = cmul(lamp[n * 33 + tau], coef[n]); const f32x2 bb = cmul(w, (f32x2){bre[n * 16 + q], bim[n * 16 + q]});
            acc += cre[pp * 64 + n] * bb.x - cim[pp * 64 + n] * bb.y; }
        WSP(float, WS_S5K)[((g * 2 + dir) * 32 + tau) * 256 + pp * 16 + q] = acc; }
    __syncthreads();
}
__device__ __forceinline__ int tr_drow(int mode, int n) {
    switch (mode) {
    case 1: if (n < 768) { const int H = n >> 6, half = (n >> 5) & 1, dd = n & 31; return (H >> 2) * 256 + half * 128 + (H & 3) * 32 + dd; } return n;
    case 2: if (n < 2048) { const int base = n & ~1023, c = n & 1023, sh = c >> 6, grp = (c >> 4) & 3; return base + (sh >> 2) * 256 + (grp & 1) * 128 + (sh & 3) * 32 + (grp >> 1) * 16 + (c & 15); } return n;
    case 3: return ((n & 255) >> 7) * 256 + (n >> 8) * 128 + (n & 127);
    case 4: return (n >> 7) * 256 + (n & 127);
    case 5: return (n >> 7) * 256 + 128 + (n & 127);
    default: return n; }
}
__device__ __forceinline__ float tr_scale(int mode, int n) { if (mode == 1) return (n >= 384 && n < 768) ? 0.125f : 1.f; if (mode == 2) return n < 1024 ? 0.125f : 1.f; return 1.f; }
__device__ __forceinline__ void p0_transpose_item(const float* W, int K, int N, bf16* WT, int mode, LAS float* scr, int item, int lane) {
    const int nblk = N / 32, kb = item / nblk, nb = item % nblk, k0 = 64 * kb, n0 = 32 * nb;
    const float sca = tr_scale(mode, n0);
#pragma unroll 8
    for (int i = 0; i < 32; ++i) { const int kk = 2 * i + (lane >> 5); scr[kk * 33 + (lane & 31)] = W[(size_t)(k0 + kk) * N + n0 + (lane & 31)] * sca; }
    asm volatile("s_waitcnt lgkmcnt(0)" ::: "memory");
    const int c = lane & 7;
#pragma unroll
    for (int j = 0; j < 4; ++j) { const int n = (lane >> 3) + 8 * j; const LAS float* s = scr + (8 * c) * 33 + n;
        u32x4 o; o.x = cvt_pk_bf16(s[0 * 33], s[1 * 33]); o.y = cvt_pk_bf16(s[2 * 33], s[3 * 33]); o.z = cvt_pk_bf16(s[4 * 33], s[5 * 33]); o.w = cvt_pk_bf16(s[6 * 33], s[7 * 33]);
        *(u32x4*)(WT + (size_t)tr_drow(mode, n0 + n) * K + k0 + 8 * c) = o; }
    asm volatile("s_waitcnt lgkmcnt(0)" ::: "memory");
}
__device__ __forceinline__ void p0a_prologue(PR p, Frame& F) {
    for (int it = F.bid; it < 224; it += F.G) { if (it < 192) p0_gemv_item(p, F, it); else p0_s5_item(p, F, it - 192); }
    LAS float* scr = (LAS float*)(F.lds + F.wave * 16384);
    const int gw = F.vcu * NWAVES + F.wave, NGW = F.G * NWAVES;
    constexpr int T0 = 1280, T1 = T0 + 64, T2 = T1 + 512, T3 = T2 + 1536, T4 = T3 + 512, T5 = T4 + 49152;
    for (int it = gw; it < T5; it += NGW) {
        if (it < T0) p0_transpose_item(p.in[I_WINAB], 1024, 2560, WSP(bf16, WS_WIN0), 1, scr, it, F.lane);
        else if (it < T1) p0_transpose_item(p.in[I_WGLU], 256, 512, WSP(bf16, WS_WGLU), 3, scr, it - T0, F.lane);
        else if (it < T2) p0_transpose_item(p.in[I_WOUTAB], 1024, 1024, WSP(bf16, WS_WOUT0), 0, scr, it - T1, F.lane);
        else if (it < T3) p0_transpose_item(p.in[I_WINC], 1024, 3072, WSP(bf16, WS_WIN1), 2, scr, it - T2, F.lane);
        else if (it < T4) p0_transpose_item(p.in[I_WOUTC], 1024, 1024, WSP(bf16, WS_WOUT1), 0, scr, it - T3, F.lane);
        else { const int r = it - T4, le = r / 1536, r1 = r % 1536, which = r1 / 512, r2 = r1 % 512;
            const float* src = p.in[which == 0 ? I_EG : (which == 1 ? I_EU : I_ED)] + (size_t)le * 1024 * 1024;
            bf16* dst = (bf16*)(p.ws + WS_EXP + (size_t)le * EXP_STRIDE + (which == 2 ? EXP_DN : 0));
            p0_transpose_item(src, 1024, 1024, dst, which == 0 ? 4 : (which == 1 ? 5 : 0), scr, r2, F.lane); }
    }
    const int gt = F.bid * NTHREADS + F.tid, NGT = F.G * NTHREADS;
    for (int i = gt; i < SEQ * 32 + 128 * 16 + 1; i += NGT) {
        if (i < SEQ * 32) { const int pos = i >> 5, k = i & 31; const float inv = powf(10000.f, -(float)(2 * k) / 64.f); const float ang = (float)pos * inv; float s, c; sincos_rev((double)ang * 0.15915494309189535, s, c);
            WSP(float, WS_ROPE0C)[i] = c; WSP(float, WS_ROPE0S)[i] = s; }
        else if (i < SEQ * 32 + 2048) { const int j = i - SEQ * 32, pos = j >> 4, k = j & 15; const float inv = powf(10000.f, -(float)(2 * k) / 32.f); const float ang = (float)pos * inv; float s, c; sincos_rev((double)ang * 0.15915494309189535, s, c);
            WSP(float, WS_ROPE1)[j] = c; WSP(float, WS_ROPE1)[2048 + j] = s; }
        else { const float* dl = p.in[I_DLAM]; float s0 = 0.f, s1 = 0.f; for (int k = 0; k < 64; ++k) { s0 += dl[k] * dl[64 + k]; s1 += dl[128 + k] * dl[192 + k]; }
            WSP(float, WS_SCAL)[0] = expf(s0) - expf(s1) + LAMBDA_INIT; }
    }
}

__device__ __forceinline__ void modulate_row(const float* xrow, const float* shift, const float* scale, bf16* orow, int lane) {
#pragma unroll
    for (int j = 0; j < 4; ++j) { const int c = 4 * lane + 256 * j; const f32x4 x = *(const f32x4*)(xrow + c), sh = *(const f32x4*)(shift + c), sc = *(const f32x4*)(scale + c);
        const f32x4 h = x * (sc + 1.f) + sh; u32x2 w; w.x = cvt_pk_bf16(h[0], h[1]); w.y = cvt_pk_bf16(h[2], h[3]); *(u32x2*)(orow + c) = w; }
}
__device__ __forceinline__ void p0b_phase(PR p, Frame& F) {
    const int gw = F.vcu * NWAVES + F.wave, NGW = F.G * NWAVES;
    const float* mod = WSP(float, WS_MOD);
    bf16* H0 = WSP(bf16, A_H0);
    for (int r = gw; r < NTOK; r += NGW) { const bool lat = r < NLAT; const int b = lat ? (r >> 13) : 4;
        const float* xr = lat ? p.in[I_X] + (size_t)r * DM : p.in[I_CTX] + (size_t)(r - NLAT) * DM;
        modulate_row(xr, mod + b * 6144, mod + b * 6144 + 1024, H0 + (size_t)r * DM, F.lane); }
    const int gt = F.bid * NTHREADS + F.tid, NGT = F.G * NTHREADS;
    const float* S5K = WSP(float, WS_S5K); const f32x2* LAMP = WSP(f32x2, WS_LAMP); const f32x2* COEF = WSP(f32x2, WS_COEF);
    bf16* BT2 = WSP(bf16, WS_BT2); bf16* BT1 = WSP(bf16, WS_BT1);
    for (int idx = gt; idx < 16 * 512 * 96; idx += NGT) {
        const int g = idx / (512 * 96), n = (idx / 96) % 512, k0 = (idx % 96) * 8, i = n >> 4, pp = n & 15; float v[8];
        if (k0 < 512) { const int j = k0 >> 4, q0 = k0 & 15;
#pragma unroll
            for (int t = 0; t < 8; ++t) { const int q = q0 + t; float x;
                if (i > j) x = S5K[((g * 2 + 0) * 32 + (i - j)) * 256 + pp * 16 + q];
                else if (i < j) x = S5K[((g * 2 + 1) * 32 + (j - i)) * 256 + pp * 16 + q];
                else x = S5K[((g * 2 + 0) * 32) * 256 + pp * 16 + q] + S5K[((g * 2 + 1) * 32) * 256 + pp * 16 + q] + (pp == q ? p.in[I_S5D][g * 16 + pp] : 0.f);
                v[t] = x; }
        } else { const int kk0 = k0 - 512, dir = kk0 >> 7, ri = (kk0 >> 6) & 1, nn0 = kk0 & 63, pw = dir == 0 ? i + 1 : S5T - i;
#pragma unroll
            for (int t = 0; t < 8; ++t) { const int nn = nn0 + t; const f32x2 cc = (f32x2){p.in[I_CRE][((dir * 16 + g) * 16 + pp) * 64 + nn], p.in[I_CIM][((dir * 16 + g) * 16 + pp) * 64 + nn]};
                const f32x2 w = cmul(cc, LAMP[((g * 2 + dir) * 64 + nn) * 33 + pw]); v[t] = ri == 0 ? w.x : -w.y; }
        }
        u32x4 o; o.x = cvt_pk_bf16(v[0], v[1]); o.y = cvt_pk_bf16(v[2], v[3]); o.z = cvt_pk_bf16(v[4], v[5]); o.w = cvt_pk_bf16(v[6], v[7]);
        *(u32x4*)(BT2 + ((size_t)g * 512 + n) * 768 + k0) = o;
    }
    for (int idx = gt; idx < 16 * 256 * 64; idx += NGT) {
        const int g = idx / (256 * 64), n = (idx / 64) % 256, k0 = (idx % 64) * 8, j = k0 >> 4, q0 = k0 & 15, dir = n >> 7, ri = (n >> 6) & 1, nn = n & 63, pw = dir == 0 ? (S5T - 1 - j) : j;
        const f32x2 w = cmul(LAMP[((g * 2 + dir) * 64 + nn) * 33 + pw], COEF[(g * 2 + dir) * 64 + nn]); float v[8];
#pragma unroll
        for (int t = 0; t < 8; ++t) { const int q = q0 + t; const f32x2 bb = cmul(w, (f32x2){p.in[I_BRE][((dir * 16 + g) * 64 + nn) * 16 + q], p.in[I_BIM][((dir * 16 + g) * 64 + nn) * 16 + q]}); v[t] = ri == 0 ? bb.x : bb.y; }
        u32x4 o; o.x = cvt_pk_bf16(v[0], v[1]); o.y = cvt_pk_bf16(v[2], v[3]); o.z = cvt_pk_bf16(v[4], v[5]); o.w = cvt_pk_bf16(v[6], v[7]);
        *(u32x4*)(BT1 + ((size_t)g * 256 + n) * 512 + k0) = o;
    }
}
__device__ __forceinline__ void ret_unit(int unit, int& bh, int& h, int& r0) {
    const int cch = unit % RNCH; bh = unit / RNCH; h = bh % RH; const int b = bh / RH;
    r0 = cch < 64 ? b * SEQ + cch * RC : NLAT + b * CTXL + (cch - 64) * RC;
}
__device__ __forceinline__ float log_gamma(PR p, int dir, int h) { const float x = p.in[I_DECAY][dir * RH + h]; return -log1pf(expf(-x)); }
constexpr int RT_LD = 136;
__device__ __forceinline__ void ret_stage_vt(const bf16* V, int r0, int h, LAS bf16* VT, int tid) {
#pragma unroll
    for (int i = 0; i < 4; ++i) { const int id = tid + 512 * i, j = id >> 4, e0 = (id & 15) * 8;
        const u32x4 raw = *(const u32x4*)(V + (size_t)(r0 + j) * 768 + h * 128 + e0);
        VT[(e0 + 0) * RT_LD + j] = (bf16)(raw.x & 0xffffu); VT[(e0 + 1) * RT_LD + j] = (bf16)(raw.x >> 16);
        VT[(e0 + 2) * RT_LD + j] = (bf16)(raw.y & 0xffffu); VT[(e0 + 3) * RT_LD + j] = (bf16)(raw.y >> 16);
        VT[(e0 + 4) * RT_LD + j] = (bf16)(raw.z & 0xffffu); VT[(e0 + 5) * RT_LD + j] = (bf16)(raw.z >> 16);
        VT[(e0 + 6) * RT_LD + j] = (bf16)(raw.w & 0xffffu); VT[(e0 + 7) * RT_LD + j] = (bf16)(raw.w >> 16); }
}
__device__ __forceinline__ void ret_states_phase(PR p, Frame& F, int first_unit_shift) {
    LAS bf16* KdTf = (LAS bf16*)F.lds; LAS bf16* KdTb = KdTf + 64 * RT_LD; LAS bf16* VT = KdTb + 64 * RT_LD;
    const bf16* QK = WSP(bf16, A_QK); const bf16* V = WSP(bf16, A_V); float* RT = p.out;
    const int w = F.wave, fr = F.lane & 15, fq = F.lane >> 4;
    for (int unit = (F.bid + first_unit_shift) % F.G; unit < NBATCH * RH * RNCH; unit += F.G) {
        int bh, h, r0; ret_unit(unit, bh, h, r0);
        const float lgf = log_gamma(p, 0, h), lgb = log_gamma(p, 1, h);
#pragma unroll
        for (int i = 0; i < 2; ++i) { const int id = F.tid + 512 * i, j = id >> 3, d0 = (id & 7) * 8;
            const u32x4 raw = *(const u32x4*)(QK + (size_t)(r0 + j) * 768 + (RH + h) * 64 + d0);
            const float df = expf(lgf * (float)(RC - 1 - j)), db = expf(lgb * (float)j);
            const unsigned wv[4] = {raw.x, raw.y, raw.z, raw.w};
#pragma unroll
            for (int t = 0; t < 4; ++t) { const float k0 = bflo(wv[t]), k1 = bfhi(wv[t]);
                KdTf[(d0 + 2 * t) * RT_LD + j] = (bf16)f2bf(k0 * df); KdTf[(d0 + 2 * t + 1) * RT_LD + j] = (bf16)f2bf(k1 * df);
                KdTb[(d0 + 2 * t) * RT_LD + j] = (bf16)f2bf(k0 * db); KdTb[(d0 + 2 * t + 1) * RT_LD + j] = (bf16)f2bf(k1 * db); } }
        ret_stage_vt(V, r0, h, VT, F.tid);
        __syncthreads();
        const int dir = w >> 2; const LAS bf16* KdT = dir ? KdTb : KdTf;
        f32x4 acc[2][4];
#pragma unroll
        for (int a = 0; a < 2; ++a)
#pragma unroll
            for (int d = 0; d < 4; ++d) acc[a][d] = (f32x4){0.f, 0.f, 0.f, 0.f};
#pragma unroll
        for (int ks = 0; ks < 4; ++ks) { bf16x8 af[2], bfr[4];
#pragma unroll
            for (int a = 0; a < 2; ++a) af[a] = *(const LAS bf16x8*)(VT + (((w & 3) * 2 + a) * 16 + fr) * RT_LD + 32 * ks + 8 * fq);
#pragma unroll
            for (int d = 0; d < 4; ++d) bfr[d] = *(const LAS bf16x8*)(KdT + (d * 16 + fr) * RT_LD + 32 * ks + 8 * fq);
#pragma unroll
            for (int a = 0; a < 2; ++a)
#pragma unroll
                for (int d = 0; d < 4; ++d) acc[a][d] = __builtin_amdgcn_mfma_f32_16x16x32_bf16(af[a], bfr[d], acc[a][d], 0, 0, 0); }
        float* out = RT + ((size_t)unit * 2 + dir) * 8192;
#pragma unroll
        for (int a = 0; a < 2; ++a)
#pragma unroll
            for (int d = 0; d < 4; ++d)
#pragma unroll
                for (int jj = 0; jj < 4; ++jj) out[(((w & 3) * 2 + a) * 16 + 4 * fq + jj) * 64 + d * 16 + fr] = acc[a][d][jj];
        __syncthreads();
    }
}
__device__ __forceinline__ void ret_scan_phase(PR p, Frame& F) {
    const float* RT = p.out; unsigned* TT = WSP(unsigned, A_TT);
    for (int it = F.bid; it < 48 * 8; it += F.G) {
        const int chain = it >> 3, slice = it & 7, dir = chain & 1, bh = chain >> 1, h = bh % RH;
        const int el = (slice * 512 + F.tid) * 2;
        const float gC = expf(log_gamma(p, dir, h) * (float)RC);
        f32x2 st = (f32x2){0.f, 0.f};
        for (int s0 = 0; s0 < RNCH; s0 += 11) {
            f32x2 r[11];
#pragma unroll
            for (int k = 0; k < 11; ++k) { const int s = s0 + k, cch = dir == 0 ? (s < 2 ? 64 + s : s - 2) : (65 - s);
                r[k] = *(const f32x2*)(RT + ((size_t)(bh * RNCH + cch) * 2 + dir) * 8192 + el); }
#pragma unroll
            for (int k = 0; k < 11; ++k) { const int s = s0 + k, cch = dir == 0 ? (s < 2 ? 64 + s : s - 2) : (65 - s);
                TT[(((size_t)(bh * RNCH + cch) * 2 + dir) * 8192 + el) >> 1] = cvt_pk_bf16(st.x, st.y);
                st = st * gC + r[k]; }
        }
    }
}
__device__ __forceinline__ void s5_scan_phase(PR p, Frame& F) {
    const float* EO = WSP(float, A_EO); bf16* UA = WSP(bf16, A_UA); const f32x2* LAMP = WSP(f32x2, WS_LAMP);
    if (F.wave != 0) return;
    for (int it = F.bid; it < 128; it += F.G) {
        const int b = it >> 5, g = (it >> 1) & 15, dir = it & 1, n = F.lane;
        const f32x2 lamT = LAMP[((g * 2 + dir) * 64 + n) * 33 + S5T];
        f32x2 st = (f32x2){0.f, 0.f};
        for (int s0 = 0; s0 < 264; s0 += 8) {
            f32x2 e[8];
#pragma unroll
            for (int k = 0; k < 8; ++k) { const int s = s0 + k;
                const int row = dir == 0 ? (s < 8 ? 1024 + b * 8 + s : b * 256 + (s - 8)) : (s < 8 ? 1024 + b * 8 + (7 - s) : b * 256 + (263 - s));
                const float* er = EO + ((size_t)g * S5ROWS + row) * 256 + dir * 128 + n; e[k] = (f32x2){er[0], er[64]}; }
#pragma unroll
            for (int k = 0; k < 8; ++k) { const int s = s0 + k;
                const int row = dir == 0 ? (s < 8 ? 1024 + b * 8 + s : b * 256 + (s - 8)) : (s < 8 ? 1024 + b * 8 + (7 - s) : b * 256 + (263 - s));
                bf16* ur = UA + ((size_t)g * S5ROWS + row) * 768 + 512 + dir * 128 + n; ur[0] = (bf16)f2bf(st.x); ur[64] = (bf16)f2bf(st.y);
                st = cmul(lamT, st) + e[k]; }
        }
    }
}
__device__ __forceinline__ void ret_out_phase(PR p, Frame& F, int first_unit_shift) {
    LAS bf16* VT = (LAS bf16*)F.lds; LAS bf16* Pw = VT + 128 * RT_LD + F.wave * 16 * RT_LD;
    const bf16* QK = WSP(bf16, A_QK); const bf16* V = WSP(bf16, A_V); const bf16* Gb = WSP(bf16, A_G); const bf16* TT = WSP(bf16, A_TT); bf16* MRG = WSP(bf16, A_MRG);
    const int w = F.wave, fr = F.lane & 15, fq = F.lane >> 4, i0 = 16 * w;
    for (int unit = (F.bid + first_unit_shift) % F.G; unit < NBATCH * RH * RNCH; unit += F.G) {
        int bh, h, r0; ret_unit(unit, bh, h, r0);
        const float lgf = log_gamma(p, 0, h), lgb = log_gamma(p, 1, h);
        ret_stage_vt(V, r0, h, VT, F.tid);
        bf16x8 aq[2];
#pragma unroll
        for (int ks = 0; ks < 2; ++ks) aq[ks] = *(const bf16x8*)(QK + (size_t)(r0 + i0 + fr) * 768 + h * 64 + 32 * ks + 8 * fq);
#pragma unroll
        for (int jt = 0; jt < 8; ++jt) { f32x4 s = (f32x4){0.f, 0.f, 0.f, 0.f};
#pragma unroll
            for (int ks = 0; ks < 2; ++ks) { const bf16x8 bk = *(const bf16x8*)(QK + (size_t)(r0 + 16 * jt + fr) * 768 + (RH + h) * 64 + 32 * ks + 8 * fq);
                s = __builtin_amdgcn_mfma_f32_16x16x32_bf16(aq[ks], bk, s, 0, 0, 0); }
#pragma unroll
            for (int jj = 0; jj < 4; ++jj) { const int dl = (i0 + 4 * fq + jj) - (16 * jt + fr);
                const float dec = dl >= 0 ? expf(lgf * (float)dl) : expf(lgb * (float)(-dl));
                Pw[(4 * fq + jj) * RT_LD + 16 * jt + fr] = (bf16)f2bf(s[jj] * dec); } }
        __syncthreads();
        f32x4 o[8];
#pragma unroll
        for (int et = 0; et < 8; ++et) o[et] = (f32x4){0.f, 0.f, 0.f, 0.f};
#pragma unroll
        for (int ks = 0; ks < 4; ++ks) { const bf16x8 ap = *(const LAS bf16x8*)(Pw + fr * RT_LD + 32 * ks + 8 * fq);
#pragma unroll
            for (int et = 0; et < 8; ++et) { const bf16x8 bv = *(const LAS bf16x8*)(VT + (16 * et + fr) * RT_LD + 32 * ks + 8 * fq);
                o[et] = __builtin_amdgcn_mfma_f32_16x16x32_bf16(ap, bv, o[et], 0, 0, 0); } }
#pragma unroll
        for (int dir = 0; dir < 2; ++dir) { const bf16* TTp = TT + ((size_t)unit * 2 + dir) * 8192; float qd[4];
#pragma unroll
            for (int jj = 0; jj < 4; ++jj) { const int i = i0 + 4 * fq + jj; qd[jj] = dir == 0 ? expf(lgf * (float)(i + 1)) : expf(lgb * (float)(RC - i)); }
#pragma unroll
            for (int et = 0; et < 8; ++et) { f32x4 t = (f32x4){0.f, 0.f, 0.f, 0.f};
#pragma unroll
                for (int ks = 0; ks < 2; ++ks) { const bf16x8 bt = *(const bf16x8*)(TTp + (16 * et + fr) * 64 + 32 * ks + 8 * fq);
                    t = __builtin_amdgcn_mfma_f32_16x16x32_bf16(aq[ks], bt, t, 0, 0, 0); }
#pragma unroll
                for (int jj = 0; jj < 4; ++jj) o[et][jj] += qd[jj] * t[jj]; } }
#pragma unroll
        for (int jj = 0; jj < 4; ++jj) { float s = 0.f;
#pragma unroll
            for (int et = 0; et < 8; ++et) s += o[et][jj];
            s += __shfl_xor(s, 1); s += __shfl_xor(s, 2); s += __shfl_xor(s, 4); s += __shfl_xor(s, 8);
            const float mu = s * (1.f / 128.f); float q = 0.f;
#pragma unroll
            for (int et = 0; et < 8; ++et) { const float d = o[et][jj] - mu; q += d * d; }
            q += __shfl_xor(q, 1); q += __shfl_xor(q, 2); q += __shfl_xor(q, 4); q += __shfl_xor(q, 8);
            const float rstd = 1.f / sqrtf(q * (1.f / 128.f) + GN_EPS);
            const size_t tok = (size_t)(r0 + i0 + 4 * fq + jj);
#pragma unroll
            for (int et = 0; et < 8; ++et) { const int col = h * 128 + 16 * et + fr; const float gv = bf2f(Gb[tok * 768 + col]);
                MRG[tok * 1024 + col] = (bf16)f2bf((o[et][jj] - mu) * rstd * (gv / (1.f + __expf(-gv)))); } }
        __syncthreads();
    }
}
struct RouteRec { int e0, e1, rk0, rk1; float w0, w1; int d0, d1; };

__device__ __forceinline__ float* xs_row(PR p, int r) { return r < NLAT ? p.out + (size_t)r * DM : WSP(float, WS_XC) + (size_t)(r - NLAT) * DM; }

template <int LAYER>
__device__ __forceinline__ void ln1_router_phase(PR p, Frame& F, const bf16* O, bf16* H2, int nrows) {
    LAS float* rw = (LAS float*)F.lds;
    LAS unsigned* lcnt = (LAS unsigned*)(F.lds + 65536);
    for (int i = F.tid; i < 1024 * 16 / 4; i += NTHREADS) ((LAS f32x4*)rw)[i] = ((const f32x4*)p.in[I_RW])[i];
    if (F.tid < 16) lcnt[F.tid] = 0u;
    __syncthreads();
    const float* mod = WSP(float, WS_MOD) + LAYER * 5 * 6144;
    const float* lng = p.in[I_LNG] + (LAYER * 2 + 0) * DM;
    RouteRec* route = WSP(RouteRec, WS_ROUTE);
    const int rpb = (nrows + F.G - 1) / F.G, rbeg = F.bid * rpb, rend = (rbeg + rpb < nrows) ? rbeg + rpb : nrows;
    const int lane = F.lane;
    for (int r = rbeg + F.wave; r < rend; r += NWAVES) {
        const bool lat = r < NLAT; const int b = lat ? (r >> 13) : 4;
        const float* xin = (LAYER == 0) ? (lat ? p.in[I_X] + (size_t)r * DM : p.in[I_CTX] + (size_t)(r - NLAT) * DM) : xs_row(p, r);
        const float* mb = mod + b * 6144;
        f32x4 v[4]; float s = 0.f;
#pragma unroll
        for (int j = 0; j < 4; ++j) { const int c = 4 * lane + 256 * j; const f32x4 x = *(const f32x4*)(xin + c), g1 = *(const f32x4*)(mb + 2048 + c);
            const u32x2 ow = *(const u32x2*)(O + (size_t)r * DM + c); const f32x4 o = (f32x4){bflo(ow.x), bfhi(ow.x), bflo(ow.y), bfhi(ow.y)};
            v[j] = x * ALPHA + g1 * o; s += (v[j][0] + v[j][1]) + (v[j][2] + v[j][3]); }
        const float mean = wave_sum(s) * (1.f / DM); float q = 0.f;
#pragma unroll
        for (int j = 0; j < 4; ++j) { v[j] = v[j] - mean; q += (v[j][0] * v[j][0] + v[j][1] * v[j][1]) + (v[j][2] * v[j][2] + v[j][3] * v[j][3]); }
        const float rstd = 1.f / sqrtf(wave_sum(q) * (1.f / DM) + LN_EPS);
        float* xo = xs_row(p, r);
        float lg[16];
#pragma unroll
        for (int e = 0; e < 16; ++e) lg[e] = 0.f;
#pragma unroll
        for (int j = 0; j < 4; ++j) { const int c = 4 * lane + 256 * j; const f32x4 gn = *(const f32x4*)(lng + c), sh = *(const f32x4*)(mb + 3072 + c), sc = *(const f32x4*)(mb + 4096 + c);
            const f32x4 x1 = v[j] * rstd * gn; *(f32x4*)(xo + c) = x1;
            const f32x4 h = x1 * (sc + 1.f) + sh; u32x2 w; w.x = cvt_pk_bf16(h[0], h[1]); w.y = cvt_pk_bf16(h[2], h[3]); *(u32x2*)(H2 + (size_t)r * DM + c) = w;
#pragma unroll
            for (int t = 0; t < 4; ++t) { const LAS f32x4* wr4 = (const LAS f32x4*)(rw + (c + t) * 16);
#pragma unroll
                for (int e4 = 0; e4 < 4; ++e4) { const f32x4 wv = wr4[e4]; lg[4 * e4 + 0] += h[t] * wv[0]; lg[4 * e4 + 1] += h[t] * wv[1]; lg[4 * e4 + 2] += h[t] * wv[2]; lg[4 * e4 + 3] += h[t] * wv[3]; } } }
#pragma unroll
        for (int e = 0; e < 16; ++e) lg[e] = wave_sum(lg[e]);
        float sc[16], bs[16];
#pragma unroll
        for (int e = 0; e < 16; ++e) { sc[e] = 1.f / (1.f + expf(-lg[e])); bs[e] = sc[e] + p.in[I_RB][e]; }
        float gbest = -INFINITY; int gsel = 0;
#pragma unroll
        for (int gq = 0; gq < 4; ++gq) { const float a = bs[4 * gq], b2 = bs[4 * gq + 1], c2 = bs[4 * gq + 2], d2 = bs[4 * gq + 3];
            const float m1 = fmaxf(fmaxf(a, b2), fmaxf(c2, d2));
            const float m2 = fmaxf(fmaxf(fminf(a, b2), fminf(c2, d2)), fminf(fmaxf(a, b2), fmaxf(c2, d2)));
            const float gs = m1 + m2; if (gs > gbest) { gbest = gs; gsel = gq; } }
        float b4[4], s4[4];
#pragma unroll
        for (int i = 0; i < 4; ++i) { b4[i] = gsel == 0 ? bs[i] : (gsel == 1 ? bs[4 + i] : (gsel == 2 ? bs[8 + i] : bs[12 + i])); s4[i] = gsel == 0 ? sc[i] : (gsel == 1 ? sc[4 + i] : (gsel == 2 ? sc[8 + i] : sc[12 + i])); }
        int i0 = 0; float bv0 = b4[0];
#pragma unroll
        for (int i = 1; i < 4; ++i) if (b4[i] > bv0) { bv0 = b4[i]; i0 = i; }
        int i1 = -1; float bv1 = -INFINITY;
#pragma unroll
        for (int i = 0; i < 4; ++i) if (i != i0 && b4[i] > bv1) { bv1 = b4[i]; i1 = i; }
        const float g0 = i0 == 0 ? s4[0] : (i0 == 1 ? s4[1] : (i0 == 2 ? s4[2] : s4[3]));
        const float g1s = i1 == 0 ? s4[0] : (i1 == 1 ? s4[1] : (i1 == 2 ? s4[2] : s4[3]));
        if (lane == 0) { RouteRec rr; rr.e0 = gsel * 4 + i0; rr.e1 = gsel * 4 + i1; rr.rk0 = (int)atomicAdd((unsigned*)&lcnt[rr.e0], 1u); rr.rk1 = (int)atomicAdd((unsigned*)&lcnt[rr.e1], 1u);
            const float den = g0 + g1s; rr.w0 = g0 / den; rr.w1 = g1s / den; rr.d0 = 0; rr.d1 = 0; route[r] = rr; }
    }
    __syncthreads();
    if (F.tid < 16) WSP(unsigned, WS_CNT)[F.bid * 16 + F.tid] = lcnt[F.tid];
    __syncthreads();
}

struct MoeTabs { LAS unsigned* tot; LAS unsigned* pstart; LAS unsigned* pendb; LAS unsigned* mybase; };
__device__ __forceinline__ MoeTabs moe_tabs(Frame& F) { MoeTabs t; LAS unsigned* m = (LAS unsigned*)(F.lds + MISC_OFF + 256); t.tot = m; t.pstart = m + 16; t.pendb = m + 32; t.mybase = m + 48; return t; }
__device__ __forceinline__ void moe_build_tabs(PR p, Frame& F, const MoeTabs& T) {
    const unsigned* cnt = WSP(unsigned, WS_CNT);
    LAS unsigned* tmp = (LAS unsigned*)(F.lds + MISC_OFF + 1024);
    { const int e = F.tid & 15, part = F.tid >> 4, per = (F.G + 31) / 32, b0 = part * per, b1 = (b0 + per < F.G) ? b0 + per : F.G; unsigned tot = 0, base = 0;
      for (int b = b0; b < b1; ++b) { const unsigned c = cnt[b * 16 + e]; tot += c; base += (b < F.bid) ? c : 0u; }
      tmp[part * 32 + e] = tot; tmp[part * 32 + 16 + e] = base; }
    __syncthreads();
    if (F.tid < 16) { unsigned tot = 0, base = 0;
#pragma unroll
        for (int q = 0; q < 32; ++q) { tot += tmp[q * 32 + F.tid]; base += tmp[q * 32 + 16 + F.tid]; }
        T.tot[F.tid] = tot; T.mybase[F.tid] = base; }
    __syncthreads();
    if (F.tid == 0) { unsigned acc = 0; for (int e = 0; e < 16; ++e) { T.pstart[e] = acc; acc += (T.tot[e] + 255u) & ~255u; T.pendb[e] = acc >> 8; } }
    __syncthreads();
}
__device__ __forceinline__ void moe_scatter_phase(PR p, Frame& F, const bf16* H2, bf16* BUF, int nrows) {
    const MoeTabs T = moe_tabs(F); moe_build_tabs(p, F, T);
    RouteRec* route = WSP(RouteRec, WS_ROUTE);
    const int rpb = (nrows + F.G - 1) / F.G, rbeg = F.bid * rpb, rend = (rbeg + rpb < nrows) ? rbeg + rpb : nrows;
    for (int r = rbeg + F.wave; r < rend; r += NWAVES) {
        const RouteRec rr = route[r];
        const int d0 = (int)(T.pstart[rr.e0] + T.mybase[rr.e0]) + rr.rk0, d1 = (int)(T.pstart[rr.e1] + T.mybase[rr.e1]) + rr.rk1;
        const u32x4* src = (const u32x4*)(H2 + (size_t)r * DM) + F.lane; const u32x4 a = src[0], b = src[64];
        u32x4* o0 = (u32x4*)(BUF + (size_t)d0 * DM) + F.lane; u32x4* o1 = (u32x4*)(BUF + (size_t)d1 * DM) + F.lane;
        o0[0] = a; o0[64] = b; o1[0] = a; o1[64] = b;
        if (F.lane == 0) { route[r].d0 = d0; route[r].d1 = d1; }
    }
    if (F.bid < 16) { const int e = F.bid; const unsigned pb = T.pstart[e] + T.tot[e], pe = T.pstart[e] + ((T.tot[e] + 255u) & ~255u);
        for (unsigned r = pb + F.wave; r < pe; r += NWAVES) { u32x4* o = (u32x4*)(BUF + (size_t)r * DM) + F.lane; o[0] = (u32x4){0u, 0u, 0u, 0u}; o[64] = (u32x4){0u, 0u, 0u, 0u}; } }
}

template <int LAYER>
__device__ __forceinline__ void ln2_phase(PR p, Frame& F, const bf16* Y, bf16* H0N, int nrows) {
    const float* mod = WSP(float, WS_MOD) + LAYER * 5 * 6144;
    const float* modn = WSP(float, WS_MOD) + (LAYER + 1) * 5 * 6144;
    const float* lng = p.in[I_LNG] + (LAYER * 2 + 1) * DM;
    const RouteRec* route = WSP(RouteRec, WS_ROUTE);
    const int gw = F.vcu * NWAVES + F.wave, NGW = F.G * NWAVES, lane = F.lane;
    for (int r = gw; r < nrows; r += NGW) {
        const bool lat = r < NLAT; const int b = lat ? (r >> 13) : 4;
        const RouteRec rr = route[r];
        const float* mb = mod + b * 6144; float* xr = xs_row(p, r);
        f32x4 v[4]; float s = 0.f;
#pragma unroll
        for (int j = 0; j < 4; ++j) { const int c = 4 * lane + 256 * j; const f32x4 x = *(const f32x4*)(xr + c), g2 = *(const f32x4*)(mb + 5120 + c);
            const u32x2 ya = *(const u32x2*)(Y + (size_t)rr.d0 * DM + c), yb = *(const u32x2*)(Y + (size_t)rr.d1 * DM + c);
            const f32x4 y = (f32x4){bflo(ya.x), bfhi(ya.x), bflo(ya.y), bfhi(ya.y)} * rr.w0 + (f32x4){bflo(yb.x), bfhi(yb.x), bflo(yb.y), bfhi(yb.y)} * rr.w1;
            v[j] = x * ALPHA + g2 * y; s += (v[j][0] + v[j][1]) + (v[j][2] + v[j][3]); }
        const float mean = wave_sum(s) * (1.f / DM); float q = 0.f;
#pragma unroll
        for (int j = 0; j < 4; ++j) { v[j] = v[j] - mean; q += (v[j][0] * v[j][0] + v[j][1] * v[j][1]) + (v[j][2] * v[j][2] + v[j][3] * v[j][3]); }
        const float rstd = 1.f / sqrtf(wave_sum(q) * (1.f / DM) + LN_EPS);
#pragma unroll
        for (int j = 0; j < 4; ++j) { const int c = 4 * lane + 256 * j; const f32x4 gn = *(const f32x4*)(lng + c); const f32x4 x2 = v[j] * rstd * gn; *(f32x4*)(xr + c) = x2;
            if (LAYER == 0) { const float* mn = modn + b * 6144; const f32x4 sh = *(const f32x4*)(mn + c), sc = *(const f32x4*)(mn + 1024 + c); const f32x4 h = x2 * (sc + 1.f) + sh;
                u32x2 w; w.x = cvt_pk_bf16(h[0], h[1]); w.y = cvt_pk_bf16(h[2], h[3]); *(u32x2*)(H0N + (size_t)r * DM + c) = w; } }
    }
}
namespace att {
constexpr int NW = 8, QBLK = 32, KVBLK = 64, LDQ = 1024, LDK = 1024, NKEY = SEQ + CTXL, NT = NKEY / KVBLK;
constexpr size_t SHM_V = KVBLK * 128 * 2, SHM_K = KVBLK * 64 * 2;
constexpr float THR = 8.f;
#define KSWZ64(row, colB) ((row) * 128 + ((colB) ^ ((((row) >> 1) & 7) << 4)))
#define SBAR() __builtin_amdgcn_sched_barrier(0)
__device__ __forceinline__ int crow(int r, int hi) { return (r & 3) + 8 * (r >> 2) + 4 * hi; }
__device__ __forceinline__ unsigned cvtpk(float lo, float hi) { unsigned r; asm volatile("v_cvt_pk_bf16_f32 %0, %1, %2" : "=v"(r) : "v"(lo), "v"(hi)); return r; }
__device__ __forceinline__ void partialSM(f32x16& p0, f32x16& p1, float& m_reg, float& mn, float& alpha) {
    constexpr float C = 1.4426950408889634f;
    float pmax = p0[0];
#pragma unroll
    for (int r = 1; r < 16; ++r) pmax = fmaxf(pmax, p0[r]);
#pragma unroll
    for (int r = 0; r < 16; ++r) pmax = fmaxf(pmax, p1[r]);
    { auto rr = __builtin_amdgcn_permlane32_swap(__float_as_uint(pmax), __float_as_uint(pmax), false, false); pmax = fmaxf(__uint_as_float(rr[0]), __uint_as_float(rr[1])); }
    if (__builtin_expect(__all(pmax - m_reg <= THR), 1)) { mn = m_reg; alpha = 1.f; }
    else { mn = fmaxf(m_reg, pmax); alpha = __builtin_amdgcn_exp2f((m_reg - mn) * C); m_reg = mn; }
    const float mnC = -mn * C;
#pragma unroll
    for (int r = 0; r < 16; ++r) p0[r] = fmaf(p0[r], C, mnC);
#pragma unroll
    for (int r = 0; r < 16; ++r) p1[r] = fmaf(p1[r], C, mnC);
#pragma unroll
    for (int r = 0; r < 16; ++r) p0[r] = __builtin_amdgcn_exp2f(p0[r]);
}
__device__ __forceinline__ void finishSM(f32x16& p0, f32x16& p1, float alpha, float& l_reg, bf16x8& pa0, bf16x8& pa1, bf16x8& pa2, bf16x8& pa3) {
#pragma unroll
    for (int r = 0; r < 16; ++r) p1[r] = __builtin_amdgcn_exp2f(p1[r]);
    float ps = 0;
#pragma unroll
    for (int r = 0; r < 16; ++r) ps += p0[r];
#pragma unroll
    for (int r = 0; r < 16; ++r) ps += p1[r];
    { auto rr = __builtin_amdgcn_permlane32_swap(__float_as_uint(ps), __float_as_uint(ps), false, false); ps = __uint_as_float(rr[0]) + __uint_as_float(rr[1]); }
    l_reg = l_reg * alpha + ps;
#define PK4(P, BASE, OUT) do { unsigned a0 = cvtpk(P[BASE + 0], P[BASE + 1]), a1 = cvtpk(P[BASE + 2], P[BASE + 3]);   \
    unsigned b0 = cvtpk(P[BASE + 4], P[BASE + 5]), b1 = cvtpk(P[BASE + 6], P[BASE + 7]);                              \
    auto r0 = __builtin_amdgcn_permlane32_swap(a0, b0, false, false); auto r1 = __builtin_amdgcn_permlane32_swap(a1, b1, false, false); \
    u32x4 w = {r0[0], r1[0], r0[1], r1[1]}; OUT = __builtin_bit_cast(bf16x8, w); } while (0)
    PK4(p0, 0, pa0); PK4(p0, 8, pa1); PK4(p1, 0, pa2); PK4(p1, 8, pa3);
#undef PK4
}
__device__ __forceinline__ void qkt(f32x16& p0, f32x16& p1, const LAS char* Ks, const bf16x8* qr, int r32, int hi) {
    p0 = f32x16{}; p1 = f32x16{};
#pragma unroll
    for (int d0 = 0; d0 < 4; ++d0) { const int cb = (d0 * 16 + hi * 8) * 2;
        const bf16x8 b0 = *(const LAS bf16x8*)(Ks + KSWZ64(r32, cb));
        const bf16x8 b1 = *(const LAS bf16x8*)(Ks + KSWZ64(32 + r32, cb));
        p0 = __builtin_amdgcn_mfma_f32_32x32x16_bf16(b0, qr[d0], p0, 0, 0, 0);
        p1 = __builtin_amdgcn_mfma_f32_32x32x16_bf16(b1, qr[d0], p1, 0, 0, 0); }
}
__device__ __forceinline__ int v_st(int k, int c) { const int kk = (k & ~0xC) | ((k & 4) << 1) | ((k & 8) >> 1); return ((kk >> 3) * 4 + (c >> 5)) * 512 + ((kk & 7) * 32 + (c & 31)) * 2; }
__device__ __forceinline__ int v_rd_base(int lane) { return ((lane & 3) << 3) | (((lane >> 2) & 3) << 6) | (((lane >> 4) & 1) << 5) | (((lane >> 5) & 1) << 8); }
constexpr int v_rd_off(int d0, int ks, int half) { return d0 * 512 + ks * 4096 + half * 2048; }
template <int OFF> __device__ __forceinline__ s16x4 tr_read(int vb) { s16x4 r; asm volatile("ds_read_b64_tr_b16 %0, %1 offset:%2" : "=&v"(r) : "v"(vb), "i"(OFF) : "memory"); return r; }
template <int D0> __device__ __forceinline__ void pv_one(f32x16& od, int vb, bf16x8 pa0, bf16x8 pa1, bf16x8 pa2, bf16x8 pa3) {
    const s16x4 l0 = tr_read<v_rd_off(D0, 0, 0)>(vb), h0 = tr_read<v_rd_off(D0, 0, 1)>(vb), l1 = tr_read<v_rd_off(D0, 1, 0)>(vb), h1 = tr_read<v_rd_off(D0, 1, 1)>(vb);
    const s16x4 l2 = tr_read<v_rd_off(D0, 2, 0)>(vb), h2 = tr_read<v_rd_off(D0, 2, 1)>(vb), l3 = tr_read<v_rd_off(D0, 3, 0)>(vb), h3 = tr_read<v_rd_off(D0, 3, 1)>(vb);
    asm volatile("s_waitcnt lgkmcnt(0)" ::: "memory"); SBAR();
#define PKV(L, H) (bf16x8){L[0], L[1], L[2], L[3], H[0], H[1], H[2], H[3]}
    od = __builtin_amdgcn_mfma_f32_32x32x16_bf16(pa0, PKV(l0, h0), od, 0, 0, 0);
    od = __builtin_amdgcn_mfma_f32_32x32x16_bf16(pa1, PKV(l1, h1), od, 0, 0, 0);
    od = __builtin_amdgcn_mfma_f32_32x32x16_bf16(pa2, PKV(l2, h2), od, 0, 0, 0);
    od = __builtin_amdgcn_mfma_f32_32x32x16_bf16(pa3, PKV(l3, h3), od, 0, 0, 0);
#undef PKV
}
__device__ __forceinline__ void pv_d0(f32x16* o, int vb, bf16x8 pa0, bf16x8 pa1, bf16x8 pa2, bf16x8 pa3) {
    pv_one<0>(o[0], vb, pa0, pa1, pa2, pa3); pv_one<1>(o[1], vb, pa0, pa1, pa2, pa3); pv_one<2>(o[2], vb, pa0, pa1, pa2, pa3); pv_one<3>(o[3], vb, pa0, pa1, pa2, pa3);
}
__device__ __forceinline__ void attn_pass(const bf16* __restrict__ Qb, const bf16* __restrict__ Kh, const bf16* __restrict__ Vh, LAS char* lds, f32x16 (&o)[4], float& l_out, int tid) {
    const int wid = tid >> 6, lane = tid & 63, r32 = lane & 31, hi = lane >> 5;
    LAS char* V_lds = lds; LAS char* K_lds = lds + 2 * SHM_V;
    LAS float* ws = (LAS float*)(lds + 2 * SHM_V + 2 * SHM_K) + wid * 64; LAS float* al_l = ws + 32;
    float m_reg = -1e30f, l_reg = 0.f; bf16x8 qr[4];
#pragma unroll
    for (int d = 0; d < 4; ++d) o[d] = f32x16{};
    const bf16* Qw = Qb + (long)(wid * QBLK + r32) * LDQ + hi * 8;
#pragma unroll
    for (int d0 = 0; d0 < 4; ++d0) qr[d0] = *(const bf16x8*)(Qw + d0 * 16);
    const int sr = tid >> 4, sc = (tid & 15) * 8, vst0 = v_st(sr, sc), vst1 = v_st(32 + sr, sc);
    const int kr = tid >> 3, kc = (tid & 7) * 8, kst = KSWZ64(kr, kc * 2);
    const int vb0 = (int)(uintptr_t)V_lds + v_rd_base(lane);
    struct { bf16x8 vs0, vs1, ks0; } sr_[2];
#define SLOAD(i, k0) do { sr_[i].vs0 = *(const bf16x8*)(&Vh[(long)((k0) + sr) * LDK + sc]); sr_[i].vs1 = *(const bf16x8*)(&Vh[(long)((k0) + 32 + sr) * LDK + sc]); \
    sr_[i].ks0 = *(const bf16x8*)(&Kh[(long)((k0) + kr) * LDK + kc]); } while (0)
#define SWRITE(b, i) do { *(LAS bf16x8*)(V_lds + (b) * SHM_V + vst0) = sr_[i].vs0; *(LAS bf16x8*)(V_lds + (b) * SHM_V + vst1) = sr_[i].vs1; \
    *(LAS bf16x8*)(K_lds + (b) * SHM_K + kst) = sr_[i].ks0; } while (0)
#define SWAIT() asm volatile("s_waitcnt vmcnt(3)" ::: "memory")
#define RESC(a) do { if (__any((a) < 1.f)) { if (hi == 0) al_l[r32] = (a); asm volatile("s_waitcnt lgkmcnt(0)" ::: "memory"); \
    _Pragma("unroll") for (int d = 0; d < 4; ++d) _Pragma("unroll") for (int r = 0; r < 16; ++r) o[d][r] *= al_l[crow(r, hi)]; } } while (0)
    f32x16 pA0, pA1, pB0, pB1; float mnA, mnB, alA, alB; bf16x8 pa0, pa1, pa2, pa3;
    constexpr int SE = 0, SO = 1;
    SLOAD(SE, 0); asm volatile("s_waitcnt vmcnt(0)" ::: "memory"); SWRITE(0, SE); __syncthreads();
    qkt(pA0, pA1, K_lds, qr, r32, hi); partialSM(pA0, pA1, m_reg, mnA, alA);
    SLOAD(SO, KVBLK); SLOAD(SE, 2 * KVBLK);
    SWAIT(); SWRITE(1, SO); __syncthreads();
#pragma nounroll
    for (int j = 1; j + 1 < NT; j += 2) {
        SBAR(); qkt(pB0, pB1, K_lds + SHM_K, qr, r32, hi);
        finishSM(pA0, pA1, alA, l_reg, pa0, pa1, pa2, pa3); SBAR();
        SLOAD(SO, (j + 2) * KVBLK); SBAR();
        pv_d0(o, vb0, pa0, pa1, pa2, pa3); partialSM(pB0, pB1, m_reg, mnB, alB);
        __syncthreads(); SWAIT(); SWRITE(0, SE);
        RESC(alB); __syncthreads();
        SBAR(); qkt(pA0, pA1, K_lds, qr, r32, hi);
        finishSM(pB0, pB1, alB, l_reg, pa0, pa1, pa2, pa3); SBAR();
        if (j + 3 < NT) SLOAD(SE, (j + 3) * KVBLK); SBAR();
        pv_d0(o, vb0 + (int)SHM_V, pa0, pa1, pa2, pa3); partialSM(pA0, pA1, m_reg, mnA, alA);
        __syncthreads(); SWAIT(); SWRITE(1, SO);
        RESC(alA); __syncthreads();
    }
    SBAR(); qkt(pB0, pB1, K_lds + SHM_K, qr, r32, hi);
    finishSM(pA0, pA1, alA, l_reg, pa0, pa1, pa2, pa3); SBAR();
    pv_d0(o, vb0, pa0, pa1, pa2, pa3); partialSM(pB0, pB1, m_reg, mnB, alB);
    __syncthreads(); RESC(alB);
    finishSM(pB0, pB1, alB, l_reg, pa0, pa1, pa2, pa3); SBAR();
    pv_d0(o, vb0 + (int)SHM_V, pa0, pa1, pa2, pa3);
    l_out = l_reg;
    __syncthreads();
#undef SLOAD
#undef SWRITE
#undef SWAIT
#undef RESC
}
}

__device__ __forceinline__ void attn_phase(PR p, Frame& F) {
    using namespace att;
    const bf16* Q = WSP(bf16, B_Q); const bf16* K = WSP(bf16, B_K); const bf16* V = WSP(bf16, B_V); bf16* AO = WSP(bf16, B_AO);
    float* stash = WSP(float, B_STASH) + (size_t)F.bid * 64 * NTHREADS + F.tid;
    const float lam = WSP(float, WS_SCAL)[0];
    const int lane = F.lane, r32 = lane & 31, hi = lane >> 5, wid = F.wave;
    LAS float* ws = (LAS float*)(F.lds + 2 * SHM_V + 2 * SHM_K) + wid * 64;
    for (int unit = F.vcu; unit < NBATCH * 8 * 32; unit += F.G) {
        const int bh = unit >> 5, qb = unit & 31, b = bh >> 3, h = bh & 7;
        const bf16* Qb = Q + ((size_t)b * SEQ + qb * 256) * LDQ + h * 128;
        const bf16* Kh = K + (size_t)b * NKEY * LDK + h * 128;
        const bf16* Vh = V + (size_t)b * NKEY * LDK + h * 128;
        f32x16 o[4]; float l;
        int tl = F.tid; asm volatile("" : "+v"(tl));
        attn_pass(Qb, Kh, Vh, (LAS char*)F.lds, o, l, tl);
        float* st = stash; asm volatile("" : "+v"(st));
        if (hi == 0) ws[r32] = l; asm volatile("s_waitcnt lgkmcnt(0)" ::: "memory");
#pragma unroll
        for (int r = 0; r < 16; ++r) { const float rl = __builtin_amdgcn_rcpf(ws[crow(r, hi)]);
#pragma unroll
            for (int d0 = 0; d0 < 4; ++d0) st[(size_t)(d0 * 16 + r) * NTHREADS] = o[d0][r] * rl; }
        __syncthreads();
        asm volatile("" : "+v"(tl));
        attn_pass(Qb + 64, Kh + 64, Vh, (LAS char*)F.lds, o, l, tl);
        asm volatile("" : "+v"(st));
        if (hi == 0) ws[r32] = l; asm volatile("s_waitcnt lgkmcnt(0)" ::: "memory");
        float ss[16];
#pragma unroll
        for (int r = 0; r < 16; ++r) { const float rl = __builtin_amdgcn_rcpf(ws[crow(r, hi)]); float q = 0.f;
#pragma unroll
            for (int d0 = 0; d0 < 4; ++d0) { const float v = st[(size_t)(d0 * 16 + r) * NTHREADS] - lam * (o[d0][r] * rl); o[d0][r] = v; q += v * v; }
            ss[r] = q; }
#pragma unroll
        for (int r = 0; r < 16; ++r) { float q = ss[r]; q += __shfl_xor(q, 1); q += __shfl_xor(q, 2); q += __shfl_xor(q, 4); q += __shfl_xor(q, 8); q += __shfl_xor(q, 16);
            ss[r] = (1.f / sqrtf(q * (1.f / 128.f) + GN_EPS)) * (1.f - LAMBDA_INIT); }
        bf16* Ow = AO + ((size_t)b * SEQ + qb * 256 + wid * QBLK) * DM + h * 128 + r32; asm volatile("" : "+v"(Ow));
#pragma unroll
        for (int d0 = 0; d0 < 4; ++d0) { const float gsub = p.in[I_SUBLN][d0 * 32 + r32];
#pragma unroll
            for (int r = 0; r < 16; ++r) Ow[(size_t)crow(r, hi) * DM + d0 * 32] = (bf16)f2bf(o[d0][r] * ss[r] * gsub); }
        __syncthreads();
    }
}
#ifndef MK_MULTI
#define MK_MULTI 0
#endif
constexpr int NPHASE = 21;

template <int LAYER>
__device__ __forceinline__ void moe_gemm1_phase(PR p, Frame& F, const bf16* BUF, bf16* HID) {
    const MoeTabs T = moe_tabs(F); moe_build_tabs(p, F, T);
    pg8::ExpertOrder S; S.g.init((int)T.pendb[15], 8, F.G, F.bid, 1024, 1024); S.pend = T.pendb; S.eB = (long)EXP_STRIDE;
    pg8::Gemm g{BUF, (const bf16*)(p.ws + WS_EXP + (size_t)LAYER * 16 * EXP_STRIDE), 1024, 1024, 1024};
    pg8::EpiSwiGlu E{HID};
    pg8::gemm_phase(F.lds, g, S, E);
}
template <int LAYER>
__device__ __forceinline__ void moe_gemm2_phase(PR p, Frame& F, const bf16* HID, bf16* Y) {
    const MoeTabs T = moe_tabs(F); moe_build_tabs(p, F, T);
    pg8::ExpertOrder S; S.g.init((int)T.pendb[15], 4, F.G, F.bid, 1024, 1024); S.pend = T.pendb; S.eB = (long)EXP_STRIDE;
    pg8::Gemm g{HID, (const bf16*)(p.ws + WS_EXP + (size_t)LAYER * 16 * EXP_STRIDE + EXP_DN), 1024, 1024, 1024};
    pg8::EpiPlain E{Y, 1024};
    pg8::gemm_phase(F.lds, g, S, E);
}

#define PHP() const CAS Params* kp_ = (const CAS Params*)__builtin_amdgcn_kernarg_segment_ptr(); asm volatile("" : "+s"(kp_)); PR p = *kp_; Frame F; { int t_ = threadIdx.x; asm volatile("" : "+v"(t_)); int g_ = gridDim.x, b_ = blockIdx.x; asm volatile("" : "+s"(g_), "+s"(b_)); \
    F.lds = lds_base; F.tid = t_; F.lane = t_ & 63; F.wave = __builtin_amdgcn_readfirstlane(t_ >> 6); F.G = g_; F.bid = b_; F.vcu = (g_ % 8 == 0) ? (b_ % 8) * (g_ / 8) + b_ / 8 : b_; }
__global__ void __launch_bounds__(NTHREADS, 2) fwd(Params p_) {
    extern __shared__ __attribute__((aligned(16))) unsigned char lds_raw[];
    LAS unsigned char* const lds_base = (LAS unsigned char*)lds_raw;
    volatile LAS unsigned* misc = (volatile LAS unsigned*)(lds_base + MISC_OFF);
    for (int u = threadIdx.x; u < 64; u += NTHREADS) misc[u] = 0u;
    __syncthreads();
    const int lo = p_.ph_lo, hi = p_.ph_hi;
    XcdBarrier bar; bar.bar = (unsigned*)(p_.ws + WS_CTL) + 4096; bar.x = 0; bar.st = misc;
    if (!MK_MULTI) bar = xcd_barrier_post((unsigned*)(p_.ws + WS_CTL) + 4096, misc);
#ifndef ONLY_PHASE
#define ONLY_PHASE -1
#endif
#define IN(k) ((ONLY_PHASE < 0 || ONLY_PHASE == (k)) && lo <= (k) && (k) < hi)
#define SEAM(k) do { if (IN(k) && IN((k) + 1)) xcd_barrier(bar); } while (0)

    if (IN(0)) { PHP(); p0a_prologue(p, F); } SEAM(0);
    if (IN(1)) { PHP(); p0b_phase(p, F); } SEAM(1);
    if (IN(2)) { PHP();
        pg8::Gemm g{WSP(bf16, A_H0), WSP(bf16, WS_WIN0), 1024, 1024, 1024}; pg8::GridOrder S; S.init(NTOK / 256, 10, F.G, F.bid, 1024, 1024);
        pg8::EpiInProj0 E{WSP(bf16, A_QK), WSP(bf16, A_V), WSP(bf16, A_G), WSP(bf16, A_UA), WSP(float, WS_ROPE0C), WSP(float, WS_ROPE0S)};
        pg8::gemm_phase(F.lds, g, S, E);
    } SEAM(2);
    if (IN(3)) { PHP();
        pg8::Gemm g{WSP(bf16, A_UA), WSP(bf16, WS_BT1), 512, 768, 512};
        pg8::BatchOrder S; S.nZ = 16; S.nM = 5; S.nN = 1; S.G = F.G; S.c = F.bid; S.tA = 256L * 768 * 2; S.tB = 256L * 512 * 2; S.zA = (long)S5ROWS * 768 * 2; S.zB = 256L * 512 * 2;
        pg8::EpiS5E E{WSP(float, A_EO)};
        pg8::gemm_phase(F.lds, g, S, E);
        ret_states_phase(p, F, ((F.G - 80) % F.G + F.G) % F.G);
    } SEAM(3);
    if (IN(4)) { PHP(); s5_scan_phase(p, F); ret_scan_phase(p, F); } SEAM(4);
    if (IN(5)) { PHP();
        pg8::Gemm g{WSP(bf16, A_UA), WSP(bf16, WS_BT2), 768, 768, 768};
        pg8::BatchOrder S; S.nZ = 16; S.nM = 5; S.nN = 2; S.G = F.G; S.c = F.bid; S.tA = 256L * 768 * 2; S.tB = 256L * 768 * 2; S.zA = (long)S5ROWS * 768 * 2; S.zB = 512L * 768 * 2;
        pg8::EpiS5Y E{WSP(bf16, A_SG)};
        pg8::gemm_phase(F.lds, g, S, E);
        ret_out_phase(p, F, ((F.G - 160) % F.G + F.G) % F.G);
    } SEAM(5);
    if (IN(6)) { PHP();
        pg8::Gemm g{WSP(bf16, A_SG), WSP(bf16, WS_WGLU), 256, 256, 256}; pg8::GridOrder S; S.init(NTOK / 256, 2, F.G, F.bid, 256, 256);
        pg8::EpiGlu E{WSP(bf16, A_MRG)};
        pg8::gemm_phase(F.lds, g, S, E);
    } SEAM(6);
    if (IN(7)) { PHP();
        pg8::Gemm g{WSP(bf16, A_MRG), WSP(bf16, WS_WOUT0), 1024, 1024, 1024}; pg8::GridOrder S; S.init(NTOK / 256, 4, F.G, F.bid, 1024, 1024);
        pg8::EpiPlain E{WSP(bf16, A_O), 1024};
        pg8::gemm_phase(F.lds, g, S, E);
    } SEAM(7);
    if (IN(8)) { PHP(); ln1_router_phase<0>(p, F, WSP(bf16, A_O), WSP(bf16, A_H2), NTOK); } SEAM(8);
    if (IN(9)) { PHP(); moe_scatter_phase(p, F, WSP(bf16, A_H2), WSP(bf16, A_BUF), NTOK); } SEAM(9);
    if (IN(10)) { PHP(); moe_gemm1_phase<0>(p, F, WSP(bf16, A_BUF), WSP(bf16, A_HID)); } SEAM(10);
    if (IN(11)) { PHP(); moe_gemm2_phase<0>(p, F, WSP(bf16, A_HID), WSP(bf16, A_Y)); } SEAM(11);
    if (IN(12)) { PHP(); ln2_phase<0>(p, F, WSP(bf16, A_Y), WSP(bf16, A_H0P), NTOK); } SEAM(12);
    if (IN(13)) { PHP();
        pg8::Gemm g{WSP(bf16, A_H0P), WSP(bf16, WS_WIN1), 1024, 1024, 1024}; pg8::InProj1Order S; S.g.init(NLAT / 256, 12, F.G, F.bid, 1024, 1024);
        pg8::EpiInProj1 E{WSP(bf16, B_Q), WSP(bf16, B_K), WSP(bf16, B_V), WSP(float, WS_ROPE1)};
        pg8::gemm_phase(F.lds, g, S, E);
    } SEAM(13);
    if (IN(14)) { PHP(); attn_phase(p, F); } SEAM(14);
    if (IN(15)) { PHP();
        pg8::Gemm g{WSP(bf16, B_AO), WSP(bf16, WS_WOUT1), 1024, 1024, 1024}; pg8::GridOrder S; S.init(NLAT / 256, 4, F.G, F.bid, 1024, 1024);
        pg8::EpiPlain E{WSP(bf16, B_O), 1024};
        pg8::gemm_phase(F.lds, g, S, E);
    } SEAM(15);
    if (IN(16)) { PHP(); ln1_router_phase<1>(p, F, WSP(bf16, B_O), WSP(bf16, B_H2), NLAT); } SEAM(16);
    if (IN(17)) { PHP(); moe_scatter_phase(p, F, WSP(bf16, B_H2), WSP(bf16, B_BUF), NLAT); } SEAM(17);
    if (IN(18)) { PHP(); moe_gemm1_phase<1>(p, F, WSP(bf16, B_BUF), WSP(bf16, B_HID)); } SEAM(18);
    if (IN(19)) { PHP(); moe_gemm2_phase<1>(p, F, WSP(bf16, B_HID), WSP(bf16, B_Y)); } SEAM(19);
    if (IN(20)) { PHP(); ln2_phase<1>(p, F, WSP(bf16, B_Y), nullptr, NLAT); }
#undef IN
#undef SEAM
}

extern "C" void kernel_launch(void* const* d_in, const int* in_sizes, int n_in, void* d_out, int out_size, void* d_ws, size_t ws_size, hipStream_t stream) {
    static int grid = 0;
    if (grid == 0) {
        if (n_in != N_IN || out_size != NLAT * DM || ws_size < WS_END) { fprintf(stderr, "kernel_launch: unexpected shapes: n_in %d out %d ws %zu (need %zu)\n", n_in, out_size, ws_size, (size_t)WS_END); grid = -1; return; }
        int dev = 0, cus = 0, per_cu = 0;
        if (hipGetDevice(&dev) != hipSuccess || hipDeviceGetAttribute(&cus, hipDeviceAttributeMultiprocessorCount, dev) != hipSuccess) { grid = -1; return; }
        if (hipFuncSetAttribute((const void*)fwd, hipFuncAttributeMaxDynamicSharedMemorySize, LDS_BYTES) != hipSuccess) { fprintf(stderr, "kernel_launch: hipFuncSetAttribute failed\n"); grid = -1; return; }
        if (hipOccupancyMaxActiveBlocksPerMultiprocessor(&per_cu, (const void*)fwd, NTHREADS, LDS_BYTES) != hipSuccess || per_cu < 1) fprintf(stderr, "kernel_launch: occupancy query reports %d\n", per_cu);
        (void)hipGetLastError();
        grid = cus > 256 ? 256 : cus;
    }
    if (grid < 0) return;
    if (hipMemsetAsync((char*)d_ws + WS_CTL, 0, CTL_BYTES, stream) != hipSuccess) return;
    Params prm{};
    for (int i = 0; i < N_IN; ++i) prm.in[i] = (const float*)d_in[i];
    prm.out = (float*)d_out; prm.ws = (unsigned char*)d_ws;
#if MK_MULTI
    for (int ph = 0; ph < NPHASE; ++ph) { prm.ph_lo = ph; prm.ph_hi = ph + 1; hipLaunchKernelGGL(fwd, dim3(grid), dim3(NTHREADS), LDS_BYTES, stream, prm); }
#else
    prm.ph_lo = 0; prm.ph_hi = NPHASE;
    hipLaunchKernelGGL(fwd, dim3(grid), dim3(NTHREADS), LDS_BYTES, stream, prm);
#endif
}
```

```cpp
#include <hip/hip_runtime.h>
#include <cstdio>
#include <cstdint>

#define LAS __attribute__((address_space(3)))
#define GAS __attribute__((address_space(1)))
typedef unsigned short bf16;
typedef short bf16x8 __attribute__((ext_vector_type(8)));
typedef short s16x4 __attribute__((ext_vector_type(4)));
typedef float f32x4 __attribute__((ext_vector_type(4)));
typedef float f32x2 __attribute__((ext_vector_type(2)));
typedef float f32x16 __attribute__((ext_vector_type(16)));
typedef unsigned u32x4 __attribute__((ext_vector_type(4)));
typedef unsigned u32x2 __attribute__((ext_vector_type(2)));

constexpr int DM = 1024, NBATCH = 4, SEQ = 8192, CTXL = 256;
constexpr int NLAT = NBATCH * SEQ, NCTX = NBATCH * CTXL, NTOK = NLAT + NCTX;
constexpr int RH = 6, RDK = 64, RDV = 128, RC = 128, RNCH = 66;
constexpr int S5G = 16, S5P = 16, S5N = 64, S5T = 32, S5ROWS = 1280;
constexpr int NEXP = 16, NB0 = 280, NB1 = 272;
constexpr float ALPHA = 1.4142135623730951f;
constexpr float LN_EPS = 1e-5f, GN_EPS = 1e-6f;
constexpr float LAMBDA_INIT = 0.35550906759096926f;
constexpr int NWAVES = 8, NTHREADS = 512;

constexpr size_t MiB = 1u << 20, KiB = 1024;
constexpr size_t WS_CTL = 0, CTL_BYTES = 1 * MiB;
constexpr size_t WS_MOD = 1 * MiB;
constexpr size_t WS_SCAL = 1 * MiB + 256 * KiB;
constexpr size_t WS_LAMP = 1 * MiB + 320 * KiB;
constexpr size_t WS_COEF = 1 * MiB + 896 * KiB;
constexpr size_t WS_ROPE0C = 2 * MiB, WS_ROPE0S = 3 * MiB;
constexpr size_t WS_ROPE1 = 4 * MiB;
constexpr size_t WS_S5K = 4 * MiB + 64 * KiB;
constexpr size_t WS_XC = 6 * MiB;
constexpr size_t WS_CNT = 10 * MiB;
constexpr size_t WS_ROUTE = 10 * MiB + 64 * KiB;
constexpr size_t WS_BT1 = 12 * MiB;
constexpr size_t WS_BT2 = 16 * MiB;
constexpr size_t WS_WIN0 = 28 * MiB;
constexpr size_t WS_WGLU = 33 * MiB;
constexpr size_t WS_WOUT0 = 34 * MiB;
constexpr size_t WS_WIN1 = 36 * MiB;
constexpr size_t WS_WOUT1 = 42 * MiB;
constexpr size_t WS_EXP = 44 * MiB;
constexpr size_t EXP_STRIDE = 6 * MiB, EXP_DN = 4 * MiB;
constexpr size_t WS_ARENA = 236 * MiB;
constexpr size_t AR(double mib) { return WS_ARENA + (size_t)(mib * 1048576.0); }
constexpr size_t A_QK = AR(0), A_V = AR(49.5), A_G = AR(99), A_UA = AR(148.5), A_TT = AR(178.5), A_EO = AR(228), A_H0 = AR(248), A_MRG = AR(248), A_SG = AR(314);
constexpr size_t A_O = AR(140), A_H2 = AR(206), A_BUF = AR(0), A_HID = AR(140), A_Y = AR(0), A_H0P = AR(140);
constexpr size_t B_Q = AR(0), B_K = AR(64), B_V = AR(206), B_STASH = AR(272), B_AO = AR(140), B_O = AR(0), B_H2 = AR(64), B_BUF = AR(140), B_HID = AR(0), B_Y = AR(140);
constexpr size_t WS_END = AR(331);

constexpr int STAGE_BYTES_LDS = 131072;
constexpr int MISC_OFF = 131072;
constexpr int LDS_BYTES = 147456;

__device__ __forceinline__ unsigned f2bf(float f) { unsigned u = __float_as_uint(f); return (u + 0x7fffu + ((u >> 16) & 1u)) >> 16; }
__device__ __forceinline__ float bf2f(unsigned b) { return __uint_as_float(b << 16); }
__device__ __forceinline__ float bflo(unsigned w) { return __uint_as_float(w << 16); }
__device__ __forceinline__ float bfhi(unsigned w) { return __uint_as_float(w & 0xffff0000u); }
__device__ __forceinline__ unsigned cvt_pk_bf16(float lo, float hi) { unsigned r; asm volatile("v_cvt_pk_bf16_f32 %0, %1, %2" : "=v"(r) : "v"(lo), "v"(hi)); return r; }
__device__ __forceinline__ float wave_sum(float v) {
#pragma unroll
    for (int o = 1; o < 64; o <<= 1) v += __shfl_xor(v, o);
    return v;
}
__device__ __forceinline__ float fast_sigmoid(float x) { return __builtin_amdgcn_rcpf(1.f + __expf(-x)); }
__device__ __forceinline__ float fast_silu(float x) { return x * fast_sigmoid(x); }
__device__ __forceinline__ float gelu_tanh(float x) { const float z = 0.7978845608028654f * (x + 0.044715f * x * x * x); const float t = 1.f - 2.f * __builtin_amdgcn_rcpf(__expf(2.f * z) + 1.f); return 0.5f * x * (1.f + t); }
__device__ __forceinline__ void sincos_rev(double rev, float& s, float& c) { const double fr = rev - rint(rev); const float y = (float)(fr * 6.283185307179586); s = sinf(y); c = cosf(y); }
__device__ __forceinline__ f32x2 cmul(f32x2 a, f32x2 b) { return (f32x2){a.x * b.x - a.y * b.y, a.x * b.y + a.y * b.x}; }

#define XB_TMO      128
#define XB_XCNT(j)  (256  + 64 * (j))
#define XB_XSUB(j)  (1280 + 64 * (j))
#define XB_XGEN(j)  (2304 + 64 * (j))
#define XB_TOP      3328
#define XB_TOPGEN   3392
#define XCD_BAR_WORDS 3456
#define XB_SPIN_CAP (1u << 22)
__device__ __forceinline__ unsigned xb_ld(unsigned* p)              { return __hip_atomic_load(p, __ATOMIC_RELAXED, __HIP_MEMORY_SCOPE_AGENT); }
__device__ __forceinline__ unsigned xb_add(unsigned* p, unsigned v) { return __hip_atomic_fetch_add(p, v, __ATOMIC_RELAXED, __HIP_MEMORY_SCOPE_AGENT); }
__device__ __forceinline__ unsigned xb_xcc_id() { return (unsigned)__builtin_amdgcn_s_getreg((3 << 11) | 20) & 0xFu; }
#define XB_SPIN(cond, bar) do { unsigned _sp = 0; while (cond) { __builtin_amdgcn_s_sleep(1); \
    if ((++_sp & 255u) == 0u) { if (xb_ld(&(bar)[XB_TMO])) break; if (_sp > XB_SPIN_CAP) { atomicAdd(&(bar)[XB_TMO], 1u); break; } } } } while (0)
struct XcdBarrier { unsigned* bar; unsigned x; volatile LAS unsigned* st; };
__device__ __forceinline__ XcdBarrier xcd_barrier_post(unsigned* bar, volatile LAS unsigned* st) {
    XcdBarrier b; b.bar = bar; b.x = xb_xcc_id(); b.st = st;
    if (threadIdx.x == 0) (void)xb_add(&bar[XB_XCNT(b.x)], 1u);
    return b;
}
__device__ __forceinline__ void xcd_barrier_complete(unsigned* bar, unsigned x, unsigned& nloc, unsigned& nx) {
    const unsigned G = gridDim.x * gridDim.y * gridDim.z;
    unsigned sum, cnt, mine, sp = 0u;
    for (;;) {
        sum = 0u; cnt = 0u; mine = 0u;
#pragma unroll
        for (unsigned j = 0; j < 16; ++j) { const unsigned c = xb_ld(&bar[XB_XCNT(j)]); sum += c; cnt += (c > 0u) ? 1u : 0u; mine = (j == x) ? c : mine; }
        if (sum == G) break;
        __builtin_amdgcn_s_sleep(1);
        if ((++sp & 255u) == 0u) { if (xb_ld(&bar[XB_TMO])) break; if (sp > XB_SPIN_CAP) { atomicAdd(&bar[XB_TMO], 1u); break; } }
    }
    nloc = mine > 0u ? mine : 1u; nx = cnt > 0u ? cnt : 1u;
}
__device__ __forceinline__ void xcd_barrier(const XcdBarrier& b) {
    asm volatile("s_waitcnt vmcnt(0)" ::: "memory");
    __syncthreads();
    if (threadIdx.x == 0) {
        unsigned* bar = b.bar;
        __builtin_amdgcn_s_waitcnt(0);
        unsigned nloc = b.st[0], nx = b.st[1];
        if (nloc == 0u) { xcd_barrier_complete(bar, b.x, nloc, nx); b.st[0] = nloc; b.st[1] = nx; }
        const unsigned old = xb_add(&bar[XB_XSUB(b.x)], 1u);
        const unsigned gen = old / nloc;
        if (old + 1u == (gen + 1u) * nloc) {
            __builtin_amdgcn_fence(__ATOMIC_RELEASE, "agent");
            asm volatile("s_waitcnt vmcnt(0)" ::: "memory");
            const unsigned og = xb_add(&bar[XB_TOP], 1u);
            const unsigned tg = og / nx;
            if (og + 1u == (tg + 1u) * nx) xb_add(&bar[XB_TOPGEN], 1u);
            else XB_SPIN(xb_ld(&bar[XB_TOPGEN]) == tg, bar);
            __builtin_amdgcn_fence(__ATOMIC_ACQUIRE, "agent");
            xb_add(&bar[XB_XGEN(b.x)], 1u);
            asm volatile("s_waitcnt vmcnt(0)" ::: "memory");
        } else {
            XB_SPIN(xb_ld(&bar[XB_XGEN(b.x)]) == gen, bar);
            __builtin_amdgcn_fence(__ATOMIC_ACQUIRE, "agent");
            asm volatile("s_waitcnt vmcnt(0)" ::: "memory");
        }
    }
    __syncthreads();
}

namespace pg8 {
constexpr int BM = 256, BK = 64, HALF = 128, HTB = HALF * BK * 2, NXCD = 8, WGM = 8;
__host__ __device__ __forceinline__ int lds_byte(int r, int c) { const int st = (r >> 4) * 2 + (c >> 5), rr = r & 15, cc = c & 31, ob = rr * 64 + cc * 2; return st * 1024 + (ob ^ (((ob >> 9) & 1) << 5)); }
__host__ __device__ __forceinline__ void stage_rc(int b, int& R, int& C) { const int st = b / 1024, sb = b % 1024, swz = sb ^ (((sb >> 9) & 1) << 5); R = (st >> 1) * 16 + swz / 64; C = (st & 1) * 32 + (swz % 64) / 2; }
__host__ __device__ __forceinline__ int perm32(int rho) { const int n = rho >> 4, i = rho & 15; return 8 * (i >> 2) + 4 * n + (i & 3); }

struct Unit { int pm, pn, z; long aoff, boff; };
struct Gemm { const bf16* A; const bf16* Bt; int K, lda, ldb; };

struct GridOrder {
    int nM, nN, nwg, G, c; long tA, tB;
    __device__ void init(int nM_, int nN_, int G_, int c_, int lda, int ldb) { nM = nM_; nN = nN_; nwg = nM * nN; G = G_; c = c_; tA = (long)BM * lda * 2; tB = (long)BM * ldb * 2; }
    __device__ __forceinline__ bool tile(long L, int& pm, int& pn) const {
        if (L >= nwg) return false;
        int wgid = (int)L; { const int q = nwg / NXCD, r = nwg % NXCD, xcd = wgid % NXCD, off = wgid / NXCD; wgid = (xcd < r ? xcd * (q + 1) : r * (q + 1) + (xcd - r) * q) + off; }
        const int nig = WGM * nN, gid = wgid / nig, fm = gid * WGM, gsz = (nM - fm) < WGM ? (nM - fm) : WGM;
        pm = fm + ((wgid % nig) % gsz); pn = (wgid % nig) / gsz; return true;
    }
    __device__ __forceinline__ bool next(int i, Unit& u) const {
        if (!tile((long)i * G + c, u.pm, u.pn)) return false;
        u.z = 0; u.aoff = u.pm * tA; u.boff = u.pn * tB; return true;
    }
};
struct BatchOrder {
    int nZ, nM, nN, G, c; long tA, tB, zA, zB;
    __device__ __forceinline__ bool next(int i, Unit& u) const {
        const long L = (long)i * G + c; if (L >= (long)nZ * nM * nN) return false;
        const int per = nM * nN; u.z = (int)(L / per); const int r = (int)(L % per); u.pm = r / nN; u.pn = r % nN;
        u.aoff = u.z * zA + u.pm * tA; u.boff = u.z * zB + u.pn * tB; return true;
    }
};
struct ExpertOrder {
    GridOrder g; const LAS unsigned* pend; long eB;
    __device__ __forceinline__ bool next(int i, Unit& u) const {
        if (!g.tile((long)i * g.G + g.c, u.pm, u.pn)) return false;
        int e = 0;
#pragma unroll
        for (int k = 0; k < 15; ++k) e += ((unsigned)u.pm >= pend[k]) ? 1 : 0;
        u.z = e; u.aoff = u.pm * g.tA; u.boff = e * eB + u.pn * g.tB; return true;
    }
};
struct InProj1Order {
    GridOrder g;
    __device__ __forceinline__ bool next(int i, Unit& u) const {
        const long L = (long)i * g.G + g.c;
        if (L < g.nwg) { g.tile(L, u.pm, u.pn); }
        else { const long Lc = L - g.nwg; if (Lc >= 32) return false; u.pm = 128 + (int)(Lc >> 3); u.pn = 4 + (int)(Lc & 7); }
        u.z = 0; u.aoff = u.pm * g.tA; u.boff = u.pn * g.tB; return true;
    }
};

template <class Epi, class Sched>
__device__ __forceinline__ void gemm_phase(LAS unsigned char* lds, const Gemm g, const Sched& S, const Epi& E) {
    const int tid = threadIdx.x, wid = __builtin_amdgcn_readfirstlane(tid >> 6), lane = tid & 63, wr = wid >> 2, wc = wid & 3, fr = lane & 15, fq = lane >> 4;
    const int K = g.K, nt = K / BK;
    unsigned voffA[2], voffB[2];
#pragma unroll
    for (int i = 0; i < 2; ++i) { int R, C; stage_rc(tid * 16 + i * 8192, R, C); const int Rb = Epi::PERM ? ((R & ~31) + perm32(R & 31)) : R;
        voffA[i] = (unsigned)(R * g.lda + C) * 2u; voffB[i] = (unsigned)(Rb * g.ldb + C) * 2u; }
    const size_t kstep = (size_t)(BK * 2);
    const size_t hstepA = (size_t)HALF * g.lda * 2, hstepB = (size_t)HALF * g.ldb * 2;
    const unsigned ldsw = (unsigned)wid * 1024u;
    const int aoff = lds_byte(wr * 64 + fr, fq * 8), boff = lds_byte(wc * 32 + fr, fq * 8);
#define PG8_SA(b, h) (((b) * 2 + (h)) * HTB)
#define PG8_SB(b, h) ((4 + (b) * 2 + (h)) * HTB)
#define PG8_STAGE(bufoff, gbase, voff) do { _Pragma("unroll") for (int _i = 0; _i < 2; ++_i) \
        __builtin_amdgcn_global_load_lds((const unsigned*)((const char*)(gbase) + (voff)[_i]), (LAS unsigned*)(lds + (bufoff) + ldsw + _i * 8192), 16, 0, 0); } while (0)
#define PG8_LDA(dst, b, h) do { _Pragma("unroll") for (int m = 0; m < 4; ++m) _Pragma("unroll") for (int k = 0; k < 2; ++k) dst[m][k] = *(const LAS bf16x8*)(lds + PG8_SA(b, h) + aoff + m * 2048 + k * 1024); } while (0)
#define PG8_LDB(dst, b, h) do { _Pragma("unroll") for (int n = 0; n < 2; ++n) _Pragma("unroll") for (int k = 0; k < 2; ++k) dst[n][k] = *(const LAS bf16x8*)(lds + PG8_SB(b, h) + boff + n * 2048 + k * 1024); } while (0)
#define PG8_MMA(ai, bj, At, Bt) do { __builtin_amdgcn_s_setprio(1); _Pragma("unroll") for (int m = 0; m < 4; ++m) _Pragma("unroll") for (int n = 0; n < 2; ++n) _Pragma("unroll") for (int k = 0; k < 2; ++k) \
        acc[ai][bj][m][n] = __builtin_amdgcn_mfma_f32_16x16x32_bf16(Bt[n][k], At[m][k], acc[ai][bj][m][n], 0, 0, 0); __builtin_amdgcn_s_setprio(0); } while (0)
#define PG8_WAIT_V(n) asm volatile("s_waitcnt vmcnt(" #n ")" ::: "memory")
#define PG8_WAIT_L(n) asm volatile("s_waitcnt lgkmcnt(" #n ")" ::: "memory")
#define PG8_BAR __builtin_amdgcn_s_barrier()
#define PG8_SCHED __builtin_amdgcn_sched_barrier(0)
    Unit cur, nxt; int ui = 0;
    if (!S.next(0, cur)) return;
    f32x4 acc[2][2][4][2];
#pragma unroll
    for (int a = 0; a < 2; ++a)
#pragma unroll
        for (int b = 0; b < 2; ++b)
#pragma unroll
            for (int m = 0; m < 4; ++m)
#pragma unroll
                for (int n = 0; n < 2; ++n) acc[a][b][m][n] = (f32x4){0.f, 0.f, 0.f, 0.f};
    bf16x8 At[4][2], B0[2][2], B1[2][2];
    const char* cA = (const char*)g.A + cur.aoff; const char* cB = (const char*)g.Bt + cur.boff;
    PG8_STAGE(PG8_SB(0, 0), cB, voffB); PG8_STAGE(PG8_SB(0, 1), cB + hstepB, voffB); PG8_STAGE(PG8_SA(0, 0), cA, voffA); PG8_STAGE(PG8_SA(0, 1), cA + hstepA, voffA);
    if (wr == 1) PG8_BAR;
    PG8_WAIT_V(2); PG8_BAR;
    PG8_STAGE(PG8_SB(1, 0), cB + kstep, voffB); PG8_STAGE(PG8_SA(1, 0), cA + kstep, voffA); PG8_STAGE(PG8_SB(1, 1), cB + hstepB + kstep, voffB);
    PG8_WAIT_V(6); PG8_BAR;
    for (;;) {
        const bool has_next = S.next(ui + 1, nxt);
        const char* nA = has_next ? (const char*)g.A + nxt.aoff : cA; const char* nB = has_next ? (const char*)g.Bt + nxt.boff : cB;
        for (int t = 0; t < nt; t += 2) {
            const bool last = (t == nt - 2);
            const char* a1 = cA + (size_t)(t + 1) * kstep;
            const char* a2 = last ? nA : cA + (size_t)(t + 2) * kstep; const char* b2 = last ? nB : cB + (size_t)(t + 2) * kstep;
            const char* a3 = a2 + kstep; const char* b3 = b2 + kstep;
            PG8_LDB(B0, 0, 0); PG8_LDB(B1, 0, 1); PG8_SCHED; PG8_LDA(At, 0, 0); PG8_STAGE(PG8_SA(1, 1), a1 + hstepA, voffA);
            PG8_WAIT_V(8); PG8_WAIT_L(0); PG8_BAR; PG8_MMA(0, 0, At, B0); PG8_MMA(0, 1, At, B1); PG8_BAR; PG8_SCHED;
            PG8_LDA(At, 0, 1); PG8_STAGE(PG8_SB(0, 0), b2, voffB); PG8_STAGE(PG8_SB(0, 1), b2 + hstepB, voffB); PG8_STAGE(PG8_SA(0, 0), a2, voffA);
            PG8_WAIT_V(8); PG8_WAIT_L(0); PG8_BAR; PG8_MMA(1, 0, At, B0); PG8_MMA(1, 1, At, B1); PG8_BAR; PG8_SCHED;
            PG8_LDB(B0, 1, 0); PG8_LDB(B1, 1, 1); PG8_SCHED; PG8_LDA(At, 1, 0); PG8_STAGE(PG8_SA(0, 1), a2 + hstepA, voffA);
            PG8_WAIT_V(8); PG8_WAIT_L(0); PG8_BAR; PG8_MMA(0, 0, At, B0); PG8_MMA(0, 1, At, B1); PG8_BAR; PG8_SCHED;
            PG8_LDA(At, 1, 1); PG8_STAGE(PG8_SB(1, 0), b3, voffB); PG8_STAGE(PG8_SB(1, 1), b3 + hstepB, voffB); PG8_STAGE(PG8_SA(1, 0), a3, voffA);
            PG8_WAIT_V(8); PG8_WAIT_L(0); PG8_BAR; PG8_MMA(1, 0, At, B0); PG8_MMA(1, 1, At, B1); PG8_BAR; PG8_SCHED;
        }
        if (wr == 0) PG8_BAR;
        E(acc, cur, wr, wc, fr, fq);
        if (!has_next) break;
#pragma unroll
        for (int a = 0; a < 2; ++a)
#pragma unroll
            for (int b = 0; b < 2; ++b)
#pragma unroll
                for (int m = 0; m < 4; ++m)
#pragma unroll
                    for (int n = 0; n < 2; ++n) acc[a][b][m][n] = (f32x4){0.f, 0.f, 0.f, 0.f};
        cur = nxt; cA = nA; cB = nB; ++ui;
        if (wr == 1) PG8_BAR;
    }
    PG8_WAIT_V(0);
    PG8_BAR;
#undef PG8_SA
#undef PG8_SB
#undef PG8_STAGE
#undef PG8_LDA
#undef PG8_LDB
#undef PG8_MMA
#undef PG8_WAIT_V
#undef PG8_WAIT_L
#undef PG8_BAR
#undef PG8_SCHED
}
}
namespace pg8 {
__device__ __forceinline__ u32x4 pack8(const f32x4 a, const f32x4 b) { u32x4 w; w.x = cvt_pk_bf16(a[0], a[1]); w.y = cvt_pk_bf16(a[2], a[3]); w.z = cvt_pk_bf16(b[0], b[1]); w.w = cvt_pk_bf16(b[2], b[3]); return w; }
typedef const f32x4 (&AccRef)[2][2][4][2];

struct EpiPlain {
    static constexpr bool PERM = true;
    bf16* O; int ldc;
    __device__ __forceinline__ void operator()(AccRef acc, const Unit& u, int wr, int wc, int fr, int fq) const {
        const int row0 = u.pm * BM + wr * 64 + fr, col0 = u.pn * BM + wc * 32 + 8 * fq;
#pragma unroll
        for (int ai = 0; ai < 2; ++ai)
#pragma unroll
            for (int m = 0; m < 4; ++m) { bf16* rowp = O + (size_t)(row0 + ai * HALF + m * 16) * ldc + col0;
#pragma unroll
                for (int bj = 0; bj < 2; ++bj) *(u32x4*)(rowp + bj * HALF) = pack8(acc[ai][bj][m][0], acc[ai][bj][m][1]); }
    }
};
struct EpiInProj0 {
    static constexpr bool PERM = true;
    bf16 *QK, *V, *G, *UA; const float *rc, *rs;
    __device__ __forceinline__ void operator()(AccRef acc, const Unit& u, int wr, int wc, int fr, int fq) const {
        const int row0 = u.pm * BM + wr * 64 + fr, pn = u.pn;
        if (pn < 3) {
            const int H = 4 * pn + wc;
#pragma unroll
            for (int ai = 0; ai < 2; ++ai)
#pragma unroll
                for (int m = 0; m < 4; ++m) {
                    const int row = row0 + ai * HALF + m * 16;
                    f32x4 c0 = (f32x4){1.f, 1.f, 1.f, 1.f}, c1 = c0, s0 = (f32x4){0.f, 0.f, 0.f, 0.f}, s1 = s0;
                    if (row < NLAT) { const int pos = row & (SEQ - 1); const float* pc = rc + pos * 32 + 8 * fq; const float* ps = rs + pos * 32 + 8 * fq;
                        c0 = *(const f32x4*)pc; c1 = *(const f32x4*)(pc + 4); s0 = *(const f32x4*)ps; s1 = *(const f32x4*)(ps + 4); }
                    const f32x4 a0 = acc[ai][0][m][0], a1 = acc[ai][0][m][1], b0 = acc[ai][1][m][0], b1 = acc[ai][1][m][1];
                    const f32x4 y10 = a0 * c0 - b0 * s0, y11 = a1 * c1 - b1 * s1, y20 = a0 * s0 + b0 * c0, y21 = a1 * s1 + b1 * c1;
                    bf16* rp = QK + (size_t)row * 768 + H * 64 + 8 * fq;
                    *(u32x4*)rp = pack8(y10, y11); *(u32x4*)(rp + 32) = pack8(y20, y21);
                }
        } else if (pn < 9) {
            bf16* base = pn < 6 ? V : G; const int colt = (pn < 6 ? pn - 3 : pn - 6) * BM + wc * 32 + 8 * fq;
#pragma unroll
            for (int ai = 0; ai < 2; ++ai)
#pragma unroll
                for (int m = 0; m < 4; ++m) { bf16* rowp = base + (size_t)(row0 + ai * HALF + m * 16) * 768 + colt;
#pragma unroll
                    for (int bj = 0; bj < 2; ++bj) *(u32x4*)(rowp + bj * HALF) = pack8(acc[ai][bj][m][0], acc[ai][bj][m][1]); }
        } else {
#pragma unroll
            for (int ai = 0; ai < 2; ++ai)
#pragma unroll
                for (int m = 0; m < 4; ++m) { const int row = row0 + ai * HALF + m * 16;
#pragma unroll
                    for (int bj = 0; bj < 2; ++bj) { const int c = bj * HALF + wc * 32 + 8 * fq, g = c >> 4, p0 = c & 15;
                        *(u32x4*)(UA + ((size_t)g * S5ROWS + (row >> 5)) * 768 + (row & 31) * 16 + p0) = pack8(acc[ai][bj][m][0], acc[ai][bj][m][1]); } }
        }
    }
};
struct EpiS5E {
    static constexpr bool PERM = false;
    float* EO;
    __device__ __forceinline__ void operator()(AccRef acc, const Unit& u, int wr, int wc, int fr, int fq) const {
        const int row0 = u.pm * BM + wr * 64 + fr, col0 = wc * 32 + 4 * fq;
#pragma unroll
        for (int ai = 0; ai < 2; ++ai)
#pragma unroll
            for (int m = 0; m < 4; ++m) { float* rowp = EO + ((size_t)u.z * S5ROWS + row0 + ai * HALF + m * 16) * 256 + col0;
#pragma unroll
                for (int bj = 0; bj < 2; ++bj)
#pragma unroll
                    for (int n = 0; n < 2; ++n) *(f32x4*)(rowp + bj * HALF + n * 16) = acc[ai][bj][m][n]; }
    }
};
struct EpiS5Y {
    static constexpr bool PERM = true;
    bf16* SG;
    __device__ __forceinline__ void operator()(AccRef acc, const Unit& u, int wr, int wc, int fr, int fq) const {
        const int row0 = u.pm * BM + wr * 64 + fr;
#pragma unroll
        for (int ai = 0; ai < 2; ++ai)
#pragma unroll
            for (int m = 0; m < 4; ++m) { const int cr = row0 + ai * HALF + m * 16;
                if (cr < NTOK / S5T) {
#pragma unroll
                    for (int bj = 0; bj < 2; ++bj) { const int cn0 = u.pn * BM + bj * HALF + wc * 32 + 8 * fq, i = cn0 >> 4, p0 = cn0 & 15;
                        f32x4 v0 = acc[ai][bj][m][0], v1 = acc[ai][bj][m][1];
#pragma unroll
                        for (int j = 0; j < 4; ++j) { v0[j] = gelu_tanh(v0[j]); v1[j] = gelu_tanh(v1[j]); }
                        *(u32x4*)(SG + (size_t)(cr * S5T + i) * 256 + u.z * 16 + p0) = pack8(v0, v1); } } }
    }
};
struct EpiGlu {
    static constexpr bool PERM = true;
    bf16* MRG;
    __device__ __forceinline__ void operator()(AccRef acc, const Unit& u, int wr, int wc, int fr, int fq) const {
        const int row0 = u.pm * BM + wr * 64 + fr, col0 = 768 + u.pn * HALF + wc * 32 + 8 * fq;
#pragma unroll
        for (int ai = 0; ai < 2; ++ai)
#pragma unroll
            for (int m = 0; m < 4; ++m) { f32x4 v0, v1;
#pragma unroll
                for (int j = 0; j < 4; ++j) { v0[j] = acc[ai][0][m][0][j] * fast_sigmoid(acc[ai][1][m][0][j]); v1[j] = acc[ai][0][m][1][j] * fast_sigmoid(acc[ai][1][m][1][j]); }
                *(u32x4*)(MRG + (size_t)(row0 + ai * HALF + m * 16) * 1024 + col0) = pack8(v0, v1); }
    }
};
struct EpiSwiGlu {
    static constexpr bool PERM = true;
    bf16* HID;
    __device__ __forceinline__ void operator()(AccRef acc, const Unit& u, int wr, int wc, int fr, int fq) const {
        const int row0 = u.pm * BM + wr * 64 + fr, col0 = u.pn * HALF + wc * 32 + 8 * fq;
#pragma unroll
        for (int ai = 0; ai < 2; ++ai)
#pragma unroll
            for (int m = 0; m < 4; ++m) { f32x4 v0, v1;
#pragma unroll
                for (int j = 0; j < 4; ++j) { v0[j] = fast_silu(acc[ai][0][m][0][j]) * acc[ai][1][m][0][j]; v1[j] = fast_silu(acc[ai][0][m][1][j]) * acc[ai][1][m][1][j]; }
                *(u32x4*)(HID + (size_t)(row0 + ai * HALF + m * 16) * 1024 + col0) = pack8(v0, v1); }
    }
};
struct EpiInProj1 {
    static constexpr bool PERM = true;
    bf16 *Q, *Kb, *Vb; const float* rope;
    __device__ __forceinline__ void operator()(AccRef acc, const Unit& u, int wr, int wc, int fr, int fq) const {
        const int row0 = u.pm * BM + wr * 64 + fr, pn = u.pn;
#pragma unroll
        for (int ai = 0; ai < 2; ++ai)
#pragma unroll
            for (int m = 0; m < 4; ++m) {
                const int row = row0 + ai * HALF + m * 16;
                const bool lat = row < NLAT;
                const int b = lat ? (row >> 13) : ((row - NLAT) >> 8), t = lat ? (row & (SEQ - 1)) : ((row - NLAT) & 255);
                const size_t krow = (size_t)b * (SEQ + CTXL) + (lat ? t : SEQ + t);
                if (pn < 8) {
                    const int sh = 4 * (pn & 3) + wc;
                    f32x4 c0 = (f32x4){1.f, 1.f, 1.f, 1.f}, c1 = c0, s0 = (f32x4){0.f, 0.f, 0.f, 0.f}, s1 = s0;
                    if (lat) { const int pos = (fq < 2) ? (t >> 6) : (t & 63); const float* pc = rope + pos * 16 + 8 * (fq & 1);
                        c0 = *(const f32x4*)pc; c1 = *(const f32x4*)(pc + 4); s0 = *(const f32x4*)(pc + 2048); s1 = *(const f32x4*)(pc + 2048 + 4); }
                    const f32x4 a0 = acc[ai][0][m][0], a1 = acc[ai][0][m][1], b0 = acc[ai][1][m][0], b1 = acc[ai][1][m][1];
                    const f32x4 y10 = a0 * c0 - b0 * s0, y11 = a1 * c1 - b1 * s1, y20 = a0 * s0 + b0 * c0, y21 = a1 * s1 + b1 * c1;
                    const int dim = (fq < 2 ? 0 : 32) + 8 * (fq & 1);
                    bf16* rp = (pn < 4) ? (Q + (size_t)row * 1024) : (Kb + krow * 1024);
                    rp += sh * 64 + dim;
                    if (pn >= 4 || lat) { *(u32x4*)rp = pack8(y10, y11); *(u32x4*)(rp + 16) = pack8(y20, y21); }
                } else {
                    bf16* rp = Vb + krow * 1024 + (pn - 8) * BM + wc * 32 + 8 * fq;
#pragma unroll
                    for (int bj = 0; bj < 2; ++bj) *(u32x4*)(rp + bj * HALF) = pack8(acc[ai][bj][m][0], acc[ai][bj][m][1]);
                }
            }
    }
};
}
enum InIdx { I_X = 0, I_C, I_CTX, I_CCTX, I_ADAW, I_ADAB, I_LNG, I_WINAB, I_DECAY, I_LAMRE, I_LAMIM, I_LOGDT, I_BRE, I_BIM, I_CRE, I_CIM, I_S5D, I_WGLU,
             I_WOUTAB, I_WINC, I_DLAM, I_SUBLN, I_WOUTC, I_RW, I_RB, I_EG, I_EU, I_ED, N_IN };
struct Params { const float* in[N_IN]; float* out; unsigned char* ws; int ph_lo, ph_hi; };
#if defined(__HIP_DEVICE_COMPILE__)
#define CAS __attribute__((address_space(4)))
#else
#define CAS
#endif
typedef const CAS Params& PR;

struct Frame {
    LAS unsigned char* lds; int tid, lane, wave, G, bid, vcu;
};
#define WSP(T, off) ((T*)(p.ws + (off)))

__device__ __forceinline__ void p0_gemv_item(PR p, Frame& F, int item) {
    LAS float* sc = (LAS float*)F.lds;
    LAS float* red = (LAS float*)(F.lds + 20480);
    const float* c = p.in[I_C]; const float* cctx = p.in[I_CCTX];
    for (int i = F.tid; i < 5120; i += NTHREADS) { const int r = i >> 10, k = i & 1023; const float v = r < 4 ? c[r * 1024 + k] : cctx[k]; sc[i] = v / (1.f + expf(-v)); }
    __syncthreads();
    const int l = item / 96, cb = item % 96, jj = F.tid & 63, kp = F.tid >> 6;
    const float* W = p.in[I_ADAW] + (size_t)l * 1024 * 6144 + cb * 64 + jj;
    float a0 = 0.f, a1 = 0.f, a2 = 0.f, a3 = 0.f, a4 = 0.f;
#pragma unroll 16
    for (int k = kp * 128; k < kp * 128 + 128; ++k) { const float w = W[(size_t)k * 6144]; a0 += sc[k] * w; a1 += sc[1024 + k] * w; a2 += sc[2048 + k] * w; a3 += sc[3072 + k] * w; a4 += sc[4096 + k] * w; }
    red[(kp * 5 + 0) * 64 + jj] = a0; red[(kp * 5 + 1) * 64 + jj] = a1; red[(kp * 5 + 2) * 64 + jj] = a2; red[(kp * 5 + 3) * 64 + jj] = a3; red[(kp * 5 + 4) * 64 + jj] = a4;
    __syncthreads();
    if (F.tid < 320) { const int r = F.tid >> 6, j = F.tid & 63; float s = 0.f;
#pragma unroll
        for (int q = 0; q < 8; ++q) s += red[(q * 5 + r) * 64 + j];
        WSP(float, WS_MOD)[(l * 5 + r) * 6144 + cb * 64 + j] = s + p.in[I_ADAB][l * 6144 + cb * 64 + j]; }
    __syncthreads();
}
__device__ __forceinline__ void p0_s5_item(PR p, Frame& F, int item) {
    const int g = item >> 1, dir = item & 1;
    LAS f32x2* lamp = (LAS f32x2*)F.lds;
    LAS f32x2* coef = lamp + 64 * 33;
    const float dt = expf(p.in[I_LOGDT][dir * 16 + g]);
    for (int i = F.tid; i < 64 * 33; i += NTHREADS) { const int n = i / 33, tau = i % 33;
        const float re = p.in[I_LAMRE][(dir * 16 + g) * 64 + n], im = p.in[I_LAMIM][(dir * 16 + g) * 64 + n];
        const float mag = expf(re * dt * (float)tau); float s, c; sincos_rev((double)im * (double)dt * (double)tau * 0.15915494309189535, s, c);
        const f32x2 v = (f32x2){mag * c, mag * s}; lamp[i] = v; WSP(f32x2, WS_LAMP)[((g * 2 + dir) * 64 + n) * 33 + tau] = v; }
    __syncthreads();
    if (F.tid < 64) { const int n = F.tid; const float re = p.in[I_LAMRE][(dir * 16 + g) * 64 + n], im = p.in[I_LAMIM][(dir * 16 + g) * 64 + n];
        const f32x2 lb = lamp[n * 33 + 1]; const float a = lb.x - 1.f, b = lb.y, den = re * re + im * im;
        const f32x2 v = (f32x2){(a * re + b * im) / den, (b * re - a * im) / den}; coef[n] = v; WSP(f32x2, WS_COEF)[(g * 2 + dir) * 64 + n] = v; }
    __syncthreads();
    const float* bre = p.in[I_BRE] + (size_t)(dir * 16 + g) * 64 * 16; const float* bim = p.in[I_BIM] + (size_t)(dir * 16 + g) * 64 * 16;
    const float* cre = p.in[I_CRE] + (size_t)(dir * 16 + g) * 16 * 64; const float* cim = p.in[I_CIM] + (size_t)(dir * 16 + g) * 16 * 64;
    for (int idx = F.tid; idx < 32 * 256; idx += NTHREADS) { const int tau = idx >> 8, pp = (idx >> 4) & 15, q = idx & 15; float acc = 0.f;
        for (int n = 0; n < 64; ++n) { const f32x2 w = cmul(lamp[n * 33 + tau], coef[n]); const f32x2 bb = cmul(w, (f32x2){bre[n * 16 + q], bim[n * 16 + q]});
            acc += cre[pp * 64 + n] * bb.x - cim[pp * 64 + n] * bb.y; }
        WSP(float, WS_S5K)[((g * 2 + dir) * 32 + tau) * 256 + pp * 16 + q] = acc; }
    __syncthreads();
}
__device__ __forceinline__ int tr_drow(int mode, int n) {
    switch (mode) {
    case 1: if (n < 768) { const int H = n >> 6, half = (n >> 5) & 1, dd = n & 31; return (H >> 2) * 256 + half * 128 + (H & 3) * 32 + dd; } return n;
    case 2: if (n < 2048) { const int base = n & ~1023, c = n & 1023, sh = c >> 6, grp = (c >> 4) & 3; return base + (sh >> 2) * 256 + (grp & 1) * 128 + (sh & 3) * 32 + (grp >> 1) * 16 + (c & 15); } return n;
    case 3: return ((n & 255) >> 7) * 256 + (n >> 8) * 128 + (n & 127);
    case 4: return (n >> 7) * 256 + (n & 127);
    case 5: return (n >> 7) * 256 + 128 + (n & 127);
    default: return n; }
}
__device__ __forceinline__ float tr_scale(int mode, int n) { if (mode == 1) return (n >= 384 && n < 768) ? 0.125f : 1.f; if (mode == 2) return n < 1024 ? 0.125f : 1.f; return 1.f; }
__device__ __forceinline__ void p0_transpose_item(const float* W, int K, int N, bf16* WT, int mode, LAS float* scr, int item, int lane) {
    const int nblk = N / 32, kb = item / nblk, nb = item % nblk, k0 = 64 * kb, n0 = 32 * nb;
    const float sca = tr_scale(mode, n0);
#pragma unroll 8
    for (int i = 0; i < 32; ++i) { const int kk = 2 * i + (lane >> 5); scr[kk * 33 + (lane & 31)] = W[(size_t)(k0 + kk) * N + n0 + (lane & 31)] * sca; }
    asm volatile("s_waitcnt lgkmcnt(0)" ::: "memory");
    const int c = lane & 7;
#pragma unroll
    for (int j = 0; j < 4; ++j) { const int n = (lane >> 3) + 8 * j; const LAS float* s = scr + (8 * c) * 33 + n;
        u32x4 o; o.x = cvt_pk_bf16(s[0 * 33], s[1 * 33]); o.y = cvt_pk_bf16(s[2 * 33], s[3 * 33]); o.z = cvt_pk_bf16(s[4 * 33], s[5 * 33]); o.w = cvt_pk_bf16(s[6 * 33], s[7 * 33]);
        *(u32x4*)(WT + (size_t)tr_drow(mode, n0 + n) * K + k0 + 8 * c) = o; }
    asm volatile("s_waitcnt lgkmcnt(0)" ::: "memory");
}
__device__ __forceinline__ void p0a_prologue(PR p, Frame& F) {
    for (int it = F.bid; it < 224; it += F.G) { if (it < 192) p0_gemv_item(p, F, it); else p0_s5_item(p, F, it - 192); }
    LAS float* scr = (LAS float*)(F.lds + F.wave * 16384);
    const int gw = F.vcu * NWAVES + F.wave, NGW = F.G * NWAVES;
    constexpr int T0 = 1280, T1 = T0 + 64, T2 = T1 + 512, T3 = T2 + 1536, T4 = T3 + 512, T5 = T4 + 49152;
    for (int it = gw; it < T5; it += NGW) {
        if (it < T0) p0_transpose_item(p.in[I_WINAB], 1024, 2560, WSP(bf16, WS_WIN0), 1, scr, it, F.lane);
        else if (it < T1) p0_transpose_item(p.in[I_WGLU], 256, 512, WSP(bf16, WS_WGLU), 3, scr, it - T0, F.lane);
        else if (it < T2) p0_transpose_item(p.in[I_WOUTAB], 1024, 1024, WSP(bf16, WS_WOUT0), 0, scr, it - T1, F.lane);
        else if (it < T3) p0_transpose_item(p.in[I_WINC], 1024, 3072, WSP(bf16, WS_WIN1), 2, scr, it - T2, F.lane);
        else if (it < T4) p0_transpose_item(p.in[I_WOUTC], 1024, 1024, WSP(bf16, WS_WOUT1), 0, scr, it - T3, F.lane);
        else { const int r = it - T4, le = r / 1536, r1 = r % 1536, which = r1 / 512, r2 = r1 % 512;
            const float* src = p.in[which == 0 ? I_EG : (which == 1 ? I_EU : I_ED)] + (size_t)le * 1024 * 1024;
            bf16* dst = (bf16*)(p.ws + WS_EXP + (size_t)le * EXP_STRIDE + (which == 2 ? EXP_DN : 0));
            p0_transpose_item(src, 1024, 1024, dst, which == 0 ? 4 : (which == 1 ? 5 : 0), scr, r2, F.lane); }
    }
    const int gt = F.bid * NTHREADS + F.tid, NGT = F.G * NTHREADS;
    for (int i = gt; i < SEQ * 32 + 128 * 16 + 1; i += NGT) {
        if (i < SEQ * 32) { const int pos = i >> 5, k = i & 31; const float inv = powf(10000.f, -(float)(2 * k) / 64.f); const float ang = (float)pos * inv; float s, c; sincos_rev((double)ang * 0.15915494309189535, s, c);
            WSP(float, WS_ROPE0C)[i] = c; WSP(float, WS_ROPE0S)[i] = s; }
        else if (i < SEQ * 32 + 2048) { const int j = i - SEQ * 32, pos = j >> 4, k = j & 15; const float inv = powf(10000.f, -(float)(2 * k) / 32.f); const float ang = (float)pos * inv; float s, c; sincos_rev((double)ang * 0.15915494309189535, s, c);
            WSP(float, WS_ROPE1)[j] = c; WSP(float, WS_ROPE1)[2048 + j] = s; }
        else { const float* dl = p.in[I_DLAM]; float s0 = 0.f, s1 = 0.f; for (int k = 0; k < 64; ++k) { s0 += dl[k] * dl[64 + k]; s1 += dl[128 + k] * dl[192 + k]; }
            WSP(float, WS_SCAL)[0] = expf(s0) - expf(s1) + LAMBDA_INIT; }
    }
}

__device__ __forceinline__ void modulate_row(const float* xrow, const float* shift, const float* scale, bf16* orow, int lane) {
#pragma unroll
    for (int j = 0; j < 4; ++j) { const int c = 4 * lane + 256 * j; const f32x4 x = *(const f32x4*)(xrow + c), sh = *(const f32x4*)(shift + c), sc = *(const f32x4*)(scale + c);
        const f32x4 h = x * (sc + 1.f) + sh; u32x2 w; w.x = cvt_pk_bf16(h[0], h[1]); w.y = cvt_pk_bf16(h[2], h[3]); *(u32x2*)(orow + c) = w; }
}
__device__ __forceinline__ void p0b_phase(PR p, Frame& F) {
    const int gw = F.vcu * NWAVES + F.wave, NGW = F.G * NWAVES;
    const float* mod = WSP(float, WS_MOD);
    bf16* H0 = WSP(bf16, A_H0);
    for (int r = gw; r < NTOK; r += NGW) { const bool lat = r < NLAT; const int b = lat ? (r >> 13) : 4;
        const float* xr = lat ? p.in[I_X] + (size_t)r * DM : p.in[I_CTX] + (size_t)(r - NLAT) * DM;
        modulate_row(xr, mod + b * 6144, mod + b * 6144 + 1024, H0 + (size_t)r * DM, F.lane); }
    const int gt = F.bid * NTHREADS + F.tid, NGT = F.G * NTHREADS;
    const float* S5K = WSP(float, WS_S5K); const f32x2* LAMP = WSP(f32x2, WS_LAMP); const f32x2* COEF = WSP(f32x2, WS_COEF);
    bf16* BT2 = WSP(bf16, WS_BT2); bf16* BT1 = WSP(bf16, WS_BT1);
    for (int idx = gt; idx < 16 * 512 * 96; idx += NGT) {
        const int g = idx / (512 * 96), n = (idx / 96) % 512, k0 = (idx % 96) * 8, i = n >> 4, pp = n & 15; float v[8];
        if (k0 < 512) { const int j = k0 >> 4, q0 = k0 & 15;
#pragma unroll
            for (int t = 0; t < 8; ++t) { const int q = q0 + t; float x;
                if (i > j) x = S5K[((g * 2 + 0) * 32 + (i - j)) * 256 + pp * 16 + q];
                else if (i < j) x = S5K[((g * 2 + 1) * 32 + (j - i)) * 256 + pp * 16 + q];
                else x = S5K[((g * 2 + 0) * 32) * 256 + pp * 16 + q] + S5K[((g * 2 + 1) * 32) * 256 + pp * 16 + q] + (pp == q ? p.in[I_S5D][g * 16 + pp] : 0.f);
                v[t] = x; }
        } else { const int kk0 = k0 - 512, dir = kk0 >> 7, ri = (kk0 >> 6) & 1, nn0 = kk0 & 63, pw = dir == 0 ? i + 1 : S5T - i;
#pragma unroll
            for (int t = 0; t < 8; ++t) { const int nn = nn0 + t; const f32x2 cc = (f32x2){p.in[I_CRE][((dir * 16 + g) * 16 + pp) * 64 + nn], p.in[I_CIM][((dir * 16 + g) * 16 + pp) * 64 + nn]};
                const f32x2 w = cmul(cc, LAMP[((g * 2 + dir) * 64 + nn) * 33 + pw]); v[t] = ri == 0 ? w.x : -w.y; }
        }
        u32x4 o; o.x = cvt_pk_bf16(v[0], v[1]); o.y = cvt_pk_bf16(v[2], v[3]); o.z = cvt_pk_bf16(v[4], v[5]); o.w = cvt_pk_bf16(v[6], v[7]);
        *(u32x4*)(BT2 + ((size_t)g * 512 + n) * 768 + k0) = o;
    }
    for (int idx = gt; idx < 16 * 256 * 64; idx += NGT) {
        const int g = idx / (256 * 64), n = (idx / 64) % 256, k0 = (idx % 64) * 8, j = k0 >> 4, q0 = k0 & 15, dir = n >> 7, ri = (n >> 6) & 1, nn = n & 63, pw = dir == 0 ? (S5T - 1 - j) : j;
        const f32x2 w = cmul(LAMP[((g * 2 + dir) * 64 + nn) * 33 + pw], COEF[(g * 2 + dir) * 64 + nn]); float v[8];
#pragma unroll
        for (int t = 0; t < 8; ++t) { const int q = q0 + t; const f32x2 bb = cmul(w, (f32x2){p.in[I_BRE][((dir * 16 + g) * 64 + nn) * 16 + q], p.in[I_BIM][((dir * 16 + g) * 64 + nn) * 16 + q]}); v[t] = ri == 0 ? bb.x : bb.y; }
        u32x4 o; o.x = cvt_pk_bf16(v[0], v[1]); o.y = cvt_pk_bf16(v[2], v[3]); o.z = cvt_pk_bf16(v[4], v[5]); o.w = cvt_pk_bf16(v[6], v[7]);
        *(u32x4*)(BT1 + ((size_t)g * 256 + n) * 512 + k0) = o;
    }
}
__device__ __forceinline__ void ret_unit(int unit, int& bh, int& h, int& r0) {
    const int cch = unit % RNCH; bh = unit / RNCH; h = bh % RH; const int b = bh / RH;
    r0 = cch < 64 ? b * SEQ + cch * RC : NLAT + b * CTXL + (cch - 64) * RC;
}
__device__ __forceinline__ float log_gamma(PR p, int dir, int h) { const float x = p.in[I_DECAY][dir * RH + h]; return -log1pf(expf(-x)); }
constexpr int RT_LD = 136;
__device__ __forceinline__ void ret_stage_vt(const bf16* V, int r0, int h, LAS bf16* VT, int tid) {
#pragma unroll
    for (int i = 0; i < 4; ++i) { const int id = tid + 512 * i, j = id >> 4, e0 = (id & 15) * 8;
        const u32x4 raw = *(const u32x4*)(V + (size_t)(r0 + j) * 768 + h * 128 + e0);
        VT[(e0 + 0) * RT_LD + j] = (bf16)(raw.x & 0xffffu); VT[(e0 + 1) * RT_LD + j] = (bf16)(raw.x >> 16);
        VT[(e0 + 2) * RT_LD + j] = (bf16)(raw.y & 0xffffu); VT[(e0 + 3) * RT_LD + j] = (bf16)(raw.y >> 16);
        VT[(e0 + 4) * RT_LD + j] = (bf16)(raw.z & 0xffffu); VT[(e0 + 5) * RT_LD + j] = (bf16)(raw.z >> 16);
        VT[(e0 + 6) * RT_LD + j] = (bf16)(raw.w & 0xffffu); VT[(e0 + 7) * RT_LD + j] = (bf16)(raw.w >> 16); }
}
__device__ __forceinline__ void ret_states_phase(PR p, Frame& F, int first_unit_shift) {
    LAS bf16* KdTf = (LAS bf16*)F.lds; LAS bf16* KdTb = KdTf + 64 * RT_LD; LAS bf16* VT = KdTb + 64 * RT_LD;
    const bf16* QK = WSP(bf16, A_QK); const bf16* V = WSP(bf16, A_V); float* RT = p.out;
    const int w = F.wave, fr = F.lane & 15, fq = F.lane >> 4;
    for (int unit = (F.bid + first_unit_shift) % F.G; unit < NBATCH * RH * RNCH; unit += F.G) {
        int bh, h, r0; ret_unit(unit, bh, h, r0);
        const float lgf = log_gamma(p, 0, h), lgb = log_gamma(p, 1, h);
#pragma unroll
        for (int i = 0; i < 2; ++i) { const int id = F.tid + 512 * i, j = id >> 3, d0 = (id & 7) * 8;
            const u32x4 raw = *(const u32x4*)(QK + (size_t)(r0 + j) * 768 + (RH + h) * 64 + d0);
            const float df = expf(lgf * (float)(RC - 1 - j)), db = expf(lgb * (float)j);
            const unsigned wv[4] = {raw.x, raw.y, raw.z, raw.w};
#pragma unroll
            for (int t = 0; t < 4; ++t) { const float k0 = bflo(wv[t]), k1 = bfhi(wv[t]);
                KdTf[(d0 + 2 * t) * RT_LD + j] = (bf16)f2bf(k0 * df); KdTf[(d0 + 2 * t + 1) * RT_LD + j] = (bf16)f2bf(k1 * df);
                KdTb[(d0 + 2 * t) * RT_LD + j] = (bf16)f2bf(k0 * db); KdTb[(d0 + 2 * t + 1) * RT_LD + j] = (bf16)f2bf(k1 * db); } }
        ret_stage_vt(V, r0, h, VT, F.tid);
        __syncthreads();
        const int dir = w >> 2; const LAS bf16* KdT = dir ? KdTb : KdTf;
        f32x4 acc[2][4];
#pragma unroll
        for (int a = 0; a < 2; ++a)
#pragma unroll
            for (int d = 0; d < 4; ++d) acc[a][d] = (f32x4){0.f, 0.f, 0.f, 0.f};
#pragma unroll
        for (int ks = 0; ks < 4; ++ks) { bf16x8 af[2], bfr[4];
#pragma unroll
            for (int a = 0; a < 2; ++a) af[a] = *(const LAS bf16x8*)(VT + (((w & 3) * 2 + a) * 16 + fr) * RT_LD + 32 * ks + 8 * fq);
#pragma unroll
            for (int d = 0; d < 4; ++d) bfr[d] = *(const LAS bf16x8*)(KdT + (d * 16 + fr) * RT_LD + 32 * ks + 8 * fq);
#pragma unroll
            for (int a = 0; a < 2; ++a)
#pragma unroll
                for (int d = 0; d < 4; ++d) acc[a][d] = __builtin_amdgcn_mfma_f32_16x16x32_bf16(af[a], bfr[d], acc[a][d], 0, 0, 0); }
        float* out = RT + ((size_t)unit * 2 + dir) * 8192;
#pragma unroll
        for (int a = 0; a < 2; ++a)
#pragma unroll
            for (int d = 0; d < 4; ++d)
#pragma unroll
                for (int jj = 0; jj < 4; ++jj) out[(((w & 3) * 2 + a) * 16 + 4 * fq + jj) * 64 + d * 16 + fr] = acc[a][d][jj];
        __syncthreads();
    }
}
__device__ __forceinline__ void ret_scan_phase(PR p, Frame& F) {
    const float* RT = p.out; unsigned* TT = WSP(unsigned, A_TT);
    for (int it = F.bid; it < 48 * 8; it += F.G) {
        const int chain = it >> 3, slice = it & 7, dir = chain & 1, bh = chain >> 1, h = bh % RH;
        const int el = (slice * 512 + F.tid) * 2;
        const float gC = expf(log_gamma(p, dir, h) * (float)RC);
        f32x2 st = (f32x2){0.f, 0.f};
        for (int s0 = 0; s0 < RNCH; s0 += 11) {
            f32x2 r[11];
#pragma unroll
            for (int k = 0; k < 11; ++k) { const int s = s0 + k, cch = dir == 0 ? (s < 2 ? 64 + s : s - 2) : (65 - s);
                r[k] = *(const f32x2*)(RT + ((size_t)(bh * RNCH + cch) * 2 + dir) * 8192 + el); }
#pragma unroll
            for (int k = 0; k < 11; ++k) { const int s = s0 + k, cch = dir == 0 ? (s < 2 ? 64 + s : s - 2) : (65 - s);
                TT[(((size_t)(bh * RNCH + cch) * 2 + dir) * 8192 + el) >> 1] = cvt_pk_bf16(st.x, st.y);
                st = st * gC + r[k]; }
        }
    }
}
__device__ __forceinline__ void s5_scan_phase(PR p, Frame& F) {
    const float* EO = WSP(float, A_EO); bf16* UA = WSP(bf16, A_UA); const f32x2* LAMP = WSP(f32x2, WS_LAMP);
    if (F.wave != 0) return;
    for (int it = F.bid; it < 128; it += F.G) {
        const int b = it >> 5, g = (it >> 1) & 15, dir = it & 1, n = F.lane;
        const f32x2 lamT = LAMP[((g * 2 + dir) * 64 + n) * 33 + S5T];
        f32x2 st = (f32x2){0.f, 0.f};
        for (int s0 = 0; s0 < 264; s0 += 8) {
            f32x2 e[8];
#pragma unroll
            for (int k = 0; k < 8; ++k) { const int s = s0 + k;
                const int row = dir == 0 ? (s < 8 ? 1024 + b * 8 + s : b * 256 + (s - 8)) : (s < 8 ? 1024 + b * 8 + (7 - s) : b * 256 + (263 - s));
                const float* er = EO + ((size_t)g * S5ROWS + row) * 256 + dir * 128 + n; e[k] = (f32x2){er[0], er[64]}; }
#pragma unroll
            for (int k = 0; k < 8; ++k) { const int s = s0 + k;
                const int row = dir == 0 ? (s < 8 ? 1024 + b * 8 + s : b * 256 + (s - 8)) : (s < 8 ? 1024 + b * 8 + (7 - s) : b * 256 + (263 - s));
                bf16* ur = UA + ((size_t)g * S5ROWS + row) * 768 + 512 + dir * 128 + n; ur[0] = (bf16)f2bf(st.x); ur[64] = (bf16)f2bf(st.y);
                st = cmul(lamT, st) + e[k]; }
        }
    }
}
__device__ __forceinline__ void ret_out_phase(PR p, Frame& F, int first_unit_shift) {
    LAS bf16* VT = (LAS bf16*)F.lds; LAS bf16* Pw = VT + 128 * RT_LD + F.wave * 16 * RT_LD;
    const bf16* QK = WSP(bf16, A_QK); const bf16* V = WSP(bf16, A_V); const bf16* Gb = WSP(bf16, A_G); const bf16* TT = WSP(bf16, A_TT); bf16* MRG = WSP(bf16, A_MRG);
    const int w = F.wave, fr = F.lane & 15, fq = F.lane >> 4, i0 = 16 * w;
    for (int unit = (F.bid + first_unit_shift) % F.G; unit < NBATCH * RH * RNCH; unit += F.G) {
        int bh, h, r0; ret_unit(unit, bh, h, r0);
        const float lgf = log_gamma(p, 0, h), lgb = log_gamma(p, 1, h);
        ret_stage_vt(V, r0, h, VT, F.tid);
        bf16x8 aq[2];
#pragma unroll
        for (int ks = 0; ks < 2; ++ks) aq[ks] = *(const bf16x8*)(QK + (size_t)(r0 + i0 + fr) * 768 + h * 64 + 32 * ks + 8 * fq);
#pragma unroll
        for (int jt = 0; jt < 8; ++jt) { f32x4 s = (f32x4){0.f, 0.f, 0.f, 0.f};
#pragma unroll
            for (int ks = 0; ks < 2; ++ks) { const bf16x8 bk = *(const bf16x8*)(QK + (size_t)(r0 + 16 * jt + fr) * 768 + (RH + h) * 64 + 32 * ks + 8 * fq);
                s = __builtin_amdgcn_mfma_f32_16x16x32_bf16(aq[ks], bk, s, 0, 0, 0); }
#pragma unroll
            for (int jj = 0; jj < 4; ++jj) { const int dl = (i0 + 4 * fq + jj) - (16 * jt + fr);
                const float dec = dl >= 0 ? expf(lgf * (float)dl) : expf(lgb * (float)(-dl));
                Pw[(4 * fq + jj) * RT_LD + 16 * jt + fr] = (bf16)f2bf(s[jj] * dec); } }
        __syncthreads();
        f32x4 o[8];
#pragma unroll
        for (int et = 0; et < 8; ++et) o[et] = (f32x4){0.f, 0.f, 0.f, 0.f};
#pragma unroll
        for (int ks = 0; ks < 4; ++ks) { const bf16x8 ap = *(const LAS bf16x8*)(Pw + fr * RT_LD + 32 * ks + 8 * fq);
#pragma unroll
            for (int et = 0; et < 8; ++et) { const bf16x8 bv = *(const LAS bf16x8*)(VT + (16 * et + fr) * RT_LD + 32 * ks + 8 * fq);
                o[et] = __builtin_amdgcn_mfma_f32_16x16x32_bf16(ap, bv, o[et], 0, 0, 0); } }
#pragma unroll
        for (int dir = 0; dir < 2; ++dir) { const bf16* TTp = TT + ((size_t)unit * 2 + dir) * 8192; float qd[4];
#pragma unroll
            for (int jj = 0; jj < 4; ++jj) { const int i = i0 + 4 * fq + jj; qd[jj] = dir == 0 ? expf(lgf * (float)(i + 1)) : expf(lgb * (float)(RC - i)); }
#pragma unroll
            for (int et = 0; et < 8; ++et) { f32x4 t = (f32x4){0.f, 0.f, 0.f, 0.f};
#pragma unroll
                for (int ks = 0; ks < 2; ++ks) { const bf16x8 bt = *(const bf16x8*)(TTp + (16 * et + fr) * 64 + 32 * ks + 8 * fq);
                    t = __builtin_amdgcn_mfma_f32_16x16x32_bf16(aq[ks], bt, t, 0, 0, 0); }
#pragma unroll
                for (int jj = 0; jj < 4; ++jj) o[et][jj] += qd[jj] * t[jj]; } }
#pragma unroll
        for (int jj = 0; jj < 4; ++jj) { float s = 0.f;
#pragma unroll
            for (int et = 0; et < 8; ++et) s += o[et][jj];
            s += __shfl_xor(s, 1); s += __shfl_xor(s, 2); s += __shfl_xor(s, 4); s += __shfl_xor(s, 8);
            const float mu = s * (1.f / 128.f); float q = 0.f;
#pragma unroll
            for (int et = 0; et < 8; ++et) { const float d = o[et][jj] - mu; q += d * d; }
            q += __shfl_xor(q, 1); q += __shfl_xor(q, 2); q += __shfl_xor(q, 4); q += __shfl_xor(q, 8);
            const float rstd = 1.f / sqrtf(q * (1.f / 128.f) + GN_EPS);
            const size_t tok = (size_t)(r0 + i0 + 4 * fq + jj);
#pragma unroll
            for (int et = 0; et < 8; ++et) { const int col = h * 128 + 16 * et + fr; const float gv = bf2f(Gb[tok * 768 + col]);
                MRG[tok * 1024 + col] = (bf16)f2bf((o[et][jj] - mu) * rstd * (gv / (1.f + __expf(-gv)))); } }
        __syncthreads();
    }
}
struct RouteRec { int e0, e1, rk0, rk1; float w0, w1; int d0, d1; };

__device__ __forceinline__ float* xs_row(PR p, int r) { return r < NLAT ? p.out + (size_t)r * DM : WSP(float, WS_XC) + (size_t)(r - NLAT) * DM; }

template <int LAYER>
__device__ __forceinline__ void ln1_router_phase(PR p, Frame& F, const bf16* O, bf16* H2, int nrows) {
    LAS float* rw = (LAS float*)F.lds;
    LAS unsigned* lcnt = (LAS unsigned*)(F.lds + 65536);
    for (int i = F.tid; i < 1024 * 16 / 4; i += NTHREADS) { const f32x4 w4 = ((const f32x4*)p.in[I_RW])[i]; const int col = i >> 2, e0 = (i & 3) * 4;
        rw[(e0 + 0) * 1024 + col] = w4[0]; rw[(e0 + 1) * 1024 + col] = w4[1]; rw[(e0 + 2) * 1024 + col] = w4[2]; rw[(e0 + 3) * 1024 + col] = w4[3]; }
    if (F.tid < 16) lcnt[F.tid] = 0u;
    __syncthreads();
    const float* mod = WSP(float, WS_MOD) + LAYER * 5 * 6144;
    const float* lng = p.in[I_LNG] + (LAYER * 2 + 0) * DM;
    RouteRec* route = WSP(RouteRec, WS_ROUTE);
    const int rpb = (nrows + F.G - 1) / F.G, rbeg = F.bid * rpb, rend = (rbeg + rpb < nrows) ? rbeg + rpb : nrows;
    const int lane = F.lane;
    for (int r = rbeg + F.wave; r < rend; r += NWAVES) {
        const bool lat = r < NLAT; const int b = lat ? (r >> 13) : 4;
        const float* xin = (LAYER == 0) ? (lat ? p.in[I_X] + (size_t)r * DM : p.in[I_CTX] + (size_t)(r - NLAT) * DM) : xs_row(p, r);
        const float* mb = mod + b * 6144;
        f32x4 v[4]; float s = 0.f;
#pragma unroll
        for (int j = 0; j < 4; ++j) { const int c = 4 * lane + 256 * j; const f32x4 x = *(const f32x4*)(xin + c), g1 = *(const f32x4*)(mb + 2048 + c);
            const u32x2 ow = *(const u32x2*)(O + (size_t)r * DM + c); const f32x4 o = (f32x4){bflo(ow.x), bfhi(ow.x), bflo(ow.y), bfhi(ow.y)};
            v[j] = x * ALPHA + g1 * o; s += (v[j][0] + v[j][1]) + (v[j][2] + v[j][3]); }
        const float mean = wave_sum(s) * (1.f / DM); float q = 0.f;
#pragma unroll
        for (int j = 0; j < 4; ++j) { v[j] = v[j] - mean; q += (v[j][0] * v[j][0] + v[j][1] * v[j][1]) + (v[j][2] * v[j][2] + v[j][3] * v[j][3]); }
        const float rstd = 1.f / sqrtf(wave_sum(q) * (1.f / DM) + LN_EPS);
        float* xo = xs_row(p, r);
        float lg[16];
#pragma unroll
        for (int e = 0; e < 16; ++e) lg[e] = 0.f;
#pragma unroll
        for (int j = 0; j < 4; ++j) { const int c = 4 * lane + 256 * j; const f32x4 gn = *(const f32x4*)(lng + c), sh = *(const f32x4*)(mb + 3072 + c), sc = *(const f32x4*)(mb + 4096 + c);
            const f32x4 x1 = v[j] * rstd * gn; *(f32x4*)(xo + c) = x1;
            const f32x4 h = x1 * (sc + 1.f) + sh; u32x2 w; w.x = cvt_pk_bf16(h[0], h[1]); w.y = cvt_pk_bf16(h[2], h[3]); *(u32x2*)(H2 + (size_t)r * DM + c) = w;
#pragma unroll
            for (int e = 0; e < 16; ++e) { const f32x4 wv = *(const LAS f32x4*)(rw + e * 1024 + c); lg[e] += (h[0] * wv[0] + h[1] * wv[1]) + (h[2] * wv[2] + h[3] * wv[3]); } }
#pragma unroll
        for (int e = 0; e < 16; ++e) lg[e] = wave_sum(lg[e]);
        float sc[16], bs[16];
#pragma unroll
        for (int e = 0; e < 16; ++e) { sc[e] = 1.f / (1.f + expf(-lg[e])); bs[e] = sc[e] + p.in[I_RB][e]; }
        float gbest = -INFINITY; int gsel = 0;
#pragma unroll
        for (int gq = 0; gq < 4; ++gq) { const float a = bs[4 * gq], b2 = bs[4 * gq + 1], c2 = bs[4 * gq + 2], d2 = bs[4 * gq + 3];
            const float m1 = fmaxf(fmaxf(a, b2), fmaxf(c2, d2));
            const float m2 = fmaxf(fmaxf(fminf(a, b2), fminf(c2, d2)), fminf(fmaxf(a, b2), fmaxf(c2, d2)));
            const float gs = m1 + m2; if (gs > gbest) { gbest = gs; gsel = gq; } }
        float b4[4], s4[4];
#pragma unroll
        for (int i = 0; i < 4; ++i) { b4[i] = gsel == 0 ? bs[i] : (gsel == 1 ? bs[4 + i] : (gsel == 2 ? bs[8 + i] : bs[12 + i])); s4[i] = gsel == 0 ? sc[i] : (gsel == 1 ? sc[4 + i] : (gsel == 2 ? sc[8 + i] : sc[12 + i])); }
        int i0 = 0; float bv0 = b4[0];
#pragma unroll
        for (int i = 1; i < 4; ++i) if (b4[i] > bv0) { bv0 = b4[i]; i0 = i; }
        int i1 = -1; float bv1 = -INFINITY;
#pragma unroll
        for (int i = 0; i < 4; ++i) if (i != i0 && b4[i] > bv1) { bv1 = b4[i]; i1 = i; }
        const float g0 = i0 == 0 ? s4[0] : (i0 == 1 ? s4[1] : (i0 == 2 ? s4[2] : s4[3]));
        const float g1s = i1 == 0 ? s4[0] : (i1 == 1 ? s4[1] : (i1 == 2 ? s4[2] : s4[3]));
        if (lane == 0) { RouteRec rr; rr.e0 = gsel * 4 + i0; rr.e1 = gsel * 4 + i1; rr.rk0 = (int)atomicAdd((unsigned*)&lcnt[rr.e0], 1u); rr.rk1 = (int)atomicAdd((unsigned*)&lcnt[rr.e1], 1u);
            const float den = g0 + g1s; rr.w0 = g0 / den; rr.w1 = g1s / den; rr.d0 = 0; rr.d1 = 0; route[r] = rr; }
    }
    __syncthreads();
    if (F.tid < 16) WSP(unsigned, WS_CNT)[F.bid * 16 + F.tid] = lcnt[F.tid];
    __syncthreads();
}

struct MoeTabs { LAS unsigned* tot; LAS unsigned* pstart; LAS unsigned* pendb; LAS unsigned* mybase; };
__device__ __forceinline__ MoeTabs moe_tabs(Frame& F) { MoeTabs t; LAS unsigned* m = (LAS unsigned*)(F.lds + MISC_OFF + 256); t.tot = m; t.pstart = m + 16; t.pendb = m + 32; t.mybase = m + 48; return t; }
__device__ __forceinline__ void moe_build_tabs(PR p, Frame& F, const MoeTabs& T) {
    const unsigned* cnt = WSP(unsigned, WS_CNT);
    LAS unsigned* tmp = (LAS unsigned*)(F.lds + MISC_OFF + 1024);
    { const int e = F.tid & 15, part = F.tid >> 4, per = (F.G + 31) / 32, b0 = part * per, b1 = (b0 + per < F.G) ? b0 + per : F.G; unsigned tot = 0, base = 0;
      for (int b = b0; b < b1; ++b) { const unsigned c = cnt[b * 16 + e]; tot += c; base += (b < F.bid) ? c : 0u; }
      tmp[part * 32 + e] = tot; tmp[part * 32 + 16 + e] = base; }
    __syncthreads();
    if (F.tid < 16) { unsigned tot = 0, base = 0;
#pragma unroll
        for (int q = 0; q < 32; ++q) { tot += tmp[q * 32 + F.tid]; base += tmp[q * 32 + 16 + F.tid]; }
        T.tot[F.tid] = tot; T.mybase[F.tid] = base; }
    __syncthreads();
    if (F.tid == 0) { unsigned acc = 0; for (int e = 0; e < 16; ++e) { T.pstart[e] = acc; acc += (T.tot[e] + 255u) & ~255u; T.pendb[e] = acc >> 8; } }
    __syncthreads();
}
__device__ __forceinline__ void moe_scatter_phase(PR p, Frame& F, const bf16* H2, bf16* BUF, int nrows) {
    const MoeTabs T = moe_tabs(F); moe_build_tabs(p, F, T);
    RouteRec* route = WSP(RouteRec, WS_ROUTE);
    const int rpb = (nrows + F.G - 1) / F.G, rbeg = F.bid * rpb, rend = (rbeg + rpb < nrows) ? rbeg + rpb : nrows;
    for (int r = rbeg + F.wave; r < rend; r += NWAVES) {
        const RouteRec rr = route[r];
        const int d0 = (int)(T.pstart[rr.e0] + T.mybase[rr.e0]) + rr.rk0, d1 = (int)(T.pstart[rr.e1] + T.mybase[rr.e1]) + rr.rk1;
        const u32x4* src = (const u32x4*)(H2 + (size_t)r * DM) + F.lane; const u32x4 a = src[0], b = src[64];
        u32x4* o0 = (u32x4*)(BUF + (size_t)d0 * DM) + F.lane; u32x4* o1 = (u32x4*)(BUF + (size_t)d1 * DM) + F.lane;
        o0[0] = a; o0[64] = b; o1[0] = a; o1[64] = b;
        if (F.lane == 0) { route[r].d0 = d0; route[r].d1 = d1; }
    }
    if (F.bid < 16) { const int e = F.bid; const unsigned pb = T.pstart[e] + T.tot[e], pe = T.pstart[e] + ((T.tot[e] + 255u) & ~255u);
        for (unsigned r = pb + F.wave; r < pe; r += NWAVES) { u32x4* o = (u32x4*)(BUF + (size_t)r * DM) + F.lane; o[0] = (u32x4){0u, 0u, 0u, 0u}; o[64] = (u32x4){0u, 0u, 0u, 0u}; } }
}

template <int LAYER>
__device__ __forceinline__ void ln2_phase(PR p, Frame& F, const bf16* Y, bf16* H0N, int nrows) {
    const float* mod = WSP(float, WS_MOD) + LAYER * 5 * 6144;
    const float* modn = WSP(float, WS_MOD) + (LAYER + 1) * 5 * 6144;
    const float* lng = p.in[I_LNG] + (LAYER * 2 + 1) * DM;
    const RouteRec* route = WSP(RouteRec, WS_ROUTE);
    const int gw = F.vcu * NWAVES + F.wave, NGW = F.G * NWAVES, lane = F.lane;
    for (int r = gw; r < nrows; r += NGW) {
        const bool lat = r < NLAT; const int b = lat ? (r >> 13) : 4;
        const RouteRec rr = route[r];
        const float* mb = mod + b * 6144; float* xr = xs_row(p, r);
        f32x4 v[4]; float s = 0.f;
#pragma unroll
        for (int j = 0; j < 4; ++j) { const int c = 4 * lane + 256 * j; const f32x4 x = *(const f32x4*)(xr + c), g2 = *(const f32x4*)(mb + 5120 + c);
            const u32x2 ya = *(const u32x2*)(Y + (size_t)rr.d0 * DM + c), yb = *(const u32x2*)(Y + (size_t)rr.d1 * DM + c);
            const f32x4 y = (f32x4){bflo(ya.x), bfhi(ya.x), bflo(ya.y), bfhi(ya.y)} * rr.w0 + (f32x4){bflo(yb.x), bfhi(yb.x), bflo(yb.y), bfhi(yb.y)} * rr.w1;
            v[j] = x * ALPHA + g2 * y; s += (v[j][0] + v[j][1]) + (v[j][2] + v[j][3]); }
        const float mean = wave_sum(s) * (1.f / DM); float q = 0.f;
#pragma unroll
        for (int j = 0; j < 4; ++j) { v[j] = v[j] - mean; q += (v[j][0] * v[j][0] + v[j][1] * v[j][1]) + (v[j][2] * v[j][2] + v[j][3] * v[j][3]); }
        const float rstd = 1.f / sqrtf(wave_sum(q) * (1.f / DM) + LN_EPS);
#pragma unroll
        for (int j = 0; j < 4; ++j) { const int c = 4 * lane + 256 * j; const f32x4 gn = *(const f32x4*)(lng + c); const f32x4 x2 = v[j] * rstd * gn; *(f32x4*)(xr + c) = x2;
            if (LAYER == 0) { const float* mn = modn + b * 6144; const f32x4 sh = *(const f32x4*)(mn + c), sc = *(const f32x4*)(mn + 1024 + c); const f32x4 h = x2 * (sc + 1.f) + sh;
                u32x2 w; w.x = cvt_pk_bf16(h[0], h[1]); w.y = cvt_pk_bf16(h[2], h[3]); *(u32x2*)(H0N + (size_t)r * DM + c) = w; } }
    }
}
namespace att {
constexpr int NW = 8, QBLK = 32, KVBLK = 64, LDQ = 1024, LDK = 1024, NKEY = SEQ + CTXL, NT = NKEY / KVBLK;
constexpr size_t SHM_V = KVBLK * 128 * 2, SHM_K = KVBLK * 64 * 2;
constexpr float THR = 8.f;
#define KSWZ64(row, colB) ((row) * 128 + ((colB) ^ ((((row) >> 1) & 7) << 4)))
#define SBAR() __builtin_amdgcn_sched_barrier(0)
__device__ __forceinline__ int crow(int r, int hi) { return (r & 3) + 8 * (r >> 2) + 4 * hi; }
__device__ __forceinline__ unsigned cvtpk(float lo, float hi) { unsigned r; asm volatile("v_cvt_pk_bf16_f32 %0, %1, %2" : "=v"(r) : "v"(lo), "v"(hi)); return r; }
__device__ __forceinline__ void partialSM(f32x16& p0, f32x16& p1, float& m_reg, float& mn, float& alpha) {
    constexpr float C = 1.4426950408889634f;
    float pmax = p0[0];
#pragma unroll
    for (int r = 1; r < 16; ++r) pmax = fmaxf(pmax, p0[r]);
#pragma unroll
    for (int r = 0; r < 16; ++r) pmax = fmaxf(pmax, p1[r]);
    { auto rr = __builtin_amdgcn_permlane32_swap(__float_as_uint(pmax), __float_as_uint(pmax), false, false); pmax = fmaxf(__uint_as_float(rr[0]), __uint_as_float(rr[1])); }
    if (__builtin_expect(__all(pmax - m_reg <= THR), 1)) { mn = m_reg; alpha = 1.f; }
    else { mn = fmaxf(m_reg, pmax); alpha = __builtin_amdgcn_exp2f((m_reg - mn) * C); m_reg = mn; }
    const float mnC = -mn * C;
#pragma unroll
    for (int r = 0; r < 16; ++r) p0[r] = fmaf(p0[r], C, mnC);
#pragma unroll
    for (int r = 0; r < 16; ++r) p1[r] = fmaf(p1[r], C, mnC);
#pragma unroll
    for (int r = 0; r < 16; ++r) p0[r] = __builtin_amdgcn_exp2f(p0[r]);
}
__device__ __forceinline__ void finishSM(f32x16& p0, f32x16& p1, float alpha, float& l_reg, bf16x8& pa0, bf16x8& pa1, bf16x8& pa2, bf16x8& pa3) {
#pragma unroll
    for (int r = 0; r < 16; ++r) p1[r] = __builtin_amdgcn_exp2f(p1[r]);
    float ps = 0;
#pragma unroll
    for (int r = 0; r < 16; ++r) ps += p0[r];
#pragma unroll
    for (int r = 0; r < 16; ++r) ps += p1[r];
    { auto rr = __builtin_amdgcn_permlane32_swap(__float_as_uint(ps), __float_as_uint(ps), false, false); ps = __uint_as_float(rr[0]) + __uint_as_float(rr[1]); }
    l_reg = l_reg * alpha + ps;
#define PK4(P, BASE, OUT) do { unsigned a0 = cvtpk(P[BASE + 0], P[BASE + 1]), a1 = cvtpk(P[BASE + 2], P[BASE + 3]);   \
    unsigned b0 = cvtpk(P[BASE + 4], P[BASE + 5]), b1 = cvtpk(P[BASE + 6], P[BASE + 7]);                              \
    auto r0 = __builtin_amdgcn_permlane32_swap(a0, b0, false, false); auto r1 = __builtin_amdgcn_permlane32_swap(a1, b1, false, false); \
    u32x4 w = {r0[0], r1[0], r0[1], r1[1]}; OUT = __builtin_bit_cast(bf16x8, w); } while (0)
    PK4(p0, 0, pa0); PK4(p0, 8, pa1); PK4(p1, 0, pa2); PK4(p1, 8, pa3);
#undef PK4
}
__device__ __forceinline__ void qkt(f32x16& p0, f32x16& p1, const LAS char* Ks, const bf16x8* qr, int r32, int hi) {
    p0 = f32x16{}; p1 = f32x16{};
#pragma unroll
    for (int d0 = 0; d0 < 4; ++d0) { const int cb = (d0 * 16 + hi * 8) * 2;
        const bf16x8 b0 = *(const LAS bf16x8*)(Ks + KSWZ64(r32, cb));
        const bf16x8 b1 = *(const LAS bf16x8*)(Ks + KSWZ64(32 + r32, cb));
        p0 = __builtin_amdgcn_mfma_f32_32x32x16_bf16(b0, qr[d0], p0, 0, 0, 0);
        p1 = __builtin_amdgcn_mfma_f32_32x32x16_bf16(b1, qr[d0], p1, 0, 0, 0); }
}
__device__ __forceinline__ int v_st(int k, int c) { const int kk = (k & ~0xC) | ((k & 4) << 1) | ((k & 8) >> 1); return ((kk >> 3) * 4 + (c >> 5)) * 512 + ((kk & 7) * 32 + (c & 31)) * 2; }
__device__ __forceinline__ int v_rd_base(int lane) { return ((lane & 3) << 3) | (((lane >> 2) & 3) << 6) | (((lane >> 4) & 1) << 5) | (((lane >> 5) & 1) << 8); }
constexpr int v_rd_off(int d0, int ks, int half) { return d0 * 512 + ks * 4096 + half * 2048; }
template <int OFF> __device__ __forceinline__ s16x4 tr_read(int vb) { s16x4 r; asm volatile("ds_read_b64_tr_b16 %0, %1 offset:%2" : "=&v"(r) : "v"(vb), "i"(OFF) : "memory"); return r; }
template <int D0> __device__ __forceinline__ void pv_one(f32x16& od, int vb, bf16x8 pa0, bf16x8 pa1, bf16x8 pa2, bf16x8 pa3) {
    const s16x4 l0 = tr_read<v_rd_off(D0, 0, 0)>(vb), h0 = tr_read<v_rd_off(D0, 0, 1)>(vb), l1 = tr_read<v_rd_off(D0, 1, 0)>(vb), h1 = tr_read<v_rd_off(D0, 1, 1)>(vb);
    const s16x4 l2 = tr_read<v_rd_off(D0, 2, 0)>(vb), h2 = tr_read<v_rd_off(D0, 2, 1)>(vb), l3 = tr_read<v_rd_off(D0, 3, 0)>(vb), h3 = tr_read<v_rd_off(D0, 3, 1)>(vb);
    asm volatile("s_waitcnt lgkmcnt(0)" ::: "memory"); SBAR();
#define PKV(L, H) (bf16x8){L[0], L[1], L[2], L[3], H[0], H[1], H[2], H[3]}
    od = __builtin_amdgcn_mfma_f32_32x32x16_bf16(pa0, PKV(l0, h0), od, 0, 0, 0);
    od = __builtin_amdgcn_mfma_f32_32x32x16_bf16(pa1, PKV(l1, h1), od, 0, 0, 0);
    od = __builtin_amdgcn_mfma_f32_32x32x16_bf16(pa2, PKV(l2, h2), od, 0, 0, 0);
    od = __builtin_amdgcn_mfma_f32_32x32x16_bf16(pa3, PKV(l3, h3), od, 0, 0, 0);
#undef PKV
}
__device__ __forceinline__ void pv_d0(f32x16* o, int vb, bf16x8 pa0, bf16x8 pa1, bf16x8 pa2, bf16x8 pa3) {
    pv_one<0>(o[0], vb, pa0, pa1, pa2, pa3); pv_one<1>(o[1], vb, pa0, pa1, pa2, pa3); pv_one<2>(o[2], vb, pa0, pa1, pa2, pa3); pv_one<3>(o[3], vb, pa0, pa1, pa2, pa3);
}
__device__ __forceinline__ void attn_pass(const bf16* __restrict__ Qb, const bf16* __restrict__ Kh, const bf16* __restrict__ Vh, LAS char* lds, f32x16 (&o)[4], float& l_out, int tid) {
    const int wid = tid >> 6, lane = tid & 63, r32 = lane & 31, hi = lane >> 5;
    LAS char* V_lds = lds; LAS char* K_lds = lds + 2 * SHM_V;
    LAS float* ws = (LAS float*)(lds + 2 * SHM_V + 2 * SHM_K) + wid * 64; LAS float* al_l = ws + 32;
    float m_reg = -1e30f, l_reg = 0.f; bf16x8 qr[4];
#pragma unroll
    for (int d = 0; d < 4; ++d) o[d] = f32x16{};
    const bf16* Qw = Qb + (long)(wid * QBLK + r32) * LDQ + hi * 8;
#pragma unroll
    for (int d0 = 0; d0 < 4; ++d0) qr[d0] = *(const bf16x8*)(Qw + d0 * 16);
    const int sr = tid >> 4, sc = (tid & 15) * 8, vst0 = v_st(sr, sc), vst1 = v_st(32 + sr, sc);
    const int kr = tid >> 3, kc = (tid & 7) * 8, kst = KSWZ64(kr, kc * 2);
    const int vb0 = (int)(uintptr_t)V_lds + v_rd_base(lane);
    struct { bf16x8 vs0, vs1, ks0; } sr_[2];
#define SLOAD(i, k0) do { sr_[i].vs0 = *(const bf16x8*)(&Vh[(long)((k0) + sr) * LDK + sc]); sr_[i].vs1 = *(const bf16x8*)(&Vh[(long)((k0) + 32 + sr) * LDK + sc]); \
    sr_[i].ks0 = *(const bf16x8*)(&Kh[(long)((k0) + kr) * LDK + kc]); } while (0)
#define SWRITE(b, i) do { *(LAS bf16x8*)(V_lds + (b) * SHM_V + vst0) = sr_[i].vs0; *(LAS bf16x8*)(V_lds + (b) * SHM_V + vst1) = sr_[i].vs1; \
    *(LAS bf16x8*)(K_lds + (b) * SHM_K + kst) = sr_[i].ks0; } while (0)
#define SWAIT() asm volatile("s_waitcnt vmcnt(3)" ::: "memory")
#define RESC(a) do { if (__any((a) < 1.f)) { if (hi == 0) al_l[r32] = (a); asm volatile("s_waitcnt lgkmcnt(0)" ::: "memory"); \
    _Pragma("unroll") for (int d = 0; d < 4; ++d) _Pragma("unroll") for (int r = 0; r < 16; ++r) o[d][r] *= al_l[crow(r, hi)]; } } while (0)
    f32x16 pA0, pA1, pB0, pB1; float mnA, mnB, alA, alB; bf16x8 pa0, pa1, pa2, pa3;
    constexpr int SE = 0, SO = 1;
    SLOAD(SE, 0); asm volatile("s_waitcnt vmcnt(0)" ::: "memory"); SWRITE(0, SE); __syncthreads();
    qkt(pA0, pA1, K_lds, qr, r32, hi); partialSM(pA0, pA1, m_reg, mnA, alA);
    SLOAD(SO, KVBLK); SLOAD(SE, 2 * KVBLK);
    SWAIT(); SWRITE(1, SO); __syncthreads();
#pragma nounroll
    for (int j = 1; j + 1 < NT; j += 2) {
        SBAR(); qkt(pB0, pB1, K_lds + SHM_K, qr, r32, hi);
        finishSM(pA0, pA1, alA, l_reg, pa0, pa1, pa2, pa3); SBAR();
        SLOAD(SO, (j + 2) * KVBLK); SBAR();
        pv_d0(o, vb0, pa0, pa1, pa2, pa3); partialSM(pB0, pB1, m_reg, mnB, alB);
        __syncthreads(); SWAIT(); SWRITE(0, SE);
        RESC(alB); __syncthreads();
        SBAR(); qkt(pA0, pA1, K_lds, qr, r32, hi);
        finishSM(pB0, pB1, alB, l_reg, pa0, pa1, pa2, pa3); SBAR();
        if (j + 3 < NT) SLOAD(SE, (j + 3) * KVBLK); SBAR();
        pv_d0(o, vb0 + (int)SHM_V, pa0, pa1, pa2, pa3); partialSM(pA0, pA1, m_reg, mnA, alA);
        __syncthreads(); SWAIT(); SWRITE(1, SO);
        RESC(alA); __syncthreads();
    }
    SBAR(); qkt(pB0, pB1, K_lds + SHM_K, qr, r32, hi);
    finishSM(pA0, pA1, alA, l_reg, pa0, pa1, pa2, pa3); SBAR();
    pv_d0(o, vb0, pa0, pa1, pa2, pa3); partialSM(pB0, pB1, m_reg, mnB, alB);
    __syncthreads(); RESC(alB);
    finishSM(pB0, pB1, alB, l_reg, pa0, pa1, pa2, pa3); SBAR();
    pv_d0(o, vb0 + (int)SHM_V, pa0, pa1, pa2, pa3);
    l_out = l_reg;
    __syncthreads();
#undef SLOAD
#undef SWRITE
#undef SWAIT
#undef RESC
}
}

__device__ __forceinline__ void attn_phase(PR p, Frame& F) {
    using namespace att;
    const bf16* Q = WSP(bf16, B_Q); const bf16* K = WSP(bf16, B_K); const bf16* V = WSP(bf16, B_V); bf16* AO = WSP(bf16, B_AO);
    float* stash = WSP(float, B_STASH) + (size_t)F.bid * 64 * NTHREADS + F.tid;
    const float lam = WSP(float, WS_SCAL)[0];
    const int lane = F.lane, r32 = lane & 31, hi = lane >> 5, wid = F.wave;
    LAS float* ws = (LAS float*)(F.lds + 2 * SHM_V + 2 * SHM_K) + wid * 64;
    for (int unit = F.vcu; unit < NBATCH * 8 * 32; unit += F.G) {
        const int bh = unit >> 5, qb = unit & 31, b = bh >> 3, h = bh & 7;
        const bf16* Qb = Q + ((size_t)b * SEQ + qb * 256) * LDQ + h * 128;
        const bf16* Kh = K + (size_t)b * NKEY * LDK + h * 128;
        const bf16* Vh = V + (size_t)b * NKEY * LDK + h * 128;
        f32x16 o[4]; float l;
        int tl = F.tid; asm volatile("" : "+v"(tl));
        attn_pass(Qb, Kh, Vh, (LAS char*)F.lds, o, l, tl);
        float* st = stash; asm volatile("" : "+v"(st));
        if (hi == 0) ws[r32] = l; asm volatile("s_waitcnt lgkmcnt(0)" ::: "memory");
#pragma unroll
        for (int r = 0; r < 16; ++r) { const float rl = __builtin_amdgcn_rcpf(ws[crow(r, hi)]);
#pragma unroll
            for (int d0 = 0; d0 < 4; ++d0) st[(size_t)(d0 * 16 + r) * NTHREADS] = o[d0][r] * rl; }
        __syncthreads();
        asm volatile("" : "+v"(tl));
        attn_pass(Qb + 64, Kh + 64, Vh, (LAS char*)F.lds, o, l, tl);
        asm volatile("" : "+v"(st));
        if (hi == 0) ws[r32] = l; asm volatile("s_waitcnt lgkmcnt(0)" ::: "memory");
        float ss[16];
#pragma unroll
        for (int r = 0; r < 16; ++r) { const float rl = __builtin_amdgcn_rcpf(ws[crow(r, hi)]); float q = 0.f;
#pragma unroll
            for (int d0 = 0; d0 < 4; ++d0) { const float v = st[(size_t)(d0 * 16 + r) * NTHREADS] - lam * (o[d0][r] * rl); o[d0][r] = v; q += v * v; }
            ss[r] = q; }
#pragma unroll
        for (int r = 0; r < 16; ++r) { float q = ss[r]; q += __shfl_xor(q, 1); q += __shfl_xor(q, 2); q += __shfl_xor(q, 4); q += __shfl_xor(q, 8); q += __shfl_xor(q, 16);
            ss[r] = (1.f / sqrtf(q * (1.f / 128.f) + GN_EPS)) * (1.f - LAMBDA_INIT); }
        bf16* Ow = AO + ((size_t)b * SEQ + qb * 256 + wid * QBLK) * DM + h * 128 + r32; asm volatile("" : "+v"(Ow));
#pragma unroll
        for (int d0 = 0; d0 < 4; ++d0) { const float gsub = p.in[I_SUBLN][d0 * 32 + r32];
#pragma unroll
            for (int r = 0; r < 16; ++r) Ow[(size_t)crow(r, hi) * DM + d0 * 32] = (bf16)f2bf(o[d0][r] * ss[r] * gsub); }
        __syncthreads();
    }
}
#ifndef MK_MULTI
#define MK_MULTI 0
#endif
constexpr int NPHASE = 21;

template <int LAYER>
__device__ __forceinline__ void moe_gemm1_phase(PR p, Frame& F, const bf16* BUF, bf16* HID) {
    const MoeTabs T = moe_tabs(F); moe_build_tabs(p, F, T);
    pg8::ExpertOrder S; S.g.init((int)T.pendb[15], 8, F.G, F.bid, 1024, 1024); S.pend = T.pendb; S.eB = (long)EXP_STRIDE;
    pg8::Gemm g{BUF, (const bf16*)(p.ws + WS_EXP + (size_t)LAYER * 16 * EXP_STRIDE), 1024, 1024, 1024};
    pg8::EpiSwiGlu E{HID};
    pg8::gemm_phase(F.lds, g, S, E);
}
template <int LAYER>
__device__ __forceinline__ void moe_gemm2_phase(PR p, Frame& F, const bf16* HID, bf16* Y) {
    const MoeTabs T = moe_tabs(F); moe_build_tabs(p, F, T);
    pg8::ExpertOrder S; S.g.init((int)T.pendb[15], 4, F.G, F.bid, 1024, 1024); S.pend = T.pendb; S.eB = (long)EXP_STRIDE;
    pg8::Gemm g{HID, (const bf16*)(p.ws + WS_EXP + (size_t)LAYER * 16 * EXP_STRIDE + EXP_DN), 1024, 1024, 1024};
    pg8::EpiPlain E{Y, 1024};
    pg8::gemm_phase(F.lds, g, S, E);
}

#define PHP() const CAS Params* kp_ = (const CAS Params*)__builtin_amdgcn_kernarg_segment_ptr(); asm volatile("" : "+s"(kp_)); PR p = *kp_; Frame F; { int t_ = threadIdx.x; asm volatile("" : "+v"(t_)); int g_ = gridDim.x, b_ = blockIdx.x; asm volatile("" : "+s"(g_), "+s"(b_)); \
    F.lds = lds_base; F.tid = t_; F.lane = t_ & 63; F.wave = __builtin_amdgcn_readfirstlane(t_ >> 6); F.G = g_; F.bid = b_; F.vcu = (g_ % 8 == 0) ? (b_ % 8) * (g_ / 8) + b_ / 8 : b_; }
__global__ void __launch_bounds__(NTHREADS, 2) fwd(Params p_) {
    extern __shared__ __attribute__((aligned(16))) unsigned char lds_raw[];
    LAS unsigned char* const lds_base = (LAS unsigned char*)lds_raw;
    volatile LAS unsigned* misc = (volatile LAS unsigned*)(lds_base + MISC_OFF);
    for (int u = threadIdx.x; u < 64; u += NTHREADS) misc[u] = 0u;
    __syncthreads();
    const int lo = p_.ph_lo, hi = p_.ph_hi;
    XcdBarrier bar; bar.bar = (unsigned*)(p_.ws + WS_CTL) + 4096; bar.x = 0; bar.st = misc;
    if (!MK_MULTI) bar = xcd_barrier_post((unsigned*)(p_.ws + WS_CTL) + 4096, misc);
#ifndef ONLY_PHASE
#define ONLY_PHASE -1
#endif
#ifndef REP_MASK
#define REP_MASK 0
#endif
#define REP(k) for (int rep_ = 0; rep_ < (((REP_MASK) >> (k)) & 1) + 1; ++rep_, __syncthreads())
#define IN(k) ((ONLY_PHASE < 0 || ONLY_PHASE == (k)) && lo <= (k) && (k) < hi)
#define SEAM(k) do { if (IN(k) && IN((k) + 1)) xcd_barrier(bar); } while (0)

    if (IN(0)) REP(0) { PHP(); p0a_prologue(p, F); } SEAM(0);
    if (IN(1)) REP(1) { PHP(); p0b_phase(p, F); } SEAM(1);
    if (IN(2)) REP(2) { PHP();
        pg8::Gemm g{WSP(bf16, A_H0), WSP(bf16, WS_WIN0), 1024, 1024, 1024}; pg8::GridOrder S; S.init(NTOK / 256, 10, F.G, F.bid, 1024, 1024);
        pg8::EpiInProj0 E{WSP(bf16, A_QK), WSP(bf16, A_V), WSP(bf16, A_G), WSP(bf16, A_UA), WSP(float, WS_ROPE0C), WSP(float, WS_ROPE0S)};
        pg8::gemm_phase(F.lds, g, S, E);
    } SEAM(2);
    if (IN(3)) REP(3) { PHP();
        pg8::Gemm g{WSP(bf16, A_UA), WSP(bf16, WS_BT1), 512, 768, 512};
        pg8::BatchOrder S; S.nZ = 16; S.nM = 5; S.nN = 1; S.G = F.G; S.c = F.bid; S.tA = 256L * 768 * 2; S.tB = 256L * 512 * 2; S.zA = (long)S5ROWS * 768 * 2; S.zB = 256L * 512 * 2;
        pg8::EpiS5E E{WSP(float, A_EO)};
        pg8::gemm_phase(F.lds, g, S, E);
        ret_states_phase(p, F, ((F.G - 80) % F.G + F.G) % F.G);
    } SEAM(3);
    if (IN(4)) REP(4) { PHP(); s5_scan_phase(p, F); ret_scan_phase(p, F); } SEAM(4);
    if (IN(5)) REP(5) { PHP();
        pg8::Gemm g{WSP(bf16, A_UA), WSP(bf16, WS_BT2), 768, 768, 768};
        pg8::BatchOrder S; S.nZ = 16; S.nM = 5; S.nN = 2; S.G = F.G; S.c = F.bid; S.tA = 256L * 768 * 2; S.tB = 256L * 768 * 2; S.zA = (long)S5ROWS * 768 * 2; S.zB = 512L * 768 * 2;
        pg8::EpiS5Y E{WSP(bf16, A_SG)};
        pg8::gemm_phase(F.lds, g, S, E);
        ret_out_phase(p, F, ((F.G - 160) % F.G + F.G) % F.G);
    } SEAM(5);
    if (IN(6)) REP(6) { PHP();
        pg8::Gemm g{WSP(bf16, A_SG), WSP(bf16, WS_WGLU), 256, 256, 256}; pg8::GridOrder S; S.init(NTOK / 256, 2, F.G, F.bid, 256, 256);
        pg8::EpiGlu E{WSP(bf16, A_MRG)};
        pg8::gemm_phase(F.lds, g, S, E);
    } SEAM(6);
    if (IN(7)) REP(7) { PHP();
        pg8::Gemm g{WSP(bf16, A_MRG), WSP(bf16, WS_WOUT0), 1024, 1024, 1024}; pg8::GridOrder S; S.init(NTOK / 256, 4, F.G, F.bid, 1024, 1024);
        pg8::EpiPlain E{WSP(bf16, A_O), 1024};
        pg8::gemm_phase(F.lds, g, S, E);
    } SEAM(7);
    if (IN(8)) REP(8) { PHP(); ln1_router_phase<0>(p, F, WSP(bf16, A_O), WSP(bf16, A_H2), NTOK); } SEAM(8);
    if (IN(9)) REP(9) { PHP(); moe_scatter_phase(p, F, WSP(bf16, A_H2), WSP(bf16, A_BUF), NTOK); } SEAM(9);
    if (IN(10)) REP(10) { PHP(); moe_gemm1_phase<0>(p, F, WSP(bf16, A_BUF), WSP(bf16, A_HID)); } SEAM(10);
    if (IN(11)) REP(11) { PHP(); moe_gemm2_phase<0>(p, F, WSP(bf16, A_HID), WSP(bf16, A_Y)); } SEAM(11);
    if (IN(12)) REP(12) { PHP(); ln2_phase<0>(p, F, WSP(bf16, A_Y), WSP(bf16, A_H0P), NTOK); } SEAM(12);
    if (IN(13)) REP(13) { PHP();
        pg8::Gemm g{WSP(bf16, A_H0P), WSP(bf16, WS_WIN1), 1024, 1024, 1024}; pg8::InProj1Order S; S.g.init(NLAT / 256, 12, F.G, F.bid, 1024, 1024);
        pg8::EpiInProj1 E{WSP(bf16, B_Q), WSP(bf16, B_K), WSP(bf16, B_V), WSP(float, WS_ROPE1)};
        pg8::gemm_phase(F.lds, g, S, E);
    } SEAM(13);
    if (IN(14)) REP(14) { PHP(); attn_phase(p, F); } SEAM(14);
    if (IN(15)) REP(15) { PHP();
        pg8::Gemm g{WSP(bf16, B_AO), WSP(bf16, WS_WOUT1), 1024, 1024, 1024}; pg8::GridOrder S; S.init(NLAT / 256, 4, F.G, F.bid, 1024, 1024);
        pg8::EpiPlain E{WSP(bf16, B_O), 1024};
        pg8::gemm_phase(F.lds, g, S, E);
    } SEAM(15);
    if (IN(16)) REP(16) { PHP(); ln1_router_phase<1>(p, F, WSP(bf16, B_O), WSP(bf16, B_H2), NLAT); } SEAM(16);
    if (IN(17)) REP(17) { PHP(); moe_scatter_phase(p, F, WSP(bf16, B_H2), WSP(bf16, B_BUF), NLAT); } SEAM(17);
    if (IN(18)) REP(18) { PHP(); moe_gemm1_phase<1>(p, F, WSP(bf16, B_BUF), WSP(bf16, B_HID)); } SEAM(18);
    if (IN(19)) REP(19) { PHP(); moe_gemm2_phase<1>(p, F, WSP(bf16, B_HID), WSP(bf16, B_Y)); } SEAM(19);
    if (IN(20)) REP(20) { PHP(); ln2_phase<1>(p, F, WSP(bf16, B_Y), nullptr, NLAT); }
#undef IN
#undef SEAM
}

extern "C" void kernel_launch(void* const* d_in, const int* in_sizes, int n_in, void* d_out, int out_size, void* d_ws, size_t ws_size, hipStream_t stream) {
    static int grid = 0;
    if (grid == 0) {
        if (n_in != N_IN || out_size != NLAT * DM || ws_size < WS_END) { fprintf(stderr, "kernel_launch: unexpected shapes: n_in %d out %d ws %zu (need %zu)\n", n_in, out_size, ws_size, (size_t)WS_END); grid = -1; return; }
        int dev = 0, cus = 0, per_cu = 0;
        if (hipGetDevice(&dev) != hipSuccess || hipDeviceGetAttribute(&cus, hipDeviceAttributeMultiprocessorCount, dev) != hipSuccess) { grid = -1; return; }
        if (hipFuncSetAttribute((const void*)fwd, hipFuncAttributeMaxDynamicSharedMemorySize, LDS_BYTES) != hipSuccess) { fprintf(stderr, "kernel_launch: hipFuncSetAttribute failed\n"); grid = -1; return; }
        if (hipOccupancyMaxActiveBlocksPerMultiprocessor(&per_cu, (const void*)fwd, NTHREADS, LDS_BYTES) != hipSuccess || per_cu < 1) fprintf(stderr, "kernel_launch: occupancy query reports %d\n", per_cu);
        (void)hipGetLastError();
        grid = cus > 256 ? 256 : cus;
    }
    if (grid < 0) return;
    if (hipMemsetAsync((char*)d_ws + WS_CTL, 0, CTL_BYTES, stream) != hipSuccess) return;
    Params prm{};
    for (int i = 0; i < N_IN; ++i) prm.in[i] = (const float*)d_in[i];
    prm.out = (float*)d_out; prm.ws = (unsigned char*)d_ws;
#if MK_MULTI
    for (int ph = 0; ph < NPHASE; ++ph) { prm.ph_lo = ph; prm.ph_hi = ph + 1; hipLaunchKernelGGL(fwd, dim3(grid), dim3(NTHREADS), LDS_BYTES, stream, prm); }
#else
    prm.ph_lo = 0; prm.ph_hi = NPHASE;
    hipLaunchKernelGGL(fwd, dim3(grid), dim3(NTHREADS), LDS_BYTES, stream, prm);
#endif
}
```

```cpp
#include <hip/hip_runtime.h>
#include <cstdio>
#include <cstdint>

#define LAS __attribute__((address_space(3)))
#define GAS __attribute__((address_space(1)))
typedef unsigned short bf16;
typedef short bf16x8 __attribute__((ext_vector_type(8)));
typedef short s16x4 __attribute__((ext_vector_type(4)));
typedef float f32x4 __attribute__((ext_vector_type(4)));
typedef float f32x2 __attribute__((ext_vector_type(2)));
typedef float f32x16 __attribute__((ext_vector_type(16)));
typedef unsigned u32x4 __attribute__((ext_vector_type(4)));
typedef unsigned u32x2 __attribute__((ext_vector_type(2)));

constexpr int DM = 1024, NBATCH = 4, SEQ = 8192, CTXL = 256;
constexpr int NLAT = NBATCH * SEQ, NCTX = NBATCH * CTXL, NTOK = NLAT + NCTX;
constexpr int RH = 6, RDK = 64, RDV = 128, RC = 128, RNCH = 66;
constexpr int S5G = 16, S5P = 16, S5N = 64, S5T = 32, S5ROWS = 1280;
constexpr int NEXP = 16, NB0 = 280, NB1 = 272;
constexpr float ALPHA = 1.4142135623730951f;
constexpr float LN_EPS = 1e-5f, GN_EPS = 1e-6f;
constexpr float LAMBDA_INIT = 0.35550906759096926f;
constexpr int NWAVES = 8, NTHREADS = 512;
#ifndef PROJ_FP8
#define PROJ_FP8 0
#endif
#ifndef PF_IN0
#define PF_IN0 PROJ_FP8
#endif
#ifndef PF_OUT0
#define PF_OUT0 1
#endif
#ifndef PF_IN1
#define PF_IN1 1
#endif
#ifndef PF_OUT1
#define PF_OUT1 1
#endif
#ifndef FP8_WIDE
#define FP8_WIDE 1
#endif
#ifndef MOE_FP8
#define MOE_FP8 1
#endif

constexpr size_t MiB = 1u << 20, KiB = 1024;
constexpr size_t WS_CTL = 0, CTL_BYTES = 1 * MiB;
constexpr size_t WS_MOD = 1 * MiB;
constexpr size_t WS_SCAL = 1 * MiB + 256 * KiB;
constexpr size_t WS_LAMP = 1 * MiB + 320 * KiB;
constexpr size_t WS_COEF = 1 * MiB + 896 * KiB;
constexpr size_t WS_ROPE0C = 2 * MiB, WS_ROPE0S = 3 * MiB;
constexpr size_t WS_ROPE1 = 4 * MiB;
constexpr size_t WS_S5K = 4 * MiB + 64 * KiB;
constexpr size_t WS_XC = 6 * MiB;
constexpr size_t WS_CNT = 10 * MiB;
constexpr size_t WS_ROUTE = 10 * MiB + 64 * KiB;
constexpr size_t WS_BT1 = 12 * MiB;
constexpr size_t WS_BT2 = 16 * MiB;
constexpr size_t WS_WIN0 = 28 * MiB;
constexpr size_t WS_WGLU = 33 * MiB;
constexpr size_t WS_WOUT0 = 34 * MiB;
constexpr size_t WS_WIN1 = 36 * MiB;
constexpr size_t WS_WOUT1 = 42 * MiB;
constexpr size_t WS_EXP = 44 * MiB;
constexpr size_t EXP_STRIDE = 6 * MiB, EXP_DN = 4 * MiB;
constexpr size_t WS_ARENA = 236 * MiB;
constexpr size_t AR(double mib) { return WS_ARENA + (size_t)(mib * 1048576.0); }
constexpr size_t A_QK = AR(0), A_V = AR(49.5), A_G = AR(99), A_UA = AR(148.5), A_TT = AR(178.5), A_EO = AR(228), A_H0 = AR(248), A_MRG = AR(248), A_SG = AR(314);
constexpr size_t A_O = AR(140), A_H2 = AR(206), A_BUF = AR(0), A_HID = AR(140), A_Y = AR(0), A_H0P = AR(140);
constexpr size_t B_Q = AR(0), B_K = AR(64), B_V = AR(206), B_STASH = AR(272), B_AO = AR(140), B_O = AR(0), B_H2 = AR(64), B_BUF = AR(140), B_HID = AR(0), B_Y = AR(140);
constexpr size_t WS_END = AR(331);
constexpr size_t B_VI = WS_EXP;

constexpr int STAGE_BYTES_LDS = 131072;
constexpr int MISC_OFF = 131072;
constexpr int LDS_BYTES = 147456;

__device__ __forceinline__ unsigned f2bf(float f) { unsigned u = __float_as_uint(f); return (u + 0x7fffu + ((u >> 16) & 1u)) >> 16; }
__device__ __forceinline__ float bf2f(unsigned b) { return __uint_as_float(b << 16); }
__device__ __forceinline__ float bflo(unsigned w) { return __uint_as_float(w << 16); }
__device__ __forceinline__ float bfhi(unsigned w) { return __uint_as_float(w & 0xffff0000u); }
__device__ __forceinline__ unsigned cvt_pk_bf16(float lo, float hi) { unsigned r; asm volatile("v_cvt_pk_bf16_f32 %0, %1, %2" : "=v"(r) : "v"(lo), "v"(hi)); return r; }
template <int CTRL> __device__ __forceinline__ float dpp_f(float v) { return __int_as_float(__builtin_amdgcn_update_dpp(0, __float_as_int(v), CTRL, 0xF, 0xF, true)); }
__device__ __forceinline__ float wave_sum(float v) {
    v += dpp_f<0xB1>(v); v += dpp_f<0x4E>(v); v += dpp_f<0x141>(v); v += dpp_f<0x140>(v);
    { auto r = __builtin_amdgcn_permlane16_swap(__float_as_uint(v), __float_as_uint(v), false, false); v = __uint_as_float(r[0]) + __uint_as_float(r[1]); }
    { auto r = __builtin_amdgcn_permlane32_swap(__float_as_uint(v), __float_as_uint(v), false, false); v = __uint_as_float(r[0]) + __uint_as_float(r[1]); }
    return v;
}
__device__ __forceinline__ float fast_sigmoid(float x) { return __builtin_amdgcn_rcpf(1.f + __expf(-x)); }
__device__ __forceinline__ float fast_silu(float x) { return x * fast_sigmoid(x); }
__device__ __forceinline__ float gelu_tanh(float x) { const float z = 0.7978845608028654f * (x + 0.044715f * x * x * x); const float t = 1.f - 2.f * __builtin_amdgcn_rcpf(__expf(2.f * z) + 1.f); return 0.5f * x * (1.f + t); }
__device__ __forceinline__ void sincos_rev(double rev, float& s, float& c) { const double fr = rev - rint(rev); const float y = (float)(fr * 6.283185307179586); s = sinf(y); c = cosf(y); }
__device__ __forceinline__ f32x2 cmul(f32x2 a, f32x2 b) { return (f32x2){a.x * b.x - a.y * b.y, a.x * b.y + a.y * b.x}; }

#define XB_TMO      128
#define XB_XCNT(j)  (256  + 64 * (j))
#define XB_XSUB(j)  (1280 + 64 * (j))
#define XB_XGEN(j)  (2304 + 64 * (j))
#define XB_TOP      3328
#define XB_TOPGEN   3392
#define XCD_BAR_WORDS 3456
#define XB_SPIN_CAP (1u << 22)
__device__ __forceinline__ unsigned xb_ld(unsigned* p)              { return __hip_atomic_load(p, __ATOMIC_RELAXED, __HIP_MEMORY_SCOPE_AGENT); }
__device__ __forceinline__ unsigned xb_add(unsigned* p, unsigned v) { return __hip_atomic_fetch_add(p, v, __ATOMIC_RELAXED, __HIP_MEMORY_SCOPE_AGENT); }
__device__ __forceinline__ unsigned xb_xcc_id() { return (unsigned)__builtin_amdgcn_s_getreg((3 << 11) | 20) & 0xFu; }
#define XB_SPIN(cond, bar) do { unsigned _sp = 0; while (cond) { __builtin_amdgcn_s_sleep(1); \
    if ((++_sp & 255u) == 0u) { if (xb_ld(&(bar)[XB_TMO])) break; if (_sp > XB_SPIN_CAP) { atomicAdd(&(bar)[XB_TMO], 1u); break; } } } } while (0)
struct XcdBarrier { unsigned* bar; unsigned x; volatile LAS unsigned* st; };
__device__ __forceinline__ XcdBarrier xcd_barrier_post(unsigned* bar, volatile LAS unsigned* st) {
    XcdBarrier b; b.bar = bar; b.x = xb_xcc_id(); b.st = st;
    if (threadIdx.x == 0) (void)xb_add(&bar[XB_XCNT(b.x)], 1u);
    return b;
}
__device__ __forceinline__ void xcd_barrier_complete(unsigned* bar, unsigned x, unsigned& nloc, unsigned& nx) {
    const unsigned G = gridDim.x * gridDim.y * gridDim.z;
    unsigned sum, cnt, mine, sp = 0u;
    for (;;) {
        sum = 0u; cnt = 0u; mine = 0u;
#pragma unroll
        for (unsigned j = 0; j < 16; ++j) { const unsigned c = xb_ld(&bar[XB_XCNT(j)]); sum += c; cnt += (c > 0u) ? 1u : 0u; mine = (j == x) ? c : mine; }
        if (sum == G) break;
        __builtin_amdgcn_s_sleep(1);
        if ((++sp & 255u) == 0u) { if (xb_ld(&bar[XB_TMO])) break; if (sp > XB_SPIN_CAP) { atomicAdd(&bar[XB_TMO], 1u); break; } }
    }
    nloc = mine > 0u ? mine : 1u; nx = cnt > 0u ? cnt : 1u;
}
__device__ __forceinline__ void xcd_barrier(const XcdBarrier& b) {
    asm volatile("s_waitcnt vmcnt(0)" ::: "memory");
    __syncthreads();
    if (threadIdx.x == 0) {
        unsigned* bar = b.bar;
        __builtin_amdgcn_s_waitcnt(0);
        unsigned nloc = b.st[0], nx = b.st[1];
        if (nloc == 0u) { xcd_barrier_complete(bar, b.x, nloc, nx); b.st[0] = nloc; b.st[1] = nx; }
        const unsigned old = xb_add(&bar[XB_XSUB(b.x)], 1u);
        const unsigned gen = old / nloc;
        if (old + 1u == (gen + 1u) * nloc) {
            __builtin_amdgcn_fence(__ATOMIC_RELEASE, "agent");
            asm volatile("s_waitcnt vmcnt(0)" ::: "memory");
            const unsigned og = xb_add(&bar[XB_TOP], 1u);
            const unsigned tg = og / nx;
            if (og + 1u == (tg + 1u) * nx) xb_add(&bar[XB_TOPGEN], 1u);
            else XB_SPIN(xb_ld(&bar[XB_TOPGEN]) == tg, bar);
            __builtin_amdgcn_fence(__ATOMIC_ACQUIRE, "agent");
            xb_add(&bar[XB_XGEN(b.x)], 1u);
            asm volatile("s_waitcnt vmcnt(0)" ::: "memory");
        } else {
            XB_SPIN(xb_ld(&bar[XB_XGEN(b.x)]) == gen, bar);
            __builtin_amdgcn_fence(__ATOMIC_ACQUIRE, "agent");
            asm volatile("s_waitcnt vmcnt(0)" ::: "memory");
        }
    }
    __syncthreads();
}

namespace pg8 {
constexpr int BM = 256, BK = 64, HALF = 128, HTB = HALF * BK * 2, NXCD = 8, WGM = 8;
__host__ __device__ __forceinline__ int lds_byte(int r, int c) { const int st = (r >> 4) * 2 + (c >> 5), rr = r & 15, cc = c & 31, ob = rr * 64 + cc * 2; return st * 1024 + (ob ^ (((ob >> 9) & 1) << 5)); }
__host__ __device__ __forceinline__ void stage_rc(int b, int& R, int& C) { const int st = b / 1024, sb = b % 1024, swz = sb ^ (((sb >> 9) & 1) << 5); R = (st >> 1) * 16 + swz / 64; C = (st & 1) * 32 + (swz % 64) / 2; }
__host__ __device__ __forceinline__ int perm32(int rho) { const int n = rho >> 4, i = rho & 15; return 8 * (i >> 2) + 4 * n + (i & 3); }

struct Unit { int pm, pn, z; long aoff, boff; };
struct Gemm { const bf16* A; const bf16* Bt; int K, lda, ldb; };

struct GridOrder {
    int nM, nN, nwg, G, c; long tA, tB;
    __device__ void init(int nM_, int nN_, int G_, int c_, int lda, int ldb) { nM = nM_; nN = nN_; nwg = nM * nN; G = G_; c = c_; tA = (long)BM * lda * 2; tB = (long)BM * ldb * 2; }
    __device__ __forceinline__ bool tile(long L, int& pm, int& pn) const {
        if (L >= nwg) return false;
        int wgid = (int)L; { const int q = nwg / NXCD, r = nwg % NXCD, xcd = wgid % NXCD, off = wgid / NXCD; wgid = (xcd < r ? xcd * (q + 1) : r * (q + 1) + (xcd - r) * q) + off; }
        const int nig = WGM * nN, gid = wgid / nig, fm = gid * WGM, gsz = (nM - fm) < WGM ? (nM - fm) : WGM;
        pm = fm + ((wgid % nig) % gsz); pn = (wgid % nig) / gsz; return true;
    }
    __device__ __forceinline__ bool next(int i, Unit& u) const {
        if (!tile((long)i * G + c, u.pm, u.pn)) return false;
        u.z = 0; u.aoff = u.pm * tA; u.boff = u.pn * tB; return true;
    }
};
struct BatchOrder {
    int nZ, nM, nN, G, c; long tA, tB, zA, zB;
    __device__ __forceinline__ bool next(int i, Unit& u) const {
        const long L = (long)i * G + c; if (L >= (long)nZ * nM * nN) return false;
        const int per = nM * nN; u.z = (int)(L / per); const int r = (int)(L % per); u.pm = r / nN; u.pn = r % nN;
        u.aoff = u.z * zA + u.pm * tA; u.boff = u.z * zB + u.pn * tB; return true;
    }
};
struct ExpertOrder {
    GridOrder g; const LAS unsigned* pend; long eB;
    __device__ __forceinline__ bool next(int i, Unit& u) const {
        if (!g.tile((long)i * g.G + g.c, u.pm, u.pn)) return false;
        int e = 0;
#pragma unroll
        for (int k = 0; k < 15; ++k) e += ((unsigned)u.pm >= pend[k]) ? 1 : 0;
        u.z = e; u.aoff = u.pm * g.tA; u.boff = e * eB + u.pn * g.tB; return true;
    }
};
struct InProj1Order {
    GridOrder g;
    __device__ __forceinline__ bool next(int i, Unit& u) const {
        const long L = (long)i * g.G + g.c;
        if (L < g.nwg) { g.tile(L, u.pm, u.pn); }
        else { const long Lc = L - g.nwg; if (Lc >= 32) return false; u.pm = 128 + (int)(Lc >> 3); u.pn = 4 + (int)(Lc & 7); }
        u.z = 0; u.aoff = u.pm * g.tA; u.boff = u.pn * g.tB; return true;
    }
};

typedef int i32x8 __attribute__((ext_vector_type(8)));
typedef int i32x4 __attribute__((ext_vector_type(4)));
__device__ __forceinline__ i32x8 cat8(bf16x8 a, bf16x8 b) { const i32x4 x = __builtin_bit_cast(i32x4, a), y = __builtin_bit_cast(i32x4, b); return (i32x8){x[0], x[1], x[2], x[3], y[0], y[1], y[2], y[3]}; }
template <bool FP8 = false, class Epi, class Sched>
__device__ __forceinline__ void gemm_phase(LAS unsigned char* lds, const Gemm g, const Sched& S, const Epi& E) {
    const int tid = threadIdx.x, wid = __builtin_amdgcn_readfirstlane(tid >> 6), lane = tid & 63, wr = wid >> 2, wc = wid & 3, fr = lane & 15, fq = lane >> 4;
    const int K = g.K, nt = K / BK;
    unsigned voffA[2], voffB[2];
#pragma unroll
    for (int i = 0; i < 2; ++i) { int R, C; stage_rc(tid * 16 + i * 8192, R, C); const int Rb = Epi::PERM ? ((R & ~31) + perm32(R & 31)) : R;
        voffA[i] = (unsigned)(R * g.lda + C) * 2u; voffB[i] = (unsigned)(Rb * g.ldb + C) * 2u; }
    const size_t kstep = (size_t)(BK * 2);
    const size_t hstepA = (size_t)HALF * g.lda * 2, hstepB = (size_t)HALF * g.ldb * 2;
    const unsigned ldsw = (unsigned)wid * 1024u;
    const int aoff = lds_byte(wr * 64 + fr, fq * 8), boff = lds_byte(wc * 32 + fr, fq * 8);
#define PG8_SA(b, h) (((b) * 2 + (h)) * HTB)
#define PG8_SB(b, h) ((4 + (b) * 2 + (h)) * HTB)
#define PG8_STAGE(bufoff, gbase, voff) do { _Pragma("unroll") for (int _i = 0; _i < 2; ++_i) \
        __builtin_amdgcn_global_load_lds((const unsigned*)((const char*)(gbase) + (voff)[_i]), (LAS unsigned*)(lds + (bufoff) + ldsw + _i * 8192), 16, 0, 0); } while (0)
#define PG8_LDA(dst, b, h) do { _Pragma("unroll") for (int m = 0; m < 4; ++m) dst[m] = cat8(*(const LAS bf16x8*)(lds + PG8_SA(b, h) + aoff + m * 2048), *(const LAS bf16x8*)(lds + PG8_SA(b, h) + aoff + m * 2048 + 1024)); } while (0)
#define PG8_LDB(dst, b, h) do { _Pragma("unroll") for (int n = 0; n < 2; ++n) dst[n] = cat8(*(const LAS bf16x8*)(lds + PG8_SB(b, h) + boff + n * 2048), *(const LAS bf16x8*)(lds + PG8_SB(b, h) + boff + n * 2048 + 1024)); } while (0)
#define PG8_Q(v, q) __builtin_bit_cast(long, __builtin_shufflevector(v, v, 2 * (q), 2 * (q) + 1))
#define PG8_HALF(v, k) __builtin_bit_cast(bf16x8, __builtin_shufflevector(v, v, 4 * (k), 4 * (k) + 1, 4 * (k) + 2, 4 * (k) + 3))
#define PG8_MMA(ai, bj, At, Bt) do { __builtin_amdgcn_s_setprio(1); _Pragma("unroll") for (int m = 0; m < 4; ++m) _Pragma("unroll") for (int n = 0; n < 2; ++n) { \
        if constexpr (FP8 && FP8_WIDE) asm volatile("v_mfma_f32_16x16x128_f8f6f4 %0, %1, %2, %0" : "+v"(acc[ai][bj][m][n]) : "v"(Bt[n]), "v"(At[m])); \
        else if constexpr (FP8) { acc[ai][bj][m][n] = __builtin_amdgcn_mfma_f32_16x16x32_fp8_fp8(PG8_Q(Bt[n], 0), PG8_Q(At[m], 0), acc[ai][bj][m][n], 0, 0, 0); acc[ai][bj][m][n] = __builtin_amdgcn_mfma_f32_16x16x32_fp8_fp8(PG8_Q(Bt[n], 1), PG8_Q(At[m], 1), acc[ai][bj][m][n], 0, 0, 0); \
            acc[ai][bj][m][n] = __builtin_amdgcn_mfma_f32_16x16x32_fp8_fp8(PG8_Q(Bt[n], 2), PG8_Q(At[m], 2), acc[ai][bj][m][n], 0, 0, 0); acc[ai][bj][m][n] = __builtin_amdgcn_mfma_f32_16x16x32_fp8_fp8(PG8_Q(Bt[n], 3), PG8_Q(At[m], 3), acc[ai][bj][m][n], 0, 0, 0); } \
        else { acc[ai][bj][m][n] = __builtin_amdgcn_mfma_f32_16x16x32_bf16(PG8_HALF(Bt[n], 0), PG8_HALF(At[m], 0), acc[ai][bj][m][n], 0, 0, 0); \
               acc[ai][bj][m][n] = __builtin_amdgcn_mfma_f32_16x16x32_bf16(PG8_HALF(Bt[n], 1), PG8_HALF(At[m], 1), acc[ai][bj][m][n], 0, 0, 0); } } __builtin_amdgcn_s_setprio(0); } while (0)
#define PG8_WAIT_V(n) asm volatile("s_waitcnt vmcnt(" #n ")" ::: "memory")
#define PG8_WAIT_L(n) asm volatile("s_waitcnt lgkmcnt(" #n ")" ::: "memory")
#define PG8_BAR __builtin_amdgcn_s_barrier()
#define PG8_SCHED __builtin_amdgcn_sched_barrier(0)
    Unit cur, nxt; int ui = 0;
    if (!S.next(0, cur)) return;
    f32x4 acc[2][2][4][2];
#pragma unroll
    for (int a = 0; a < 2; ++a)
#pragma unroll
        for (int b = 0; b < 2; ++b)
#pragma unroll
            for (int m = 0; m < 4; ++m)
#pragma unroll
                for (int n = 0; n < 2; ++n) acc[a][b][m][n] = (f32x4){0.f, 0.f, 0.f, 0.f};
    i32x8 At[4], B0[2], B1[2];
    const char* cA = (const char*)g.A + cur.aoff; const char* cB = (const char*)g.Bt + cur.boff;
    PG8_STAGE(PG8_SB(0, 0), cB, voffB); PG8_STAGE(PG8_SB(0, 1), cB + hstepB, voffB); PG8_STAGE(PG8_SA(0, 0), cA, voffA); PG8_STAGE(PG8_SA(0, 1), cA + hstepA, voffA);
    if (wr == 1) PG8_BAR;
    PG8_WAIT_V(2); PG8_BAR;
    PG8_STAGE(PG8_SB(1, 0), cB + kstep, voffB); PG8_STAGE(PG8_SA(1, 0), cA + kstep, voffA); PG8_STAGE(PG8_SB(1, 1), cB + hstepB + kstep, voffB);
    PG8_WAIT_V(6); PG8_BAR;
    for (;;) {
        const bool has_next = S.next(ui + 1, nxt);
        const char* nA = has_next ? (const char*)g.A + nxt.aoff : cA; const char* nB = has_next ? (const char*)g.Bt + nxt.boff : cB;
#pragma nounroll
        for (int t = 0; t < nt; t += 2) {
            const bool last = (t == nt - 2);
            const char* a1 = cA + (size_t)(t + 1) * kstep;
            const char* a2 = last ? nA : cA + (size_t)(t + 2) * kstep; const char* b2 = last ? nB : cB + (size_t)(t + 2) * kstep;
            const char* a3 = a2 + kstep; const char* b3 = b2 + kstep;
            PG8_LDB(B0, 0, 0); PG8_LDB(B1, 0, 1); PG8_SCHED; PG8_LDA(At, 0, 0); PG8_STAGE(PG8_SA(1, 1), a1 + hstepA, voffA);
            PG8_WAIT_V(8); PG8_WAIT_L(0); PG8_BAR; PG8_MMA(0, 0, At, B0); PG8_MMA(0, 1, At, B1); PG8_BAR; PG8_SCHED;
            PG8_LDA(At, 0, 1); PG8_STAGE(PG8_SB(0, 0), b2, voffB); PG8_STAGE(PG8_SB(0, 1), b2 + hstepB, voffB); PG8_STAGE(PG8_SA(0, 0), a2, voffA);
            PG8_WAIT_V(8); PG8_WAIT_L(0); PG8_BAR; PG8_MMA(1, 0, At, B0); PG8_MMA(1, 1, At, B1); PG8_BAR; PG8_SCHED;
            PG8_LDB(B0, 1, 0); PG8_LDB(B1, 1, 1); PG8_SCHED; PG8_LDA(At, 1, 0); PG8_STAGE(PG8_SA(0, 1), a2 + hstepA, voffA);
            PG8_WAIT_V(8); PG8_WAIT_L(0); PG8_BAR; PG8_MMA(0, 0, At, B0); PG8_MMA(0, 1, At, B1); PG8_BAR; PG8_SCHED;
            PG8_LDA(At, 1, 1); PG8_STAGE(PG8_SB(1, 0), b3, voffB); PG8_STAGE(PG8_SB(1, 1), b3 + hstepB, voffB); PG8_STAGE(PG8_SA(1, 0), a3, voffA);
            PG8_WAIT_V(8); PG8_WAIT_L(0); PG8_BAR; PG8_MMA(1, 0, At, B0); PG8_MMA(1, 1, At, B1); PG8_BAR; PG8_SCHED;
        }
        if (wr == 0) PG8_BAR;
        if constexpr (FP8 && FP8_WIDE) {
#pragma unroll
            for (int a = 0; a < 2; ++a)
#pragma unroll
                for (int b = 0; b < 2; ++b) asm volatile("s_nop 15" : "+v"(acc[a][b][0][0]), "+v"(acc[a][b][0][1]), "+v"(acc[a][b][1][0]), "+v"(acc[a][b][1][1]), "+v"(acc[a][b][2][0]), "+v"(acc[a][b][2][1]), "+v"(acc[a][b][3][0]), "+v"(acc[a][b][3][1])); }
        E(acc, cur, wr, wc, fr, fq);
        if (!has_next) break;
#pragma unroll
        for (int a = 0; a < 2; ++a)
#pragma unroll
            for (int b = 0; b < 2; ++b)
#pragma unroll
                for (int m = 0; m < 4; ++m)
#pragma unroll
                    for (int n = 0; n < 2; ++n) acc[a][b][m][n] = (f32x4){0.f, 0.f, 0.f, 0.f};
        cur = nxt; cA = nA; cB = nB; ++ui;
        if (wr == 1) PG8_BAR;
    }
    PG8_WAIT_V(0);
    PG8_BAR;
#undef PG8_SA
#undef PG8_SB
#undef PG8_STAGE
#undef PG8_LDA
#undef PG8_LDB
#undef PG8_MMA
#undef PG8_HALF
#undef PG8_Q
#undef PG8_WAIT_V
#undef PG8_WAIT_L
#undef PG8_BAR
#undef PG8_SCHED
}
}
namespace pg8 {
__device__ __forceinline__ u32x4 pack8(const f32x4 a, const f32x4 b) { u32x4 w; w.x = cvt_pk_bf16(a[0], a[1]); w.y = cvt_pk_bf16(a[2], a[3]); w.z = cvt_pk_bf16(b[0], b[1]); w.w = cvt_pk_bf16(b[2], b[3]); return w; }
typedef const f32x4 (&AccRef)[2][2][4][2];
__device__ __forceinline__ float clamp448(float x) { return __builtin_fminf(__builtin_fmaxf(x, -448.f), 448.f); }
__device__ __forceinline__ unsigned pack4_fp8(float a, float b, float c, float d) { int w = __builtin_amdgcn_cvt_pk_fp8_f32(clamp448(a), clamp448(b), 0, false); w = __builtin_amdgcn_cvt_pk_fp8_f32(clamp448(c), clamp448(d), w, true); return (unsigned)w; }
__device__ __forceinline__ unsigned char to_fp8(float x) { return (unsigned char)(__builtin_amdgcn_cvt_pk_fp8_f32(clamp448(x), 0.f, 0, false) & 0xff); }
constexpr float PSC_IN0 = PF_IN0 ? 0.03125f : 1.f, PSC_IN1 = PF_IN1 ? 0.03125f : 1.f, PSC_OUT0 = PF_OUT0 ? 0.03125f : 1.f, PSC_OUT1 = PF_OUT1 ? 0.03125f : 1.f;

struct EpiPlain {
    static constexpr bool PERM = true;
    bf16* O; int ldc;
    __device__ __forceinline__ void operator()(AccRef acc, const Unit& u, int wr, int wc, int fr, int fq) const {
        const int row0 = u.pm * BM + wr * 64 + fr, col0 = u.pn * BM + wc * 32 + 8 * fq;
#pragma unroll
        for (int ai = 0; ai < 2; ++ai)
#pragma unroll
            for (int m = 0; m < 4; ++m) { bf16* rowp = O + (size_t)(row0 + ai * HALF + m * 16) * ldc + col0;
#pragma unroll
                for (int bj = 0; bj < 2; ++bj) *(u32x4*)(rowp + bj * HALF) = pack8(acc[ai][bj][m][0], acc[ai][bj][m][1]); }
    }
};
struct EpiInProj0 {
    static constexpr bool PERM = true;
    bf16 *QK, *V, *G, *UA; const float *rc, *rs;
    __device__ __forceinline__ void operator()(AccRef acc, const Unit& u, int wr, int wc, int fr, int fq) const {
        const int row0 = u.pm * BM + wr * 64 + fr, pn = u.pn;
        if (pn < 3) {
            const int H = 4 * pn + wc;
#pragma unroll
            for (int ai = 0; ai < 2; ++ai)
#pragma unroll
                for (int m = 0; m < 4; ++m) {
                    const int row = row0 + ai * HALF + m * 16;
                    f32x4 c0 = (f32x4){1.f, 1.f, 1.f, 1.f}, c1 = c0, s0 = (f32x4){0.f, 0.f, 0.f, 0.f}, s1 = s0;
                    if (row < NLAT) { const int pos = row & (SEQ - 1); const float* pc = rc + pos * 32 + 8 * fq; const float* ps = rs + pos * 32 + 8 * fq;
                        c0 = *(const f32x4*)pc; c1 = *(const f32x4*)(pc + 4); s0 = *(const f32x4*)ps; s1 = *(const f32x4*)(ps + 4); }
                    const f32x4 a0 = acc[ai][0][m][0] * PSC_IN0, a1 = acc[ai][0][m][1] * PSC_IN0, b0 = acc[ai][1][m][0] * PSC_IN0, b1 = acc[ai][1][m][1] * PSC_IN0;
                    const f32x4 y10 = a0 * c0 - b0 * s0, y11 = a1 * c1 - b1 * s1, y20 = a0 * s0 + b0 * c0, y21 = a1 * s1 + b1 * c1;
                    bf16* rp = QK + (size_t)row * 768 + H * 64 + 8 * fq;
                    *(u32x4*)rp = pack8(y10, y11); *(u32x4*)(rp + 32) = pack8(y20, y21);
                }
        } else if (pn < 9) {
            bf16* base = pn < 6 ? V : G; const int colt = (pn < 6 ? pn - 3 : pn - 6) * BM + wc * 32 + 8 * fq;
#pragma unroll
            for (int ai = 0; ai < 2; ++ai)
#pragma unroll
                for (int m = 0; m < 4; ++m) { bf16* rowp = base + (size_t)(row0 + ai * HALF + m * 16) * 768 + colt;
#pragma unroll
                    for (int bj = 0; bj < 2; ++bj) *(u32x4*)(rowp + bj * HALF) = pack8(acc[ai][bj][m][0] * PSC_IN0, acc[ai][bj][m][1] * PSC_IN0); }
        } else {
#pragma unroll
            for (int ai = 0; ai < 2; ++ai)
#pragma unroll
                for (int m = 0; m < 4; ++m) { const int row = row0 + ai * HALF + m * 16;
#pragma unroll
                    for (int bj = 0; bj < 2; ++bj) { const int c = bj * HALF + wc * 32 + 8 * fq, g = c >> 4, p0 = c & 15;
                        *(u32x4*)(UA + ((size_t)g * S5ROWS + (row >> 5)) * 768 + (row & 31) * 16 + p0) = pack8(acc[ai][bj][m][0] * PSC_IN0, acc[ai][bj][m][1] * PSC_IN0); } }
        }
    }
};
struct EpiS5E {
    static constexpr bool PERM = false;
    float* EO;
    __device__ __forceinline__ void operator()(AccRef acc, const Unit& u, int wr, int wc, int fr, int fq) const {
        const int row0 = u.pm * BM + wr * 64 + fr, col0 = wc * 32 + 4 * fq;
#pragma unroll
        for (int ai = 0; ai < 2; ++ai)
#pragma unroll
            for (int m = 0; m < 4; ++m) { float* rowp = EO + ((size_t)u.z * S5ROWS + row0 + ai * HALF + m * 16) * 256 + col0;
#pragma unroll
                for (int bj = 0; bj < 2; ++bj)
#pragma unroll
                    for (int n = 0; n < 2; ++n) *(f32x4*)(rowp + bj * HALF + n * 16) = acc[ai][bj][m][n]; }
    }
};
struct EpiS5Y {
    static constexpr bool PERM = true;
    bf16* SG;
    __device__ __forceinline__ void operator()(AccRef acc, const Unit& u, int wr, int wc, int fr, int fq) const {
        const int row0 = u.pm * BM + wr * 64 + fr;
#pragma unroll
        for (int ai = 0; ai < 2; ++ai)
#pragma unroll
            for (int m = 0; m < 4; ++m) { const int cr = row0 + ai * HALF + m * 16;
                if (cr < NTOK / S5T) {
#pragma unroll
                    for (int bj = 0; bj < 2; ++bj) { const int cn0 = u.pn * BM + bj * HALF + wc * 32 + 8 * fq, i = cn0 >> 4, p0 = cn0 & 15;
                        f32x4 v0 = acc[ai][bj][m][0], v1 = acc[ai][bj][m][1];
#pragma unroll
                        for (int j = 0; j < 4; ++j) { v0[j] = gelu_tanh(v0[j]); v1[j] = gelu_tanh(v1[j]); }
                        *(u32x4*)(SG + (size_t)(cr * S5T + i) * 256 + u.z * 16 + p0) = pack8(v0, v1); } } }
    }
};
struct EpiGlu {
    static constexpr bool PERM = true;
    bf16* MRG;
    __device__ __forceinline__ void operator()(AccRef acc, const Unit& u, int wr, int wc, int fr, int fq) const {
        const int row0 = u.pm * BM + wr * 64 + fr, col0 = 768 + u.pn * HALF + wc * 32 + 8 * fq;
#pragma unroll
        for (int ai = 0; ai < 2; ++ai)
#pragma unroll
            for (int m = 0; m < 4; ++m) { f32x4 v0, v1;
#pragma unroll
                for (int j = 0; j < 4; ++j) { v0[j] = acc[ai][0][m][0][j] * fast_sigmoid(acc[ai][1][m][0][j]); v1[j] = acc[ai][0][m][1][j] * fast_sigmoid(acc[ai][1][m][1][j]); }
                if (PF_OUT0) { u32x2 w; w.x = pack4_fp8(v0[0], v0[1], v0[2], v0[3]); w.y = pack4_fp8(v1[0], v1[1], v1[2], v1[3]); *(u32x2*)((unsigned char*)MRG + (size_t)(row0 + ai * HALF + m * 16) * 1024 + col0) = w; }
                else *(u32x4*)(MRG + (size_t)(row0 + ai * HALF + m * 16) * 1024 + col0) = pack8(v0, v1); }
    }
};
struct EpiSwiGlu {
    static constexpr bool PERM = true;
    bf16* HID;
    __device__ __forceinline__ void operator()(AccRef acc, const Unit& u, int wr, int wc, int fr, int fq) const {
        const int row0 = u.pm * BM + wr * 64 + fr, col0 = u.pn * HALF + wc * 32 + 8 * fq;
#pragma unroll
        for (int ai = 0; ai < 2; ++ai)
#pragma unroll
            for (int m = 0; m < 4; ++m) { f32x4 v0, v1;
#pragma unroll
                for (int j = 0; j < 4; ++j) { v0[j] = fast_silu(acc[ai][0][m][0][j]) * acc[ai][1][m][0][j]; v1[j] = fast_silu(acc[ai][0][m][1][j]) * acc[ai][1][m][1][j]; }
                *(u32x4*)(HID + (size_t)(row0 + ai * HALF + m * 16) * 1024 + col0) = pack8(v0, v1); }
    }
};
struct EpiSwiGlu8 {
    static constexpr bool PERM = true;
    unsigned char* HID;
    __device__ __forceinline__ void operator()(AccRef acc, const Unit& u, int wr, int wc, int fr, int fq) const {
        const int row0 = u.pm * BM + wr * 64 + fr, col0 = u.pn * HALF + wc * 32 + 8 * fq;
#pragma unroll
        for (int ai = 0; ai < 2; ++ai)
#pragma unroll
            for (int m = 0; m < 4; ++m) { f32x4 v0, v1;
#pragma unroll
                for (int j = 0; j < 4; ++j) { v0[j] = fast_silu(acc[ai][0][m][0][j] * 0.03125f) * (acc[ai][1][m][0][j] * 0.03125f); v1[j] = fast_silu(acc[ai][0][m][1][j] * 0.03125f) * (acc[ai][1][m][1][j] * 0.03125f); }
                u32x2 w; w.x = pack4_fp8(v0[0], v0[1], v0[2], v0[3]); w.y = pack4_fp8(v1[0], v1[1], v1[2], v1[3]);
                *(u32x2*)(HID + (size_t)(row0 + ai * HALF + m * 16) * 1024 + col0) = w; }
    }
};
struct EpiPlainS {
    static constexpr bool PERM = true;
    bf16* O; int ldc; float sc;
    __device__ __forceinline__ void operator()(AccRef acc, const Unit& u, int wr, int wc, int fr, int fq) const {
        const int row0 = u.pm * BM + wr * 64 + fr, col0 = u.pn * BM + wc * 32 + 8 * fq;
#pragma unroll
        for (int ai = 0; ai < 2; ++ai)
#pragma unroll
            for (int m = 0; m < 4; ++m) { bf16* rowp = O + (size_t)(row0 + ai * HALF + m * 16) * ldc + col0;
#pragma unroll
                for (int bj = 0; bj < 2; ++bj) *(u32x4*)(rowp + bj * HALF) = pack8(acc[ai][bj][m][0] * sc, acc[ai][bj][m][1] * sc); }
    }
};
struct EpiInProj1 {
    static constexpr bool PERM = true;
    bf16 *Q, *Kb, *Vb; const float* rope;
    __device__ __forceinline__ void operator()(AccRef acc, const Unit& u, int wr, int wc, int fr, int fq) const {
        const int row0 = u.pm * BM + wr * 64 + fr, pn = u.pn;
#pragma unroll
        for (int ai = 0; ai < 2; ++ai)
#pragma unroll
            for (int m = 0; m < 4; ++m) {
                const int row = row0 + ai * HALF + m * 16;
                const bool lat = row < NLAT;
                const int b = lat ? (row >> 13) : ((row - NLAT) >> 8), t = lat ? (row & (SEQ - 1)) : ((row - NLAT) & 255);
                const size_t krow = (size_t)b * (SEQ + CTXL) + (lat ? t : SEQ + t);
                if (pn < 8) {
                    const int sh = 4 * (pn & 3) + wc;
                    f32x4 c0 = (f32x4){1.f, 1.f, 1.f, 1.f}, c1 = c0, s0 = (f32x4){0.f, 0.f, 0.f, 0.f}, s1 = s0;
                    if (lat) { const int pos = (fq < 2) ? (t >> 6) : (t & 63); const float* pc = rope + pos * 16 + 8 * (fq & 1);
                        c0 = *(const f32x4*)pc; c1 = *(const f32x4*)(pc + 4); s0 = *(const f32x4*)(pc + 2048); s1 = *(const f32x4*)(pc + 2048 + 4); }
                    const f32x4 a0 = acc[ai][0][m][0] * PSC_IN1, a1 = acc[ai][0][m][1] * PSC_IN1, b0 = acc[ai][1][m][0] * PSC_IN1, b1 = acc[ai][1][m][1] * PSC_IN1;
                    const f32x4 y10 = a0 * c0 - b0 * s0, y11 = a1 * c1 - b1 * s1, y20 = a0 * s0 + b0 * c0, y21 = a1 * s1 + b1 * c1;
                    const int dim = (fq < 2 ? 0 : 32) + 8 * (fq & 1);
                    unsigned char* rp = (pn < 4) ? ((unsigned char*)Q + (size_t)row * 1024) : ((unsigned char*)Kb + krow * 1024);
                    rp += sh * 64 + dim;
                    if (pn >= 4 || lat) { u32x2 w1, w2; w1.x = pack4_fp8(y10[0], y10[1], y10[2], y10[3]); w1.y = pack4_fp8(y11[0], y11[1], y11[2], y11[3]); w2.x = pack4_fp8(y20[0], y20[1], y20[2], y20[3]); w2.y = pack4_fp8(y21[0], y21[1], y21[2], y21[3]);
                        *(u32x2*)rp = w1; *(u32x2*)(rp + 16) = w2; }
                } else {
                    bf16* rp = Vb + krow * 1024 + (pn - 8) * BM + wc * 32 + 8 * fq;
#pragma unroll
                    for (int bj = 0; bj < 2; ++bj) *(u32x4*)(rp + bj * HALF) = pack8(acc[ai][bj][m][0] * PSC_IN1, acc[ai][bj][m][1] * PSC_IN1);
                }
            }
    }
};
}
enum InIdx { I_X = 0, I_C, I_CTX, I_CCTX, I_ADAW, I_ADAB, I_LNG, I_WINAB, I_DECAY, I_LAMRE, I_LAMIM, I_LOGDT, I_BRE, I_BIM, I_CRE, I_CIM, I_S5D, I_WGLU,
             I_WOUTAB, I_WINC, I_DLAM, I_SUBLN, I_WOUTC, I_RW, I_RB, I_EG, I_EU, I_ED, N_IN };
struct Params { const float* in[N_IN]; float* out; unsigned char* ws; int ph_lo, ph_hi; };
#if defined(__HIP_DEVICE_COMPILE__)
#define CAS __attribute__((address_space(4)))
#else
#define CAS
#endif
typedef const CAS Params& PR;

struct Frame {
    LAS unsigned char* lds; int tid, lane, wave, G, bid, vcu;
};
#define WSP(T, off) ((T*)(p.ws + (off)))

__device__ __forceinline__ void p0_gemv_item(PR p, Frame& F, int item) {
    LAS float* sc = (LAS float*)F.lds;
    LAS float* red = (LAS float*)(F.lds + 20480);
    const float* c = p.in[I_C]; const float* cctx = p.in[I_CCTX];
    for (int i = F.tid; i < 5120; i += NTHREADS) { const int r = i >> 10, k = i & 1023; const float v = r < 4 ? c[r * 1024 + k] : cctx[k]; sc[i] = v / (1.f + expf(-v)); }
    __syncthreads();
    const int l = item / 96, cb = item % 96, jj = F.tid & 63, kp = F.tid >> 6;
    const float* W = p.in[I_ADAW] + (size_t)l * 1024 * 6144 + cb * 64 + jj;
    float a0 = 0.f, a1 = 0.f, a2 = 0.f, a3 = 0.f, a4 = 0.f;
#pragma unroll 16
    for (int k = kp * 128; k < kp * 128 + 128; ++k) { const float w = W[(size_t)k * 6144]; a0 += sc[k] * w; a1 += sc[1024 + k] * w; a2 += sc[2048 + k] * w; a3 += sc[3072 + k] * w; a4 += sc[4096 + k] * w; }
    red[(kp * 5 + 0) * 64 + jj] = a0; red[(kp * 5 + 1) * 64 + jj] = a1; red[(kp * 5 + 2) * 64 + jj] = a2; red[(kp * 5 + 3) * 64 + jj] = a3; red[(kp * 5 + 4) * 64 + jj] = a4;
    __syncthreads();
    if (F.tid < 320) { const int r = F.tid >> 6, j = F.tid & 63; float s = 0.f;
#pragma unroll
        for (int q = 0; q < 8; ++q) s += red[(q * 5 + r) * 64 + j];
        WSP(float, WS_MOD)[(l * 5 + r) * 6144 + cb * 64 + j] = s + p.in[I_ADAB][l * 6144 + cb * 64 + j]; }
    __syncthreads();
}
__device__ __forceinline__ void p0_s5_item(PR p, Frame& F, int item) {
    const int g = item >> 1, dir = item & 1;
    LAS f32x2* lamp = (LAS f32x2*)F.lds;
    LAS f32x2* coef = lamp + 64 * 33;
    const float dt = expf(p.in[I_LOGDT][dir * 16 + g]);
    for (int i = F.tid; i < 64 * 33; i += NTHREADS) { const int n = i / 33, tau = i % 33;
        const float re = p.in[I_LAMRE][(dir * 16 + g) * 64 + n], im = p.in[I_LAMIM][(dir * 16 + g) * 64 + n];
        const float mag = expf(re * dt * (float)tau); float s, c; sincos_rev((double)im * (double)dt * (double)tau * 0.15915494309189535, s, c);
        const f32x2 v = (f32x2){mag * c, mag * s}; lamp[i] = v; WSP(f32x2, WS_LAMP)[((g * 2 + dir) * 64 + n) * 33 + tau] = v; }
    __syncthreads();
    if (F.tid < 64) { const int n = F.tid; const float re = p.in[I_LAMRE][(dir * 16 + g) * 64 + n], im = p.in[I_LAMIM][(dir * 16 + g) * 64 + n];
        const f32x2 lb = lamp[n * 33 + 1]; const float a = lb.x - 1.f, b = lb.y, den = re * re + im * im;
        const f32x2 v = (f32x2){(a * re + b * im) / den, (b * re - a * im) / den}; coef[n] = v; WSP(f32x2, WS_COEF)[(g * 2 + dir) * 64 + n] = v; }
    __syncthreads();
    const float* bre = p.in[I_BRE] + (size_t)(dir * 16 + g) * 64 * 16; const float* bim = p.in[I_BIM] + (size_t)(dir * 16 + g) * 64 * 16;
    const float* cre = p.in[I_CRE] + (size_t)(dir * 16 + g) * 16 * 64; const float* cim = p.in[I_CIM] + (size_t)(dir * 16 + g) * 16 * 64;
    for (int idx = F.tid; idx < 32 * 256; idx += NTHREADS) { const int tau = idx >> 8, pp = (idx >> 4) & 15, q = idx & 15; float acc = 0.f;
        for (int n = 0; n < 64; ++n) { const f32x2 w = cmul(lamp[n * 33 + tau], coef[n]); const f32x2 bb = cmul(w, (f32x2){bre[n * 16 + q], bim[n * 16 + q]});
            acc += cre[pp * 64 + n] * bb.x - cim[pp * 64 + n] * bb.y; }
        WSP(float, WS_S5K)[((g * 2 + dir) * 32 + tau) * 256 + pp * 16 + q] = acc; }
    __syncthreads();
}
__device__ __forceinline__ int tr_drow(int mode, int n) {
    switch (mode) {
    case 1: if (n < 768) { const int H = n >> 6, half = (n >> 5) & 1, dd = n & 31; return (H >> 2) * 256 + half * 128 + (H & 3) * 32 + dd; } return n;
    case 2: if (n < 2048) { const int base = n & ~1023, c = n & 1023, sh = c >> 6, grp = (c >> 4) & 3; return base + (sh >> 2) * 256 + (grp & 1) * 128 + (sh & 3) * 32 + (grp >> 1) * 16 + (c & 15); } return n;
    case 3: return ((n & 255) >> 7) * 256 + (n >> 8) * 128 + (n & 127);
    case 4: return (n >> 7) * 256 + (n & 127);
    case 5: return (n >> 7) * 256 + 128 + (n & 127);
    default: return n; }
}
__device__ __forceinline__ float tr_scale(int mode, int n) { if (mode == 1) return (n >= 384 && n < 768) ? 0.125f : 1.f; if (mode == 2) return n < 1024 ? 0.5f * 1.4426950408889634f : (n < 2048 ? 0.25f : 1.f); return 1.f; }
struct TrItem { const float* W; bf16* WT; int K, N, mode, item, f8; };
__device__ __forceinline__ void tr_load(const TrItem& d, f32x4 (&t)[8], int lane) {
    const int nblk = d.N / 32, kb = d.item / nblk, nb = d.item % nblk, k0 = 64 * kb, n0 = 32 * nb, kq = lane >> 3, nq = (lane & 7) * 4;
#pragma unroll
    for (int i = 0; i < 8; ++i) t[i] = *(const f32x4*)(d.W + (size_t)(k0 + 8 * i + kq) * d.N + n0 + nq);
}
__device__ __forceinline__ void tr_finish(const TrItem& d, const f32x4 (&t)[8], LAS float* scr, int lane) {
    const int nblk = d.N / 32, kb = d.item / nblk, nb = d.item % nblk, k0 = 64 * kb, n0 = 32 * nb, kq = lane >> 3, nq = (lane & 7) * 4;
    const float sca = tr_scale(d.mode, n0);
#pragma unroll
    for (int i = 0; i < 8; ++i) { LAS float* q = scr + (8 * i + kq) * 33 + nq; q[0] = t[i][0] * sca; q[1] = t[i][1] * sca; q[2] = t[i][2] * sca; q[3] = t[i][3] * sca; }
    asm volatile("s_waitcnt lgkmcnt(0)" ::: "memory");
    const int c = lane & 7;
#pragma unroll
    for (int j = 0; j < 4; ++j) { const int n = (lane >> 3) + 8 * j; const LAS float* s = scr + (8 * c) * 33 + n;
        if (d.f8) { u32x2 o; o.x = pg8::pack4_fp8(s[0 * 33] * 32.f, s[1 * 33] * 32.f, s[2 * 33] * 32.f, s[3 * 33] * 32.f); o.y = pg8::pack4_fp8(s[4 * 33] * 32.f, s[5 * 33] * 32.f, s[6 * 33] * 32.f, s[7 * 33] * 32.f);
            *(u32x2*)((unsigned char*)d.WT + (size_t)tr_drow(d.mode, n0 + n) * d.K + k0 + 8 * c) = o; }
        else { u32x4 o; o.x = cvt_pk_bf16(s[0 * 33], s[1 * 33]); o.y = cvt_pk_bf16(s[2 * 33], s[3 * 33]); o.z = cvt_pk_bf16(s[4 * 33], s[5 * 33]); o.w = cvt_pk_bf16(s[6 * 33], s[7 * 33]);
            *(u32x4*)(d.WT + (size_t)tr_drow(d.mode, n0 + n) * d.K + k0 + 8 * c) = o; } }
    asm volatile("s_waitcnt lgkmcnt(0)" ::: "memory");
}
constexpr int TR_T0 = 1280, TR_T1 = TR_T0 + 64, TR_T2 = TR_T1 + 512, TR_T3 = TR_T2 + 1536, TR_T4 = TR_T3 + 512, TR_T5 = TR_T4 + 49152;
__device__ __forceinline__ TrItem tr_decode(PR p, int it) {
    TrItem d; d.f8 = 0;
    if (it < TR_T0) { d.W = p.in[I_WINAB]; d.WT = WSP(bf16, WS_WIN0); d.K = 1024; d.N = 2560; d.mode = 1; d.item = it; d.f8 = PF_IN0; }
    else if (it < TR_T1) { d.W = p.in[I_WGLU]; d.WT = WSP(bf16, WS_WGLU); d.K = 256; d.N = 512; d.mode = 3; d.item = it - TR_T0; }
    else if (it < TR_T2) { d.W = p.in[I_WOUTAB]; d.WT = WSP(bf16, WS_WOUT0); d.K = 1024; d.N = 1024; d.mode = 0; d.item = it - TR_T1; d.f8 = PF_OUT0; }
    else if (it < TR_T3) { d.W = p.in[I_WINC]; d.WT = WSP(bf16, WS_WIN1); d.K = 1024; d.N = 3072; d.mode = 2; d.item = it - TR_T2; d.f8 = PF_IN1; }
    else if (it < TR_T4) { d.W = p.in[I_WOUTC]; d.WT = WSP(bf16, WS_WOUT1); d.K = 1024; d.N = 1024; d.mode = 0; d.item = it - TR_T3; d.f8 = PF_OUT1; }
    else { const int r = it - TR_T4, le = r / 1536, r1 = r % 1536, which = r1 / 512;
        d.W = p.in[which == 0 ? I_EG : (which == 1 ? I_EU : I_ED)] + (size_t)le * 1024 * 1024;
        d.WT = (bf16*)(p.ws + WS_EXP + (size_t)le * EXP_STRIDE + (which == 2 ? EXP_DN : 0)); d.K = 1024; d.N = 1024; d.mode = which == 0 ? 4 : (which == 1 ? 5 : 0); d.item = r1 % 512; d.f8 = MOE_FP8; }
    return d;
}
__device__ __forceinline__ void p0a_prologue(PR p, Frame& F) {
    for (int it = F.bid; it < 224; it += F.G) { if (it < 192) p0_gemv_item(p, F, it); else p0_s5_item(p, F, it - 192); }
    LAS float* scr = (LAS float*)(F.lds + F.wave * 16384);
    const int gw = F.vcu * NWAVES + F.wave, NGW = F.G * NWAVES;
    { f32x4 ta[8], tb[8]; int it = gw;
      TrItem da = tr_decode(p, it < TR_T5 ? it : 0), db = da;
      if (it < TR_T5) tr_load(da, ta, F.lane);
      while (it < TR_T5) {
          const int nx = it + NGW;
          if (nx < TR_T5) { db = tr_decode(p, nx); tr_load(db, tb, F.lane); }
          tr_finish(da, ta, scr, F.lane);
          it = nx; if (it >= TR_T5) break;
          const int nx2 = it + NGW;
          if (nx2 < TR_T5) { da = tr_decode(p, nx2); tr_load(da, ta, F.lane); }
          tr_finish(db, tb, scr, F.lane);
          it = nx2;
      } }
    const int gt = F.bid * NTHREADS + F.tid, NGT = F.G * NTHREADS;
    for (int i = gt; i < SEQ * 32 + 128 * 16 + 1; i += NGT) {
        if (i < SEQ * 32) { const int pos = i >> 5, k = i & 31; const float inv = powf(10000.f, -(float)(2 * k) / 64.f); const float ang = (float)pos * inv; float s, c; sincos_rev((double)ang * 0.15915494309189535, s, c);
            WSP(float, WS_ROPE0C)[i] = c; WSP(float, WS_ROPE0S)[i] = s; }
        else if (i < SEQ * 32 + 2048) { const int j = i - SEQ * 32, pos = j >> 4, k = j & 15; const float inv = powf(10000.f, -(float)(2 * k) / 32.f); const float ang = (float)pos * inv; float s, c; sincos_rev((double)ang * 0.15915494309189535, s, c);
            WSP(float, WS_ROPE1)[j] = c; WSP(float, WS_ROPE1)[2048 + j] = s; }
        else { const float* dl = p.in[I_DLAM]; float s0 = 0.f, s1 = 0.f; for (int k = 0; k < 64; ++k) { s0 += dl[k] * dl[64 + k]; s1 += dl[128 + k] * dl[192 + k]; }
            WSP(float, WS_SCAL)[0] = expf(s0) - expf(s1) + LAMBDA_INIT; }
    }
}

__device__ __forceinline__ void modulate_row(const float* xrow, const float* shift, const float* scale, bf16* orow, int lane) {
#pragma unroll
    for (int j = 0; j < 4; ++j) { const int c = 4 * lane + 256 * j; const f32x4 x = *(const f32x4*)(xrow + c), sh = *(const f32x4*)(shift + c), sc = *(const f32x4*)(scale + c);
        const f32x4 h = x * (sc + 1.f) + sh; u32x2 w; w.x = cvt_pk_bf16(h[0], h[1]); w.y = cvt_pk_bf16(h[2], h[3]); *(u32x2*)(orow + c) = w; }
}
__device__ __forceinline__ void p0b_phase(PR p, Frame& F) {
    const int gw = F.vcu * NWAVES + F.wave, NGW = F.G * NWAVES;
    const float* mod = WSP(float, WS_MOD);
    bf16* H0 = WSP(bf16, A_H0);
    for (int r0 = gw; r0 < NTOK; r0 += 2 * NGW) {
        const int r1 = r0 + NGW; const bool has1 = r1 < NTOK;
        const bool lat0 = r0 < NLAT, lat1 = r1 < NLAT; const int b0 = lat0 ? (r0 >> 13) : 4, b1 = lat1 ? (r1 >> 13) : 4;
        const float* x0 = lat0 ? p.in[I_X] + (size_t)r0 * DM : p.in[I_CTX] + (size_t)(r0 - NLAT) * DM;
        const float* x1 = has1 ? (lat1 ? p.in[I_X] + (size_t)r1 * DM : p.in[I_CTX] + (size_t)(r1 - NLAT) * DM) : x0;
        f32x4 a[4], c[4];
#pragma unroll
        for (int j = 0; j < 4; ++j) { a[j] = *(const f32x4*)(x0 + 4 * F.lane + 256 * j); c[j] = *(const f32x4*)(x1 + 4 * F.lane + 256 * j); }
#pragma unroll
        for (int j = 0; j < 4; ++j) { const int cc = 4 * F.lane + 256 * j; const f32x4 sh = *(const f32x4*)(mod + b0 * 6144 + cc), sc = *(const f32x4*)(mod + b0 * 6144 + 1024 + cc);
            const f32x4 h = a[j] * (sc + 1.f) + sh;
            if (PF_IN0) *(unsigned*)((unsigned char*)H0 + (size_t)r0 * DM + cc) = pg8::pack4_fp8(h[0], h[1], h[2], h[3]);
            else { u32x2 w; w.x = cvt_pk_bf16(h[0], h[1]); w.y = cvt_pk_bf16(h[2], h[3]); *(u32x2*)(H0 + (size_t)r0 * DM + cc) = w; } }
        if (has1) {
#pragma unroll
            for (int j = 0; j < 4; ++j) { const int cc = 4 * F.lane + 256 * j; const f32x4 sh = *(const f32x4*)(mod + b1 * 6144 + cc), sc = *(const f32x4*)(mod + b1 * 6144 + 1024 + cc);
                const f32x4 h = c[j] * (sc + 1.f) + sh;
                if (PF_IN0) *(unsigned*)((unsigned char*)H0 + (size_t)r1 * DM + cc) = pg8::pack4_fp8(h[0], h[1], h[2], h[3]);
                else { u32x2 w; w.x = cvt_pk_bf16(h[0], h[1]); w.y = cvt_pk_bf16(h[2], h[3]); *(u32x2*)(H0 + (size_t)r1 * DM + cc) = w; } } }
    }
    const int gt = F.bid * NTHREADS + F.tid, NGT = F.G * NTHREADS;
    const float* S5K = WSP(float, WS_S5K); const f32x2* LAMP = WSP(f32x2, WS_LAMP); const f32x2* COEF = WSP(f32x2, WS_COEF);
    bf16* BT2 = WSP(bf16, WS_BT2); bf16* BT1 = WSP(bf16, WS_BT1);
    for (int idx = gt; idx < 16 * 512 * 96; idx += NGT) {
        const int g = idx / (512 * 96), n = (idx / 96) % 512, k0 = (idx % 96) * 8, i = n >> 4, pp = n & 15; float v[8];
        if (k0 < 512) { const int j = k0 >> 4, q0 = k0 & 15;
#pragma unroll
            for (int t = 0; t < 8; ++t) { const int q = q0 + t; float x;
                if (i > j) x = S5K[((g * 2 + 0) * 32 + (i - j)) * 256 + pp * 16 + q];
                else if (i < j) x = S5K[((g * 2 + 1) * 32 + (j - i)) * 256 + pp * 16 + q];
                else x = S5K[((g * 2 + 0) * 32) * 256 + pp * 16 + q] + S5K[((g * 2 + 1) * 32) * 256 + pp * 16 + q] + (pp == q ? p.in[I_S5D][g * 16 + pp] : 0.f);
                v[t] = x; }
        } else { const int kk0 = k0 - 512, dir = kk0 >> 7, ri = (kk0 >> 6) & 1, nn0 = kk0 & 63, pw = dir == 0 ? i + 1 : S5T - i;
#pragma unroll
            for (int t = 0; t < 8; ++t) { const int nn = nn0 + t; const f32x2 cc = (f32x2){p.in[I_CRE][((dir * 16 + g) * 16 + pp) * 64 + nn], p.in[I_CIM][((dir * 16 + g) * 16 + pp) * 64 + nn]};
                const f32x2 w = cmul(cc, LAMP[((g * 2 + dir) * 64 + nn) * 33 + pw]); v[t] = ri == 0 ? w.x : -w.y; }
        }
        u32x4 o; o.x = cvt_pk_bf16(v[0], v[1]); o.y = cvt_pk_bf16(v[2], v[3]); o.z = cvt_pk_bf16(v[4], v[5]); o.w = cvt_pk_bf16(v[6], v[7]);
        *(u32x4*)(BT2 + ((size_t)g * 512 + n) * 768 + k0) = o;
    }
    for (int idx = gt; idx < 16 * 256 * 64; idx += NGT) {
        const int g = idx / (256 * 64), n = (idx / 64) % 256, k0 = (idx % 64) * 8, j = k0 >> 4, q0 = k0 & 15, dir = n >> 7, ri = (n >> 6) & 1, nn = n & 63, pw = dir == 0 ? (S5T - 1 - j) : j;
        const f32x2 w = cmul(LAMP[((g * 2 + dir) * 64 + nn) * 33 + pw], COEF[(g * 2 + dir) * 64 + nn]); float v[8];
#pragma unroll
        for (int t = 0; t < 8; ++t) { const int q = q0 + t; const f32x2 bb = cmul(w, (f32x2){p.in[I_BRE][((dir * 16 + g) * 64 + nn) * 16 + q], p.in[I_BIM][((dir * 16 + g) * 64 + nn) * 16 + q]}); v[t] = ri == 0 ? bb.x : bb.y; }
        u32x4 o; o.x = cvt_pk_bf16(v[0], v[1]); o.y = cvt_pk_bf16(v[2], v[3]); o.z = cvt_pk_bf16(v[4], v[5]); o.w = cvt_pk_bf16(v[6], v[7]);
        *(u32x4*)(BT1 + ((size_t)g * 256 + n) * 512 + k0) = o;
    }
}
__device__ __forceinline__ void ret_unit(int unit, int& bh, int& h, int& r0) {
    const int cch = unit % RNCH; bh = unit / RNCH; h = bh % RH; const int b = bh / RH;
    r0 = cch < 64 ? b * SEQ + cch * RC : NLAT + b * CTXL + (cch - 64) * RC;
}
__device__ __forceinline__ float log_gamma(PR p, int dir, int h) { const float x = p.in[I_DECAY][dir * RH + h]; return -log1pf(expf(-x)); }
struct RetDeal { int u, stride, end; };
__device__ __forceinline__ RetDeal ret_deal(int c, int G, int NG, int a, int total) {
    RetDeal d;
    if (G <= NG) { d.u = c; d.stride = G; d.end = total; }
    else if (c < NG) { d.u = c; d.stride = NG; d.end = NG * a; }
    else { d.u = NG * a + (c - NG); d.stride = G - NG; d.end = total; }
    return d;
}
constexpr int RT_LD = 136;
__device__ __forceinline__ void ret_stage_vt(const bf16* V, int r0, int h, LAS bf16* VT, int tid) {
#pragma unroll
    for (int i = 0; i < 4; ++i) { const int id = tid + 512 * i, j = id >> 4, e0 = (id & 15) * 8;
        const u32x4 raw = *(const u32x4*)(V + (size_t)(r0 + j) * 768 + h * 128 + e0);
        VT[(e0 + 0) * RT_LD + j] = (bf16)(raw.x & 0xffffu); VT[(e0 + 1) * RT_LD + j] = (bf16)(raw.x >> 16);
        VT[(e0 + 2) * RT_LD + j] = (bf16)(raw.y & 0xffffu); VT[(e0 + 3) * RT_LD + j] = (bf16)(raw.y >> 16);
        VT[(e0 + 4) * RT_LD + j] = (bf16)(raw.z & 0xffffu); VT[(e0 + 5) * RT_LD + j] = (bf16)(raw.z >> 16);
        VT[(e0 + 6) * RT_LD + j] = (bf16)(raw.w & 0xffffu); VT[(e0 + 7) * RT_LD + j] = (bf16)(raw.w >> 16); }
}
__device__ __forceinline__ void ret_states_phase(PR p, Frame& F, int NG, int a) {
    LAS bf16* KdTf = (LAS bf16*)F.lds; LAS bf16* KdTb = KdTf + 64 * RT_LD; LAS bf16* VT = KdTb + 64 * RT_LD;
    const bf16* QK = WSP(bf16, A_QK); const bf16* V = WSP(bf16, A_V); float* RT = p.out;
    const int w = F.wave, fr = F.lane & 15, fq = F.lane >> 4;
    const RetDeal dl_ = ret_deal(F.bid, F.G, NG, a, NBATCH * RH * RNCH);
    for (int unit = dl_.u; unit < dl_.end; unit += dl_.stride) {
        int bh, h, r0; ret_unit(unit, bh, h, r0);
        const float lgf = log_gamma(p, 0, h), lgb = log_gamma(p, 1, h);
#pragma unroll
        for (int i = 0; i < 2; ++i) { const int id = F.tid + 512 * i, j = id >> 3, d0 = (id & 7) * 8;
            const u32x4 raw = *(const u32x4*)(QK + (size_t)(r0 + j) * 768 + (RH + h) * 64 + d0);
            const float df = expf(lgf * (float)(RC - 1 - j)), db = expf(lgb * (float)j);
            const unsigned wv[4] = {raw.x, raw.y, raw.z, raw.w};
#pragma unroll
            for (int t = 0; t < 4; ++t) { const float k0 = bflo(wv[t]), k1 = bfhi(wv[t]);
                KdTf[(d0 + 2 * t) * RT_LD + j] = (bf16)f2bf(k0 * df); KdTf[(d0 + 2 * t + 1) * RT_LD + j] = (bf16)f2bf(k1 * df);
                KdTb[(d0 + 2 * t) * RT_LD + j] = (bf16)f2bf(k0 * db); KdTb[(d0 + 2 * t + 1) * RT_LD + j] = (bf16)f2bf(k1 * db); } }
        ret_stage_vt(V, r0, h, VT, F.tid);
        __syncthreads();
        const int dir = w >> 2; const LAS bf16* KdT = dir ? KdTb : KdTf;
        f32x4 acc[2][4];
#pragma unroll
        for (int a = 0; a < 2; ++a)
#pragma unroll
            for (int d = 0; d < 4; ++d) acc[a][d] = (f32x4){0.f, 0.f, 0.f, 0.f};
#pragma unroll
        for (int ks = 0; ks < 4; ++ks) { bf16x8 af[2], bfr[4];
#pragma unroll
            for (int a = 0; a < 2; ++a) af[a] = *(const LAS bf16x8*)(VT + (((w & 3) * 2 + a) * 16 + fr) * RT_LD + 32 * ks + 8 * fq);
#pragma unroll
            for (int d = 0; d < 4; ++d) bfr[d] = *(const LAS bf16x8*)(KdT + (d * 16 + fr) * RT_LD + 32 * ks + 8 * fq);
#pragma unroll
            for (int a = 0; a < 2; ++a)
#pragma unroll
                for (int d = 0; d < 4; ++d) acc[a][d] = __builtin_amdgcn_mfma_f32_16x16x32_bf16(af[a], bfr[d], acc[a][d], 0, 0, 0); }
        float* out = RT + ((size_t)unit * 2 + dir) * 8192;
#pragma unroll
        for (int a = 0; a < 2; ++a)
#pragma unroll
            for (int d = 0; d < 4; ++d)
#pragma unroll
                for (int jj = 0; jj < 4; ++jj) out[(((w & 3) * 2 + a) * 16 + 4 * fq + jj) * 64 + d * 16 + fr] = acc[a][d][jj];
        __syncthreads();
    }
}
__device__ __forceinline__ void ret_scan_phase(PR p, Frame& F) {
    const float* RT = p.out; bf16* TT = WSP(bf16, A_TT);
    const int gt = F.bid * NTHREADS + F.tid, NGT = F.G * NTHREADS;
    for (int e = gt; e < 48 * 8192; e += NGT) {
        const int chain = e >> 13, el = e & 8191, dir = chain & 1, bh = chain >> 1, h = bh % RH;
        const float gC = expf(log_gamma(p, dir, h) * (float)RC);
        float st = 0.f;
        for (int s0 = 0; s0 < RNCH; s0 += 11) {
            float r[11];
#pragma unroll
            for (int k = 0; k < 11; ++k) { const int s = s0 + k, cch = dir == 0 ? (s < 2 ? 64 + s : s - 2) : (65 - s);
                r[k] = RT[((size_t)(bh * RNCH + cch) * 2 + dir) * 8192 + el]; }
#pragma unroll
            for (int k = 0; k < 11; ++k) { const int s = s0 + k, cch = dir == 0 ? (s < 2 ? 64 + s : s - 2) : (65 - s);
                TT[((size_t)(bh * RNCH + cch) * 2 + dir) * 8192 + el] = (bf16)f2bf(st);
                st = st * gC + r[k]; }
        }
    }
}
__device__ __forceinline__ void s5_scan_phase(PR p, Frame& F) {
    const float* EO = WSP(float, A_EO); bf16* UA = WSP(bf16, A_UA); const f32x2* LAMP = WSP(f32x2, WS_LAMP);
    if (F.wave != 0) return;
    for (int it = F.bid; it < 128; it += F.G) {
        const int b = it >> 5, g = (it >> 1) & 15, dir = it & 1, n = F.lane;
        const f32x2 lamT = LAMP[((g * 2 + dir) * 64 + n) * 33 + S5T];
        f32x2 st = (f32x2){0.f, 0.f};
#define S5ROW(s_) (dir == 0 ? ((s_) < 8 ? 1024 + b * 8 + (s_) : b * 256 + ((s_) - 8)) : ((s_) < 8 ? 1024 + b * 8 + (7 - (s_)) : b * 256 + (263 - (s_))))
#define S5LOAD(dst, s0_) do { _Pragma("unroll") for (int k = 0; k < 24; ++k) { const float* er = EO + ((size_t)g * S5ROWS + S5ROW((s0_) + k)) * 256 + dir * 128 + n; dst[k] = (f32x2){er[0], er[64]}; } } while (0)
#define S5STEP(src, s0_) do { _Pragma("unroll") for (int k = 0; k < 24; ++k) { bf16* ur = UA + ((size_t)g * S5ROWS + S5ROW((s0_) + k)) * 768 + 512 + dir * 128 + n; \
            ur[0] = (bf16)f2bf(st.x); ur[64] = (bf16)f2bf(st.y); st = cmul(lamT, st) + src[k]; } } while (0)
        f32x2 ea[24], eb[24];
        S5LOAD(ea, 0);
#pragma unroll 1
        for (int s0 = 0; s0 < 264; s0 += 48) {
            if (s0 + 24 < 264) S5LOAD(eb, s0 + 24);
            S5STEP(ea, s0);
            if (s0 + 24 >= 264) break;
            if (s0 + 48 < 264) S5LOAD(ea, s0 + 48);
            S5STEP(eb, s0 + 24);
        }
#undef S5ROW
#undef S5LOAD
#undef S5STEP
    }
}
__device__ __forceinline__ void ret_out_phase(PR p, Frame& F, int NG, int a) {
    constexpr int KT_LD = 72, GO_LD = 136;
    LAS bf16* VT = (LAS bf16*)F.lds; LAS bf16* Pw = VT + 128 * RT_LD + F.wave * 16 * RT_LD;
    LAS bf16* Kt = VT + 256 * RT_LD;
    LAS bf16* GO = Kt + 128 * KT_LD;
    const bf16* QK = WSP(bf16, A_QK); const bf16* V = WSP(bf16, A_V); const bf16* Gb = WSP(bf16, A_G); const bf16* TT = WSP(bf16, A_TT); bf16* MRG = WSP(bf16, A_MRG);
    const int w = F.wave, fr = F.lane & 15, fq = F.lane >> 4, i0 = 16 * w;
    const RetDeal dl_ = ret_deal(F.bid, F.G, NG, a, NBATCH * RH * RNCH);
    for (int unit = dl_.u; unit < dl_.end; unit += dl_.stride) {
        int bh, h, r0; ret_unit(unit, bh, h, r0);
        const float lgf2 = log_gamma(p, 0, h) * 1.4426950408889634f, lgb2 = log_gamma(p, 1, h) * 1.4426950408889634f;
        ret_stage_vt(V, r0, h, VT, F.tid);
#pragma unroll
        for (int i = 0; i < 2; ++i) { const int id = F.tid + 512 * i, j = id >> 3, c = (id & 7) * 8;
            *(LAS u32x4*)(Kt + j * KT_LD + c) = *(const u32x4*)(QK + (size_t)(r0 + j) * 768 + (RH + h) * 64 + c); }
#pragma unroll
        for (int i = 0; i < 4; ++i) { const int id = F.tid + 512 * i, j = id >> 4, c = (id & 15) * 8;
            *(LAS u32x4*)(GO + j * GO_LD + c) = *(const u32x4*)(Gb + (size_t)(r0 + j) * 768 + h * 128 + c); }
        bf16x8 aq[2];
#pragma unroll
        for (int ks = 0; ks < 2; ++ks) aq[ks] = *(const bf16x8*)(QK + (size_t)(r0 + i0 + fr) * 768 + h * 64 + 32 * ks + 8 * fq);
        __syncthreads();
#pragma unroll
        for (int jt = 0; jt < 8; ++jt) { f32x4 sc = (f32x4){0.f, 0.f, 0.f, 0.f};
#pragma unroll
            for (int ks = 0; ks < 2; ++ks) { const bf16x8 bk = *(const LAS bf16x8*)(Kt + (16 * jt + fr) * KT_LD + 32 * ks + 8 * fq);
                sc = __builtin_amdgcn_mfma_f32_16x16x32_bf16(aq[ks], bk, sc, 0, 0, 0); }
#pragma unroll
            for (int jj = 0; jj < 4; ++jj) { const int dl = (i0 + 4 * fq + jj) - (16 * jt + fr);
                const float dec = __builtin_amdgcn_exp2f(dl >= 0 ? lgf2 * (float)dl : lgb2 * (float)(-dl));
                Pw[(4 * fq + jj) * RT_LD + 16 * jt + fr] = (bf16)f2bf(sc[jj] * dec); } }
        asm volatile("s_waitcnt lgkmcnt(0)" ::: "memory");
        f32x4 o[8];
#pragma unroll
        for (int et = 0; et < 8; ++et) o[et] = (f32x4){0.f, 0.f, 0.f, 0.f};
#pragma unroll
        for (int ks = 0; ks < 4; ++ks) { const bf16x8 ap = *(const LAS bf16x8*)(Pw + fr * RT_LD + 32 * ks + 8 * fq);
#pragma unroll
            for (int et = 0; et < 8; ++et) { const bf16x8 bv = *(const LAS bf16x8*)(VT + (16 * et + fr) * RT_LD + 32 * ks + 8 * fq);
                o[et] = __builtin_amdgcn_mfma_f32_16x16x32_bf16(ap, bv, o[et], 0, 0, 0); } }
#pragma unroll
        for (int dir = 0; dir < 2; ++dir) { const bf16* TTp = TT + ((size_t)unit * 2 + dir) * 8192; float qd[4];
#pragma unroll
            for (int jj = 0; jj < 4; ++jj) { const int i = i0 + 4 * fq + jj; qd[jj] = __builtin_amdgcn_exp2f(dir == 0 ? lgf2 * (float)(i + 1) : lgb2 * (float)(RC - i)); }
#pragma unroll
            for (int et = 0; et < 8; ++et) { f32x4 t = (f32x4){0.f, 0.f, 0.f, 0.f};
#pragma unroll
                for (int ks = 0; ks < 2; ++ks) { const bf16x8 bt = *(const bf16x8*)(TTp + (16 * et + fr) * 64 + 32 * ks + 8 * fq);
                    t = __builtin_amdgcn_mfma_f32_16x16x32_bf16(aq[ks], bt, t, 0, 0, 0); }
#pragma unroll
                for (int jj = 0; jj < 4; ++jj) o[et][jj] += qd[jj] * t[jj]; } }
#pragma unroll
        for (int jj = 0; jj < 4; ++jj) { float s = 0.f;
#pragma unroll
            for (int et = 0; et < 8; ++et) s += o[et][jj];
            s += __shfl_xor(s, 1); s += __shfl_xor(s, 2); s += __shfl_xor(s, 4); s += __shfl_xor(s, 8);
            const float mu = s * (1.f / 128.f); float q = 0.f;
#pragma unroll
            for (int et = 0; et < 8; ++et) { const float d = o[et][jj] - mu; q += d * d; }
            q += __shfl_xor(q, 1); q += __shfl_xor(q, 2); q += __shfl_xor(q, 4); q += __shfl_xor(q, 8);
            const float rstd = 1.f / sqrtf(q * (1.f / 128.f) + GN_EPS);
            LAS bf16* grow = GO + (i0 + 4 * fq + jj) * GO_LD + fr;
#pragma unroll
            for (int et = 0; et < 8; ++et) { const float gv = bf2f(grow[16 * et]); grow[16 * et] = (bf16)f2bf((o[et][jj] - mu) * rstd * (gv * fast_sigmoid(gv))); } }
        __syncthreads();
#pragma unroll
        for (int i = 0; i < 4; ++i) { const int id = F.tid + 512 * i, j = id >> 4, c = (id & 15) * 8; const u32x4 v = *(const LAS u32x4*)(GO + j * GO_LD + c);
            const size_t off = (size_t)(r0 + j) * 1024 + h * 128 + c;
            if (PF_OUT0) { u32x2 q8; q8.x = pg8::pack4_fp8(bflo(v.x), bfhi(v.x), bflo(v.y), bfhi(v.y)); q8.y = pg8::pack4_fp8(bflo(v.z), bfhi(v.z), bflo(v.w), bfhi(v.w)); *(u32x2*)((unsigned char*)MRG + off) = q8; }
            else *(u32x4*)(MRG + off) = v; }
        __syncthreads();
    }
}
struct RouteRec { int e0, e1, rk0, rk1; float w0, w1; int d0, d1; };

__device__ __forceinline__ float* xs_row(PR p, int r) { return r < NLAT ? p.out + (size_t)r * DM : WSP(float, WS_XC) + (size_t)(r - NLAT) * DM; }

template <int LAYER>
__device__ __forceinline__ void ln1_router_phase(PR p, Frame& F, const bf16* O, bf16* H2, int nrows) {
    LAS float* rw = (LAS float*)F.lds;
    LAS unsigned* lcnt = (LAS unsigned*)(F.lds + 65536);
    for (int i = F.tid; i < 1024 * 16 / 4; i += NTHREADS) { const f32x4 w4 = ((const f32x4*)p.in[I_RW])[i]; const int col = i >> 2, e0 = (i & 3) * 4;
        rw[(e0 + 0) * 1024 + col] = w4[0]; rw[(e0 + 1) * 1024 + col] = w4[1]; rw[(e0 + 2) * 1024 + col] = w4[2]; rw[(e0 + 3) * 1024 + col] = w4[3]; }
    if (F.tid < 16) lcnt[F.tid] = 0u;
    __syncthreads();
    const float* mod = WSP(float, WS_MOD) + LAYER * 5 * 6144;
    const float* lng = p.in[I_LNG] + (LAYER * 2 + 0) * DM;
    RouteRec* route = WSP(RouteRec, WS_ROUTE);
    const int rpb = (nrows + F.G - 1) / F.G, rbeg = F.bid * rpb, rend = (rbeg + rpb < nrows) ? rbeg + rpb : nrows;
    const int lane = F.lane;
    f32x4 nx[4]; u32x2 no[4];
#define LN1_LOAD(r_) do { const bool lt_ = (r_) < NLAT; const float* xi_ = (LAYER == 0) ? (lt_ ? p.in[I_X] + (size_t)(r_) * DM : p.in[I_CTX] + (size_t)((r_) - NLAT) * DM) : xs_row(p, (r_)); \
        _Pragma("unroll") for (int j = 0; j < 4; ++j) { const int c = 4 * lane + 256 * j; nx[j] = *(const f32x4*)(xi_ + c); no[j] = *(const u32x2*)(O + (size_t)(r_) * DM + c); } } while (0)
    if (rbeg + F.wave < rend) LN1_LOAD(rbeg + F.wave);
    for (int r = rbeg + F.wave; r < rend; r += NWAVES) {
        const bool lat = r < NLAT; const int b = lat ? (r >> 13) : 4;
        const float* mb = mod + b * 6144;
        f32x4 v[4]; float s = 0.f;
#pragma unroll
        for (int j = 0; j < 4; ++j) { const int c = 4 * lane + 256 * j; const f32x4 g1 = *(const f32x4*)(mb + 2048 + c);
            const f32x4 o = (f32x4){bflo(no[j].x), bfhi(no[j].x), bflo(no[j].y), bfhi(no[j].y)};
            v[j] = nx[j] * ALPHA + g1 * o; s += (v[j][0] + v[j][1]) + (v[j][2] + v[j][3]); }
        if (r + NWAVES < rend) LN1_LOAD(r + NWAVES);
        const float mean = wave_sum(s) * (1.f / DM); float q = 0.f;
#pragma unroll
        for (int j = 0; j < 4; ++j) { v[j] = v[j] - mean; q += (v[j][0] * v[j][0] + v[j][1] * v[j][1]) + (v[j][2] * v[j][2] + v[j][3] * v[j][3]); }
        const float rstd = 1.f / sqrtf(wave_sum(q) * (1.f / DM) + LN_EPS);
        float* xo = xs_row(p, r);
        float lg[16];
#pragma unroll
        for (int e = 0; e < 16; ++e) lg[e] = 0.f;
#pragma unroll
        for (int j = 0; j < 4; ++j) { const int c = 4 * lane + 256 * j; const f32x4 gn = *(const f32x4*)(lng + c), sh = *(const f32x4*)(mb + 3072 + c), sc = *(const f32x4*)(mb + 4096 + c);
            const f32x4 x1 = v[j] * rstd * gn; *(f32x4*)(xo + c) = x1;
            const f32x4 h = x1 * (sc + 1.f) + sh;
            if (MOE_FP8) *(unsigned*)((unsigned char*)H2 + (size_t)r * DM + c) = pg8::pack4_fp8(h[0], h[1], h[2], h[3]);
            else { u32x2 w; w.x = cvt_pk_bf16(h[0], h[1]); w.y = cvt_pk_bf16(h[2], h[3]); *(u32x2*)(H2 + (size_t)r * DM + c) = w; }
#pragma unroll
            for (int e = 0; e < 16; ++e) { const f32x4 wv = *(const LAS f32x4*)(rw + e * 1024 + c); lg[e] = fmaf(h[0], wv[0], fmaf(h[1], wv[1], fmaf(h[2], wv[2], fmaf(h[3], wv[3], lg[e])))); } }
#pragma unroll
        for (int e = 0; e < 16; ++e) lg[e] = wave_sum(lg[e]);
        float sc[16], bs[16];
#pragma unroll
        for (int e = 0; e < 16; ++e) { sc[e] = __builtin_amdgcn_rcpf(1.f + __expf(-lg[e])); bs[e] = sc[e] + p.in[I_RB][e]; }
        float gbest = -INFINITY; int gsel = 0;
#pragma unroll
        for (int gq = 0; gq < 4; ++gq) { const float a = bs[4 * gq], b2 = bs[4 * gq + 1], c2 = bs[4 * gq + 2], d2 = bs[4 * gq + 3];
            const float m1 = fmaxf(fmaxf(a, b2), fmaxf(c2, d2));
            const float m2 = fmaxf(fmaxf(fminf(a, b2), fminf(c2, d2)), fminf(fmaxf(a, b2), fmaxf(c2, d2)));
            const float gs = m1 + m2; if (gs > gbest) { gbest = gs; gsel = gq; } }
        float b4[4], s4[4];
#pragma unroll
        for (int i = 0; i < 4; ++i) { b4[i] = gsel == 0 ? bs[i] : (gsel == 1 ? bs[4 + i] : (gsel == 2 ? bs[8 + i] : bs[12 + i])); s4[i] = gsel == 0 ? sc[i] : (gsel == 1 ? sc[4 + i] : (gsel == 2 ? sc[8 + i] : sc[12 + i])); }
        int i0 = 0; float bv0 = b4[0];
#pragma unroll
        for (int i = 1; i < 4; ++i) if (b4[i] > bv0) { bv0 = b4[i]; i0 = i; }
        int i1 = -1; float bv1 = -INFINITY;
#pragma unroll
        for (int i = 0; i < 4; ++i) if (i != i0 && b4[i] > bv1) { bv1 = b4[i]; i1 = i; }
        const float g0 = i0 == 0 ? s4[0] : (i0 == 1 ? s4[1] : (i0 == 2 ? s4[2] : s4[3]));
        const float g1s = i1 == 0 ? s4[0] : (i1 == 1 ? s4[1] : (i1 == 2 ? s4[2] : s4[3]));
        if (lane == 0) { RouteRec rr; rr.e0 = gsel * 4 + i0; rr.e1 = gsel * 4 + i1; rr.rk0 = (int)atomicAdd((unsigned*)&lcnt[rr.e0], 1u); rr.rk1 = (int)atomicAdd((unsigned*)&lcnt[rr.e1], 1u);
            const float den = g0 + g1s; rr.w0 = g0 / den; rr.w1 = g1s / den; rr.d0 = 0; rr.d1 = 0; route[r] = rr; }
    }
#undef LN1_LOAD
    __syncthreads();
    if (F.tid < 16) WSP(unsigned, WS_CNT)[F.bid * 16 + F.tid] = lcnt[F.tid];
    __syncthreads();
}

struct MoeTabs { LAS unsigned* tot; LAS unsigned* pstart; LAS unsigned* pendb; LAS unsigned* mybase; };
__device__ __forceinline__ MoeTabs moe_tabs(Frame& F) { MoeTabs t; LAS unsigned* m = (LAS unsigned*)(F.lds + MISC_OFF + 256); t.tot = m; t.pstart = m + 16; t.pendb = m + 32; t.mybase = m + 48; return t; }
__device__ __forceinline__ void moe_build_tabs(PR p, Frame& F, const MoeTabs& T) {
    const unsigned* cnt = WSP(unsigned, WS_CNT);
    LAS unsigned* tmp = (LAS unsigned*)(F.lds + MISC_OFF + 1024);
    { const int e = F.tid & 15, part = F.tid >> 4, per = (F.G + 31) / 32, b0 = part * per, b1 = (b0 + per < F.G) ? b0 + per : F.G; unsigned tot = 0, base = 0;
      for (int b = b0; b < b1; ++b) { const unsigned c = cnt[b * 16 + e]; tot += c; base += (b < F.bid) ? c : 0u; }
      tmp[part * 32 + e] = tot; tmp[part * 32 + 16 + e] = base; }
    __syncthreads();
    if (F.tid < 16) { unsigned tot = 0, base = 0;
#pragma unroll
        for (int q = 0; q < 32; ++q) { tot += tmp[q * 32 + F.tid]; base += tmp[q * 32 + 16 + F.tid]; }
        T.tot[F.tid] = tot; T.mybase[F.tid] = base; }
    __syncthreads();
    if (F.tid == 0) { unsigned acc = 0; for (int e = 0; e < 16; ++e) { T.pstart[e] = acc; acc += (T.tot[e] + 255u) & ~255u; T.pendb[e] = acc >> 8; } }
    __syncthreads();
}
__device__ __forceinline__ void moe_scatter_phase(PR p, Frame& F, const bf16* H2, bf16* BUF, int nrows) {
    const MoeTabs T = moe_tabs(F); moe_build_tabs(p, F, T);
    RouteRec* route = WSP(RouteRec, WS_ROUTE);
    const int rpb = (nrows + F.G - 1) / F.G, rbeg = F.bid * rpb, rend = (rbeg + rpb < nrows) ? rbeg + rpb : nrows;
    for (int r = rbeg + F.wave; r < rend; r += NWAVES) {
        const RouteRec rr = route[r];
        const int d0 = (int)(T.pstart[rr.e0] + T.mybase[rr.e0]) + rr.rk0, d1 = (int)(T.pstart[rr.e1] + T.mybase[rr.e1]) + rr.rk1;
        if (MOE_FP8) { const u32x4 a = *((const u32x4*)((const unsigned char*)H2 + (size_t)r * DM) + F.lane);
            *((u32x4*)((unsigned char*)BUF + (size_t)d0 * DM) + F.lane) = a; *((u32x4*)((unsigned char*)BUF + (size_t)d1 * DM) + F.lane) = a; }
        else { const u32x4* src = (const u32x4*)(H2 + (size_t)r * DM) + F.lane; const u32x4 a = src[0], b = src[64];
            u32x4* o0 = (u32x4*)(BUF + (size_t)d0 * DM) + F.lane; u32x4* o1 = (u32x4*)(BUF + (size_t)d1 * DM) + F.lane;
            o0[0] = a; o0[64] = b; o1[0] = a; o1[64] = b; }
        if (F.lane == 0) { route[r].d0 = d0; route[r].d1 = d1; }
    }
    if (F.bid < 16) { const int e = F.bid; const unsigned pb = T.pstart[e] + T.tot[e], pe = T.pstart[e] + ((T.tot[e] + 255u) & ~255u);
        for (unsigned r = pb + F.wave; r < pe; r += NWAVES) { if (MOE_FP8) { *((u32x4*)((unsigned char*)BUF + (size_t)r * DM) + F.lane) = (u32x4){0u, 0u, 0u, 0u}; } else { u32x4* o = (u32x4*)(BUF + (size_t)r * DM) + F.lane; o[0] = (u32x4){0u, 0u, 0u, 0u}; o[64] = (u32x4){0u, 0u, 0u, 0u}; } } }
}

template <int LAYER>
__device__ __forceinline__ void ln2_phase(PR p, Frame& F, const bf16* Y, bf16* H0N, int nrows) {
    const float* mod = WSP(float, WS_MOD) + LAYER * 5 * 6144;
    const float* modn = WSP(float, WS_MOD) + (LAYER + 1) * 5 * 6144;
    const float* lng = p.in[I_LNG] + (LAYER * 2 + 1) * DM;
    const RouteRec* route = WSP(RouteRec, WS_ROUTE);
    const int gw = F.vcu * NWAVES + F.wave, NGW = F.G * NWAVES, lane = F.lane;
    f32x4 nx[4]; u32x2 nya[4], nyb[4]; float nw0 = 0.f, nw1 = 0.f;
#define LN2_LOAD(r_) do { const RouteRec rr_ = route[(r_)]; nw0 = rr_.w0; nw1 = rr_.w1; const float* xr_ = xs_row(p, (r_)); \
        _Pragma("unroll") for (int j = 0; j < 4; ++j) { const int c = 4 * lane + 256 * j; nx[j] = *(const f32x4*)(xr_ + c); nya[j] = *(const u32x2*)(Y + (size_t)rr_.d0 * DM + c); nyb[j] = *(const u32x2*)(Y + (size_t)rr_.d1 * DM + c); } } while (0)
    if (gw < nrows) LN2_LOAD(gw);
    for (int r = gw; r < nrows; r += NGW) {
        const bool lat = r < NLAT; const int b = lat ? (r >> 13) : 4;
        const float* mb = mod + b * 6144; float* xr = xs_row(p, r);
        f32x4 v[4]; float s = 0.f;
#pragma unroll
        for (int j = 0; j < 4; ++j) { const int c = 4 * lane + 256 * j; const f32x4 g2 = *(const f32x4*)(mb + 5120 + c);
            const f32x4 y = (f32x4){bflo(nya[j].x), bfhi(nya[j].x), bflo(nya[j].y), bfhi(nya[j].y)} * nw0 + (f32x4){bflo(nyb[j].x), bfhi(nyb[j].x), bflo(nyb[j].y), bfhi(nyb[j].y)} * nw1;
            v[j] = nx[j] * ALPHA + g2 * y; s += (v[j][0] + v[j][1]) + (v[j][2] + v[j][3]); }
        if (r + NGW < nrows) LN2_LOAD(r + NGW);
        const float mean = wave_sum(s) * (1.f / DM); float q = 0.f;
#pragma unroll
        for (int j = 0; j < 4; ++j) { v[j] = v[j] - mean; q += (v[j][0] * v[j][0] + v[j][1] * v[j][1]) + (v[j][2] * v[j][2] + v[j][3] * v[j][3]); }
        const float rstd = 1.f / sqrtf(wave_sum(q) * (1.f / DM) + LN_EPS);
#pragma unroll
        for (int j = 0; j < 4; ++j) { const int c = 4 * lane + 256 * j; const f32x4 gn = *(const f32x4*)(lng + c); f32x4 x2 = v[j] * rstd * gn;
            *(f32x4*)(xr + c) = x2;
            if (LAYER == 0) { const float* mn = modn + b * 6144; const f32x4 sh = *(const f32x4*)(mn + c), sc = *(const f32x4*)(mn + 1024 + c); const f32x4 h = x2 * (sc + 1.f) + sh;
                if (PF_IN1) *(unsigned*)((unsigned char*)H0N + (size_t)r * DM + c) = pg8::pack4_fp8(h[0], h[1], h[2], h[3]);
                else { u32x2 w; w.x = cvt_pk_bf16(h[0], h[1]); w.y = cvt_pk_bf16(h[2], h[3]); *(u32x2*)(H0N + (size_t)r * DM + c) = w; } } }
    }
#undef LN2_LOAD
}
namespace att {
using pg8::i32x8; using pg8::i32x4;
constexpr int NW = 8, QBLK = 32, KVBLK = 64, LDQ = 1024, LDK = 1024, NKEY = SEQ + CTXL, NT = NKEY / KVBLK;
constexpr size_t SHM_V = KVBLK * 128 * 2, SHM_K = KVBLK * 64 * 2;
constexpr float THR = 8.f;
#define KSWZ64(row, colB) ((row) * 128 + ((colB) ^ ((((row) >> 1) & 7) << 4)))
#define SBAR() __builtin_amdgcn_sched_barrier(0)
__device__ __forceinline__ int crow(int r, int hi) { return (r & 3) + 8 * (r >> 2) + 4 * hi; }
__device__ __forceinline__ unsigned cvtpk(float lo, float hi) { unsigned r; asm volatile("v_cvt_pk_bf16_f32 %0, %1, %2" : "=v"(r) : "v"(lo), "v"(hi)); return r; }
__device__ __forceinline__ void partialSM(f32x16& p0, f32x16& p1, float& m_reg, float& mn, float& alpha) {
    constexpr float C = 1.4426950408889634f;
    float pmax = p0[0];
#pragma unroll
    for (int r = 1; r < 16; ++r) pmax = fmaxf(pmax, p0[r]);
#pragma unroll
    for (int r = 0; r < 16; ++r) pmax = fmaxf(pmax, p1[r]);
    { auto rr = __builtin_amdgcn_permlane32_swap(__float_as_uint(pmax), __float_as_uint(pmax), false, false); pmax = fmaxf(__uint_as_float(rr[0]), __uint_as_float(rr[1])); }
    if (__builtin_expect(__all(pmax - m_reg <= THR), 1)) { mn = m_reg; alpha = 1.f; }
    else { mn = fmaxf(m_reg, pmax); alpha = __builtin_amdgcn_exp2f((m_reg - mn) * C); m_reg = mn; }
    const float mnC = -mn * C;
#pragma unroll
    for (int r = 0; r < 16; ++r) p0[r] = fmaf(p0[r], C, mnC);
#pragma unroll
    for (int r = 0; r < 16; ++r) p1[r] = fmaf(p1[r], C, mnC);
#pragma unroll
    for (int r = 0; r < 16; ++r) p0[r] = __builtin_amdgcn_exp2f(p0[r]);
}
__device__ __forceinline__ void finishSM(f32x16& p0, f32x16& p1, float alpha, float& l_reg, bf16x8& pa0, bf16x8& pa1, bf16x8& pa2, bf16x8& pa3) {
#pragma unroll
    for (int r = 0; r < 16; ++r) p1[r] = __builtin_amdgcn_exp2f(p1[r]);
    float ps = 0;
#pragma unroll
    for (int r = 0; r < 16; ++r) ps += p0[r];
#pragma unroll
    for (int r = 0; r < 16; ++r) ps += p1[r];
    { auto rr = __builtin_amdgcn_permlane32_swap(__float_as_uint(ps), __float_as_uint(ps), false, false); ps = __uint_as_float(rr[0]) + __uint_as_float(rr[1]); }
    l_reg = l_reg * alpha + ps;
#define PK4(P, BASE, OUT) do { unsigned a0 = cvtpk(P[BASE + 0], P[BASE + 1]), a1 = cvtpk(P[BASE + 2], P[BASE + 3]);   \
    unsigned b0 = cvtpk(P[BASE + 4], P[BASE + 5]), b1 = cvtpk(P[BASE + 6], P[BASE + 7]);                              \
    auto r0 = __builtin_amdgcn_permlane32_swap(a0, b0, false, false); auto r1 = __builtin_amdgcn_permlane32_swap(a1, b1, false, false); \
    u32x4 w = {r0[0], r1[0], r0[1], r1[1]}; OUT = __builtin_bit_cast(bf16x8, w); } while (0)
    PK4(p0, 0, pa0); PK4(p0, 8, pa1); PK4(p1, 0, pa2); PK4(p1, 8, pa3);
#undef PK4
}
__device__ __forceinline__ void qkt(f32x16& p0, f32x16& p1, const LAS char* Ks, const bf16x8* qr, int r32, int hi) {
    p0 = f32x16{}; p1 = f32x16{};
#pragma unroll
    for (int d0 = 0; d0 < 4; ++d0) { const int cb = (d0 * 16 + hi * 8) * 2;
        const bf16x8 b0 = *(const LAS bf16x8*)(Ks + KSWZ64(r32, cb));
        const bf16x8 b1 = *(const LAS bf16x8*)(Ks + KSWZ64(32 + r32, cb));
        p0 = __builtin_amdgcn_mfma_f32_32x32x16_bf16(b0, qr[d0], p0, 0, 0, 0);
        p1 = __builtin_amdgcn_mfma_f32_32x32x16_bf16(b1, qr[d0], p1, 0, 0, 0); }
}
__device__ __forceinline__ int v_st(int k, int c) { const int kk = (k & ~0xC) | ((k & 4) << 1) | ((k & 8) >> 1); return ((kk >> 3) * 4 + (c >> 5)) * 512 + ((kk & 7) * 32 + (c & 31)) * 2; }
__device__ __forceinline__ int v_rd_base(int lane) { return ((lane & 3) << 3) | (((lane >> 2) & 3) << 6) | (((lane >> 4) & 1) << 5) | (((lane >> 5) & 1) << 8); }
constexpr int v_rd_off(int d0, int ks, int half) { return d0 * 512 + ks * 4096 + half * 2048; }
template <int OFF> __device__ __forceinline__ s16x4 tr_read(int vb) { s16x4 r; asm volatile("ds_read_b64_tr_b16 %0, %1 offset:%2" : "=&v"(r) : "v"(vb), "i"(OFF) : "memory"); return r; }
template <int D0> __device__ __forceinline__ void pv_one(f32x16& od, int vb, bf16x8 pa0, bf16x8 pa1, bf16x8 pa2, bf16x8 pa3) {
    const s16x4 l0 = tr_read<v_rd_off(D0, 0, 0)>(vb), h0 = tr_read<v_rd_off(D0, 0, 1)>(vb), l1 = tr_read<v_rd_off(D0, 1, 0)>(vb), h1 = tr_read<v_rd_off(D0, 1, 1)>(vb);
    const s16x4 l2 = tr_read<v_rd_off(D0, 2, 0)>(vb), h2 = tr_read<v_rd_off(D0, 2, 1)>(vb), l3 = tr_read<v_rd_off(D0, 3, 0)>(vb), h3 = tr_read<v_rd_off(D0, 3, 1)>(vb);
    asm volatile("s_waitcnt lgkmcnt(0)" ::: "memory"); SBAR();
#define PKV(L, H) (bf16x8){L[0], L[1], L[2], L[3], H[0], H[1], H[2], H[3]}
    od = __builtin_amdgcn_mfma_f32_32x32x16_bf16(pa0, PKV(l0, h0), od, 0, 0, 0);
    od = __builtin_amdgcn_mfma_f32_32x32x16_bf16(pa1, PKV(l1, h1), od, 0, 0, 0);
    od = __builtin_amdgcn_mfma_f32_32x32x16_bf16(pa2, PKV(l2, h2), od, 0, 0, 0);
    od = __builtin_amdgcn_mfma_f32_32x32x16_bf16(pa3, PKV(l3, h3), od, 0, 0, 0);
#undef PKV
}
__device__ __forceinline__ void pv_d0(f32x16* o, int vb, bf16x8 pa0, bf16x8 pa1, bf16x8 pa2, bf16x8 pa3) {
    pv_one<0>(o[0], vb, pa0, pa1, pa2, pa3); pv_one<1>(o[1], vb, pa0, pa1, pa2, pa3); pv_one<2>(o[2], vb, pa0, pa1, pa2, pa3); pv_one<3>(o[3], vb, pa0, pa1, pa2, pa3);
}
__device__ __forceinline__ void qkt_neg(f32x16& p0, f32x16& p1, int ka0, int ka1, const i32x8& qf, const f32x16& negm) {
    const i32x4 a0 = *(const LAS i32x4*)(uintptr_t)(unsigned)ka0, a1 = *(const LAS i32x4*)(uintptr_t)(unsigned)ka1;
    const i32x4 b0 = *(const LAS i32x4*)(uintptr_t)(unsigned)(ka0 + 2048), b1 = *(const LAS i32x4*)(uintptr_t)(unsigned)(ka1 + 2048);
    const i32x8 k0 = (i32x8){a0[0], a0[1], a0[2], a0[3], a1[0], a1[1], a1[2], a1[3]}, k1 = (i32x8){b0[0], b0[1], b0[2], b0[3], b1[0], b1[1], b1[2], b1[3]};
    asm volatile("v_mfma_f32_32x32x64_f8f6f4 %0, %1, %2, %3" : "=&v"(p0) : "v"(k0), "v"(qf), "v"(negm));
    asm volatile("v_mfma_f32_32x32x64_f8f6f4 %0, %1, %2, %3" : "=&v"(p1) : "v"(k1), "v"(qf), "v"(negm));
    asm volatile("s_nop 15\n\ts_nop 7" : "+v"(p0), "+v"(p1));
}
constexpr float THR2 = 8.f;
template <bool FIRST> __device__ __forceinline__ void partialSM2(f32x16& p0, f32x16& p1, float& m_reg, f32x16& negm, float& alpha) {
    float pmax = p0[0];
#pragma unroll
    for (int r = 1; r < 16; ++r) pmax = fmaxf(pmax, p0[r]);
#pragma unroll
    for (int r = 0; r < 16; ++r) pmax = fmaxf(pmax, p1[r]);
    { auto rr = __builtin_amdgcn_permlane32_swap(__float_as_uint(pmax), __float_as_uint(pmax), false, false); pmax = fmaxf(__uint_as_float(rr[0]), __uint_as_float(rr[1])); }
    if (!FIRST && __builtin_expect(__all(pmax <= THR2), 1)) { alpha = 1.f; }
    else { const float d = FIRST ? pmax : fmaxf(pmax, 0.f);
        alpha = FIRST ? 1.f : __builtin_amdgcn_exp2f(-d); m_reg += d;
#pragma unroll
        for (int r = 0; r < 16; ++r) { p0[r] -= d; p1[r] -= d; negm[r] = -m_reg; } }
#pragma unroll
    for (int r = 0; r < 16; ++r) p0[r] = __builtin_amdgcn_exp2f(p0[r]);
}
__device__ __forceinline__ void finishSM2(f32x16& p0, f32x16& p1, bf16x8& pa0, bf16x8& pa1, bf16x8& pa2, bf16x8& pa3) {
#pragma unroll
    for (int r = 0; r < 16; ++r) p1[r] = __builtin_amdgcn_exp2f(p1[r]);
#define PK4(P, BASE, OUT) do { unsigned a0 = cvtpk(P[BASE + 0], P[BASE + 1]), a1 = cvtpk(P[BASE + 2], P[BASE + 3]);   \
    unsigned b0 = cvtpk(P[BASE + 4], P[BASE + 5]), b1 = cvtpk(P[BASE + 6], P[BASE + 7]);                              \
    auto r0 = __builtin_amdgcn_permlane32_swap(a0, b0, false, false); auto r1 = __builtin_amdgcn_permlane32_swap(a1, b1, false, false); \
    u32x4 w = {r0[0], r1[0], r0[1], r1[1]}; OUT = __builtin_bit_cast(bf16x8, w); } while (0)
    PK4(p0, 0, pa0); PK4(p0, 8, pa1); PK4(p1, 0, pa2); PK4(p1, 8, pa3);
#undef PK4
}
__device__ __forceinline__ int vimg_off(int d, int key, int perm) {
    const int kk = key & 31, top = key >> 5, hi = (kk >> 2) & 1, r = (kk & 3) + 4 * (kk >> 3), byte = 32 * hi + ((r + 16 * top) ^ perm);
    return d * 64 + ((((byte >> 4) ^ ((d >> 2) & 3))) << 4) + (byte & 15);
}
__device__ __forceinline__ void finishSM8(f32x16& p0, f32x16& p1, i32x8& pP) {
#pragma unroll
    for (int r = 0; r < 16; ++r) p1[r] = __builtin_amdgcn_exp2f(p1[r]);
#pragma unroll
    for (int v = 0; v < 4; ++v) { int w = __builtin_amdgcn_cvt_pk_fp8_f32(p0[4 * v], p0[4 * v + 1], 0, false); pP[v] = __builtin_amdgcn_cvt_pk_fp8_f32(p0[4 * v + 2], p0[4 * v + 3], w, true); }
#pragma unroll
    for (int v = 0; v < 4; ++v) { int w = __builtin_amdgcn_cvt_pk_fp8_f32(p1[4 * v], p1[4 * v + 1], 0, false); pP[4 + v] = __builtin_amdgcn_cvt_pk_fp8_f32(p1[4 * v + 2], p1[4 * v + 3], w, true); }
}
__device__ __forceinline__ void pv8(f32x16 (&o)[4], f32x16& ls, int va0, int va1, const i32x8& pP, const i32x8& ones8) {
    i32x8 vf[4];
#pragma unroll
    for (int d0 = 0; d0 < 4; ++d0) { const i32x4 a = *(const LAS i32x4*)(uintptr_t)(unsigned)(va0 + d0 * 2048), b = *(const LAS i32x4*)(uintptr_t)(unsigned)(va1 + d0 * 2048);
        vf[d0] = (i32x8){a[0], a[1], a[2], a[3], b[0], b[1], b[2], b[3]}; }
    i32x8 pq = pP; asm volatile("s_nop 1" : "+v"(pq));
#pragma unroll
    for (int d0 = 0; d0 < 4; ++d0) asm volatile("v_mfma_f32_32x32x64_f8f6f4 %0, %1, %2, %0" : "+v"(o[d0]) : "v"(pq), "v"(vf[d0]));
    asm volatile("v_mfma_f32_32x32x64_f8f6f4 %0, %1, %2, %0" : "+v"(ls) : "v"(pq), "v"(ones8));
}
constexpr int SLOT = 24576, WS_OFF = 3 * SLOT, QL_OFF = WS_OFF + 2048;
__device__ __forceinline__ void attn_pass(const unsigned char* __restrict__ Qb, const unsigned char* __restrict__ Kh, const unsigned char* __restrict__ VIh, LAS char* lds, f32x16 (&o)[4], f32x16& ls, int tid) {
    const int wid = tid >> 6, lane = tid & 63, r32 = lane & 31, hi = lane >> 5;
    LAS float* ws = (LAS float*)(lds + WS_OFF) + wid * 64; LAS float* al_l = ws + 32;
    float m_reg = 0.f; f32x16 negm = f32x16{}; ls = f32x16{};
    const i32x8 ones8 = (i32x8){0x38383838, 0x38383838, 0x38383838, 0x38383838, 0x38383838, 0x38383838, 0x38383838, 0x38383838};
#pragma unroll
    for (int d = 0; d < 4; ++d) o[d] = f32x16{};
    i32x8 qf; { const unsigned char* Qw = Qb + (long)(wid * QBLK + r32) * 1024 + hi * 32; const i32x4 a = *(const i32x4*)Qw, b = *(const i32x4*)(Qw + 16); qf = (i32x8){a[0], a[1], a[2], a[3], b[0], b[1], b[2], b[3]}; }
    const int wu = __builtin_amdgcn_readfirstlane(wid);
    unsigned goffk;
    { const int q0 = (wu & 3) * 64 + lane, krow = q0 >> 2, g = (q0 & 3) ^ ((krow >> 2) & 3); goffk = (unsigned)(krow * 1024 + g * 16); }
    const int ka0 = (int)(uintptr_t)lds + 16384 + r32 * 64 + (((2 * hi) ^ ((r32 >> 2) & 3)) << 4), ka1 = (int)(uintptr_t)lds + 16384 + r32 * 64 + (((2 * hi + 1) ^ ((r32 >> 2) & 3)) << 4);
    const unsigned goffv = (unsigned)(wu * 1024 + lane * 16);
    const int va0 = (int)(uintptr_t)lds + r32 * 64 + (((2 * hi) ^ ((r32 >> 2) & 3)) << 4), va1 = (int)(uintptr_t)lds + r32 * 64 + (((2 * hi + 1) ^ ((r32 >> 2) & 3)) << 4);
#define SDMA(k0, s_) do { LAS char* sb_ = lds + (s_) * SLOT + wu * 1024; \
        __builtin_amdgcn_global_load_lds((const unsigned*)(VIh + (size_t)((k0) / KVBLK) * 8192 + goffv), (LAS unsigned*)(sb_), 16, 0, 0); \
        if (wu < 4) __builtin_amdgcn_global_load_lds((const unsigned*)(Kh + (size_t)(k0) * 1024 + goffk), (LAS unsigned*)(sb_ + 16384), 16, 0, 0); } while (0)
#define ABAR() do { asm volatile("s_waitcnt lgkmcnt(0)" ::: "memory"); __builtin_amdgcn_s_barrier(); asm volatile("" ::: "memory"); } while (0)
#define RESC(a) do { if (__any((a) < 1.f)) { if (hi == 0) al_l[r32] = (a); asm volatile("s_nop 15\n\ts_nop 15\n\ts_waitcnt lgkmcnt(0)" : "+v"(o[0]), "+v"(o[1]), "+v"(o[2]), "+v"(o[3]), "+v"(ls) :: "memory"); \
    _Pragma("unroll") for (int r = 0; r < 16; ++r) { const float a_ = al_l[crow(r, hi)]; ls[r] *= a_; _Pragma("unroll") for (int d = 0; d < 4; ++d) o[d][r] *= a_; } } } while (0)
#define NEXT3(s_) ((s_) == 2 ? 0 : (s_) + 1)
    f32x16 pA0, pA1, pB0, pB1; float alA, alB; i32x8 pP;
    if (wid >= 4) __builtin_amdgcn_s_setprio(1);
    SDMA(0, 0); asm volatile("s_waitcnt vmcnt(0)" ::: "memory"); ABAR();
    SDMA(KVBLK, 1);
    qkt_neg(pA0, pA1, ka0, ka1, qf, negm); partialSM2<true>(pA0, pA1, m_reg, negm, alA);
    asm volatile("s_waitcnt vmcnt(0)" ::: "memory"); ABAR();
    int sK = 1, sV = 0, sW = 2;
#pragma nounroll
    for (int j = 1; j + 1 < NT; j += 2) {
        SDMA((j + 1) * KVBLK, sW);
        SBAR(); qkt_neg(pB0, pB1, ka0 + sK * SLOT, ka1 + sK * SLOT, qf, negm);
        finishSM8(pA0, pA1, pP); SBAR();
        pv8(o, ls, va0 + sV * SLOT, va1 + sV * SLOT, pP, ones8); partialSM2<false>(pB0, pB1, m_reg, negm, alB);
        RESC(alB);
        asm volatile("s_waitcnt vmcnt(0)" ::: "memory"); ABAR();
        { const int t_ = sV; sV = sK; sK = sW; sW = t_; }
        { const int jn = (j + 2 < NT) ? (j + 2) : (NT - 1); SDMA(jn * KVBLK, sW); }
        SBAR(); qkt_neg(pA0, pA1, ka0 + sK * SLOT, ka1 + sK * SLOT, qf, negm);
        finishSM8(pB0, pB1, pP); SBAR();
        pv8(o, ls, va0 + sV * SLOT, va1 + sV * SLOT, pP, ones8); partialSM2<false>(pA0, pA1, m_reg, negm, alA);
        RESC(alA);
        asm volatile("s_waitcnt vmcnt(0)" ::: "memory"); ABAR();
        { const int t_ = sV; sV = sK; sK = sW; sW = t_; }
    }
    SBAR(); qkt_neg(pB0, pB1, ka0 + sK * SLOT, ka1 + sK * SLOT, qf, negm);
    finishSM8(pA0, pA1, pP); SBAR();
    pv8(o, ls, va0 + sV * SLOT, va1 + sV * SLOT, pP, ones8); partialSM2<false>(pB0, pB1, m_reg, negm, alB);
    RESC(alB);
    finishSM8(pB0, pB1, pP); SBAR();
    pv8(o, ls, va0 + sK * SLOT, va1 + sK * SLOT, pP, ones8);
    __builtin_amdgcn_s_setprio(0);
    asm volatile("s_nop 15\n\ts_nop 15\n\ts_nop 15\n\ts_nop 15" : "+v"(o[0]), "+v"(o[1]), "+v"(o[2]), "+v"(o[3]), "+v"(ls));
    ABAR();
#undef SDMA
#undef ABAR
#undef RESC
#undef NEXT3
}
}

__device__ __forceinline__ void vt_image_phase(PR p, Frame& F) {
    const bf16* V = WSP(bf16, B_V); unsigned char* VI = p.ws + B_VI;
    LAS unsigned char* img = (LAS unsigned char*)(F.lds + F.wave * 16384);
    const int gw = F.vcu * NWAVES + F.wave, NGW = F.G * NWAVES, lane = F.lane;
    const unsigned probe = (unsigned)__builtin_amdgcn_cvt_pk_fp8_f32(1.f, 2.f, 0, false);
    const int pshift = (probe & 0xffffu) ? 0 : 16, perm = ((((probe >> pshift) & 0xffu) == 0x38u) ? 0 : 1) | (pshift ? 2 : 0);
    for (int it = gw; it < NBATCH * 8 * att::NT; it += NGW) {
        const int t = it % att::NT, bh = it / att::NT, b = bh >> 3, h = bh & 7;
        const bf16* src = V + ((size_t)b * att::NKEY + t * 64) * 1024 + h * 128;
#pragma unroll 1
        for (int i0 = 0; i0 < 16; i0 += 4) {
            u32x4 x[4];
#pragma unroll
            for (int i = 0; i < 4; ++i) { const int id = lane + 64 * (i0 + i), key = id >> 4, dc = (id & 15) * 8; x[i] = *(const u32x4*)(src + (size_t)key * 1024 + dc); }
#pragma unroll
            for (int i = 0; i < 4; ++i) { const int id = lane + 64 * (i0 + i), key = id >> 4, dc = (id & 15) * 8; const unsigned w[4] = {x[i].x, x[i].y, x[i].z, x[i].w};
#pragma unroll
                for (int e = 0; e < 4; ++e) { const float lo = bflo(w[e]), hi_ = bfhi(w[e]);
                    img[att::vimg_off(dc + 2 * e, key, perm)] = (unsigned char)((__builtin_amdgcn_cvt_pk_fp8_f32(lo, lo, 0, false) >> pshift) & 0xff); img[att::vimg_off(dc + 2 * e + 1, key, perm)] = (unsigned char)((__builtin_amdgcn_cvt_pk_fp8_f32(hi_, hi_, 0, false) >> pshift) & 0xff); } }
        }
        asm volatile("s_waitcnt lgkmcnt(0)" ::: "memory");
        unsigned char* dst = VI + (size_t)it * 8192;
#pragma unroll
        for (int i = 0; i < 8; ++i) *(u32x4*)(dst + (lane + 64 * i) * 16) = *(const LAS u32x4*)(img + (lane + 64 * i) * 16);
        asm volatile("s_waitcnt lgkmcnt(0)" ::: "memory");
    }
}
__device__ __forceinline__ void attn_phase(PR p, Frame& F) {
    using namespace att;
    const unsigned char* Q = p.ws + B_Q; const unsigned char* K = p.ws + B_K; bf16* AO = WSP(bf16, B_AO);
    for (int unit = F.vcu; unit < NBATCH * 8 * 32; unit += F.G) {
        const int bh = unit >> 5, qb = unit & 31, b = bh >> 3, h = bh & 7;
        const unsigned char* Qb = Q + ((size_t)b * SEQ + qb * 256) * 1024 + h * 128;
        const unsigned char* Kh = K + (size_t)b * NKEY * 1024 + h * 128;
        const unsigned char* VIh = p.ws + B_VI + (size_t)(b * 8 + h) * NT * 8192;
        f32x16 o[4]; f32x16 ls;
        int tl = F.tid; asm volatile("" : "+v"(tl));
        attn_pass(Qb, Kh, VIh, (LAS char*)F.lds, o, ls, tl);
        asm volatile("" : "+v"(tl));
        { float* st = WSP(float, B_STASH) + (size_t)F.bid * 64 * NTHREADS + tl;
#pragma unroll
          for (int r = 0; r < 16; ++r) { const float rl = __builtin_amdgcn_rcpf(ls[r]);
#pragma unroll
              for (int d0 = 0; d0 < 4; ++d0) st[(size_t)(d0 * 16 + r) * NTHREADS] = o[d0][r] * rl; } }
        __syncthreads();
        asm volatile("" : "+v"(tl));
        attn_pass(Qb + 64, Kh + 64, VIh, (LAS char*)F.lds, o, ls, tl);
        asm volatile("" : "+v"(tl));
        { const int lane = tl & 63, r32 = lane & 31, hi = lane >> 5, wid = tl >> 6;
          const float* st = WSP(float, B_STASH) + (size_t)F.bid * 64 * NTHREADS + tl;
          const float lam = WSP(float, WS_SCAL)[0];
          float ss[16];
#pragma unroll
          for (int r = 0; r < 16; ++r) { const float rl = __builtin_amdgcn_rcpf(ls[r]); float q = 0.f;
#pragma unroll
              for (int d0 = 0; d0 < 4; ++d0) { const float v = st[(size_t)(d0 * 16 + r) * NTHREADS] - lam * (o[d0][r] * rl); o[d0][r] = v; q += v * v; }
              ss[r] = q; }
#pragma unroll
          for (int r = 0; r < 16; ++r) { float q = ss[r]; q += __shfl_xor(q, 1); q += __shfl_xor(q, 2); q += __shfl_xor(q, 4); q += __shfl_xor(q, 8); q += __shfl_xor(q, 16);
              ss[r] = (1.f / sqrtf(q * (1.f / 128.f) + GN_EPS)) * (1.f - LAMBDA_INIT); }
          bf16* Ow = PF_OUT1 ? (bf16*)((unsigned char*)AO + ((size_t)b * SEQ + qb * 256 + wid * QBLK) * DM + h * 128 + r32) : AO + ((size_t)b * SEQ + qb * 256 + wid * QBLK) * DM + h * 128 + r32;
#pragma unroll
          for (int d0 = 0; d0 < 4; ++d0) { const float gsub = p.in[I_SUBLN][d0 * 32 + r32];
#pragma unroll
              for (int r = 0; r < 16; ++r) { if (PF_OUT1) ((unsigned char*)Ow)[(size_t)crow(r, hi) * DM + d0 * 32] = pg8::to_fp8(o[d0][r] * ss[r] * gsub); else Ow[(size_t)crow(r, hi) * DM + d0 * 32] = (bf16)f2bf(o[d0][r] * ss[r] * gsub); } } }
        __syncthreads();
    }
}
#ifndef MK_MULTI
#define MK_MULTI 0
#endif
constexpr int NPHASE = 22;

template <int LAYER>
__device__ __forceinline__ void moe_gemm1_phase(PR p, Frame& F, const bf16* BUF, bf16* HID) {
    const MoeTabs T = moe_tabs(F); moe_build_tabs(p, F, T);
    const int LD = MOE_FP8 ? 512 : 1024;
    pg8::ExpertOrder S; S.g.init((int)T.pendb[15], 8, F.G, F.bid, LD, LD); S.pend = T.pendb; S.eB = (long)EXP_STRIDE;
    pg8::Gemm g{BUF, (const bf16*)(p.ws + WS_EXP + (size_t)LAYER * 16 * EXP_STRIDE), LD, LD, LD};
    if (MOE_FP8) { pg8::EpiSwiGlu8 E{(unsigned char*)HID}; pg8::gemm_phase<true>(F.lds, g, S, E); }
    else { pg8::EpiSwiGlu E{HID}; pg8::gemm_phase(F.lds, g, S, E); }
}
template <int LAYER>
__device__ __forceinline__ void moe_gemm2_phase(PR p, Frame& F, const bf16* HID, bf16* Y) {
    const MoeTabs T = moe_tabs(F); moe_build_tabs(p, F, T);
    const int LD = MOE_FP8 ? 512 : 1024;
    pg8::ExpertOrder S; S.g.init((int)T.pendb[15], 4, F.G, F.bid, LD, LD); S.pend = T.pendb; S.eB = (long)EXP_STRIDE;
    pg8::Gemm g{HID, (const bf16*)(p.ws + WS_EXP + (size_t)LAYER * 16 * EXP_STRIDE + EXP_DN), LD, LD, LD};
    if (MOE_FP8) { pg8::EpiPlainS E{Y, 1024, 0.03125f}; pg8::gemm_phase<true>(F.lds, g, S, E); }
    else { pg8::EpiPlain E{Y, 1024}; pg8::gemm_phase(F.lds, g, S, E); }
}

#define PHP() const CAS Params* kp_ = (const CAS Params*)__builtin_amdgcn_kernarg_segment_ptr(); asm volatile("" : "+s"(kp_)); PR p = *kp_; Frame F; { int t_ = threadIdx.x; asm volatile("" : "+v"(t_)); int g_ = gridDim.x, b_ = blockIdx.x; asm volatile("" : "+s"(g_), "+s"(b_)); \
    F.lds = lds_base; F.tid = t_; F.lane = t_ & 63; F.wave = __builtin_amdgcn_readfirstlane(t_ >> 6); F.G = g_; F.bid = b_; F.vcu = (g_ % 8 == 0) ? (b_ % 8) * (g_ / 8) + b_ / 8 : b_; }
__global__ void __launch_bounds__(NTHREADS, 2) fwd(Params p_) {
    extern __shared__ __attribute__((aligned(16))) unsigned char lds_raw[];
    LAS unsigned char* const lds_base = (LAS unsigned char*)lds_raw;
    volatile LAS unsigned* misc = (volatile LAS unsigned*)(lds_base + MISC_OFF);
    for (int u = threadIdx.x; u < 64; u += NTHREADS) misc[u] = 0u;
    __syncthreads();
    const int lo = p_.ph_lo, hi = p_.ph_hi;
    XcdBarrier bar; bar.bar = (unsigned*)(p_.ws + WS_CTL) + 4096; bar.x = 0; bar.st = misc;
    if (!MK_MULTI) bar = xcd_barrier_post((unsigned*)(p_.ws + WS_CTL) + 4096, misc);
#ifndef ONLY_PHASE
#define ONLY_PHASE -1
#endif
#ifndef REP_MASK
#define REP_MASK 0
#endif
#define REP(k) for (int rep_ = 0; rep_ < (((REP_MASK) >> (k)) & 1) + 1; ++rep_, __syncthreads())
#define IN(k) ((ONLY_PHASE < 0 || ONLY_PHASE == (k)) && lo <= (k) && (k) < hi)
#define SEAM(k) do { if (IN(k) && IN((k) + 1)) xcd_barrier(bar); } while (0)
#ifdef DIAG_A
#define STAMP(k) do { if ((k) == DIAG_A || (k) == DIAG_B) { if (blockIdx.x == 0 && threadIdx.x == 0) { unsigned long long* st_ = (unsigned long long*)(p_.ws + WS_SCAL + 64) + ((k) == DIAG_B ? 2 : 0); st_[0] = __builtin_amdgcn_s_memtime(); st_[1] = __builtin_amdgcn_s_memrealtime(); } } } while (0)
#define STAMPE(k) do { } while (0)
#else
#define STAMP(k) do { } while (0)
#define STAMPE(k) do { } while (0)
#endif

    STAMP(0); if (IN(0)) REP(0) { PHP(); p0a_prologue(p, F); } STAMPE(0); SEAM(0);
    STAMP(1); if (IN(1)) REP(1) { PHP(); p0b_phase(p, F); } STAMPE(1); SEAM(1);
    STAMP(2); if (IN(2)) REP(2) { PHP();
        constexpr int LD = PF_IN0 ? 512 : 1024; pg8::Gemm g{WSP(bf16, A_H0), WSP(bf16, WS_WIN0), LD, LD, LD}; pg8::GridOrder S; S.init(NTOK / 256, 10, F.G, F.bid, LD, LD);
        pg8::EpiInProj0 E{WSP(bf16, A_QK), WSP(bf16, A_V), WSP(bf16, A_G), WSP(bf16, A_UA), WSP(float, WS_ROPE0C), WSP(float, WS_ROPE0S)};
        pg8::gemm_phase<PF_IN0 != 0>(F.lds, g, S, E);
    } STAMPE(2); SEAM(2);
    STAMP(3); if (IN(3)) REP(3) { PHP();
        pg8::Gemm g{WSP(bf16, A_UA), WSP(bf16, WS_BT1), 512, 768, 512};
        pg8::BatchOrder S; S.nZ = 16; S.nM = 5; S.nN = 1; S.G = F.G; S.c = F.bid; S.tA = 256L * 768 * 2; S.tB = 256L * 512 * 2; S.zA = (long)S5ROWS * 768 * 2; S.zB = 256L * 512 * 2;
        pg8::EpiS5E E{WSP(float, A_EO)};
        pg8::gemm_phase(F.lds, g, S, E);
        ret_states_phase(p, F, 80, 3);
    } STAMPE(3); SEAM(3);
    STAMP(4); if (IN(4)) REP(4) { PHP(); s5_scan_phase(p, F); ret_scan_phase(p, F); } STAMPE(4); SEAM(4);
    STAMP(5); if (IN(5)) REP(5) { PHP();
        pg8::Gemm g{WSP(bf16, A_UA), WSP(bf16, WS_BT2), 768, 768, 768};
        pg8::BatchOrder S; S.nZ = 16; S.nM = 5; S.nN = 2; S.G = F.G; S.c = F.bid; S.tA = 256L * 768 * 2; S.tB = 256L * 768 * 2; S.zA = (long)S5ROWS * 768 * 2; S.zB = 512L * 768 * 2;
        pg8::EpiS5Y E{WSP(bf16, A_SG)};
        pg8::gemm_phase(F.lds, g, S, E);
#ifdef RET_REP
        for (int rr_ = 0; rr_ < RET_REP; ++rr_) { ret_out_phase(p, F, 160, 6); __syncthreads(); }
#endif
        ret_out_phase(p, F, 160, 6);
    } STAMPE(5); SEAM(5);
    STAMP(6); if (IN(6)) REP(6) { PHP();
        pg8::Gemm g{WSP(bf16, A_SG), WSP(bf16, WS_WGLU), 256, 256, 256}; pg8::GridOrder S; S.init(NTOK / 256, 2, F.G, F.bid, 256, 256);
        pg8::EpiGlu E{WSP(bf16, A_MRG)};
        pg8::gemm_phase(F.lds, g, S, E);
    } STAMPE(6); SEAM(6);
    STAMP(7); if (IN(7)) REP(7) { PHP();
        constexpr int LD = PF_OUT0 ? 512 : 1024; pg8::Gemm g{WSP(bf16, A_MRG), WSP(bf16, WS_WOUT0), LD, LD, LD}; pg8::GridOrder S; S.init(NTOK / 256, 4, F.G, F.bid, LD, LD);
        pg8::EpiPlainS E{WSP(bf16, A_O), 1024, pg8::PSC_OUT0};
        pg8::gemm_phase<PF_OUT0 != 0>(F.lds, g, S, E);
    } STAMPE(7); SEAM(7);
    STAMP(8); if (IN(8)) REP(8) { PHP(); ln1_router_phase<0>(p, F, WSP(bf16, A_O), WSP(bf16, A_H2), NTOK); } STAMPE(8); SEAM(8);
    STAMP(9); if (IN(9)) REP(9) { PHP(); moe_scatter_phase(p, F, WSP(bf16, A_H2), WSP(bf16, A_BUF), NTOK); } STAMPE(9); SEAM(9);
    STAMP(10); if (IN(10)) REP(10) { PHP(); moe_gemm1_phase<0>(p, F, WSP(bf16, A_BUF), WSP(bf16, A_HID)); } STAMPE(10); SEAM(10);
    STAMP(11); if (IN(11)) REP(11) { PHP(); moe_gemm2_phase<0>(p, F, WSP(bf16, A_HID), WSP(bf16, A_Y)); } STAMPE(11); SEAM(11);
    STAMP(12); if (IN(12)) REP(12) { PHP(); ln2_phase<0>(p, F, WSP(bf16, A_Y), WSP(bf16, A_H0P), NTOK); } STAMPE(12); SEAM(12);
    STAMP(13); if (IN(13)) REP(13) { PHP();
        constexpr int LD = PF_IN1 ? 512 : 1024; pg8::Gemm g{WSP(bf16, A_H0P), WSP(bf16, WS_WIN1), LD, LD, LD}; pg8::InProj1Order S; S.g.init(NLAT / 256, 12, F.G, F.bid, LD, LD);
        pg8::EpiInProj1 E{WSP(bf16, B_Q), WSP(bf16, B_K), WSP(bf16, B_V), WSP(float, WS_ROPE1)};
        pg8::gemm_phase<PF_IN1 != 0>(F.lds, g, S, E);
    } STAMPE(13); SEAM(13);
    STAMP(14); if (IN(14)) REP(14) { PHP(); vt_image_phase(p, F); } STAMPE(14); SEAM(14);
    STAMP(15); if (IN(15)) REP(15) { PHP(); attn_phase(p, F); } STAMPE(15); SEAM(15);
    STAMP(16); if (IN(16)) REP(16) { PHP();
        constexpr int LD = PF_OUT1 ? 512 : 1024; pg8::Gemm g{WSP(bf16, B_AO), WSP(bf16, WS_WOUT1), LD, LD, LD}; pg8::GridOrder S; S.init(NLAT / 256, 4, F.G, F.bid, LD, LD);
        pg8::EpiPlainS E{WSP(bf16, B_O), 1024, pg8::PSC_OUT1};
        pg8::gemm_phase<PF_OUT1 != 0>(F.lds, g, S, E);
    } STAMPE(16); SEAM(16);
    STAMP(17); if (IN(17)) REP(17) { PHP(); ln1_router_phase<1>(p, F, WSP(bf16, B_O), WSP(bf16, B_H2), NLAT); } STAMPE(17); SEAM(17);
    STAMP(18); if (IN(18)) REP(18) { PHP(); moe_scatter_phase(p, F, WSP(bf16, B_H2), WSP(bf16, B_BUF), NLAT); } STAMPE(18); SEAM(18);
    STAMP(19); if (IN(19)) REP(19) { PHP(); moe_gemm1_phase<1>(p, F, WSP(bf16, B_BUF), WSP(bf16, B_HID)); } STAMPE(19); SEAM(19);
    STAMP(20); if (IN(20)) REP(20) { PHP(); moe_gemm2_phase<1>(p, F, WSP(bf16, B_HID), WSP(bf16, B_Y)); } STAMPE(20); SEAM(20);
    STAMP(21); if (IN(21)) REP(21) { PHP(); ln2_phase<1>(p, F, WSP(bf16, B_Y), nullptr, NLAT); }
#ifdef DIAG_A
    if (blockIdx.x == 0 && threadIdx.x == 0) {
        unsigned long long* st_ = (unsigned long long*)(p_.ws + WS_SCAL + 64);
        if (DIAG_B == NPHASE) { st_[2] = __builtin_amdgcn_s_memtime(); st_[3] = __builtin_amdgcn_s_memrealtime(); }
        const unsigned long long ticks = 4ull * (st_[3] - st_[1]);
        const unsigned long long t0 = __builtin_amdgcn_s_memrealtime();
        while (__builtin_amdgcn_s_memrealtime() - t0 < ticks) __builtin_amdgcn_s_sleep(8);
    }
#endif
#undef IN
#undef SEAM
}

extern "C" void kernel_launch(void* const* d_in, const int* in_sizes, int n_in, void* d_out, int out_size, void* d_ws, size_t ws_size, hipStream_t stream) {
    static int grid = 0;
    if (grid == 0) {
        if (n_in != N_IN || out_size != NLAT * DM || ws_size < WS_END) { fprintf(stderr, "kernel_launch: unexpected shapes: n_in %d out %d ws %zu (need %zu)\n", n_in, out_size, ws_size, (size_t)WS_END); grid = -1; return; }
        int dev = 0, cus = 0, per_cu = 0;
        if (hipGetDevice(&dev) != hipSuccess || hipDeviceGetAttribute(&cus, hipDeviceAttributeMultiprocessorCount, dev) != hipSuccess) { grid = -1; return; }
        if (hipFuncSetAttribute((const void*)fwd, hipFuncAttributeMaxDynamicSharedMemorySize, LDS_BYTES) != hipSuccess) { fprintf(stderr, "kernel_launch: hipFuncSetAttribute failed\n"); grid = -1; return; }
        if (hipOccupancyMaxActiveBlocksPerMultiprocessor(&per_cu, (const void*)fwd, NTHREADS, LDS_BYTES) != hipSuccess || per_cu < 1) fprintf(stderr, "kernel_launch: occupancy query reports %d\n", per_cu);
        (void)hipGetLastError();
        grid = cus > 256 ? 256 : cus;
    }
    if (grid < 0) return;
    if (hipMemsetAsync((char*)d_ws + WS_CTL, 0, CTL_BYTES, stream) != hipSuccess) return;
    Params prm{};
    for (int i = 0; i < N_IN; ++i) prm.in[i] = (const float*)d_in[i];
    prm.out = (float*)d_out; prm.ws = (unsigned char*)d_ws;
#if MK_MULTI
    for (int ph = 0; ph < NPHASE; ++ph) { prm.ph_lo = ph; prm.ph_hi = ph + 1; hipLaunchKernelGGL(fwd, dim3(grid), dim3(NTHREADS), LDS_BYTES, stream, prm); }
#else
    prm.ph_lo = 0; prm.ph_hi = NPHASE;
    hipLaunchKernelGGL(fwd, dim3(grid), dim3(NTHREADS), LDS_BYTES, stream, prm);
#endif
}
```

```cpp
#include <hip/hip_runtime.h>
#include <cstdio>
#include <cstdint>

#define LAS __attribute__((address_space(3)))
#define GAS __attribute__((address_space(1)))
typedef unsigned short bf16;
typedef short bf16x8 __attribute__((ext_vector_type(8)));
typedef short s16x4 __attribute__((ext_vector_type(4)));
typedef float f32x4 __attribute__((ext_vector_type(4)));
typedef float f32x2 __attribute__((ext_vector_type(2)));
typedef float f32x16 __attribute__((ext_vector_type(16)));
typedef unsigned u32x4 __attribute__((ext_vector_type(4)));
typedef unsigned u32x2 __attribute__((ext_vector_type(2)));

constexpr int DM = 1024, NBATCH = 4, SEQ = 8192, CTXL = 256;
constexpr int NLAT = NBATCH * SEQ, NCTX = NBATCH * CTXL, NTOK = NLAT + NCTX;
constexpr int RH = 6, RDK = 64, RDV = 128, RC = 128, RNCH = 66;
constexpr int S5G = 16, S5P = 16, S5N = 64, S5T = 32, S5ROWS = 1280;
constexpr int NEXP = 16, NB0 = 280, NB1 = 272;
constexpr float ALPHA = 1.4142135623730951f;
constexpr float LN_EPS = 1e-5f, GN_EPS = 1e-6f;
constexpr float LAMBDA_INIT = 0.35550906759096926f;
constexpr int NWAVES = 8, NTHREADS = 512;
#ifndef PROJ_FP8
#define PROJ_FP8 0
#endif
#ifndef PF_IN0
#define PF_IN0 PROJ_FP8
#endif
#ifndef PF_OUT0
#define PF_OUT0 1
#endif
#ifndef PF_IN1
#define PF_IN1 1
#endif
#ifndef PF_OUT1
#define PF_OUT1 1
#endif
#ifndef FP8_WIDE
#define FP8_WIDE 1
#endif
#ifndef MOE_FP8
#define MOE_FP8 1
#endif

constexpr size_t MiB = 1u << 20, KiB = 1024;
constexpr size_t WS_CTL = 0, CTL_BYTES = 1 * MiB;
constexpr size_t WS_MOD = 1 * MiB;
constexpr size_t WS_SCAL = 1 * MiB + 256 * KiB;
constexpr size_t WS_LAMP = 1 * MiB + 320 * KiB;
constexpr size_t WS_COEF = 1 * MiB + 896 * KiB;
constexpr size_t WS_ROPE0C = 2 * MiB, WS_ROPE0S = 3 * MiB;
constexpr size_t WS_ROPE1 = 4 * MiB;
constexpr size_t WS_S5K = 4 * MiB + 64 * KiB;
constexpr size_t WS_XC = 6 * MiB;
constexpr size_t WS_CNT = 10 * MiB;
constexpr size_t WS_ROUTE = 10 * MiB + 64 * KiB;
constexpr size_t WS_BT1 = 12 * MiB;
constexpr size_t WS_BT2 = 16 * MiB;
constexpr size_t WS_WIN0 = 28 * MiB;
constexpr size_t WS_WGLU = 33 * MiB;
constexpr size_t WS_WOUT0 = 34 * MiB;
constexpr size_t WS_WIN1 = 36 * MiB;
constexpr size_t WS_WOUT1 = 42 * MiB;
constexpr size_t WS_EXP = 44 * MiB;
constexpr size_t EXP_STRIDE = 6 * MiB, EXP_DN = 4 * MiB;
constexpr size_t WS_ARENA = 236 * MiB;
constexpr size_t AR(double mib) { return WS_ARENA + (size_t)(mib * 1048576.0); }
constexpr size_t A_QK = AR(0), A_V = AR(49.5), A_G = AR(99), A_UA = AR(148.5), A_TT = AR(178.5), A_EO = AR(228), A_H0 = AR(248), A_MRG = AR(248), A_SG = AR(314);
constexpr size_t A_O = AR(140), A_H2 = AR(206), A_BUF = AR(0), A_HID = AR(140), A_Y = AR(0), A_H0P = AR(140);
constexpr size_t B_Q = AR(0), B_K = AR(64), B_V = AR(206), B_STASH = AR(272), B_AO = AR(140), B_O = AR(0), B_H2 = AR(64), B_BUF = AR(140), B_HID = AR(0), B_Y = AR(140);
constexpr size_t WS_END = AR(331);
constexpr size_t B_VI = WS_EXP;

constexpr int STAGE_BYTES_LDS = 131072;
constexpr int MISC_OFF = 131072;
constexpr int LDS_BYTES = 147456;

__device__ __forceinline__ unsigned f2bf(float f) { unsigned u = __float_as_uint(f); return (u + 0x7fffu + ((u >> 16) & 1u)) >> 16; }
__device__ __forceinline__ float bf2f(unsigned b) { return __uint_as_float(b << 16); }
__device__ __forceinline__ float bflo(unsigned w) { return __uint_as_float(w << 16); }
__device__ __forceinline__ float bfhi(unsigned w) { return __uint_as_float(w & 0xffff0000u); }
__device__ __forceinline__ unsigned cvt_pk_bf16(float lo, float hi) { unsigned r; asm volatile("v_cvt_pk_bf16_f32 %0, %1, %2" : "=v"(r) : "v"(lo), "v"(hi)); return r; }
template <int CTRL> __device__ __forceinline__ float dpp_f(float v) { return __int_as_float(__builtin_amdgcn_update_dpp(0, __float_as_int(v), CTRL, 0xF, 0xF, true)); }
__device__ __forceinline__ float wave_sum(float v) {
    v += dpp_f<0xB1>(v); v += dpp_f<0x4E>(v); v += dpp_f<0x141>(v); v += dpp_f<0x140>(v);
    { auto r = __builtin_amdgcn_permlane16_swap(__float_as_uint(v), __float_as_uint(v), false, false); v = __uint_as_float(r[0]) + __uint_as_float(r[1]); }
    { auto r = __builtin_amdgcn_permlane32_swap(__float_as_uint(v), __float_as_uint(v), false, false); v = __uint_as_float(r[0]) + __uint_as_float(r[1]); }
    return v;
}
__device__ __forceinline__ float fast_sigmoid(float x) { return __builtin_amdgcn_rcpf(1.f + __expf(-x)); }
__device__ __forceinline__ float fast_silu(float x) { return x * fast_sigmoid(x); }
__device__ __forceinline__ float gelu_tanh(float x) { const float z = 0.7978845608028654f * (x + 0.044715f * x * x * x); const float t = 1.f - 2.f * __builtin_amdgcn_rcpf(__expf(2.f * z) + 1.f); return 0.5f * x * (1.f + t); }
__device__ __forceinline__ void sincos_rev(double rev, float& s, float& c) { const double fr = rev - rint(rev); const float y = (float)(fr * 6.283185307179586); s = sinf(y); c = cosf(y); }
__device__ __forceinline__ f32x2 cmul(f32x2 a, f32x2 b) { return (f32x2){a.x * b.x - a.y * b.y, a.x * b.y + a.y * b.x}; }

#define XB_TMO      128
#define XB_XCNT(j)  (256  + 64 * (j))
#define XB_XSUB(j)  (1280 + 64 * (j))
#define XB_XGEN(j)  (2304 + 64 * (j))
#define XB_TOP      3328
#define XB_TOPGEN   3392
#define XCD_BAR_WORDS 3456
#define XB_SPIN_CAP (1u << 22)
__device__ __forceinline__ unsigned xb_ld(unsigned* p)              { return __hip_atomic_load(p, __ATOMIC_RELAXED, __HIP_MEMORY_SCOPE_AGENT); }
__device__ __forceinline__ unsigned xb_add(unsigned* p, unsigned v) { return __hip_atomic_fetch_add(p, v, __ATOMIC_RELAXED, __HIP_MEMORY_SCOPE_AGENT); }
__device__ __forceinline__ unsigned xb_xcc_id() { return (unsigned)__builtin_amdgcn_s_getreg((3 << 11) | 20) & 0xFu; }
#define XB_SPIN(cond, bar) do { unsigned _sp = 0; while (cond) { __builtin_amdgcn_s_sleep(1); \
    if ((++_sp & 255u) == 0u) { if (xb_ld(&(bar)[XB_TMO])) break; if (_sp > XB_SPIN_CAP) { atomicAdd(&(bar)[XB_TMO], 1u); break; } } } } while (0)
struct XcdBarrier { unsigned* bar; unsigned x; volatile LAS unsigned* st; };
__device__ __forceinline__ XcdBarrier xcd_barrier_post(unsigned* bar, volatile LAS unsigned* st) {
    XcdBarrier b; b.bar = bar; b.x = xb_xcc_id(); b.st = st;
    if (threadIdx.x == 0) (void)xb_add(&bar[XB_XCNT(b.x)], 1u);
    return b;
}
__device__ __forceinline__ void xcd_barrier_complete(unsigned* bar, unsigned x, unsigned& nloc, unsigned& nx) {
    const unsigned G = gridDim.x * gridDim.y * gridDim.z;
    unsigned sum, cnt, mine, sp = 0u;
    for (;;) {
        sum = 0u; cnt = 0u; mine = 0u;
#pragma unroll
        for (unsigned j = 0; j < 16; ++j) { const unsigned c = xb_ld(&bar[XB_XCNT(j)]); sum += c; cnt += (c > 0u) ? 1u : 0u; mine = (j == x) ? c : mine; }
        if (sum == G) break;
        __builtin_amdgcn_s_sleep(1);
        if ((++sp & 255u) == 0u) { if (xb_ld(&bar[XB_TMO])) break; if (sp > XB_SPIN_CAP) { atomicAdd(&bar[XB_TMO], 1u); break; } }
    }
    nloc = mine > 0u ? mine : 1u; nx = cnt > 0u ? cnt : 1u;
}
__device__ __forceinline__ void xcd_barrier(const XcdBarrier& b) {
    asm volatile("s_waitcnt vmcnt(0)" ::: "memory");
    __syncthreads();
    if (threadIdx.x == 0) {
        unsigned* bar = b.bar;
        __builtin_amdgcn_s_waitcnt(0);
        unsigned nloc = b.st[0], nx = b.st[1];
        if (nloc == 0u) { xcd_barrier_complete(bar, b.x, nloc, nx); b.st[0] = nloc; b.st[1] = nx; }
        const unsigned old = xb_add(&bar[XB_XSUB(b.x)], 1u);
        const unsigned gen = old / nloc;
        if (old + 1u == (gen + 1u) * nloc) {
            __builtin_amdgcn_fence(__ATOMIC_RELEASE, "agent");
            asm volatile("s_waitcnt vmcnt(0)" ::: "memory");
            const unsigned og = xb_add(&bar[XB_TOP], 1u);
            const unsigned tg = og / nx;
            if (og + 1u == (tg + 1u) * nx) xb_add(&bar[XB_TOPGEN], 1u);
            else XB_SPIN(xb_ld(&bar[XB_TOPGEN]) == tg, bar);
            __builtin_amdgcn_fence(__ATOMIC_ACQUIRE, "agent");
            xb_add(&bar[XB_XGEN(b.x)], 1u);
            asm volatile("s_waitcnt vmcnt(0)" ::: "memory");
        } else {
            XB_SPIN(xb_ld(&bar[XB_XGEN(b.x)]) == gen, bar);
            __builtin_amdgcn_fence(__ATOMIC_ACQUIRE, "agent");
            asm volatile("s_waitcnt vmcnt(0)" ::: "memory");
        }
    }
    __syncthreads();
}

namespace pg8 {
constexpr int BM = 256, BK = 64, HALF = 128, HTB = HALF * BK * 2, NXCD = 8, WGM = 8;
__host__ __device__ __forceinline__ int lds_byte(int r, int c) { const int st = (r >> 4) * 2 + (c >> 5), rr = r & 15, cc = c & 31, ob = rr * 64 + cc * 2; return st * 1024 + (ob ^ (((ob >> 9) & 1) << 5)); }
__host__ __device__ __forceinline__ void stage_rc(int b, int& R, int& C) { const int st = b / 1024, sb = b % 1024, swz = sb ^ (((sb >> 9) & 1) << 5); R = (st >> 1) * 16 + swz / 64; C = (st & 1) * 32 + (swz % 64) / 2; }
__host__ __device__ __forceinline__ int perm32(int rho) { const int n = rho >> 4, i = rho & 15; return 8 * (i >> 2) + 4 * n + (i & 3); }

struct Unit { int pm, pn, z; long aoff, boff; };
struct Gemm { const bf16* A; const bf16* Bt; int K, lda, ldb; };

struct GridOrder {
    int nM, nN, nwg, G, c; long tA, tB;
    __device__ void init(int nM_, int nN_, int G_, int c_, int lda, int ldb) { nM = nM_; nN = nN_; nwg = nM * nN; G = G_; c = c_; tA = (long)BM * lda * 2; tB = (long)BM * ldb * 2; }
    __device__ __forceinline__ bool tile(long L, int& pm, int& pn) const {
        if (L >= nwg) return false;
        int wgid = (int)L; { const int q = nwg / NXCD, r = nwg % NXCD, xcd = wgid % NXCD, off = wgid / NXCD; wgid = (xcd < r ? xcd * (q + 1) : r * (q + 1) + (xcd - r) * q) + off; }
        const int nig = WGM * nN, gid = wgid / nig, fm = gid * WGM, gsz = (nM - fm) < WGM ? (nM - fm) : WGM;
        pm = fm + ((wgid % nig) % gsz); pn = (wgid % nig) / gsz; return true;
    }
    __device__ __forceinline__ bool next(int i, Unit& u) const {
        if (!tile((long)i * G + c, u.pm, u.pn)) return false;
        u.z = 0; u.aoff = u.pm * tA; u.boff = u.pn * tB; return true;
    }
};
struct BatchOrder {
    int nZ, nM, nN, G, c; long tA, tB, zA, zB;
    __device__ __forceinline__ bool next(int i, Unit& u) const {
        const long L = (long)i * G + c; if (L >= (long)nZ * nM * nN) return false;
        const int per = nM * nN; u.z = (int)(L / per); const int r = (int)(L % per); u.pm = r / nN; u.pn = r % nN;
        u.aoff = u.z * zA + u.pm * tA; u.boff = u.z * zB + u.pn * tB; return true;
    }
};
struct ExpertOrder {
    GridOrder g; const LAS unsigned* pend; long eB;
    __device__ __forceinline__ bool next(int i, Unit& u) const {
        if (!g.tile((long)i * g.G + g.c, u.pm, u.pn)) return false;
        int e = 0;
#pragma unroll
        for (int k = 0; k < 15; ++k) e += ((unsigned)u.pm >= pend[k]) ? 1 : 0;
        u.z = e; u.aoff = u.pm * g.tA; u.boff = e * eB + u.pn * g.tB; return true;
    }
};
struct InProj1Order {
    GridOrder g;
    __device__ __forceinline__ bool next(int i, Unit& u) const {
        const long L = (long)i * g.G + g.c;
        if (L < g.nwg) { g.tile(L, u.pm, u.pn); }
        else { const long Lc = L - g.nwg; if (Lc >= 32) return false; u.pm = 128 + (int)(Lc >> 3); u.pn = 4 + (int)(Lc & 7); }
        u.z = 0; u.aoff = u.pm * g.tA; u.boff = u.pn * g.tB; return true;
    }
};

typedef int i32x8 __attribute__((ext_vector_type(8)));
typedef int i32x4 __attribute__((ext_vector_type(4)));
__device__ __forceinline__ i32x8 cat8(bf16x8 a, bf16x8 b) { const i32x4 x = __builtin_bit_cast(i32x4, a), y = __builtin_bit_cast(i32x4, b); return (i32x8){x[0], x[1], x[2], x[3], y[0], y[1], y[2], y[3]}; }
template <bool FP8 = false, class Epi, class Sched>
__device__ __forceinline__ void gemm_phase(LAS unsigned char* lds, const Gemm g, const Sched& S, const Epi& E) {
    const int tid = threadIdx.x, wid = __builtin_amdgcn_readfirstlane(tid >> 6), lane = tid & 63, wr = wid >> 2, wc = wid & 3, fr = lane & 15, fq = lane >> 4;
    const int K = g.K, nt = K / BK;
    unsigned voffA[2], voffB[2];
#pragma unroll
    for (int i = 0; i < 2; ++i) { int R, C; stage_rc(tid * 16 + i * 8192, R, C); const int Rb = Epi::PERM ? ((R & ~31) + perm32(R & 31)) : R;
        voffA[i] = (unsigned)(R * g.lda + C) * 2u; voffB[i] = (unsigned)(Rb * g.ldb + C) * 2u; }
    const size_t kstep = (size_t)(BK * 2);
    const size_t hstepA = (size_t)HALF * g.lda * 2, hstepB = (size_t)HALF * g.ldb * 2;
    const unsigned ldsw = (unsigned)wid * 1024u;
    const int aoff = lds_byte(wr * 64 + fr, fq * 8), boff = lds_byte(wc * 32 + fr, fq * 8);
#define PG8_SA(b, h) (((b) * 2 + (h)) * HTB)
#define PG8_SB(b, h) ((4 + (b) * 2 + (h)) * HTB)
#define PG8_STAGE(bufoff, gbase, voff) do { _Pragma("unroll") for (int _i = 0; _i < 2; ++_i) \
        __builtin_amdgcn_global_load_lds((const unsigned*)((const char*)(gbase) + (voff)[_i]), (LAS unsigned*)(lds + (bufoff) + ldsw + _i * 8192), 16, 0, 0); } while (0)
#define PG8_LDA(dst, b, h) do { _Pragma("unroll") for (int m = 0; m < 4; ++m) dst[m] = cat8(*(const LAS bf16x8*)(lds + PG8_SA(b, h) + aoff + m * 2048), *(const LAS bf16x8*)(lds + PG8_SA(b, h) + aoff + m * 2048 + 1024)); } while (0)
#define PG8_LDB(dst, b, h) do { _Pragma("unroll") for (int n = 0; n < 2; ++n) dst[n] = cat8(*(const LAS bf16x8*)(lds + PG8_SB(b, h) + boff + n * 2048), *(const LAS bf16x8*)(lds + PG8_SB(b, h) + boff + n * 2048 + 1024)); } while (0)
#define PG8_Q(v, q) __builtin_bit_cast(long, __builtin_shufflevector(v, v, 2 * (q), 2 * (q) + 1))
#define PG8_HALF(v, k) __builtin_bit_cast(bf16x8, __builtin_shufflevector(v, v, 4 * (k), 4 * (k) + 1, 4 * (k) + 2, 4 * (k) + 3))
#define PG8_MMA(ai, bj, At, Bt) do { __builtin_amdgcn_s_setprio(1); _Pragma("unroll") for (int m = 0; m < 4; ++m) _Pragma("unroll") for (int n = 0; n < 2; ++n) { \
        if constexpr (FP8 && FP8_WIDE) asm volatile("v_mfma_f32_16x16x128_f8f6f4 %0, %1, %2, %0" : "+v"(acc[ai][bj][m][n]) : "v"(Bt[n]), "v"(At[m])); \
        else if constexpr (FP8) { acc[ai][bj][m][n] = __builtin_amdgcn_mfma_f32_16x16x32_fp8_fp8(PG8_Q(Bt[n], 0), PG8_Q(At[m], 0), acc[ai][bj][m][n], 0, 0, 0); acc[ai][bj][m][n] = __builtin_amdgcn_mfma_f32_16x16x32_fp8_fp8(PG8_Q(Bt[n], 1), PG8_Q(At[m], 1), acc[ai][bj][m][n], 0, 0, 0); \
            acc[ai][bj][m][n] = __builtin_amdgcn_mfma_f32_16x16x32_fp8_fp8(PG8_Q(Bt[n], 2), PG8_Q(At[m], 2), acc[ai][bj][m][n], 0, 0, 0); acc[ai][bj][m][n] = __builtin_amdgcn_mfma_f32_16x16x32_fp8_fp8(PG8_Q(Bt[n], 3), PG8_Q(At[m], 3), acc[ai][bj][m][n], 0, 0, 0); } \
        else { acc[ai][bj][m][n] = __builtin_amdgcn_mfma_f32_16x16x32_bf16(PG8_HALF(Bt[n], 0), PG8_HALF(At[m], 0), acc[ai][bj][m][n], 0, 0, 0); \
               acc[ai][bj][m][n] = __builtin_amdgcn_mfma_f32_16x16x32_bf16(PG8_HALF(Bt[n], 1), PG8_HALF(At[m], 1), acc[ai][bj][m][n], 0, 0, 0); } } __builtin_amdgcn_s_setprio(0); } while (0)
#define PG8_WAIT_V(n) asm volatile("s_waitcnt vmcnt(" #n ")" ::: "memory")
#define PG8_WAIT_L(n) asm volatile("s_waitcnt lgkmcnt(" #n ")" ::: "memory")
#define PG8_BAR __builtin_amdgcn_s_barrier()
#define PG8_SCHED __builtin_amdgcn_sched_barrier(0)
    Unit cur, nxt; int ui = 0;
    if (!S.next(0, cur)) return;
    f32x4 acc[2][2][4][2];
#pragma unroll
    for (int a = 0; a < 2; ++a)
#pragma unroll
        for (int b = 0; b < 2; ++b)
#pragma unroll
            for (int m = 0; m < 4; ++m)
#pragma unroll
                for (int n = 0; n < 2; ++n) acc[a][b][m][n] = (f32x4){0.f, 0.f, 0.f, 0.f};
    i32x8 At[4], B0[2], B1[2];
    const char* cA = (const char*)g.A + cur.aoff; const char* cB = (const char*)g.Bt + cur.boff;
    PG8_STAGE(PG8_SB(0, 0), cB, voffB); PG8_STAGE(PG8_SB(0, 1), cB + hstepB, voffB); PG8_STAGE(PG8_SA(0, 0), cA, voffA); PG8_STAGE(PG8_SA(0, 1), cA + hstepA, voffA);
    if (wr == 1) PG8_BAR;
    PG8_WAIT_V(2); PG8_BAR;
    PG8_STAGE(PG8_SB(1, 0), cB + kstep, voffB); PG8_STAGE(PG8_SA(1, 0), cA + kstep, voffA); PG8_STAGE(PG8_SB(1, 1), cB + hstepB + kstep, voffB);
    PG8_WAIT_V(6); PG8_BAR;
    for (;;) {
        const bool has_next = S.next(ui + 1, nxt);
        const char* nA = has_next ? (const char*)g.A + nxt.aoff : cA; const char* nB = has_next ? (const char*)g.Bt + nxt.boff : cB;
#pragma nounroll
        for (int t = 0; t < nt; t += 2) {
            const bool last = (t == nt - 2);
            const char* a1 = cA + (size_t)(t + 1) * kstep;
            const char* a2 = last ? nA : cA + (size_t)(t + 2) * kstep; const char* b2 = last ? nB : cB + (size_t)(t + 2) * kstep;
            const char* a3 = a2 + kstep; const char* b3 = b2 + kstep;
            PG8_LDB(B0, 0, 0); PG8_LDB(B1, 0, 1); PG8_SCHED; PG8_LDA(At, 0, 0); PG8_STAGE(PG8_SA(1, 1), a1 + hstepA, voffA);
            PG8_WAIT_V(8); PG8_WAIT_L(0); PG8_BAR; PG8_MMA(0, 0, At, B0); PG8_MMA(0, 1, At, B1); PG8_BAR; PG8_SCHED;
            PG8_LDA(At, 0, 1); PG8_STAGE(PG8_SB(0, 0), b2, voffB); PG8_STAGE(PG8_SB(0, 1), b2 + hstepB, voffB); PG8_STAGE(PG8_SA(0, 0), a2, voffA);
            PG8_WAIT_V(8); PG8_WAIT_L(0); PG8_BAR; PG8_MMA(1, 0, At, B0); PG8_MMA(1, 1, At, B1); PG8_BAR; PG8_SCHED;
            PG8_LDB(B0, 1, 0); PG8_LDB(B1, 1, 1); PG8_SCHED; PG8_LDA(At, 1, 0); PG8_STAGE(PG8_SA(0, 1), a2 + hstepA, voffA);
            PG8_WAIT_V(8); PG8_WAIT_L(0); PG8_BAR; PG8_MMA(0, 0, At, B0); PG8_MMA(0, 1, At, B1); PG8_BAR; PG8_SCHED;
            PG8_LDA(At, 1, 1); PG8_STAGE(PG8_SB(1, 0), b3, voffB); PG8_STAGE(PG8_SB(1, 1), b3 + hstepB, voffB); PG8_STAGE(PG8_SA(1, 0), a3, voffA);
            PG8_WAIT_V(8); PG8_WAIT_L(0); PG8_BAR; PG8_MMA(1, 0, At, B0); PG8_MMA(1, 1, At, B1); PG8_BAR; PG8_SCHED;
        }
        if (wr == 0) PG8_BAR;
        if constexpr (FP8 && FP8_WIDE) {
#pragma unroll
            for (int a = 0; a < 2; ++a)
#pragma unroll
                for (int b = 0; b < 2; ++b) asm volatile("s_nop 15" : "+v"(acc[a][b][0][0]), "+v"(acc[a][b][0][1]), "+v"(acc[a][b][1][0]), "+v"(acc[a][b][1][1]), "+v"(acc[a][b][2][0]), "+v"(acc[a][b][2][1]), "+v"(acc[a][b][3][0]), "+v"(acc[a][b][3][1])); }
        E(acc, cur, wr, wc, fr, fq);
        if (!has_next) break;
#pragma unroll
        for (int a = 0; a < 2; ++a)
#pragma unroll
            for (int b = 0; b < 2; ++b)
#pragma unroll
                for (int m = 0; m < 4; ++m)
#pragma unroll
                    for (int n = 0; n < 2; ++n) acc[a][b][m][n] = (f32x4){0.f, 0.f, 0.f, 0.f};
        cur = nxt; cA = nA; cB = nB; ++ui;
        if (wr == 1) PG8_BAR;
    }
    PG8_WAIT_V(0);
    PG8_BAR;
#undef PG8_SA
#undef PG8_SB
#undef PG8_STAGE
#undef PG8_LDA
#undef PG8_LDB
#undef PG8_MMA
#undef PG8_HALF
#undef PG8_Q
#undef PG8_WAIT_V
#undef PG8_WAIT_L
#undef PG8_BAR
#undef PG8_SCHED
}
}
namespace pg8 {
__device__ __forceinline__ u32x4 pack8(const f32x4 a, const f32x4 b) { u32x4 w; w.x = cvt_pk_bf16(a[0], a[1]); w.y = cvt_pk_bf16(a[2], a[3]); w.z = cvt_pk_bf16(b[0], b[1]); w.w = cvt_pk_bf16(b[2], b[3]); return w; }
typedef const f32x4 (&AccRef)[2][2][4][2];
__device__ __forceinline__ float clamp448(float x) { return __builtin_fminf(__builtin_fmaxf(x, -448.f), 448.f); }
__device__ __forceinline__ unsigned pack4_fp8(float a, float b, float c, float d) { int w = __builtin_amdgcn_cvt_pk_fp8_f32(clamp448(a), clamp448(b), 0, false); w = __builtin_amdgcn_cvt_pk_fp8_f32(clamp448(c), clamp448(d), w, true); return (unsigned)w; }
__device__ __forceinline__ unsigned char to_fp8(float x) { return (unsigned char)(__builtin_amdgcn_cvt_pk_fp8_f32(clamp448(x), 0.f, 0, false) & 0xff); }
constexpr float PSC_IN0 = PF_IN0 ? 0.03125f : 1.f, PSC_IN1 = PF_IN1 ? 0.03125f : 1.f, PSC_OUT0 = PF_OUT0 ? 0.03125f : 1.f, PSC_OUT1 = PF_OUT1 ? 0.03125f : 1.f;

struct EpiPlain {
    static constexpr bool PERM = true;
    bf16* O; int ldc;
    __device__ __forceinline__ void operator()(AccRef acc, const Unit& u, int wr, int wc, int fr, int fq) const {
        const int row0 = u.pm * BM + wr * 64 + fr, col0 = u.pn * BM + wc * 32 + 8 * fq;
#pragma unroll
        for (int ai = 0; ai < 2; ++ai)
#pragma unroll
            for (int m = 0; m < 4; ++m) { bf16* rowp = O + (size_t)(row0 + ai * HALF + m * 16) * ldc + col0;
#pragma unroll
                for (int bj = 0; bj < 2; ++bj) *(u32x4*)(rowp + bj * HALF) = pack8(acc[ai][bj][m][0], acc[ai][bj][m][1]); }
    }
};
struct EpiInProj0 {
    static constexpr bool PERM = true;
    bf16 *QK, *V, *G, *UA; const float *rc, *rs;
    __device__ __forceinline__ void operator()(AccRef acc, const Unit& u, int wr, int wc, int fr, int fq) const {
        const int row0 = u.pm * BM + wr * 64 + fr, pn = u.pn;
        if (pn < 3) {
            const int H = 4 * pn + wc;
#pragma unroll
            for (int ai = 0; ai < 2; ++ai)
#pragma unroll
                for (int m = 0; m < 4; ++m) {
                    const int row = row0 + ai * HALF + m * 16;
                    f32x4 c0 = (f32x4){1.f, 1.f, 1.f, 1.f}, c1 = c0, s0 = (f32x4){0.f, 0.f, 0.f, 0.f}, s1 = s0;
                    if (row < NLAT) { const int pos = row & (SEQ - 1); const float* pc = rc + pos * 32 + 8 * fq; const float* ps = rs + pos * 32 + 8 * fq;
                        c0 = *(const f32x4*)pc; c1 = *(const f32x4*)(pc + 4); s0 = *(const f32x4*)ps; s1 = *(const f32x4*)(ps + 4); }
                    const f32x4 a0 = acc[ai][0][m][0] * PSC_IN0, a1 = acc[ai][0][m][1] * PSC_IN0, b0 = acc[ai][1][m][0] * PSC_IN0, b1 = acc[ai][1][m][1] * PSC_IN0;
                    const f32x4 y10 = a0 * c0 - b0 * s0, y11 = a1 * c1 - b1 * s1, y20 = a0 * s0 + b0 * c0, y21 = a1 * s1 + b1 * c1;
                    bf16* rp = QK + (size_t)row * 768 + H * 64 + 8 * fq;
                    *(u32x4*)rp = pack8(y10, y11); *(u32x4*)(rp + 32) = pack8(y20, y21);
                }
        } else if (pn < 9) {
            bf16* base = pn < 6 ? V : G; const int colt = (pn < 6 ? pn - 3 : pn - 6) * BM + wc * 32 + 8 * fq;
#pragma unroll
            for (int ai = 0; ai < 2; ++ai)
#pragma unroll
                for (int m = 0; m < 4; ++m) { bf16* rowp = base + (size_t)(row0 + ai * HALF + m * 16) * 768 + colt;
#pragma unroll
                    for (int bj = 0; bj < 2; ++bj) *(u32x4*)(rowp + bj * HALF) = pack8(acc[ai][bj][m][0] * PSC_IN0, acc[ai][bj][m][1] * PSC_IN0); }
        } else {
#pragma unroll
            for (int ai = 0; ai < 2; ++ai)
#pragma unroll
                for (int m = 0; m < 4; ++m) { const int row = row0 + ai * HALF + m * 16;
#pragma unroll
                    for (int bj = 0; bj < 2; ++bj) { const int c = bj * HALF + wc * 32 + 8 * fq, g = c >> 4, p0 = c & 15;
                        *(u32x4*)(UA + ((size_t)g * S5ROWS + (row >> 5)) * 768 + (row & 31) * 16 + p0) = pack8(acc[ai][bj][m][0] * PSC_IN0, acc[ai][bj][m][1] * PSC_IN0); } }
        }
    }
};
struct EpiS5E {
    static constexpr bool PERM = false;
    float* EO;
    __device__ __forceinline__ void operator()(AccRef acc, const Unit& u, int wr, int wc, int fr, int fq) const {
        const int row0 = u.pm * BM + wr * 64 + fr, col0 = wc * 32 + 4 * fq;
#pragma unroll
        for (int ai = 0; ai < 2; ++ai)
#pragma unroll
            for (int m = 0; m < 4; ++m) { float* rowp = EO + ((size_t)u.z * S5ROWS + row0 + ai * HALF + m * 16) * 256 + col0;
#pragma unroll
                for (int bj = 0; bj < 2; ++bj)
#pragma unroll
                    for (int n = 0; n < 2; ++n) *(f32x4*)(rowp + bj * HALF + n * 16) = acc[ai][bj][m][n]; }
    }
};
struct EpiS5Y {
    static constexpr bool PERM = true;
    bf16* SG;
    __device__ __forceinline__ void operator()(AccRef acc, const Unit& u, int wr, int wc, int fr, int fq) const {
        const int row0 = u.pm * BM + wr * 64 + fr;
#pragma unroll
        for (int ai = 0; ai < 2; ++ai)
#pragma unroll
            for (int m = 0; m < 4; ++m) { const int cr = row0 + ai * HALF + m * 16;
                if (cr < NTOK / S5T) {
#pragma unroll
                    for (int bj = 0; bj < 2; ++bj) { const int cn0 = u.pn * BM + bj * HALF + wc * 32 + 8 * fq, i = cn0 >> 4, p0 = cn0 & 15;
                        f32x4 v0 = acc[ai][bj][m][0], v1 = acc[ai][bj][m][1];
#pragma unroll
                        for (int j = 0; j < 4; ++j) { v0[j] = gelu_tanh(v0[j]); v1[j] = gelu_tanh(v1[j]); }
                        *(u32x4*)(SG + (size_t)(cr * S5T + i) * 256 + u.z * 16 + p0) = pack8(v0, v1); } } }
    }
};
struct EpiGlu {
    static constexpr bool PERM = true;
    bf16* MRG;
    __device__ __forceinline__ void operator()(AccRef acc, const Unit& u, int wr, int wc, int fr, int fq) const {
        const int row0 = u.pm * BM + wr * 64 + fr, col0 = 768 + u.pn * HALF + wc * 32 + 8 * fq;
#pragma unroll
        for (int ai = 0; ai < 2; ++ai)
#pragma unroll
            for (int m = 0; m < 4; ++m) { f32x4 v0, v1;
#pragma unroll
                for (int j = 0; j < 4; ++j) { v0[j] = acc[ai][0][m][0][j] * fast_sigmoid(acc[ai][1][m][0][j]); v1[j] = acc[ai][0][m][1][j] * fast_sigmoid(acc[ai][1][m][1][j]); }
                if (PF_OUT0) { u32x2 w; w.x = pack4_fp8(v0[0], v0[1], v0[2], v0[3]); w.y = pack4_fp8(v1[0], v1[1], v1[2], v1[3]); *(u32x2*)((unsigned char*)MRG + (size_t)(row0 + ai * HALF + m * 16) * 1024 + col0) = w; }
                else *(u32x4*)(MRG + (size_t)(row0 + ai * HALF + m * 16) * 1024 + col0) = pack8(v0, v1); }
    }
};
struct EpiSwiGlu {
    static constexpr bool PERM = true;
    bf16* HID;
    __device__ __forceinline__ void operator()(AccRef acc, const Unit& u, int wr, int wc, int fr, int fq) const {
        const int row0 = u.pm * BM + wr * 64 + fr, col0 = u.pn * HALF + wc * 32 + 8 * fq;
#pragma unroll
        for (int ai = 0; ai < 2; ++ai)
#pragma unroll
            for (int m = 0; m < 4; ++m) { f32x4 v0, v1;
#pragma unroll
                for (int j = 0; j < 4; ++j) { v0[j] = fast_silu(acc[ai][0][m][0][j]) * acc[ai][1][m][0][j]; v1[j] = fast_silu(acc[ai][0][m][1][j]) * acc[ai][1][m][1][j]; }
                *(u32x4*)(HID + (size_t)(row0 + ai * HALF + m * 16) * 1024 + col0) = pack8(v0, v1); }
    }
};
struct EpiSwiGlu8 {
    static constexpr bool PERM = true;
    unsigned char* HID;
    __device__ __forceinline__ void operator()(AccRef acc, const Unit& u, int wr, int wc, int fr, int fq) const {
        const int row0 = u.pm * BM + wr * 64 + fr, col0 = u.pn * HALF + wc * 32 + 8 * fq;
#pragma unroll
        for (int ai = 0; ai < 2; ++ai)
#pragma unroll
            for (int m = 0; m < 4; ++m) { f32x4 v0, v1;
#pragma unroll
                for (int j = 0; j < 4; ++j) { v0[j] = fast_silu(acc[ai][0][m][0][j] * 0.03125f) * (acc[ai][1][m][0][j] * 0.03125f); v1[j] = fast_silu(acc[ai][0][m][1][j] * 0.03125f) * (acc[ai][1][m][1][j] * 0.03125f); }
                u32x2 w; w.x = pack4_fp8(v0[0], v0[1], v0[2], v0[3]); w.y = pack4_fp8(v1[0], v1[1], v1[2], v1[3]);
                *(u32x2*)(HID + (size_t)(row0 + ai * HALF + m * 16) * 1024 + col0) = w; }
    }
};
struct EpiPlainS {
    static constexpr bool PERM = true;
    bf16* O; int ldc; float sc;
    __device__ __forceinline__ void operator()(AccRef acc, const Unit& u, int wr, int wc, int fr, int fq) const {
        const int row0 = u.pm * BM + wr * 64 + fr, col0 = u.pn * BM + wc * 32 + 8 * fq;
#pragma unroll
        for (int ai = 0; ai < 2; ++ai)
#pragma unroll
            for (int m = 0; m < 4; ++m) { bf16* rowp = O + (size_t)(row0 + ai * HALF + m * 16) * ldc + col0;
#pragma unroll
                for (int bj = 0; bj < 2; ++bj) *(u32x4*)(rowp + bj * HALF) = pack8(acc[ai][bj][m][0] * sc, acc[ai][bj][m][1] * sc); }
    }
};
struct EpiInProj1 {
    static constexpr bool PERM = true;
    bf16 *Q, *Kb, *Vb; const float* rope;
    __device__ __forceinline__ void operator()(AccRef acc, const Unit& u, int wr, int wc, int fr, int fq) const {
        const int row0 = u.pm * BM + wr * 64 + fr, pn = u.pn;
#pragma unroll
        for (int ai = 0; ai < 2; ++ai)
#pragma unroll
            for (int m = 0; m < 4; ++m) {
                const int row = row0 + ai * HALF + m * 16;
                const bool lat = row < NLAT;
                const int b = lat ? (row >> 13) : ((row - NLAT) >> 8), t = lat ? (row & (SEQ - 1)) : ((row - NLAT) & 255);
                const size_t krow = (size_t)b * (SEQ + CTXL) + (lat ? t : SEQ + t);
                if (pn < 8) {
                    const int sh = 4 * (pn & 3) + wc;
                    f32x4 c0 = (f32x4){1.f, 1.f, 1.f, 1.f}, c1 = c0, s0 = (f32x4){0.f, 0.f, 0.f, 0.f}, s1 = s0;
                    if (lat) { const int pos = (fq < 2) ? (t >> 6) : (t & 63); const float* pc = rope + pos * 16 + 8 * (fq & 1);
                        c0 = *(const f32x4*)pc; c1 = *(const f32x4*)(pc + 4); s0 = *(const f32x4*)(pc + 2048); s1 = *(const f32x4*)(pc + 2048 + 4); }
                    const f32x4 a0 = acc[ai][0][m][0] * PSC_IN1, a1 = acc[ai][0][m][1] * PSC_IN1, b0 = acc[ai][1][m][0] * PSC_IN1, b1 = acc[ai][1][m][1] * PSC_IN1;
                    const f32x4 y10 = a0 * c0 - b0 * s0, y11 = a1 * c1 - b1 * s1, y20 = a0 * s0 + b0 * c0, y21 = a1 * s1 + b1 * c1;
                    const int dim = (fq < 2 ? 0 : 32) + 8 * (fq & 1);
                    unsigned char* rp = (pn < 4) ? ((unsigned char*)Q + (size_t)row * 1024) : ((unsigned char*)Kb + krow * 1024);
                    rp += sh * 64 + dim;
                    if (pn >= 4 || lat) { u32x2 w1, w2; w1.x = pack4_fp8(y10[0], y10[1], y10[2], y10[3]); w1.y = pack4_fp8(y11[0], y11[1], y11[2], y11[3]); w2.x = pack4_fp8(y20[0], y20[1], y20[2], y20[3]); w2.y = pack4_fp8(y21[0], y21[1], y21[2], y21[3]);
                        *(u32x2*)rp = w1; *(u32x2*)(rp + 16) = w2; }
                } else {
                    bf16* rp = Vb + krow * 1024 + (pn - 8) * BM + wc * 32 + 8 * fq;
#pragma unroll
                    for (int bj = 0; bj < 2; ++bj) *(u32x4*)(rp + bj * HALF) = pack8(acc[ai][bj][m][0] * PSC_IN1, acc[ai][bj][m][1] * PSC_IN1);
                }
            }
    }
};
}
enum InIdx { I_X = 0, I_C, I_CTX, I_CCTX, I_ADAW, I_ADAB, I_LNG, I_WINAB, I_DECAY, I_LAMRE, I_LAMIM, I_LOGDT, I_BRE, I_BIM, I_CRE, I_CIM, I_S5D, I_WGLU,
             I_WOUTAB, I_WINC, I_DLAM, I_SUBLN, I_WOUTC, I_RW, I_RB, I_EG, I_EU, I_ED, N_IN };
struct Params { const float* in[N_IN]; float* out; unsigned char* ws; int ph_lo, ph_hi; };
#if defined(__HIP_DEVICE_COMPILE__)
#define CAS __attribute__((address_space(4)))
#else
#define CAS
#endif
typedef const CAS Params& PR;

struct Frame {
    LAS unsigned char* lds; int tid, lane, wave, G, bid, vcu;
};
#define WSP(T, off) ((T*)(p.ws + (off)))

__device__ __forceinline__ void p0_gemv_item(PR p, Frame& F, int item) {
    LAS float* sc = (LAS float*)F.lds;
    LAS float* red = (LAS float*)(F.lds + 20480);
    const float* c = p.in[I_C]; const float* cctx = p.in[I_CCTX];
    for (int i = F.tid; i < 5120; i += NTHREADS) { const int r = i >> 10, k = i & 1023; const float v = r < 4 ? c[r * 1024 + k] : cctx[k]; sc[i] = v / (1.f + expf(-v)); }
    __syncthreads();
    const int l = item / 96, cb = item % 96, jj = F.tid & 63, kp = F.tid >> 6;
    const float* W = p.in[I_ADAW] + (size_t)l * 1024 * 6144 + cb * 64 + jj;
    float a0 = 0.f, a1 = 0.f, a2 = 0.f, a3 = 0.f, a4 = 0.f;
#pragma unroll 16
    for (int k = kp * 128; k < kp * 128 + 128; ++k) { const float w = W[(size_t)k * 6144]; a0 += sc[k] * w; a1 += sc[1024 + k] * w; a2 += sc[2048 + k] * w; a3 += sc[3072 + k] * w; a4 += sc[4096 + k] * w; }
    red[(kp * 5 + 0) * 64 + jj] = a0; red[(kp * 5 + 1) * 64 + jj] = a1; red[(kp * 5 + 2) * 64 + jj] = a2; red[(kp * 5 + 3) * 64 + jj] = a3; red[(kp * 5 + 4) * 64 + jj] = a4;
    __syncthreads();
    if (F.tid < 320) { const int r = F.tid >> 6, j = F.tid & 63; float s = 0.f;
#pragma unroll
        for (int q = 0; q < 8; ++q) s += red[(q * 5 + r) * 64 + j];
        WSP(float, WS_MOD)[(l * 5 + r) * 6144 + cb * 64 + j] = s + p.in[I_ADAB][l * 6144 + cb * 64 + j]; }
    __syncthreads();
}
__device__ __forceinline__ void p0_s5_item(PR p, Frame& F, int item) {
    const int g = item >> 1, dir = item & 1;
    LAS f32x2* lamp = (LAS f32x2*)F.lds;
    LAS f32x2* coef = lamp + 64 * 33;
    const float dt = expf(p.in[I_LOGDT][dir * 16 + g]);
    for (int i = F.tid; i < 64 * 33; i += NTHREADS) { const int n = i / 33, tau = i % 33;
        const float re = p.in[I_LAMRE][(dir * 16 + g) * 64 + n], im = p.in[I_LAMIM][(dir * 16 + g) * 64 + n];
        const float mag = expf(re * dt * (float)tau); float s, c; sincos_rev((double)im * (double)dt * (double)tau * 0.15915494309189535, s, c);
        const f32x2 v = (f32x2){mag * c, mag * s}; lamp[i] = v; WSP(f32x2, WS_LAMP)[((g * 2 + dir) * 64 + n) * 33 + tau] = v; }
    __syncthreads();
    if (F.tid < 64) { const int n = F.tid; const float re = p.in[I_LAMRE][(dir * 16 + g) * 64 + n], im = p.in[I_LAMIM][(dir * 16 + g) * 64 + n];
        const f32x2 lb = lamp[n * 33 + 1]; const float a = lb.x - 1.f, b = lb.y, den = re * re + im * im;
        const f32x2 v = (f32x2){(a * re + b * im) / den, (b * re - a * im) / den}; coef[n] = v; WSP(f32x2, WS_COEF)[(g * 2 + dir) * 64 + n] = v; }
    __syncthreads();
    const float* bre = p.in[I_BRE] + (size_t)(dir * 16 + g) * 64 * 16; const float* bim = p.in[I_BIM] + (size_t)(dir * 16 + g) * 64 * 16;
    const float* cre = p.in[I_CRE] + (size_t)(dir * 16 + g) * 16 * 64; const float* cim = p.in[I_CIM] + (size_t)(dir * 16 + g) * 16 * 64;
    for (int idx = F.tid; idx < 32 * 256; idx += NTHREADS) { const int tau = idx >> 8, pp = (idx >> 4) & 15, q = idx & 15; float acc = 0.f;
        for (int n = 0; n < 64; ++n) { const f32x2 w = cmul(lamp[n * 33 + tau], coef[n]); const f32x2 bb = cmul(w, (f32x2){bre[n * 16 + q], bim[n * 16 + q]});
            acc += cre[pp * 64 + n] * bb.x - cim[pp * 64 + n] * bb.y; }
        WSP(float, WS_S5K)[((g * 2 + dir) * 32 + tau) * 256 + pp * 16 + q] = acc; }
    __syncthreads();
}
__device__ __forceinline__ int tr_drow(int mode, int n) {
    switch (mode) {
    case 1: if (n < 768) { const int H = n >> 6, half = (n >> 5) & 1, dd = n & 31; return (H >> 2) * 256 + half * 128 + (H & 3) * 32 + dd; } return n;
    case 2: if (n < 2048) { const int base = n & ~1023, c = n & 1023, sh = c >> 6, grp = (c >> 4) & 3; return base + (sh >> 2) * 256 + (grp & 1) * 128 + (sh & 3) * 32 + (grp >> 1) * 16 + (c & 15); } return n;
    case 3: return ((n & 255) >> 7) * 256 + (n >> 8) * 128 + (n & 127);
    case 4: return (n >> 7) * 256 + (n & 127);
    case 5: return (n >> 7) * 256 + 128 + (n & 127);
    default: return n; }
}
__device__ __forceinline__ float tr_scale(int mode, int n) { if (mode == 1) return (n >= 384 && n < 768) ? 0.125f : 1.f; if (mode == 2) return n < 1024 ? 0.5f * 1.4426950408889634f : (n < 2048 ? 0.25f : 1.f); return 1.f; }
struct TrItem { const float* W; bf16* WT; int K, N, mode, item, f8; };
__device__ __forceinline__ void tr_load(const TrItem& d, f32x4 (&t)[8], int lane) {
    const int nblk = d.N / 32, kb = d.item / nblk, nb = d.item % nblk, k0 = 64 * kb, n0 = 32 * nb, kq = lane >> 3, nq = (lane & 7) * 4;
#pragma unroll
    for (int i = 0; i < 8; ++i) t[i] = *(const f32x4*)(d.W + (size_t)(k0 + 8 * i + kq) * d.N + n0 + nq);
}
__device__ __forceinline__ void tr_finish(const TrItem& d, const f32x4 (&t)[8], LAS float* scr, int lane) {
    const int nblk = d.N / 32, kb = d.item / nblk, nb = d.item % nblk, k0 = 64 * kb, n0 = 32 * nb, kq = lane >> 3, nq = (lane & 7) * 4;
    const float sca = tr_scale(d.mode, n0);
#pragma unroll
    for (int i = 0; i < 8; ++i) { LAS float* q = scr + (8 * i + kq) * 33 + nq; q[0] = t[i][0] * sca; q[1] = t[i][1] * sca; q[2] = t[i][2] * sca; q[3] = t[i][3] * sca; }
    asm volatile("s_waitcnt lgkmcnt(0)" ::: "memory");
    const int c = lane & 7;
#pragma unroll
    for (int j = 0; j < 4; ++j) { const int n = (lane >> 3) + 8 * j; const LAS float* s = scr + (8 * c) * 33 + n;
        if (d.f8) { u32x2 o; o.x = pg8::pack4_fp8(s[0 * 33] * 32.f, s[1 * 33] * 32.f, s[2 * 33] * 32.f, s[3 * 33] * 32.f); o.y = pg8::pack4_fp8(s[4 * 33] * 32.f, s[5 * 33] * 32.f, s[6 * 33] * 32.f, s[7 * 33] * 32.f);
            *(u32x2*)((unsigned char*)d.WT + (size_t)tr_drow(d.mode, n0 + n) * d.K + k0 + 8 * c) = o; }
        else { u32x4 o; o.x = cvt_pk_bf16(s[0 * 33], s[1 * 33]); o.y = cvt_pk_bf16(s[2 * 33], s[3 * 33]); o.z = cvt_pk_bf16(s[4 * 33], s[5 * 33]); o.w = cvt_pk_bf16(s[6 * 33], s[7 * 33]);
            *(u32x4*)(d.WT + (size_t)tr_drow(d.mode, n0 + n) * d.K + k0 + 8 * c) = o; } }
    asm volatile("s_waitcnt lgkmcnt(0)" ::: "memory");
}
constexpr int TR_T0 = 1280, TR_T1 = TR_T0 + 64, TR_T2 = TR_T1 + 512, TR_T3 = TR_T2 + 1536, TR_T4 = TR_T3 + 512, TR_T5 = TR_T4 + 49152;
__device__ __forceinline__ TrItem tr_decode(PR p, int it) {
    TrItem d; d.f8 = 0;
    if (it < TR_T0) { d.W = p.in[I_WINAB]; d.WT = WSP(bf16, WS_WIN0); d.K = 1024; d.N = 2560; d.mode = 1; d.item = it; d.f8 = PF_IN0; }
    else if (it < TR_T1) { d.W = p.in[I_WGLU]; d.WT = WSP(bf16, WS_WGLU); d.K = 256; d.N = 512; d.mode = 3; d.item = it - TR_T0; }
    else if (it < TR_T2) { d.W = p.in[I_WOUTAB]; d.WT = WSP(bf16, WS_WOUT0); d.K = 1024; d.N = 1024; d.mode = 0; d.item = it - TR_T1; d.f8 = PF_OUT0; }
    else if (it < TR_T3) { d.W = p.in[I_WINC]; d.WT = WSP(bf16, WS_WIN1); d.K = 1024; d.N = 3072; d.mode = 2; d.item = it - TR_T2; d.f8 = PF_IN1; }
    else if (it < TR_T4) { d.W = p.in[I_WOUTC]; d.WT = WSP(bf16, WS_WOUT1); d.K = 1024; d.N = 1024; d.mode = 0; d.item = it - TR_T3; d.f8 = PF_OUT1; }
    else { const int r = it - TR_T4, le = r / 1536, r1 = r % 1536, which = r1 / 512;
        d.W = p.in[which == 0 ? I_EG : (which == 1 ? I_EU : I_ED)] + (size_t)le * 1024 * 1024;
        d.WT = (bf16*)(p.ws + WS_EXP + (size_t)le * EXP_STRIDE + (which == 2 ? EXP_DN : 0)); d.K = 1024; d.N = 1024; d.mode = which == 0 ? 4 : (which == 1 ? 5 : 0); d.item = r1 % 512; d.f8 = MOE_FP8; }
    return d;
}
__device__ __forceinline__ void p0a_prologue(PR p, Frame& F) {
    for (int it = F.bid; it < 224; it += F.G) { if (it < 192) p0_gemv_item(p, F, it); else p0_s5_item(p, F, it - 192); }
    LAS float* scr = (LAS float*)(F.lds + F.wave * 16384);
    const int gw = F.vcu * NWAVES + F.wave, NGW = F.G * NWAVES;
    { f32x4 ta[8], tb[8]; int it = gw;
      TrItem da = tr_decode(p, it < TR_T5 ? it : 0), db = da;
      if (it < TR_T5) tr_load(da, ta, F.lane);
      while (it < TR_T5) {
          const int nx = it + NGW;
          if (nx < TR_T5) { db = tr_decode(p, nx); tr_load(db, tb, F.lane); }
          tr_finish(da, ta, scr, F.lane);
          it = nx; if (it >= TR_T5) break;
          const int nx2 = it + NGW;
          if (nx2 < TR_T5) { da = tr_decode(p, nx2); tr_load(da, ta, F.lane); }
          tr_finish(db, tb, scr, F.lane);
          it = nx2;
      } }
    const int gt = F.bid * NTHREADS + F.tid, NGT = F.G * NTHREADS;
    for (int i = gt; i < SEQ * 32 + 128 * 16 + 1; i += NGT) {
        if (i < SEQ * 32) { const int pos = i >> 5, k = i & 31; const float inv = powf(10000.f, -(float)(2 * k) / 64.f); const float ang = (float)pos * inv; float s, c; sincos_rev((double)ang * 0.15915494309189535, s, c);
            WSP(float, WS_ROPE0C)[i] = c; WSP(float, WS_ROPE0S)[i] = s; }
        else if (i < SEQ * 32 + 2048) { const int j = i - SEQ * 32, pos = j >> 4, k = j & 15; const float inv = powf(10000.f, -(float)(2 * k) / 32.f); const float ang = (float)pos * inv; float s, c; sincos_rev((double)ang * 0.15915494309189535, s, c);
            WSP(float, WS_ROPE1)[j] = c; WSP(float, WS_ROPE1)[2048 + j] = s; }
        else { const float* dl = p.in[I_DLAM]; float s0 = 0.f, s1 = 0.f; for (int k = 0; k < 64; ++k) { s0 += dl[k] * dl[64 + k]; s1 += dl[128 + k] * dl[192 + k]; }
            WSP(float, WS_SCAL)[0] = expf(s0) - expf(s1) + LAMBDA_INIT; }
    }
}

__device__ __forceinline__ void modulate_row(const float* xrow, const float* shift, const float* scale, bf16* orow, int lane) {
#pragma unroll
    for (int j = 0; j < 4; ++j) { const int c = 4 * lane + 256 * j; const f32x4 x = *(const f32x4*)(xrow + c), sh = *(const f32x4*)(shift + c), sc = *(const f32x4*)(scale + c);
        const f32x4 h = x * (sc + 1.f) + sh; u32x2 w; w.x = cvt_pk_bf16(h[0], h[1]); w.y = cvt_pk_bf16(h[2], h[3]); *(u32x2*)(orow + c) = w; }
}
__device__ __forceinline__ void p0b_phase(PR p, Frame& F) {
    const int gw = F.vcu * NWAVES + F.wave, NGW = F.G * NWAVES;
    const float* mod = WSP(float, WS_MOD);
    bf16* H0 = WSP(bf16, A_H0);
    for (int r0 = gw; r0 < NTOK; r0 += 2 * NGW) {
        const int r1 = r0 + NGW; const bool has1 = r1 < NTOK;
        const bool lat0 = r0 < NLAT, lat1 = r1 < NLAT; const int b0 = lat0 ? (r0 >> 13) : 4, b1 = lat1 ? (r1 >> 13) : 4;
        const float* x0 = lat0 ? p.in[I_X] + (size_t)r0 * DM : p.in[I_CTX] + (size_t)(r0 - NLAT) * DM;
        const float* x1 = has1 ? (lat1 ? p.in[I_X] + (size_t)r1 * DM : p.in[I_CTX] + (size_t)(r1 - NLAT) * DM) : x0;
        f32x4 a[4], c[4];
#pragma unroll
        for (int j = 0; j < 4; ++j) { a[j] = *(const f32x4*)(x0 + 4 * F.lane + 256 * j); c[j] = *(const f32x4*)(x1 + 4 * F.lane + 256 * j); }
#pragma unroll
        for (int j = 0; j < 4; ++j) { const int cc = 4 * F.lane + 256 * j; const f32x4 sh = *(const f32x4*)(mod + b0 * 6144 + cc), sc = *(const f32x4*)(mod + b0 * 6144 + 1024 + cc);
            const f32x4 h = a[j] * (sc + 1.f) + sh;
            if (PF_IN0) *(unsigned*)((unsigned char*)H0 + (size_t)r0 * DM + cc) = pg8::pack4_fp8(h[0], h[1], h[2], h[3]);
            else { u32x2 w; w.x = cvt_pk_bf16(h[0], h[1]); w.y = cvt_pk_bf16(h[2], h[3]); *(u32x2*)(H0 + (size_t)r0 * DM + cc) = w; } }
        if (has1) {
#pragma unroll
            for (int j = 0; j < 4; ++j) { const int cc = 4 * F.lane + 256 * j; const f32x4 sh = *(const f32x4*)(mod + b1 * 6144 + cc), sc = *(const f32x4*)(mod + b1 * 6144 + 1024 + cc);
                const f32x4 h = c[j] * (sc + 1.f) + sh;
                if (PF_IN0) *(unsigned*)((unsigned char*)H0 + (size_t)r1 * DM + cc) = pg8::pack4_fp8(h[0], h[1], h[2], h[3]);
                else { u32x2 w; w.x = cvt_pk_bf16(h[0], h[1]); w.y = cvt_pk_bf16(h[2], h[3]); *(u32x2*)(H0 + (size_t)r1 * DM + cc) = w; } } }
    }
    const int gt = F.bid * NTHREADS + F.tid, NGT = F.G * NTHREADS;
    const float* S5K = WSP(float, WS_S5K); const f32x2* LAMP = WSP(f32x2, WS_LAMP); const f32x2* COEF = WSP(f32x2, WS_COEF);
    bf16* BT2 = WSP(bf16, WS_BT2); bf16* BT1 = WSP(bf16, WS_BT1);
    for (int idx = gt; idx < 16 * 512 * 96; idx += NGT) {
        const int g = idx / (512 * 96), n = (idx / 96) % 512, k0 = (idx % 96) * 8, i = n >> 4, pp = n & 15; float v[8];
        if (k0 < 512) { const int j = k0 >> 4, q0 = k0 & 15;
#pragma unroll
            for (int t = 0; t < 8; ++t) { const int q = q0 + t; float x;
                if (i > j) x = S5K[((g * 2 + 0) * 32 + (i - j)) * 256 + pp * 16 + q];
                else if (i < j) x = S5K[((g * 2 + 1) * 32 + (j - i)) * 256 + pp * 16 + q];
                else x = S5K[((g * 2 + 0) * 32) * 256 + pp * 16 + q] + S5K[((g * 2 + 1) * 32) * 256 + pp * 16 + q] + (pp == q ? p.in[I_S5D][g * 16 + pp] : 0.f);
                v[t] = x; }
        } else { const int kk0 = k0 - 512, dir = kk0 >> 7, ri = (kk0 >> 6) & 1, nn0 = kk0 & 63, pw = dir == 0 ? i + 1 : S5T - i;
#pragma unroll
            for (int t = 0; t < 8; ++t) { const int nn = nn0 + t; const f32x2 cc = (f32x2){p.in[I_CRE][((dir * 16 + g) * 16 + pp) * 64 + nn], p.in[I_CIM][((dir * 16 + g) * 16 + pp) * 64 + nn]};
                const f32x2 w = cmul(cc, LAMP[((g * 2 + dir) * 64 + nn) * 33 + pw]); v[t] = ri == 0 ? w.x : -w.y; }
        }
        u32x4 o; o.x = cvt_pk_bf16(v[0], v[1]); o.y = cvt_pk_bf16(v[2], v[3]); o.z = cvt_pk_bf16(v[4], v[5]); o.w = cvt_pk_bf16(v[6], v[7]);
        *(u32x4*)(BT2 + ((size_t)g * 512 + n) * 768 + k0) = o;
    }
    for (int idx = gt; idx < 16 * 256 * 64; idx += NGT) {
        const int g = idx / (256 * 64), n = (idx / 64) % 256, k0 = (idx % 64) * 8, j = k0 >> 4, q0 = k0 & 15, dir = n >> 7, ri = (n >> 6) & 1, nn = n & 63, pw = dir == 0 ? (S5T - 1 - j) : j;
        const f32x2 w = cmul(LAMP[((g * 2 + dir) * 64 + nn) * 33 + pw], COEF[(g * 2 + dir) * 64 + nn]); float v[8];
#pragma unroll
        for (int t = 0; t < 8; ++t) { const int q = q0 + t; const f32x2 bb = cmul(w, (f32x2){p.in[I_BRE][((dir * 16 + g) * 64 + nn) * 16 + q], p.in[I_BIM][((dir * 16 + g) * 64 + nn) * 16 + q]}); v[t] = ri == 0 ? bb.x : bb.y; }
        u32x4 o; o.x = cvt_pk_bf16(v[0], v[1]); o.y = cvt_pk_bf16(v[2], v[3]); o.z = cvt_pk_bf16(v[4], v[5]); o.w = cvt_pk_bf16(v[6], v[7]);
        *(u32x4*)(BT1 + ((size_t)g * 256 + n) * 512 + k0) = o;
    }
}
__device__ __forceinline__ void ret_unit(int unit, int& bh, int& h, int& r0) {
    const int cch = unit % RNCH; bh = unit / RNCH; h = bh % RH; const int b = bh / RH;
    r0 = cch < 64 ? b * SEQ + cch * RC : NLAT + b * CTXL + (cch - 64) * RC;
}
__device__ __forceinline__ float log_gamma(PR p, int dir, int h) { const float x = p.in[I_DECAY][dir * RH + h]; return -log1pf(expf(-x)); }
struct RetDeal { int u, stride, end; };
__device__ __forceinline__ RetDeal ret_deal(int c, int G, int NG, int a, int total) {
    RetDeal d;
    if (G <= NG) { d.u = c; d.stride = G; d.end = total; }
    else if (c < NG) { d.u = c; d.stride = NG; d.end = NG * a; }
    else { d.u = NG * a + (c - NG); d.stride = G - NG; d.end = total; }
    return d;
}
constexpr int RT_LD = 136;
__device__ __forceinline__ void ret_stage_vt(const bf16* V, int r0, int h, LAS bf16* VT, int tid) {
#pragma unroll
    for (int i = 0; i < 4; ++i) { const int id = tid + 512 * i, j = id >> 4, e0 = (id & 15) * 8;
        const u32x4 raw = *(const u32x4*)(V + (size_t)(r0 + j) * 768 + h * 128 + e0);
        VT[(e0 + 0) * RT_LD + j] = (bf16)(raw.x & 0xffffu); VT[(e0 + 1) * RT_LD + j] = (bf16)(raw.x >> 16);
        VT[(e0 + 2) * RT_LD + j] = (bf16)(raw.y & 0xffffu); VT[(e0 + 3) * RT_LD + j] = (bf16)(raw.y >> 16);
        VT[(e0 + 4) * RT_LD + j] = (bf16)(raw.z & 0xffffu); VT[(e0 + 5) * RT_LD + j] = (bf16)(raw.z >> 16);
        VT[(e0 + 6) * RT_LD + j] = (bf16)(raw.w & 0xffffu); VT[(e0 + 7) * RT_LD + j] = (bf16)(raw.w >> 16); }
}
__device__ __forceinline__ void ret_states_phase(PR p, Frame& F, int NG, int a) {
    LAS bf16* KdTf = (LAS bf16*)F.lds; LAS bf16* KdTb = KdTf + 64 * RT_LD; LAS bf16* VT = KdTb + 64 * RT_LD;
    const bf16* QK = WSP(bf16, A_QK); const bf16* V = WSP(bf16, A_V); float* RT = p.out;
    const int w = F.wave, fr = F.lane & 15, fq = F.lane >> 4;
    const RetDeal dl_ = ret_deal(F.bid, F.G, NG, a, NBATCH * RH * RNCH);
    for (int unit = dl_.u; unit < dl_.end; unit += dl_.stride) {
        int bh, h, r0; ret_unit(unit, bh, h, r0);
        const float lgf = log_gamma(p, 0, h), lgb = log_gamma(p, 1, h);
#pragma unroll
        for (int i = 0; i < 2; ++i) { const int id = F.tid + 512 * i, j = id >> 3, d0 = (id & 7) * 8;
            const u32x4 raw = *(const u32x4*)(QK + (size_t)(r0 + j) * 768 + (RH + h) * 64 + d0);
            const float df = expf(lgf * (float)(RC - 1 - j)), db = expf(lgb * (float)j);
            const unsigned wv[4] = {raw.x, raw.y, raw.z, raw.w};
#pragma unroll
            for (int t = 0; t < 4; ++t) { const float k0 = bflo(wv[t]), k1 = bfhi(wv[t]);
                KdTf[(d0 + 2 * t) * RT_LD + j] = (bf16)f2bf(k0 * df); KdTf[(d0 + 2 * t + 1) * RT_LD + j] = (bf16)f2bf(k1 * df);
                KdTb[(d0 + 2 * t) * RT_LD + j] = (bf16)f2bf(k0 * db); KdTb[(d0 + 2 * t + 1) * RT_LD + j] = (bf16)f2bf(k1 * db); } }
        ret_stage_vt(V, r0, h, VT, F.tid);
        __syncthreads();
        const int dir = w >> 2; const LAS bf16* KdT = dir ? KdTb : KdTf;
        f32x4 acc[2][4];
#pragma unroll
        for (int a = 0; a < 2; ++a)
#pragma unroll
            for (int d = 0; d < 4; ++d) acc[a][d] = (f32x4){0.f, 0.f, 0.f, 0.f};
#pragma unroll
        for (int ks = 0; ks < 4; ++ks) { bf16x8 af[2], bfr[4];
#pragma unroll
            for (int a = 0; a < 2; ++a) af[a] = *(const LAS bf16x8*)(VT + (((w & 3) * 2 + a) * 16 + fr) * RT_LD + 32 * ks + 8 * fq);
#pragma unroll
            for (int d = 0; d < 4; ++d) bfr[d] = *(const LAS bf16x8*)(KdT + (d * 16 + fr) * RT_LD + 32 * ks + 8 * fq);
#pragma unroll
            for (int a = 0; a < 2; ++a)
#pragma unroll
                for (int d = 0; d < 4; ++d) acc[a][d] = __builtin_amdgcn_mfma_f32_16x16x32_bf16(af[a], bfr[d], acc[a][d], 0, 0, 0); }
        float* out = RT + ((size_t)unit * 2 + dir) * 8192;
#pragma unroll
        for (int a = 0; a < 2; ++a)
#pragma unroll
            for (int d = 0; d < 4; ++d)
#pragma unroll
                for (int jj = 0; jj < 4; ++jj) out[(((w & 3) * 2 + a) * 16 + 4 * fq + jj) * 64 + d * 16 + fr] = acc[a][d][jj];
        __syncthreads();
    }
}
__device__ __forceinline__ void ret_scan_phase(PR p, Frame& F) {
    const float* RT = p.out; bf16* TT = WSP(bf16, A_TT);
    const int gt = F.bid * NTHREADS + F.tid, NGT = F.G * NTHREADS;
    for (int e = gt; e < 48 * 8192; e += NGT) {
        const int chain = e >> 13, el = e & 8191, dir = chain & 1, bh = chain >> 1, h = bh % RH;
        const float gC = expf(log_gamma(p, dir, h) * (float)RC);
        float st = 0.f;
        for (int s0 = 0; s0 < RNCH; s0 += 11) {
            float r[11];
#pragma unroll
            for (int k = 0; k < 11; ++k) { const int s = s0 + k, cch = dir == 0 ? (s < 2 ? 64 + s : s - 2) : (65 - s);
                r[k] = RT[((size_t)(bh * RNCH + cch) * 2 + dir) * 8192 + el]; }
#pragma unroll
            for (int k = 0; k < 11; ++k) { const int s = s0 + k, cch = dir == 0 ? (s < 2 ? 64 + s : s - 2) : (65 - s);
                TT[((size_t)(bh * RNCH + cch) * 2 + dir) * 8192 + el] = (bf16)f2bf(st);
                st = st * gC + r[k]; }
        }
    }
}
__device__ __forceinline__ void s5_scan_phase(PR p, Frame& F) {
    const float* EO = WSP(float, A_EO); bf16* UA = WSP(bf16, A_UA); const f32x2* LAMP = WSP(f32x2, WS_LAMP);
    if (F.wave != 0) return;
    for (int it = F.bid; it < 128; it += F.G) {
        const int b = it >> 5, g = (it >> 1) & 15, dir = it & 1, n = F.lane;
        const f32x2 lamT = LAMP[((g * 2 + dir) * 64 + n) * 33 + S5T];
        f32x2 st = (f32x2){0.f, 0.f};
#define S5ROW(s_) (dir == 0 ? ((s_) < 8 ? 1024 + b * 8 + (s_) : b * 256 + ((s_) - 8)) : ((s_) < 8 ? 1024 + b * 8 + (7 - (s_)) : b * 256 + (263 - (s_))))
#define S5LOAD(dst, s0_) do { _Pragma("unroll") for (int k = 0; k < 24; ++k) { const float* er = EO + ((size_t)g * S5ROWS + S5ROW((s0_) + k)) * 256 + dir * 128 + n; dst[k] = (f32x2){er[0], er[64]}; } } while (0)
#define S5STEP(src, s0_) do { _Pragma("unroll") for (int k = 0; k < 24; ++k) { bf16* ur = UA + ((size_t)g * S5ROWS + S5ROW((s0_) + k)) * 768 + 512 + dir * 128 + n; \
            ur[0] = (bf16)f2bf(st.x); ur[64] = (bf16)f2bf(st.y); st = cmul(lamT, st) + src[k]; } } while (0)
        f32x2 ea[24], eb[24];
        S5LOAD(ea, 0);
#pragma unroll 1
        for (int s0 = 0; s0 < 264; s0 += 48) {
            if (s0 + 24 < 264) S5LOAD(eb, s0 + 24);
            S5STEP(ea, s0);
            if (s0 + 24 >= 264) break;
            if (s0 + 48 < 264) S5LOAD(ea, s0 + 48);
            S5STEP(eb, s0 + 24);
        }
#undef S5ROW
#undef S5LOAD
#undef S5STEP
    }
}
__device__ __forceinline__ void ret_out_phase(PR p, Frame& F, int NG, int a) {
    constexpr int KT_LD = 72, GO_LD = 136;
    LAS bf16* VT = (LAS bf16*)F.lds; LAS bf16* Pw = VT + 128 * RT_LD + F.wave * 16 * RT_LD;
    LAS bf16* Kt = VT + 256 * RT_LD;
    LAS bf16* GO = Kt + 128 * KT_LD;
    const bf16* QK = WSP(bf16, A_QK); const bf16* V = WSP(bf16, A_V); const bf16* Gb = WSP(bf16, A_G); const bf16* TT = WSP(bf16, A_TT); bf16* MRG = WSP(bf16, A_MRG);
    const int w = F.wave, fr = F.lane & 15, fq = F.lane >> 4, i0 = 16 * w;
    const RetDeal dl_ = ret_deal(F.bid, F.G, NG, a, NBATCH * RH * RNCH);
    for (int unit = dl_.u; unit < dl_.end; unit += dl_.stride) {
        int bh, h, r0; ret_unit(unit, bh, h, r0);
        const float lgf2 = log_gamma(p, 0, h) * 1.4426950408889634f, lgb2 = log_gamma(p, 1, h) * 1.4426950408889634f;
        ret_stage_vt(V, r0, h, VT, F.tid);
#pragma unroll
        for (int i = 0; i < 2; ++i) { const int id = F.tid + 512 * i, j = id >> 3, c = (id & 7) * 8;
            *(LAS u32x4*)(Kt + j * KT_LD + c) = *(const u32x4*)(QK + (size_t)(r0 + j) * 768 + (RH + h) * 64 + c); }
#pragma unroll
        for (int i = 0; i < 4; ++i) { const int id = F.tid + 512 * i, j = id >> 4, c = (id & 15) * 8;
            *(LAS u32x4*)(GO + j * GO_LD + c) = *(const u32x4*)(Gb + (size_t)(r0 + j) * 768 + h * 128 + c); }
        bf16x8 aq[2];
#pragma unroll
        for (int ks = 0; ks < 2; ++ks) aq[ks] = *(const bf16x8*)(QK + (size_t)(r0 + i0 + fr) * 768 + h * 64 + 32 * ks + 8 * fq);
        __syncthreads();
#pragma unroll
        for (int jt = 0; jt < 8; ++jt) { f32x4 sc = (f32x4){0.f, 0.f, 0.f, 0.f};
#pragma unroll
            for (int ks = 0; ks < 2; ++ks) { const bf16x8 bk = *(const LAS bf16x8*)(Kt + (16 * jt + fr) * KT_LD + 32 * ks + 8 * fq);
                sc = __builtin_amdgcn_mfma_f32_16x16x32_bf16(aq[ks], bk, sc, 0, 0, 0); }
#pragma unroll
            for (int jj = 0; jj < 4; ++jj) { const int dl = (i0 + 4 * fq + jj) - (16 * jt + fr);
                const float dec = __builtin_amdgcn_exp2f(dl >= 0 ? lgf2 * (float)dl : lgb2 * (float)(-dl));
                Pw[(4 * fq + jj) * RT_LD + 16 * jt + fr] = (bf16)f2bf(sc[jj] * dec); } }
        asm volatile("s_waitcnt lgkmcnt(0)" ::: "memory");
        f32x4 o[8];
#pragma unroll
        for (int et = 0; et < 8; ++et) o[et] = (f32x4){0.f, 0.f, 0.f, 0.f};
#pragma unroll
        for (int ks = 0; ks < 4; ++ks) { const bf16x8 ap = *(const LAS bf16x8*)(Pw + fr * RT_LD + 32 * ks + 8 * fq);
#pragma unroll
            for (int et = 0; et < 8; ++et) { const bf16x8 bv = *(const LAS bf16x8*)(VT + (16 * et + fr) * RT_LD + 32 * ks + 8 * fq);
                o[et] = __builtin_amdgcn_mfma_f32_16x16x32_bf16(ap, bv, o[et], 0, 0, 0); } }
#pragma unroll
        for (int dir = 0; dir < 2; ++dir) { const bf16* TTp = TT + ((size_t)unit * 2 + dir) * 8192; float qd[4];
#pragma unroll
            for (int jj = 0; jj < 4; ++jj) { const int i = i0 + 4 * fq + jj; qd[jj] = __builtin_amdgcn_exp2f(dir == 0 ? lgf2 * (float)(i + 1) : lgb2 * (float)(RC - i)); }
#pragma unroll
            for (int et = 0; et < 8; ++et) { f32x4 t = (f32x4){0.f, 0.f, 0.f, 0.f};
#pragma unroll
                for (int ks = 0; ks < 2; ++ks) { const bf16x8 bt = *(const bf16x8*)(TTp + (16 * et + fr) * 64 + 32 * ks + 8 * fq);
                    t = __builtin_amdgcn_mfma_f32_16x16x32_bf16(aq[ks], bt, t, 0, 0, 0); }
#pragma unroll
                for (int jj = 0; jj < 4; ++jj) o[et][jj] += qd[jj] * t[jj]; } }
#pragma unroll
        for (int jj = 0; jj < 4; ++jj) { float s = 0.f;
#pragma unroll
            for (int et = 0; et < 8; ++et) s += o[et][jj];
            s += __shfl_xor(s, 1); s += __shfl_xor(s, 2); s += __shfl_xor(s, 4); s += __shfl_xor(s, 8);
            const float mu = s * (1.f / 128.f); float q = 0.f;
#pragma unroll
            for (int et = 0; et < 8; ++et) { const float d = o[et][jj] - mu; q += d * d; }
            q += __shfl_xor(q, 1); q += __shfl_xor(q, 2); q += __shfl_xor(q, 4); q += __shfl_xor(q, 8);
            const float rstd = 1.f / sqrtf(q * (1.f / 128.f) + GN_EPS);
            LAS bf16* grow = GO + (i0 + 4 * fq + jj) * GO_LD + fr;
#pragma unroll
            for (int et = 0; et < 8; ++et) { const float gv = bf2f(grow[16 * et]); grow[16 * et] = (bf16)f2bf((o[et][jj] - mu) * rstd * (gv * fast_sigmoid(gv))); } }
        __syncthreads();
#pragma unroll
        for (int i = 0; i < 4; ++i) { const int id = F.tid + 512 * i, j = id >> 4, c = (id & 15) * 8; const u32x4 v = *(const LAS u32x4*)(GO + j * GO_LD + c);
            const size_t off = (size_t)(r0 + j) * 1024 + h * 128 + c;
            if (PF_OUT0) { u32x2 q8; q8.x = pg8::pack4_fp8(bflo(v.x), bfhi(v.x), bflo(v.y), bfhi(v.y)); q8.y = pg8::pack4_fp8(bflo(v.z), bfhi(v.z), bflo(v.w), bfhi(v.w)); *(u32x2*)((unsigned char*)MRG + off) = q8; }
            else *(u32x4*)(MRG + off) = v; }
        __syncthreads();
    }
}
struct RouteRec { int e0, e1, rk0, rk1; float w0, w1; int d0, d1; };

__device__ __forceinline__ float* xs_row(PR p, int r) { return r < NLAT ? p.out + (size_t)r * DM : WSP(float, WS_XC) + (size_t)(r - NLAT) * DM; }

template <int LAYER>
__device__ __forceinline__ void ln1_router_phase(PR p, Frame& F, const bf16* O, bf16* H2, int nrows) {
    LAS float* rw = (LAS float*)F.lds;
    LAS unsigned* lcnt = (LAS unsigned*)(F.lds + 65536);
    for (int i = F.tid; i < 1024 * 16 / 4; i += NTHREADS) { const f32x4 w4 = ((const f32x4*)p.in[I_RW])[i]; const int col = i >> 2, e0 = (i & 3) * 4;
        rw[(e0 + 0) * 1024 + col] = w4[0]; rw[(e0 + 1) * 1024 + col] = w4[1]; rw[(e0 + 2) * 1024 + col] = w4[2]; rw[(e0 + 3) * 1024 + col] = w4[3]; }
    if (F.tid < 16) lcnt[F.tid] = 0u;
    __syncthreads();
    const float* mod = WSP(float, WS_MOD) + LAYER * 5 * 6144;
    const float* lng = p.in[I_LNG] + (LAYER * 2 + 0) * DM;
    RouteRec* route = WSP(RouteRec, WS_ROUTE);
    const int rpb = (nrows + F.G - 1) / F.G, rbeg = F.bid * rpb, rend = (rbeg + rpb < nrows) ? rbeg + rpb : nrows;
    const int lane = F.lane;
    f32x4 nx[4]; u32x2 no[4];
#define LN1_LOAD(r_) do { const bool lt_ = (r_) < NLAT; const float* xi_ = (LAYER == 0) ? (lt_ ? p.in[I_X] + (size_t)(r_) * DM : p.in[I_CTX] + (size_t)((r_) - NLAT) * DM) : xs_row(p, (r_)); \
        _Pragma("unroll") for (int j = 0; j < 4; ++j) { const int c = 4 * lane + 256 * j; nx[j] = *(const f32x4*)(xi_ + c); no[j] = *(const u32x2*)(O + (size_t)(r_) * DM + c); } } while (0)
    if (rbeg + F.wave < rend) LN1_LOAD(rbeg + F.wave);
    for (int r = rbeg + F.wave; r < rend; r += NWAVES) {
        const bool lat = r < NLAT; const int b = lat ? (r >> 13) : 4;
        const float* mb = mod + b * 6144;
        f32x4 v[4]; float s = 0.f;
#pragma unroll
        for (int j = 0; j < 4; ++j) { const int c = 4 * lane + 256 * j; const f32x4 g1 = *(const f32x4*)(mb + 2048 + c);
            const f32x4 o = (f32x4){bflo(no[j].x), bfhi(no[j].x), bflo(no[j].y), bfhi(no[j].y)};
            v[j] = nx[j] * ALPHA + g1 * o; s += (v[j][0] + v[j][1]) + (v[j][2] + v[j][3]); }
        if (r + NWAVES < rend) LN1_LOAD(r + NWAVES);
        const float mean = wave_sum(s) * (1.f / DM); float q = 0.f;
#pragma unroll
        for (int j = 0; j < 4; ++j) { v[j] = v[j] - mean; q += (v[j][0] * v[j][0] + v[j][1] * v[j][1]) + (v[j][2] * v[j][2] + v[j][3] * v[j][3]); }
        const float rstd = 1.f / sqrtf(wave_sum(q) * (1.f / DM) + LN_EPS);
        float* xo = xs_row(p, r);
        float lg[16];
#pragma unroll
        for (int e = 0; e < 16; ++e) lg[e] = 0.f;
#pragma unroll
        for (int j = 0; j < 4; ++j) { const int c = 4 * lane + 256 * j; const f32x4 gn = *(const f32x4*)(lng + c), sh = *(const f32x4*)(mb + 3072 + c), sc = *(const f32x4*)(mb + 4096 + c);
            const f32x4 x1 = v[j] * rstd * gn; *(f32x4*)(xo + c) = x1;
            const f32x4 h = x1 * (sc + 1.f) + sh;
            if (MOE_FP8) *(unsigned*)((unsigned char*)H2 + (size_t)r * DM + c) = pg8::pack4_fp8(h[0], h[1], h[2], h[3]);
            else { u32x2 w; w.x = cvt_pk_bf16(h[0], h[1]); w.y = cvt_pk_bf16(h[2], h[3]); *(u32x2*)(H2 + (size_t)r * DM + c) = w; }
#pragma unroll
            for (int e = 0; e < 16; ++e) { const f32x4 wv = *(const LAS f32x4*)(rw + e * 1024 + c); lg[e] = fmaf(h[0], wv[0], fmaf(h[1], wv[1], fmaf(h[2], wv[2], fmaf(h[3], wv[3], lg[e])))); } }
#pragma unroll
        for (int e = 0; e < 16; ++e) lg[e] = wave_sum(lg[e]);
        float sc[16], bs[16];
#pragma unroll
        for (int e = 0; e < 16; ++e) { sc[e] = __builtin_amdgcn_rcpf(1.f + __expf(-lg[e])); bs[e] = sc[e] + p.in[I_RB][e]; }
        float gbest = -INFINITY; int gsel = 0;
#pragma unroll
        for (int gq = 0; gq < 4; ++gq) { const float a = bs[4 * gq], b2 = bs[4 * gq + 1], c2 = bs[4 * gq + 2], d2 = bs[4 * gq + 3];
            const float m1 = fmaxf(fmaxf(a, b2), fmaxf(c2, d2));
            const float m2 = fmaxf(fmaxf(fminf(a, b2), fminf(c2, d2)), fminf(fmaxf(a, b2), fmaxf(c2, d2)));
            const float gs = m1 + m2; if (gs > gbest) { gbest = gs; gsel = gq; } }
        float b4[4], s4[4];
#pragma unroll
        for (int i = 0; i < 4; ++i) { b4[i] = gsel == 0 ? bs[i] : (gsel == 1 ? bs[4 + i] : (gsel == 2 ? bs[8 + i] : bs[12 + i])); s4[i] = gsel == 0 ? sc[i] : (gsel == 1 ? sc[4 + i] : (gsel == 2 ? sc[8 + i] : sc[12 + i])); }
        int i0 = 0; float bv0 = b4[0];
#pragma unroll
        for (int i = 1; i < 4; ++i) if (b4[i] > bv0) { bv0 = b4[i]; i0 = i; }
        int i1 = -1; float bv1 = -INFINITY;
#pragma unroll
        for (int i = 0; i < 4; ++i) if (i != i0 && b4[i] > bv1) { bv1 = b4[i]; i1 = i; }
        const float g0 = i0 == 0 ? s4[0] : (i0 == 1 ? s4[1] : (i0 == 2 ? s4[2] : s4[3]));
        const float g1s = i1 == 0 ? s4[0] : (i1 == 1 ? s4[1] : (i1 == 2 ? s4[2] : s4[3]));
        if (lane == 0) { RouteRec rr; rr.e0 = gsel * 4 + i0; rr.e1 = gsel * 4 + i1; rr.rk0 = (int)atomicAdd((unsigned*)&lcnt[rr.e0], 1u); rr.rk1 = (int)atomicAdd((unsigned*)&lcnt[rr.e1], 1u);
            const float den = g0 + g1s; rr.w0 = g0 / den; rr.w1 = g1s / den; rr.d0 = 0; rr.d1 = 0; route[r] = rr; }
    }
#undef LN1_LOAD
    __syncthreads();
    if (F.tid < 16) WSP(unsigned, WS_CNT)[F.bid * 16 + F.tid] = lcnt[F.tid];
    __syncthreads();
}

struct MoeTabs { LAS unsigned* tot; LAS unsigned* pstart; LAS unsigned* pendb; LAS unsigned* mybase; };
__device__ __forceinline__ MoeTabs moe_tabs(Frame& F) { MoeTabs t; LAS unsigned* m = (LAS unsigned*)(F.lds + MISC_OFF + 256); t.tot = m; t.pstart = m + 16; t.pendb = m + 32; t.mybase = m + 48; return t; }
__device__ __forceinline__ void moe_build_tabs(PR p, Frame& F, const MoeTabs& T) {
    const unsigned* cnt = WSP(unsigned, WS_CNT);
    LAS unsigned* tmp = (LAS unsigned*)(F.lds + MISC_OFF + 1024);
    { const int e = F.tid & 15, part = F.tid >> 4, per = (F.G + 31) / 32, b0 = part * per, b1 = (b0 + per < F.G) ? b0 + per : F.G; unsigned tot = 0, base = 0;
      for (int b = b0; b < b1; ++b) { const unsigned c = cnt[b * 16 + e]; tot += c; base += (b < F.bid) ? c : 0u; }
      tmp[part * 32 + e] = tot; tmp[part * 32 + 16 + e] = base; }
    __syncthreads();
    if (F.tid < 16) { unsigned tot = 0, base = 0;
#pragma unroll
        for (int q = 0; q < 32; ++q) { tot += tmp[q * 32 + F.tid]; base += tmp[q * 32 + 16 + F.tid]; }
        T.tot[F.tid] = tot; T.mybase[F.tid] = base; }
    __syncthreads();
    if (F.tid == 0) { unsigned acc = 0; for (int e = 0; e < 16; ++e) { T.pstart[e] = acc; acc += (T.tot[e] + 255u) & ~255u; T.pendb[e] = acc >> 8; } }
    __syncthreads();
}
__device__ __forceinline__ void moe_scatter_phase(PR p, Frame& F, const bf16* H2, bf16* BUF, int nrows) {
    const MoeTabs T = moe_tabs(F); moe_build_tabs(p, F, T);
    RouteRec* route = WSP(RouteRec, WS_ROUTE);
    const int rpb = (nrows + F.G - 1) / F.G, rbeg = F.bid * rpb, rend = (rbeg + rpb < nrows) ? rbeg + rpb : nrows;
    for (int r = rbeg + F.wave; r < rend; r += NWAVES) {
        const RouteRec rr = route[r];
        const int d0 = (int)(T.pstart[rr.e0] + T.mybase[rr.e0]) + rr.rk0, d1 = (int)(T.pstart[rr.e1] + T.mybase[rr.e1]) + rr.rk1;
        if (MOE_FP8) { const u32x4 a = *((const u32x4*)((const unsigned char*)H2 + (size_t)r * DM) + F.lane);
            *((u32x4*)((unsigned char*)BUF + (size_t)d0 * DM) + F.lane) = a; *((u32x4*)((unsigned char*)BUF + (size_t)d1 * DM) + F.lane) = a; }
        else { const u32x4* src = (const u32x4*)(H2 + (size_t)r * DM) + F.lane; const u32x4 a = src[0], b = src[64];
            u32x4* o0 = (u32x4*)(BUF + (size_t)d0 * DM) + F.lane; u32x4* o1 = (u32x4*)(BUF + (size_t)d1 * DM) + F.lane;
            o0[0] = a; o0[64] = b; o1[0] = a; o1[64] = b; }
        if (F.lane == 0) { route[r].d0 = d0; route[r].d1 = d1; }
    }
    if (F.bid < 16) { const int e = F.bid; const unsigned pb = T.pstart[e] + T.tot[e], pe = T.pstart[e] + ((T.tot[e] + 255u) & ~255u);
        for (unsigned r = pb + F.wave; r < pe; r += NWAVES) { if (MOE_FP8) { *((u32x4*)((unsigned char*)BUF + (size_t)r * DM) + F.lane) = (u32x4){0u, 0u, 0u, 0u}; } else { u32x4* o = (u32x4*)(BUF + (size_t)r * DM) + F.lane; o[0] = (u32x4){0u, 0u, 0u, 0u}; o[64] = (u32x4){0u, 0u, 0u, 0u}; } } }
}

template <int LAYER>
__device__ __forceinline__ void ln2_phase(PR p, Frame& F, const bf16* Y, bf16* H0N, int nrows) {
    const float* mod = WSP(float, WS_MOD) + LAYER * 5 * 6144;
    const float* modn = WSP(float, WS_MOD) + (LAYER + 1) * 5 * 6144;
    const float* lng = p.in[I_LNG] + (LAYER * 2 + 1) * DM;
    const RouteRec* route = WSP(RouteRec, WS_ROUTE);
    const int gw = F.vcu * NWAVES + F.wave, NGW = F.G * NWAVES, lane = F.lane;
    f32x4 nx[4]; u32x2 nya[4], nyb[4]; float nw0 = 0.f, nw1 = 0.f;
#define LN2_LOAD(r_) do { const RouteRec rr_ = route[(r_)]; nw0 = rr_.w0; nw1 = rr_.w1; const float* xr_ = xs_row(p, (r_)); \
        _Pragma("unroll") for (int j = 0; j < 4; ++j) { const int c = 4 * lane + 256 * j; nx[j] = *(const f32x4*)(xr_ + c); nya[j] = *(const u32x2*)(Y + (size_t)rr_.d0 * DM + c); nyb[j] = *(const u32x2*)(Y + (size_t)rr_.d1 * DM + c); } } while (0)
    if (gw < nrows) LN2_LOAD(gw);
    for (int r = gw; r < nrows; r += NGW) {
        const bool lat = r < NLAT; const int b = lat ? (r >> 13) : 4;
        const float* mb = mod + b * 6144; float* xr = xs_row(p, r);
        f32x4 v[4]; float s = 0.f;
#pragma unroll
        for (int j = 0; j < 4; ++j) { const int c = 4 * lane + 256 * j; const f32x4 g2 = *(const f32x4*)(mb + 5120 + c);
            const f32x4 y = (f32x4){bflo(nya[j].x), bfhi(nya[j].x), bflo(nya[j].y), bfhi(nya[j].y)} * nw0 + (f32x4){bflo(nyb[j].x), bfhi(nyb[j].x), bflo(nyb[j].y), bfhi(nyb[j].y)} * nw1;
            v[j] = nx[j] * ALPHA + g2 * y; s += (v[j][0] + v[j][1]) + (v[j][2] + v[j][3]); }
        if (r + NGW < nrows) LN2_LOAD(r + NGW);
        const float mean = wave_sum(s) * (1.f / DM); float q = 0.f;
#pragma unroll
        for (int j = 0; j < 4; ++j) { v[j] = v[j] - mean; q += (v[j][0] * v[j][0] + v[j][1] * v[j][1]) + (v[j][2] * v[j][2] + v[j][3] * v[j][3]); }
        const float rstd = 1.f / sqrtf(wave_sum(q) * (1.f / DM) + LN_EPS);
#pragma unroll
        for (int j = 0; j < 4; ++j) { const int c = 4 * lane + 256 * j; const f32x4 gn = *(const f32x4*)(lng + c); f32x4 x2 = v[j] * rstd * gn;
            *(f32x4*)(xr + c) = x2;
            if (LAYER == 0) { const float* mn = modn + b * 6144; const f32x4 sh = *(const f32x4*)(mn + c), sc = *(const f32x4*)(mn + 1024 + c); const f32x4 h = x2 * (sc + 1.f) + sh;
                if (PF_IN1) *(unsigned*)((unsigned char*)H0N + (size_t)r * DM + c) = pg8::pack4_fp8(h[0], h[1], h[2], h[3]);
                else { u32x2 w; w.x = cvt_pk_bf16(h[0], h[1]); w.y = cvt_pk_bf16(h[2], h[3]); *(u32x2*)(H0N + (size_t)r * DM + c) = w; } } }
    }
#undef LN2_LOAD
}
namespace att {
using pg8::i32x8; using pg8::i32x4;
constexpr int NW = 8, QBLK = 32, KVBLK = 64, LDQ = 1024, LDK = 1024, NKEY = SEQ + CTXL, NT = NKEY / KVBLK;
constexpr size_t SHM_V = KVBLK * 128 * 2, SHM_K = KVBLK * 64 * 2;
constexpr float THR = 8.f;
#define KSWZ64(row, colB) ((row) * 128 + ((colB) ^ ((((row) >> 1) & 7) << 4)))
#define SBAR() __builtin_amdgcn_sched_barrier(0)
__device__ __forceinline__ int crow(int r, int hi) { return (r & 3) + 8 * (r >> 2) + 4 * hi; }
__device__ __forceinline__ unsigned cvtpk(float lo, float hi) { unsigned r; asm volatile("v_cvt_pk_bf16_f32 %0, %1, %2" : "=v"(r) : "v"(lo), "v"(hi)); return r; }
__device__ __forceinline__ void partialSM(f32x16& p0, f32x16& p1, float& m_reg, float& mn, float& alpha) {
    constexpr float C = 1.4426950408889634f;
    float pmax = p0[0];
#pragma unroll
    for (int r = 1; r < 16; ++r) pmax = fmaxf(pmax, p0[r]);
#pragma unroll
    for (int r = 0; r < 16; ++r) pmax = fmaxf(pmax, p1[r]);
    { auto rr = __builtin_amdgcn_permlane32_swap(__float_as_uint(pmax), __float_as_uint(pmax), false, false); pmax = fmaxf(__uint_as_float(rr[0]), __uint_as_float(rr[1])); }
    if (__builtin_expect(__all(pmax - m_reg <= THR), 1)) { mn = m_reg; alpha = 1.f; }
    else { mn = fmaxf(m_reg, pmax); alpha = __builtin_amdgcn_exp2f((m_reg - mn) * C); m_reg = mn; }
    const float mnC = -mn * C;
#pragma unroll
    for (int r = 0; r < 16; ++r) p0[r] = fmaf(p0[r], C, mnC);
#pragma unroll
    for (int r = 0; r < 16; ++r) p1[r] = fmaf(p1[r], C, mnC);
#pragma unroll
    for (int r = 0; r < 16; ++r) p0[r] = __builtin_amdgcn_exp2f(p0[r]);
}
__device__ __forceinline__ void finishSM(f32x16& p0, f32x16& p1, float alpha, float& l_reg, bf16x8& pa0, bf16x8& pa1, bf16x8& pa2, bf16x8& pa3) {
#pragma unroll
    for (int r = 0; r < 16; ++r) p1[r] = __builtin_amdgcn_exp2f(p1[r]);
    float ps = 0;
#pragma unroll
    for (int r = 0; r < 16; ++r) ps += p0[r];
#pragma unroll
    for (int r = 0; r < 16; ++r) ps += p1[r];
    { auto rr = __builtin_amdgcn_permlane32_swap(__float_as_uint(ps), __float_as_uint(ps), false, false); ps = __uint_as_float(rr[0]) + __uint_as_float(rr[1]); }
    l_reg = l_reg * alpha + ps;
#define PK4(P, BASE, OUT) do { unsigned a0 = cvtpk(P[BASE + 0], P[BASE + 1]), a1 = cvtpk(P[BASE + 2], P[BASE + 3]);   \
    unsigned b0 = cvtpk(P[BASE + 4], P[BASE + 5]), b1 = cvtpk(P[BASE + 6], P[BASE + 7]);                              \
    auto r0 = __builtin_amdgcn_permlane32_swap(a0, b0, false, false); auto r1 = __builtin_amdgcn_permlane32_swap(a1, b1, false, false); \
    u32x4 w = {r0[0], r1[0], r0[1], r1[1]}; OUT = __builtin_bit_cast(bf16x8, w); } while (0)
    PK4(p0, 0, pa0); PK4(p0, 8, pa1); PK4(p1, 0, pa2); PK4(p1, 8, pa3);
#undef PK4
}
__device__ __forceinline__ void qkt(f32x16& p0, f32x16& p1, const LAS char* Ks, const bf16x8* qr, int r32, int hi) {
    p0 = f32x16{}; p1 = f32x16{};
#pragma unroll
    for (int d0 = 0; d0 < 4; ++d0) { const int cb = (d0 * 16 + hi * 8) * 2;
        const bf16x8 b0 = *(const LAS bf16x8*)(Ks + KSWZ64(r32, cb));
        const bf16x8 b1 = *(const LAS bf16x8*)(Ks + KSWZ64(32 + r32, cb));
        p0 = __builtin_amdgcn_mfma_f32_32x32x16_bf16(b0, qr[d0], p0, 0, 0, 0);
        p1 = __builtin_amdgcn_mfma_f32_32x32x16_bf16(b1, qr[d0], p1, 0, 0, 0); }
}
__device__ __forceinline__ int v_st(int k, int c) { const int kk = (k & ~0xC) | ((k & 4) << 1) | ((k & 8) >> 1); return ((kk >> 3) * 4 + (c >> 5)) * 512 + ((kk & 7) * 32 + (c & 31)) * 2; }
__device__ __forceinline__ int v_rd_base(int lane) { return ((lane & 3) << 3) | (((lane >> 2) & 3) << 6) | (((lane >> 4) & 1) << 5) | (((lane >> 5) & 1) << 8); }
constexpr int v_rd_off(int d0, int ks, int half) { return d0 * 512 + ks * 4096 + half * 2048; }
template <int OFF> __device__ __forceinline__ s16x4 tr_read(int vb) { s16x4 r; asm volatile("ds_read_b64_tr_b16 %0, %1 offset:%2" : "=&v"(r) : "v"(vb), "i"(OFF) : "memory"); return r; }
template <int D0> __device__ __forceinline__ void pv_one(f32x16& od, int vb, bf16x8 pa0, bf16x8 pa1, bf16x8 pa2, bf16x8 pa3) {
    const s16x4 l0 = tr_read<v_rd_off(D0, 0, 0)>(vb), h0 = tr_read<v_rd_off(D0, 0, 1)>(vb), l1 = tr_read<v_rd_off(D0, 1, 0)>(vb), h1 = tr_read<v_rd_off(D0, 1, 1)>(vb);
    const s16x4 l2 = tr_read<v_rd_off(D0, 2, 0)>(vb), h2 = tr_read<v_rd_off(D0, 2, 1)>(vb), l3 = tr_read<v_rd_off(D0, 3, 0)>(vb), h3 = tr_read<v_rd_off(D0, 3, 1)>(vb);
    asm volatile("s_waitcnt lgkmcnt(0)" ::: "memory"); SBAR();
#define PKV(L, H) (bf16x8){L[0], L[1], L[2], L[3], H[0], H[1], H[2], H[3]}
    od = __builtin_amdgcn_mfma_f32_32x32x16_bf16(pa0, PKV(l0, h0), od, 0, 0, 0);
    od = __builtin_amdgcn_mfma_f32_32x32x16_bf16(pa1, PKV(l1, h1), od, 0, 0, 0);
    od = __builtin_amdgcn_mfma_f32_32x32x16_bf16(pa2, PKV(l2, h2), od, 0, 0, 0);
    od = __builtin_amdgcn_mfma_f32_32x32x16_bf16(pa3, PKV(l3, h3), od, 0, 0, 0);
#undef PKV
}
__device__ __forceinline__ void pv_d0(f32x16* o, int vb, bf16x8 pa0, bf16x8 pa1, bf16x8 pa2, bf16x8 pa3) {
    pv_one<0>(o[0], vb, pa0, pa1, pa2, pa3); pv_one<1>(o[1], vb, pa0, pa1, pa2, pa3); pv_one<2>(o[2], vb, pa0, pa1, pa2, pa3); pv_one<3>(o[3], vb, pa0, pa1, pa2, pa3);
}
template <bool TIE = true> __device__ __forceinline__ void qkt_neg(f32x16& p0, f32x16& p1, int ka0, int ka1, const i32x8& qf, f32x16& negm) {
    const i32x4 a0 = *(const LAS i32x4*)(uintptr_t)(unsigned)ka0, a1 = *(const LAS i32x4*)(uintptr_t)(unsigned)ka1;
    const i32x4 b0 = *(const LAS i32x4*)(uintptr_t)(unsigned)(ka0 + 2048), b1 = *(const LAS i32x4*)(uintptr_t)(unsigned)(ka1 + 2048);
    const i32x8 k0 = (i32x8){a0[0], a0[1], a0[2], a0[3], a1[0], a1[1], a1[2], a1[3]}, k1 = (i32x8){b0[0], b0[1], b0[2], b0[3], b1[0], b1[1], b1[2], b1[3]};
    asm volatile("v_mfma_f32_32x32x64_f8f6f4 %0, %2, %3, %1" : "=&v"(p0), "+v"(negm) : "v"(k0), "v"(qf));
    asm volatile("v_mfma_f32_32x32x64_f8f6f4 %0, %2, %3, %1" : "=&v"(p1), "+v"(negm) : "v"(k1), "v"(qf));
    if (TIE) asm volatile("s_nop 15\n\ts_nop 7" : "+v"(p0), "+v"(p1));
}
constexpr float THR2 = 8.f;
template <bool FIRST> __device__ __forceinline__ void partialSM2(f32x16& p0, f32x16& p1, float& m_reg, f32x16& negm, float& alpha) {
    float pmax = p0[0];
#pragma unroll
    for (int r = 1; r < 16; ++r) pmax = fmaxf(pmax, p0[r]);
#pragma unroll
    for (int r = 0; r < 16; ++r) pmax = fmaxf(pmax, p1[r]);
    { auto rr = __builtin_amdgcn_permlane32_swap(__float_as_uint(pmax), __float_as_uint(pmax), false, false); pmax = fmaxf(__uint_as_float(rr[0]), __uint_as_float(rr[1])); }
    if (!FIRST && __builtin_expect(__all(pmax <= THR2), 1)) { alpha = 1.f; }
    else { const float d = FIRST ? pmax : fmaxf(pmax, 0.f);
        alpha = FIRST ? 1.f : __builtin_amdgcn_exp2f(-d); m_reg += d;
#pragma unroll
        for (int r = 0; r < 16; ++r) { p0[r] -= d; p1[r] -= d; negm[r] = -m_reg; } }
#pragma unroll
    for (int r = 0; r < 16; ++r) p0[r] = __builtin_amdgcn_exp2f(p0[r]);
}
__device__ __forceinline__ void finishSM2(f32x16& p0, f32x16& p1, bf16x8& pa0, bf16x8& pa1, bf16x8& pa2, bf16x8& pa3) {
#pragma unroll
    for (int r = 0; r < 16; ++r) p1[r] = __builtin_amdgcn_exp2f(p1[r]);
#define PK4(P, BASE, OUT) do { unsigned a0 = cvtpk(P[BASE + 0], P[BASE + 1]), a1 = cvtpk(P[BASE + 2], P[BASE + 3]);   \
    unsigned b0 = cvtpk(P[BASE + 4], P[BASE + 5]), b1 = cvtpk(P[BASE + 6], P[BASE + 7]);                              \
    auto r0 = __builtin_amdgcn_permlane32_swap(a0, b0, false, false); auto r1 = __builtin_amdgcn_permlane32_swap(a1, b1, false, false); \
    u32x4 w = {r0[0], r1[0], r0[1], r1[1]}; OUT = __builtin_bit_cast(bf16x8, w); } while (0)
    PK4(p0, 0, pa0); PK4(p0, 8, pa1); PK4(p1, 0, pa2); PK4(p1, 8, pa3);
#undef PK4
}
__device__ __forceinline__ int vimg_off(int d, int key, int perm) {
    const int kk = key & 31, top = key >> 5, hi = (kk >> 2) & 1, r = (kk & 3) + 4 * (kk >> 3), byte = 32 * hi + ((r + 16 * top) ^ perm);
    return d * 64 + ((((byte >> 4) ^ ((d >> 2) & 3))) << 4) + (byte & 15);
}
__device__ __forceinline__ void finishSM8(f32x16& p0, f32x16& p1, i32x8& pP) {
#pragma unroll
    for (int r = 0; r < 16; ++r) p1[r] = __builtin_amdgcn_exp2f(p1[r]);
#pragma unroll
    for (int v = 0; v < 4; ++v) { int w = __builtin_amdgcn_cvt_pk_fp8_f32(p0[4 * v], p0[4 * v + 1], 0, false); pP[v] = __builtin_amdgcn_cvt_pk_fp8_f32(p0[4 * v + 2], p0[4 * v + 3], w, true); }
#pragma unroll
    for (int v = 0; v < 4; ++v) { int w = __builtin_amdgcn_cvt_pk_fp8_f32(p1[4 * v], p1[4 * v + 1], 0, false); pP[4 + v] = __builtin_amdgcn_cvt_pk_fp8_f32(p1[4 * v + 2], p1[4 * v + 3], w, true); }
}
__device__ __forceinline__ void pv8(f32x16 (&o)[4], f32x16& ls, int va0, int va1, const i32x8& pP, const i32x8& ones8) {
    i32x8 vf[4];
#pragma unroll
    for (int d0 = 0; d0 < 4; ++d0) { const i32x4 a = *(const LAS i32x4*)(uintptr_t)(unsigned)(va0 + d0 * 2048), b = *(const LAS i32x4*)(uintptr_t)(unsigned)(va1 + d0 * 2048);
        vf[d0] = (i32x8){a[0], a[1], a[2], a[3], b[0], b[1], b[2], b[3]}; }
    i32x8 pq = pP; asm volatile("s_nop 1" : "+v"(pq));
#pragma unroll
    for (int d0 = 0; d0 < 4; ++d0) asm volatile("v_mfma_f32_32x32x64_f8f6f4 %0, %1, %2, %0" : "+v"(o[d0]) : "v"(pq), "v"(vf[d0]));
    asm volatile("v_mfma_f32_32x32x64_f8f6f4 %0, %1, %2, %0" : "+v"(ls) : "v"(pq), "v"(ones8));
}
__device__ __forceinline__ void mseg7(f32x16& p0, f32x16& p1, f32x16 (&o)[4], f32x16& ls, int ka0, int ka1, int va0, int va1, const i32x8& qf, const f32x16& negm, const i32x8& pP, const i32x8& ones8) {
    const i32x4 a0 = *(const LAS i32x4*)(uintptr_t)(unsigned)ka0, a1 = *(const LAS i32x4*)(uintptr_t)(unsigned)ka1;
    const i32x4 b0 = *(const LAS i32x4*)(uintptr_t)(unsigned)(ka0 + 2048), b1 = *(const LAS i32x4*)(uintptr_t)(unsigned)(ka1 + 2048);
    const i32x8 k0 = (i32x8){a0[0], a0[1], a0[2], a0[3], a1[0], a1[1], a1[2], a1[3]}, k1 = (i32x8){b0[0], b0[1], b0[2], b0[3], b1[0], b1[1], b1[2], b1[3]};
    i32x8 vf[4];
#pragma unroll
    for (int d0 = 0; d0 < 4; ++d0) { const i32x4 a = *(const LAS i32x4*)(uintptr_t)(unsigned)(va0 + d0 * 2048), b = *(const LAS i32x4*)(uintptr_t)(unsigned)(va1 + d0 * 2048);
        vf[d0] = (i32x8){a[0], a[1], a[2], a[3], b[0], b[1], b[2], b[3]}; }
    asm volatile("s_nop 1\n\t"
                 "v_mfma_f32_32x32x64_f8f6f4 %0, %7, %9, %10\n\t"
                 "v_mfma_f32_32x32x64_f8f6f4 %1, %8, %9, %10\n\t"
                 "v_mfma_f32_32x32x64_f8f6f4 %2, %11, %12, %2\n\t"
                 "v_mfma_f32_32x32x64_f8f6f4 %3, %11, %13, %3\n\t"
                 "v_mfma_f32_32x32x64_f8f6f4 %4, %11, %14, %4\n\t"
                 "v_mfma_f32_32x32x64_f8f6f4 %5, %11, %15, %5\n\t"
                 "v_mfma_f32_32x32x64_f8f6f4 %6, %11, %16, %6"
                 : "=&v"(p0), "=&v"(p1), "+v"(o[0]), "+v"(o[1]), "+v"(o[2]), "+v"(o[3]), "+v"(ls)
                 : "v"(k0), "v"(k1), "v"(qf), "v"(negm), "v"(pP), "v"(vf[0]), "v"(vf[1]), "v"(vf[2]), "v"(vf[3]), "v"(ones8));
}
__device__ __forceinline__ void mseg2(f32x16& p0, f32x16& p1, int ka0, int ka1, const i32x8& qf, const f32x16& negm) {
    const i32x4 a0 = *(const LAS i32x4*)(uintptr_t)(unsigned)ka0, a1 = *(const LAS i32x4*)(uintptr_t)(unsigned)ka1;
    const i32x4 b0 = *(const LAS i32x4*)(uintptr_t)(unsigned)(ka0 + 2048), b1 = *(const LAS i32x4*)(uintptr_t)(unsigned)(ka1 + 2048);
    const i32x8 k0 = (i32x8){a0[0], a0[1], a0[2], a0[3], a1[0], a1[1], a1[2], a1[3]}, k1 = (i32x8){b0[0], b0[1], b0[2], b0[3], b1[0], b1[1], b1[2], b1[3]};
    asm volatile("v_mfma_f32_32x32x64_f8f6f4 %0, %2, %4, %5\n\t"
                 "v_mfma_f32_32x32x64_f8f6f4 %1, %3, %4, %5\n\t"
                 "s_nop 15\n\ts_nop 7"
                 : "=&v"(p0), "=&v"(p1) : "v"(k0), "v"(k1), "v"(qf), "v"(negm));
}
template <int LO, int HI> __device__ __forceinline__ void exps(f32x16& a, f32x16& b) {
#pragma unroll
    for (int i = LO; i < HI; ++i) { if (i < 16) a[i & 15] = __builtin_amdgcn_exp2f(a[i & 15]); else b[i & 15] = __builtin_amdgcn_exp2f(b[i & 15]); }
}
template <int LO, int HI> __device__ __forceinline__ void cvts(const f32x16& a, const f32x16& b, i32x8& pP) {
#pragma unroll
    for (int c = LO; c < HI; ++c) { const int e = 2 * c; const float x0 = (e < 16) ? a[e & 15] : b[e & 15], x1 = (e < 16) ? a[(e + 1) & 15] : b[(e + 1) & 15];
        if (c & 1) pP[c >> 1] = __builtin_amdgcn_cvt_pk_fp8_f32(x0, x1, pP[c >> 1], true); else pP[c >> 1] = __builtin_amdgcn_cvt_pk_fp8_f32(x0, x1, 0, false); }
}
__device__ __forceinline__ float rowmax32(const f32x16& a, const f32x16& b) {
    float m0 = fmaxf(fmaxf(a[0], a[1]), a[2]), m1 = fmaxf(fmaxf(b[0], b[1]), b[2]);
#pragma unroll
    for (int r = 3; r < 15; r += 2) { m0 = fmaxf(fmaxf(m0, a[r]), a[r + 1]); m1 = fmaxf(fmaxf(m1, b[r]), b[r + 1]); }
    float pmax = fmaxf(fmaxf(m0, m1), fmaxf(a[15], b[15]));
    { auto rr = __builtin_amdgcn_permlane32_swap(__float_as_uint(pmax), __float_as_uint(pmax), false, false); pmax = fmaxf(__uint_as_float(rr[0]), __uint_as_float(rr[1])); }
    return pmax;
}
__device__ __forceinline__ i32x8 ldfrag(int a0, int a1) { const i32x4 a = *(const LAS i32x4*)(uintptr_t)(unsigned)a0, b = *(const LAS i32x4*)(uintptr_t)(unsigned)a1; return (i32x8){a[0], a[1], a[2], a[3], b[0], b[1], b[2], b[3]}; }
constexpr int SLOT = 12288, NSLOT = 8, WS_OFF = NSLOT * SLOT, QL_OFF = WS_OFF + 2048;
__device__ __forceinline__ void attn_pass(const unsigned char* __restrict__ Qb, const unsigned char* __restrict__ Kh, const unsigned char* __restrict__ VIh, LAS char* lds, f32x16 (&o)[4], f32x16& ls, int tid) {
    const int wid = tid >> 6, lane = tid & 63, r32 = lane & 31, hi = lane >> 5;
    LAS float* ws = (LAS float*)(lds + WS_OFF) + wid * 64; LAS float* al_l = ws + 32;
    float m_reg = 0.f; f32x16 negm = f32x16{}; ls = f32x16{};
    asm volatile("" : "+v"(negm));
    const i32x8 ones8 = (i32x8){0x38383838, 0x38383838, 0x38383838, 0x38383838, 0x38383838, 0x38383838, 0x38383838, 0x38383838};
#pragma unroll
    for (int d = 0; d < 4; ++d) o[d] = f32x16{};
    i32x8 qf; { const unsigned char* Qw = Qb + (long)(wid * QBLK + r32) * 1024 + hi * 32; const i32x4 a = *(const i32x4*)Qw, b = *(const i32x4*)(Qw + 16); qf = (i32x8){a[0], a[1], a[2], a[3], b[0], b[1], b[2], b[3]}; }
    const int wu = __builtin_amdgcn_readfirstlane(wid);
    unsigned goffk;
    { const int q0 = (wu & 3) * 64 + lane, krow = q0 >> 2, g = (q0 & 3) ^ ((krow >> 2) & 3); goffk = (unsigned)(krow * 1024 + g * 16); }
    const int ka0 = (int)(uintptr_t)lds + 8192 + r32 * 64 + (((2 * hi) ^ ((r32 >> 2) & 3)) << 4), ka1 = (int)(uintptr_t)lds + 8192 + r32 * 64 + (((2 * hi + 1) ^ ((r32 >> 2) & 3)) << 4);
    const unsigned goffv = (unsigned)(wu * 1024 + lane * 16);
    const int va0 = (int)(uintptr_t)lds + r32 * 64 + (((2 * hi) ^ ((r32 >> 2) & 3)) << 4), va1 = (int)(uintptr_t)lds + r32 * 64 + (((2 * hi + 1) ^ ((r32 >> 2) & 3)) << 4);
#define SDMA(t_, s_) do { LAS char* sb_ = lds + (s_) * SLOT + wu * 1024; \
        __builtin_amdgcn_global_load_lds((const unsigned*)(VIh + (size_t)(t_) * 8192 + goffv), (LAS unsigned*)(sb_), 16, 0, 0); \
        if (wu < 4) __builtin_amdgcn_global_load_lds((const unsigned*)(Kh + (size_t)(t_) * (KVBLK * 1024) + goffk), (LAS unsigned*)(sb_ + 8192), 16, 0, 0); } while (0)
#define ABAR() do { asm volatile("s_waitcnt lgkmcnt(0)" ::: "memory"); __builtin_amdgcn_s_barrier(); asm volatile("" ::: "memory"); } while (0)
#define DWAIT() do { if (wu < 4) asm volatile("s_waitcnt vmcnt(2)" ::: "memory"); else asm volatile("s_waitcnt vmcnt(1)" ::: "memory"); } while (0)
#define MF_S(dst_, kf_) asm volatile("v_mfma_f32_32x32x64_f8f6f4 %0, %1, %2, %3" : "=&v"(dst_) : "v"(kf_), "v"(qf), "v"(negm))
#define MF_PV(acc_, pin_, vf_) asm volatile("v_mfma_f32_32x32x64_f8f6f4 %0, %1, %2, %0" : "+v"(acc_) : "v"(pin_), "v"(vf_))
#define SLOWPATH(C0, C1, FIRST_) do { const float d_ = (FIRST_) ? pmax : fmaxf(pmax, 0.f); const float a_ = (FIRST_) ? 1.f : __builtin_amdgcn_exp2f(-d_); m_reg += d_; \
        _Pragma("unroll") for (int r = 0; r < 16; ++r) { C0[r] -= d_; C1[r] -= d_; negm[r] = -m_reg; } \
        asm volatile("" : "+v"(negm)); \
        if (__any(a_ < 1.f)) { if (hi == 0) al_l[r32] = a_; \
            asm volatile("s_nop 15\n\ts_nop 15\n\ts_waitcnt lgkmcnt(0)" : "+v"(o[0]), "+v"(o[1]), "+v"(o[2]), "+v"(o[3]), "+v"(ls) :: "memory"); \
            _Pragma("unroll") for (int r = 0; r < 16; ++r) { const float s_ = al_l[crow(r, hi)]; ls[r] *= s_; _Pragma("unroll") for (int d = 0; d < 4; ++d) o[d][r] *= s_; } } } while (0)
#define BODY(C0, C1, PIN, POUT, j_, FIRSTCHK_) do { \
        { const int tn_ = ((j_) + 3 < NT) ? ((j_) + 3) : (NT - 1); SDMA(tn_, ((j_) + 3) & 7); } \
        const int ks_ = ((((j_) + 1 < NT) ? ((j_) + 1) : (NT - 1)) & 7) * SLOT, vs_ = ((((j_) > 0) ? ((j_) - 1) : 0) & 7) * SLOT; \
        const i32x8 v0_ = ldfrag(va0 + vs_, va1 + vs_), v1_ = ldfrag(va0 + vs_ + 2048, va1 + vs_ + 2048); \
        SBAR(); asm volatile("s_nop 11" : "+v"(C0), "+v"(C1));     \
        const float pmax = rowmax32(C0, C1); \
        { const bool first_ = (FIRSTCHK_) && (j_) == 0; if (__builtin_expect(first_ || !__all(pmax <= THR2), 0)) SLOWPATH(C0, C1, first_); } \
        SBAR(); MF_PV(o[0], PIN, v0_); const i32x8 v2_ = ldfrag(va0 + vs_ + 4096, va1 + vs_ + 4096), v3_ = ldfrag(va0 + vs_ + 6144, va1 + vs_ + 6144); exps<0, 5>(C0, C1); \
        SBAR(); MF_PV(o[1], PIN, v1_); exps<5, 10>(C0, C1); cvts<0, 2>(C0, C1, POUT); \
        SBAR(); MF_PV(o[2], PIN, v2_); const i32x8 k0_ = ldfrag(ka0 + ks_, ka1 + ks_), k1_ = ldfrag(ka0 + ks_ + 2048, ka1 + ks_ + 2048); exps<10, 15>(C0, C1); cvts<2, 5>(C0, C1, POUT); \
        SBAR(); MF_PV(o[3], PIN, v3_); exps<15, 20>(C0, C1); cvts<5, 8>(C0, C1, POUT); \
        SBAR(); MF_S(C0, k0_); exps<20, 25>(C0, C1); cvts<8, 10>(C0, C1, POUT); \
        SBAR(); MF_PV(ls, PIN, ones8); exps<25, 30>(C0, C1); cvts<10, 13>(C0, C1, POUT); \
        SBAR(); exps<30, 32>(C0, C1); cvts<13, 16>(C0, C1, POUT); asm volatile("" :: "v"(POUT));     \
        SBAR(); MF_S(C1, k1_); \
        SBAR(); DWAIT(); ABAR(); } while (0)
    f32x16 pX0, pX1; i32x8 pPa = i32x8{}, pPb = i32x8{};
    SDMA(0, 0); SDMA(1, 1); SDMA(2, 2); asm volatile("s_waitcnt vmcnt(0)" ::: "memory"); ABAR();
    { const i32x8 k0_ = ldfrag(ka0, ka1), k1_ = ldfrag(ka0 + 2048, ka1 + 2048); MF_S(pX0, k0_); MF_S(pX1, k1_); asm volatile("s_nop 15\n\ts_nop 7" : "+v"(pX0), "+v"(pX1)); }
    static_assert(NT % 2 == 0, "the loop is unrolled by two");
#pragma nounroll
    for (int j = 0; j < NT; j += 2) {
        BODY(pX0, pX1, pPa, pPb, j, true);
        BODY(pX0, pX1, pPb, pPa, j + 1, false);
    }
    { const int vs_ = ((NT - 1) & 7) * SLOT;
      const i32x8 v0_ = ldfrag(va0 + vs_, va1 + vs_), v1_ = ldfrag(va0 + vs_ + 2048, va1 + vs_ + 2048), v2_ = ldfrag(va0 + vs_ + 4096, va1 + vs_ + 4096), v3_ = ldfrag(va0 + vs_ + 6144, va1 + vs_ + 6144);
      MF_PV(o[0], pPa, v0_); MF_PV(o[1], pPa, v1_); MF_PV(o[2], pPa, v2_); MF_PV(o[3], pPa, v3_); MF_PV(ls, pPa, ones8); }
    asm volatile("s_waitcnt vmcnt(0)" ::: "memory");
    asm volatile("s_nop 15\n\ts_nop 15\n\ts_nop 15\n\ts_nop 15" : "+v"(o[0]), "+v"(o[1]), "+v"(o[2]), "+v"(o[3]), "+v"(ls));
    ABAR();
#undef BODY
#undef SLOWPATH
#undef MF_S
#undef MF_PV
#undef DWAIT
#undef SDMA
#undef ABAR
}
}

__device__ __forceinline__ void vt_image_phase(PR p, Frame& F) {
    const bf16* V = WSP(bf16, B_V); unsigned char* VI = p.ws + B_VI;
    LAS unsigned char* img = (LAS unsigned char*)(F.lds + F.wave * 16384);
    const int gw = F.vcu * NWAVES + F.wave, NGW = F.G * NWAVES, lane = F.lane;
    const unsigned probe = (unsigned)__builtin_amdgcn_cvt_pk_fp8_f32(1.f, 2.f, 0, false);
    const int pshift = (probe & 0xffffu) ? 0 : 16, perm = ((((probe >> pshift) & 0xffu) == 0x38u) ? 0 : 1) | (pshift ? 2 : 0);
    for (int it = gw; it < NBATCH * 8 * att::NT; it += NGW) {
        const int t = it % att::NT, bh = it / att::NT, b = bh >> 3, h = bh & 7;
        const bf16* src = V + ((size_t)b * att::NKEY + t * 64) * 1024 + h * 128;
#pragma unroll 1
        for (int i0 = 0; i0 < 16; i0 += 4) {
            u32x4 x[4];
#pragma unroll
            for (int i = 0; i < 4; ++i) { const int id = lane + 64 * (i0 + i), key = id >> 4, dc = (id & 15) * 8; x[i] = *(const u32x4*)(src + (size_t)key * 1024 + dc); }
#pragma unroll
            for (int i = 0; i < 4; ++i) { const int id = lane + 64 * (i0 + i), key = id >> 4, dc = (id & 15) * 8; const unsigned w[4] = {x[i].x, x[i].y, x[i].z, x[i].w};
#pragma unroll
                for (int e = 0; e < 4; ++e) { const float lo = bflo(w[e]), hi_ = bfhi(w[e]);
                    img[att::vimg_off(dc + 2 * e, key, perm)] = (unsigned char)((__builtin_amdgcn_cvt_pk_fp8_f32(lo, lo, 0, false) >> pshift) & 0xff); img[att::vimg_off(dc + 2 * e + 1, key, perm)] = (unsigned char)((__builtin_amdgcn_cvt_pk_fp8_f32(hi_, hi_, 0, false) >> pshift) & 0xff); } }
        }
        asm volatile("s_waitcnt lgkmcnt(0)" ::: "memory");
        unsigned char* dst = VI + (size_t)it * 8192;
#pragma unroll
        for (int i = 0; i < 8; ++i) *(u32x4*)(dst + (lane + 64 * i) * 16) = *(const LAS u32x4*)(img + (lane + 64 * i) * 16);
        asm volatile("s_waitcnt lgkmcnt(0)" ::: "memory");
    }
}
__device__ __forceinline__ void attn_phase(PR p, Frame& F) {
    using namespace att;
    const unsigned char* Q = p.ws + B_Q; const unsigned char* K = p.ws + B_K; bf16* AO = WSP(bf16, B_AO);
    for (int unit = F.vcu; unit < NBATCH * 8 * 32; unit += F.G) {
        const int bh = unit >> 5, qb = unit & 31, b = bh >> 3, h = bh & 7;
        const unsigned char* Qb = Q + ((size_t)b * SEQ + qb * 256) * 1024 + h * 128;
        const unsigned char* Kh = K + (size_t)b * NKEY * 1024 + h * 128;
        const unsigned char* VIh = p.ws + B_VI + (size_t)(b * 8 + h) * NT * 8192;
        f32x16 o[4]; f32x16 ls;
        int tl = F.tid; asm volatile("" : "+v"(tl));
        attn_pass(Qb, Kh, VIh, (LAS char*)F.lds, o, ls, tl);
        asm volatile("" : "+v"(tl));
        { float* st = WSP(float, B_STASH) + (size_t)F.bid * 64 * NTHREADS + tl;
#pragma unroll
          for (int r = 0; r < 16; ++r) { const float rl = __builtin_amdgcn_rcpf(ls[r]);
#pragma unroll
              for (int d0 = 0; d0 < 4; ++d0) st[(size_t)(d0 * 16 + r) * NTHREADS] = o[d0][r] * rl; } }
        __syncthreads();
        asm volatile("" : "+v"(tl));
        attn_pass(Qb + 64, Kh + 64, VIh, (LAS char*)F.lds, o, ls, tl);
        asm volatile("" : "+v"(tl));
        { const int lane = tl & 63, r32 = lane & 31, hi = lane >> 5, wid = tl >> 6;
          const float* st = WSP(float, B_STASH) + (size_t)F.bid * 64 * NTHREADS + tl;
          const float lam = WSP(float, WS_SCAL)[0];
          float ss[16];
#pragma unroll
          for (int r = 0; r < 16; ++r) { const float rl = __builtin_amdgcn_rcpf(ls[r]); float q = 0.f;
#pragma unroll
              for (int d0 = 0; d0 < 4; ++d0) { const float v = st[(size_t)(d0 * 16 + r) * NTHREADS] - lam * (o[d0][r] * rl); o[d0][r] = v; q += v * v; }
              ss[r] = q; }
#pragma unroll
          for (int r = 0; r < 16; ++r) { float q = ss[r]; q += __shfl_xor(q, 1); q += __shfl_xor(q, 2); q += __shfl_xor(q, 4); q += __shfl_xor(q, 8); q += __shfl_xor(q, 16);
              ss[r] = (1.f / sqrtf(q * (1.f / 128.f) + GN_EPS)) * (1.f - LAMBDA_INIT); }
          bf16* Ow = PF_OUT1 ? (bf16*)((unsigned char*)AO + ((size_t)b * SEQ + qb * 256 + wid * QBLK) * DM + h * 128 + r32) : AO + ((size_t)b * SEQ + qb * 256 + wid * QBLK) * DM + h * 128 + r32;
#pragma unroll
          for (int d0 = 0; d0 < 4; ++d0) { const float gsub = p.in[I_SUBLN][d0 * 32 + r32];
#pragma unroll
              for (int r = 0; r < 16; ++r) { if (PF_OUT1) ((unsigned char*)Ow)[(size_t)crow(r, hi) * DM + d0 * 32] = pg8::to_fp8(o[d0][r] * ss[r] * gsub); else Ow[(size_t)crow(r, hi) * DM + d0 * 32] = (bf16)f2bf(o[d0][r] * ss[r] * gsub); } } }
        __syncthreads();
    }
}
#ifndef MK_MULTI
#define MK_MULTI 0
#endif
constexpr int NPHASE = 22;

template <int LAYER>
__device__ __forceinline__ void moe_gemm1_phase(PR p, Frame& F, const bf16* BUF, bf16* HID) {
    const MoeTabs T = moe_tabs(F); moe_build_tabs(p, F, T);
    const int LD = MOE_FP8 ? 512 : 1024;
    pg8::ExpertOrder S; S.g.init((int)T.pendb[15], 8, F.G, F.bid, LD, LD); S.pend = T.pendb; S.eB = (long)EXP_STRIDE;
    pg8::Gemm g{BUF, (const bf16*)(p.ws + WS_EXP + (size_t)LAYER * 16 * EXP_STRIDE), LD, LD, LD};
    if (MOE_FP8) { pg8::EpiSwiGlu8 E{(unsigned char*)HID}; pg8::gemm_phase<true>(F.lds, g, S, E); }
    else { pg8::EpiSwiGlu E{HID}; pg8::gemm_phase(F.lds, g, S, E); }
}
template <int LAYER>
__device__ __forceinline__ void moe_gemm2_phase(PR p, Frame& F, const bf16* HID, bf16* Y) {
    const MoeTabs T = moe_tabs(F); moe_build_tabs(p, F, T);
    const int LD = MOE_FP8 ? 512 : 1024;
    pg8::ExpertOrder S; S.g.init((int)T.pendb[15], 4, F.G, F.bid, LD, LD); S.pend = T.pendb; S.eB = (long)EXP_STRIDE;
    pg8::Gemm g{HID, (const bf16*)(p.ws + WS_EXP + (size_t)LAYER * 16 * EXP_STRIDE + EXP_DN), LD, LD, LD};
    if (MOE_FP8) { pg8::EpiPlainS E{Y, 1024, 0.03125f}; pg8::gemm_phase<true>(F.lds, g, S, E); }
    else { pg8::EpiPlain E{Y, 1024}; pg8::gemm_phase(F.lds, g, S, E); }
}

#define PHP() const CAS Params* kp_ = (const CAS Params*)__builtin_amdgcn_kernarg_segment_ptr(); asm volatile("" : "+s"(kp_)); PR p = *kp_; Frame F; { int t_ = threadIdx.x; asm volatile("" : "+v"(t_)); int g_ = gridDim.x, b_ = blockIdx.x; asm volatile("" : "+s"(g_), "+s"(b_)); \
    F.lds = lds_base; F.tid = t_; F.lane = t_ & 63; F.wave = __builtin_amdgcn_readfirstlane(t_ >> 6); F.G = g_; F.bid = b_; F.vcu = (g_ % 8 == 0) ? (b_ % 8) * (g_ / 8) + b_ / 8 : b_; }
__global__ void __launch_bounds__(NTHREADS, 2) fwd(Params p_) {
    extern __shared__ __attribute__((aligned(16))) unsigned char lds_raw[];
    LAS unsigned char* const lds_base = (LAS unsigned char*)lds_raw;
    volatile LAS unsigned* misc = (volatile LAS unsigned*)(lds_base + MISC_OFF);
    for (int u = threadIdx.x; u < 64; u += NTHREADS) misc[u] = 0u;
    __syncthreads();
    const int lo = p_.ph_lo, hi = p_.ph_hi;
    XcdBarrier bar; bar.bar = (unsigned*)(p_.ws + WS_CTL) + 4096; bar.x = 0; bar.st = misc;
    if (!MK_MULTI) bar = xcd_barrier_post((unsigned*)(p_.ws + WS_CTL) + 4096, misc);
#ifndef ONLY_PHASE
#define ONLY_PHASE -1
#endif
#ifndef REP_MASK
#define REP_MASK 0
#endif
#define REP(k) for (int rep_ = 0; rep_ < (((REP_MASK) >> (k)) & 1) + 1; ++rep_, __syncthreads())
#define IN(k) ((ONLY_PHASE < 0 || ONLY_PHASE == (k)) && lo <= (k) && (k) < hi)
#define SEAM(k) do { if (IN(k) && IN((k) + 1)) xcd_barrier(bar); } while (0)
#ifdef DIAG_A
#define STAMP(k) do { if ((k) == DIAG_A || (k) == DIAG_B) { if (blockIdx.x == 0 && threadIdx.x == 0) { unsigned long long* st_ = (unsigned long long*)(p_.ws + WS_SCAL + 64) + ((k) == DIAG_B ? 2 : 0); st_[0] = __builtin_amdgcn_s_memtime(); st_[1] = __builtin_amdgcn_s_memrealtime(); } } } while (0)
#define STAMPE(k) do { } while (0)
#else
#define STAMP(k) do { } while (0)
#define STAMPE(k) do { } while (0)
#endif

    STAMP(0); if (IN(0)) REP(0) { PHP(); p0a_prologue(p, F); } STAMPE(0); SEAM(0);
    STAMP(1); if (IN(1)) REP(1) { PHP(); p0b_phase(p, F); } STAMPE(1); SEAM(1);
    STAMP(2); if (IN(2)) REP(2) { PHP();
        constexpr int LD = PF_IN0 ? 512 : 1024; pg8::Gemm g{WSP(bf16, A_H0), WSP(bf16, WS_WIN0), LD, LD, LD}; pg8::GridOrder S; S.init(NTOK / 256, 10, F.G, F.bid, LD, LD);
        pg8::EpiInProj0 E{WSP(bf16, A_QK), WSP(bf16, A_V), WSP(bf16, A_G), WSP(bf16, A_UA), WSP(float, WS_ROPE0C), WSP(float, WS_ROPE0S)};
        pg8::gemm_phase<PF_IN0 != 0>(F.lds, g, S, E);
    } STAMPE(2); SEAM(2);
    STAMP(3); if (IN(3)) REP(3) { PHP();
        pg8::Gemm g{WSP(bf16, A_UA), WSP(bf16, WS_BT1), 512, 768, 512};
        pg8::BatchOrder S; S.nZ = 16; S.nM = 5; S.nN = 1; S.G = F.G; S.c = F.bid; S.tA = 256L * 768 * 2; S.tB = 256L * 512 * 2; S.zA = (long)S5ROWS * 768 * 2; S.zB = 256L * 512 * 2;
        pg8::EpiS5E E{WSP(float, A_EO)};
        pg8::gemm_phase(F.lds, g, S, E);
        ret_states_phase(p, F, 80, 3);
    } STAMPE(3); SEAM(3);
    STAMP(4); if (IN(4)) REP(4) { PHP(); s5_scan_phase(p, F); ret_scan_phase(p, F); } STAMPE(4); SEAM(4);
    STAMP(5); if (IN(5)) REP(5) { PHP();
        pg8::Gemm g{WSP(bf16, A_UA), WSP(bf16, WS_BT2), 768, 768, 768};
        pg8::BatchOrder S; S.nZ = 16; S.nM = 5; S.nN = 2; S.G = F.G; S.c = F.bid; S.tA = 256L * 768 * 2; S.tB = 256L * 768 * 2; S.zA = (long)S5ROWS * 768 * 2; S.zB = 512L * 768 * 2;
        pg8::EpiS5Y E{WSP(bf16, A_SG)};
        pg8::gemm_phase(F.lds, g, S, E);
#ifdef RET_REP
        for (int rr_ = 0; rr_ < RET_REP; ++rr_) { ret_out_phase(p, F, 160, 6); __syncthreads(); }
#endif
        ret_out_phase(p, F, 160, 6);
    } STAMPE(5); SEAM(5);
    STAMP(6); if (IN(6)) REP(6) { PHP();
        pg8::Gemm g{WSP(bf16, A_SG), WSP(bf16, WS_WGLU), 256, 256, 256}; pg8::GridOrder S; S.init(NTOK / 256, 2, F.G, F.bid, 256, 256);
        pg8::EpiGlu E{WSP(bf16, A_MRG)};
        pg8::gemm_phase(F.lds, g, S, E);
    } STAMPE(6); SEAM(6);
    STAMP(7); if (IN(7)) REP(7) { PHP();
        constexpr int LD = PF_OUT0 ? 512 : 1024; pg8::Gemm g{WSP(bf16, A_MRG), WSP(bf16, WS_WOUT0), LD, LD, LD}; pg8::GridOrder S; S.init(NTOK / 256, 4, F.G, F.bid, LD, LD);
        pg8::EpiPlainS E{WSP(bf16, A_O), 1024, pg8::PSC_OUT0};
        pg8::gemm_phase<PF_OUT0 != 0>(F.lds, g, S, E);
    } STAMPE(7); SEAM(7);
    STAMP(8); if (IN(8)) REP(8) { PHP(); ln1_router_phase<0>(p, F, WSP(bf16, A_O), WSP(bf16, A_H2), NTOK); } STAMPE(8); SEAM(8);
    STAMP(9); if (IN(9)) REP(9) { PHP(); moe_scatter_phase(p, F, WSP(bf16, A_H2), WSP(bf16, A_BUF), NTOK); } STAMPE(9); SEAM(9);
    STAMP(10); if (IN(10)) REP(10) { PHP(); moe_gemm1_phase<0>(p, F, WSP(bf16, A_BUF), WSP(bf16, A_HID)); } STAMPE(10); SEAM(10);
    STAMP(11); if (IN(11)) REP(11) { PHP(); moe_gemm2_phase<0>(p, F, WSP(bf16, A_HID), WSP(bf16, A_Y)); } STAMPE(11); SEAM(11);
    STAMP(12); if (IN(12)) REP(12) { PHP(); ln2_phase<0>(p, F, WSP(bf16, A_Y), WSP(bf16, A_H0P), NTOK); } STAMPE(12); SEAM(12);
    STAMP(13); if (IN(13)) REP(13) { PHP();
        constexpr int LD = PF_IN1 ? 512 : 1024; pg8::Gemm g{WSP(bf16, A_H0P), WSP(bf16, WS_WIN1), LD, LD, LD}; pg8::InProj1Order S; S.g.init(NLAT / 256, 12, F.G, F.bid, LD, LD);
        pg8::EpiInProj1 E{WSP(bf16, B_Q), WSP(bf16, B_K), WSP(bf16, B_V), WSP(float, WS_ROPE1)};
        pg8::gemm_phase<PF_IN1 != 0>(F.lds, g, S, E);
    } STAMPE(13); SEAM(13);
    STAMP(14); if (IN(14)) REP(14) { PHP(); vt_image_phase(p, F); } STAMPE(14); SEAM(14);
    STAMP(15); if (IN(15)) REP(15) { PHP(); attn_phase(p, F); } STAMPE(15); SEAM(15);
    STAMP(16); if (IN(16)) REP(16) { PHP();
        constexpr int LD = PF_OUT1 ? 512 : 1024; pg8::Gemm g{WSP(bf16, B_AO), WSP(bf16, WS_WOUT1), LD, LD, LD}; pg8::GridOrder S; S.init(NLAT / 256, 4, F.G, F.bid, LD, LD);
        pg8::EpiPlainS E{WSP(bf16, B_O), 1024, pg8::PSC_OUT1};
        pg8::gemm_phase<PF_OUT1 != 0>(F.lds, g, S, E);
    } STAMPE(16); SEAM(16);
    STAMP(17); if (IN(17)) REP(17) { PHP(); ln1_router_phase<1>(p, F, WSP(bf16, B_O), WSP(bf16, B_H2), NLAT); } STAMPE(17); SEAM(17);
    STAMP(18); if (IN(18)) REP(18) { PHP(); moe_scatter_phase(p, F, WSP(bf16, B_H2), WSP(bf16, B_BUF), NLAT); } STAMPE(18); SEAM(18);
    STAMP(19); if (IN(19)) REP(19) { PHP(); moe_gemm1_phase<1>(p, F, WSP(bf16, B_BUF), WSP(bf16, B_HID)); } STAMPE(19); SEAM(19);
    STAMP(20); if (IN(20)) REP(20) { PHP(); moe_gemm2_phase<1>(p, F, WSP(bf16, B_HID), WSP(bf16, B_Y)); } STAMPE(20); SEAM(20);
    STAMP(21); if (IN(21)) REP(21) { PHP(); ln2_phase<1>(p, F, WSP(bf16, B_Y), nullptr, NLAT); }
#ifdef DIAG_SEG
    if (blockIdx.x == 0 && threadIdx.x == 0) {
        const unsigned long long ticks = *(volatile unsigned long long*)(p_.ws + 65536) / 16ull;
        const unsigned long long t0 = __builtin_amdgcn_s_memrealtime();
        while (__builtin_amdgcn_s_memrealtime() - t0 < ticks) __builtin_amdgcn_s_sleep(8);
    }
#endif
#ifdef DIAG_A
    if (blockIdx.x == 0 && threadIdx.x == 0) {
        unsigned long long* st_ = (unsigned long long*)(p_.ws + WS_SCAL + 64);
        if (DIAG_B == NPHASE) { st_[2] = __builtin_amdgcn_s_memtime(); st_[3] = __builtin_amdgcn_s_memrealtime(); }
        const unsigned long long ticks = 4ull * (st_[3] - st_[1]);
        const unsigned long long t0 = __builtin_amdgcn_s_memrealtime();
        while (__builtin_amdgcn_s_memrealtime() - t0 < ticks) __builtin_amdgcn_s_sleep(8);
    }
#endif
#undef IN
#undef SEAM
}

extern "C" void kernel_launch(void* const* d_in, const int* in_sizes, int n_in, void* d_out, int out_size, void* d_ws, size_t ws_size, hipStream_t stream) {
    static int grid = 0;
    if (grid == 0) {
        if (n_in != N_IN || out_size != NLAT * DM || ws_size < WS_END) { fprintf(stderr, "kernel_launch: unexpected shapes: n_in %d out %d ws %zu (need %zu)\n", n_in, out_size, ws_size, (size_t)WS_END); grid = -1; return; }
        int dev = 0, cus = 0, per_cu = 0;
        if (hipGetDevice(&dev) != hipSuccess || hipDeviceGetAttribute(&cus, hipDeviceAttributeMultiprocessorCount, dev) != hipSuccess) { grid = -1; return; }
        if (hipFuncSetAttribute((const void*)fwd, hipFuncAttributeMaxDynamicSharedMemorySize, LDS_BYTES) != hipSuccess) { fprintf(stderr, "kernel_launch: hipFuncSetAttribute failed\n"); grid = -1; return; }
        if (hipOccupancyMaxActiveBlocksPerMultiprocessor(&per_cu, (const void*)fwd, NTHREADS, LDS_BYTES) != hipSuccess || per_cu < 1) fprintf(stderr, "kernel_launch: occupancy query reports %d\n", per_cu);
        (void)hipGetLastError();
        grid = cus > 256 ? 256 : cus;
    }
    if (grid < 0) return;
    if (hipMemsetAsync((char*)d_ws + WS_CTL, 0, CTL_BYTES, stream) != hipSuccess) return;
    Params prm{};
    for (int i = 0; i < N_IN; ++i) prm.in[i] = (const float*)d_in[i];
    prm.out = (float*)d_out; prm.ws = (unsigned char*)d_ws;
#if MK_MULTI
    for (int ph = 0; ph < NPHASE; ++ph) { prm.ph_lo = ph; prm.ph_hi = ph + 1; hipLaunchKernelGGL(fwd, dim3(grid), dim3(NTHREADS), LDS_BYTES, stream, prm); }
#else
    prm.ph_lo = 0; prm.ph_hi = NPHASE;
    hipLaunchKernelGGL(fwd, dim3(grid), dim3(NTHREADS), LDS_BYTES, stream, prm);
#endif
}
```

```cpp
#include <hip/hip_runtime.h>
#include <cstdio>
#include <cstdint>

#define LAS __attribute__((address_space(3)))
#define GAS __attribute__((address_space(1)))
typedef unsigned short bf16;
typedef short bf16x8 __attribute__((ext_vector_type(8)));
typedef short s16x4 __attribute__((ext_vector_type(4)));
typedef float f32x4 __attribute__((ext_vector_type(4)));
typedef float f32x2 __attribute__((ext_vector_type(2)));
typedef float f32x16 __attribute__((ext_vector_type(16)));
typedef unsigned u32x4 __attribute__((ext_vector_type(4)));
typedef unsigned u32x2 __attribute__((ext_vector_type(2)));

constexpr int DM = 1024, NBATCH = 4, SEQ = 8192, CTXL = 256;
constexpr int NLAT = NBATCH * SEQ, NCTX = NBATCH * CTXL, NTOK = NLAT + NCTX;
constexpr int RH = 6, RDK = 64, RDV = 128, RC = 128, RNCH = 66;
constexpr int S5G = 16, S5P = 16, S5N = 64, S5T = 32, S5ROWS = 1280;
constexpr int NEXP = 16, NB0 = 280, NB1 = 272;
constexpr float ALPHA = 1.4142135623730951f;
constexpr float LN_EPS = 1e-5f, GN_EPS = 1e-6f;
constexpr float LAMBDA_INIT = 0.35550906759096926f;
constexpr int NWAVES = 8, NTHREADS = 512;
#ifndef PROJ_FP8
#define PROJ_FP8 0
#endif
#ifndef PF_IN0
#define PF_IN0 PROJ_FP8
#endif
#ifndef PF_OUT0
#define PF_OUT0 1
#endif
#ifndef PF_IN1
#define PF_IN1 1
#endif
#ifndef PF_OUT1
#define PF_OUT1 1
#endif
#ifndef FP8_WIDE
#define FP8_WIDE 1
#endif
#ifndef MOE_FP8
#define MOE_FP8 1
#endif

constexpr size_t MiB = 1u << 20, KiB = 1024;
constexpr size_t WS_CTL = 0, CTL_BYTES = 1 * MiB;
constexpr size_t WS_MOD = 1 * MiB;
constexpr size_t WS_SCAL = 1 * MiB + 256 * KiB;
constexpr size_t WS_LAMP = 1 * MiB + 320 * KiB;
constexpr size_t WS_COEF = 1 * MiB + 896 * KiB;
constexpr size_t WS_ROPE0C = 2 * MiB, WS_ROPE0S = 3 * MiB;
constexpr size_t WS_ROPE1 = 4 * MiB;
constexpr size_t WS_S5K = 4 * MiB + 64 * KiB;
constexpr size_t WS_XC = 6 * MiB;
constexpr size_t WS_CNT = 10 * MiB;
constexpr size_t WS_ROUTE = 10 * MiB + 64 * KiB;
constexpr size_t WS_BT1 = 12 * MiB;
constexpr size_t WS_BT2 = 16 * MiB;
constexpr size_t WS_WIN0 = 28 * MiB;
constexpr size_t WS_WGLU = 33 * MiB;
constexpr size_t WS_WOUT0 = 34 * MiB;
constexpr size_t WS_WIN1 = 36 * MiB;
constexpr size_t WS_WOUT1 = 42 * MiB;
constexpr size_t WS_EXP = 44 * MiB;
constexpr size_t EXP_STRIDE = 6 * MiB, EXP_DN = 4 * MiB;
constexpr size_t WS_ARENA = 236 * MiB;
constexpr size_t AR(double mib) { return WS_ARENA + (size_t)(mib * 1048576.0); }
constexpr size_t A_QK = AR(0), A_V = AR(49.5), A_G = AR(99), A_UA = AR(148.5), A_TT = AR(178.5), A_EO = AR(228), A_H0 = AR(248), A_MRG = AR(248), A_SG = AR(314);
constexpr size_t A_O = AR(140), A_H2 = AR(206), A_BUF = AR(0), A_HID = AR(140), A_Y = AR(0), A_H0P = AR(140);
constexpr size_t B_Q = AR(0), B_K = AR(64), B_V = AR(206), B_STASH = AR(272), B_AO = AR(140), B_O = AR(0), B_H2 = AR(64), B_BUF = AR(140), B_HID = AR(0), B_Y = AR(140);
constexpr size_t WS_END = AR(331);
constexpr size_t B_VI = WS_EXP;

constexpr int STAGE_BYTES_LDS = 131072;
constexpr int MISC_OFF = 131072;
constexpr int LDS_BYTES = 147456;

__device__ __forceinline__ unsigned f2bf(float f) { unsigned u = __float_as_uint(f); return (u + 0x7fffu + ((u >> 16) & 1u)) >> 16; }
__device__ __forceinline__ float bf2f(unsigned b) { return __uint_as_float(b << 16); }
__device__ __forceinline__ float bflo(unsigned w) { return __uint_as_float(w << 16); }
__device__ __forceinline__ float bfhi(unsigned w) { return __uint_as_float(w & 0xffff0000u); }
__device__ __forceinline__ unsigned cvt_pk_bf16(float lo, float hi) { unsigned r; asm volatile("v_cvt_pk_bf16_f32 %0, %1, %2" : "=v"(r) : "v"(lo), "v"(hi)); return r; }
template <int CTRL> __device__ __forceinline__ float dpp_f(float v) { return __int_as_float(__builtin_amdgcn_update_dpp(0, __float_as_int(v), CTRL, 0xF, 0xF, true)); }
__device__ __forceinline__ float wave_sum(float v) {
    v += dpp_f<0xB1>(v); v += dpp_f<0x4E>(v); v += dpp_f<0x141>(v); v += dpp_f<0x140>(v);
    { auto r = __builtin_amdgcn_permlane16_swap(__float_as_uint(v), __float_as_uint(v), false, false); v = __uint_as_float(r[0]) + __uint_as_float(r[1]); }
    { auto r = __builtin_amdgcn_permlane32_swap(__float_as_uint(v), __float_as_uint(v), false, false); v = __uint_as_float(r[0]) + __uint_as_float(r[1]); }
    return v;
}
__device__ __forceinline__ float fast_sigmoid(float x) { return __builtin_amdgcn_rcpf(1.f + __expf(-x)); }
__device__ __forceinline__ float fast_silu(float x) { return x * fast_sigmoid(x); }
__device__ __forceinline__ float gelu_tanh(float x) { const float z = 0.7978845608028654f * (x + 0.044715f * x * x * x); const float t = 1.f - 2.f * __builtin_amdgcn_rcpf(__expf(2.f * z) + 1.f); return 0.5f * x * (1.f + t); }
__device__ __forceinline__ void sincos_rev(double rev, float& s, float& c) { const double fr = rev - rint(rev); const float y = (float)(fr * 6.283185307179586); s = sinf(y); c = cosf(y); }
__device__ __forceinline__ f32x2 cmul(f32x2 a, f32x2 b) { return (f32x2){a.x * b.x - a.y * b.y, a.x * b.y + a.y * b.x}; }

#define XB_TMO      128
#define XB_XCNT(j)  (256  + 64 * (j))
#define XB_XSUB(j)  (1280 + 64 * (j))
#define XB_XGEN(j)  (2304 + 64 * (j))
#define XB_TOP      3328
#define XB_TOPGEN   3392
#define XCD_BAR_WORDS 3456
#define XB_SPIN_CAP (1u << 22)
__device__ __forceinline__ unsigned xb_ld(unsigned* p)              { return __hip_atomic_load(p, __ATOMIC_RELAXED, __HIP_MEMORY_SCOPE_AGENT); }
__device__ __forceinline__ unsigned xb_add(unsigned* p, unsigned v) { return __hip_atomic_fetch_add(p, v, __ATOMIC_RELAXED, __HIP_MEMORY_SCOPE_AGENT); }
__device__ __forceinline__ unsigned xb_xcc_id() { return (unsigned)__builtin_amdgcn_s_getreg((3 << 11) | 20) & 0xFu; }
#define XB_SPIN(cond, bar) do { unsigned _sp = 0; while (cond) { __builtin_amdgcn_s_sleep(1); \
    if ((++_sp & 255u) == 0u) { if (xb_ld(&(bar)[XB_TMO])) break; if (_sp > XB_SPIN_CAP) { atomicAdd(&(bar)[XB_TMO], 1u); break; } } } } while (0)
struct XcdBarrier { unsigned* bar; unsigned x; volatile LAS unsigned* st; };
__device__ __forceinline__ XcdBarrier xcd_barrier_post(unsigned* bar, volatile LAS unsigned* st) {
    XcdBarrier b; b.bar = bar; b.x = xb_xcc_id(); b.st = st;
    if (threadIdx.x == 0) (void)xb_add(&bar[XB_XCNT(b.x)], 1u);
    return b;
}
__device__ __forceinline__ void xcd_barrier_complete(unsigned* bar, unsigned x, unsigned& nloc, unsigned& nx) {
    const unsigned G = gridDim.x * gridDim.y * gridDim.z;
    unsigned sum, cnt, mine, sp = 0u;
    for (;;) {
        sum = 0u; cnt = 0u; mine = 0u;
#pragma unroll
        for (unsigned j = 0; j < 16; ++j) { const unsigned c = xb_ld(&bar[XB_XCNT(j)]); sum += c; cnt += (c > 0u) ? 1u : 0u; mine = (j == x) ? c : mine; }
        if (sum == G) break;
        __builtin_amdgcn_s_sleep(1);
        if ((++sp & 255u) == 0u) { if (xb_ld(&bar[XB_TMO])) break; if (sp > XB_SPIN_CAP) { atomicAdd(&bar[XB_TMO], 1u); break; } }
    }
    nloc = mine > 0u ? mine : 1u; nx = cnt > 0u ? cnt : 1u;
}
__device__ __forceinline__ void xcd_barrier(const XcdBarrier& b) {
    asm volatile("s_waitcnt vmcnt(0)" ::: "memory");
    __syncthreads();
    if (threadIdx.x == 0) {
        unsigned* bar = b.bar;
        __builtin_amdgcn_s_waitcnt(0);
        unsigned nloc = b.st[0], nx = b.st[1];
        if (nloc == 0u) { xcd_barrier_complete(bar, b.x, nloc, nx); b.st[0] = nloc; b.st[1] = nx; }
        const unsigned old = xb_add(&bar[XB_XSUB(b.x)], 1u);
        const unsigned gen = old / nloc;
        if (old + 1u == (gen + 1u) * nloc) {
            __builtin_amdgcn_fence(__ATOMIC_RELEASE, "agent");
            asm volatile("s_waitcnt vmcnt(0)" ::: "memory");
            const unsigned og = xb_add(&bar[XB_TOP], 1u);
            const unsigned tg = og / nx;
            if (og + 1u == (tg + 1u) * nx) xb_add(&bar[XB_TOPGEN], 1u);
            else XB_SPIN(xb_ld(&bar[XB_TOPGEN]) == tg, bar);
            __builtin_amdgcn_fence(__ATOMIC_ACQUIRE, "agent");
            xb_add(&bar[XB_XGEN(b.x)], 1u);
            asm volatile("s_waitcnt vmcnt(0)" ::: "memory");
        } else {
            XB_SPIN(xb_ld(&bar[XB_XGEN(b.x)]) == gen, bar);
            __builtin_amdgcn_fence(__ATOMIC_ACQUIRE, "agent");
            asm volatile("s_waitcnt vmcnt(0)" ::: "memory");
        }
    }
    __syncthreads();
}

namespace pg8 {
constexpr int BM = 256, BK = 64, HALF = 128, HTB = HALF * BK * 2, NXCD = 8, WGM = 8;
__host__ __device__ __forceinline__ int lds_byte(int r, int c) { const int st = (r >> 4) * 2 + (c >> 5), rr = r & 15, cc = c & 31, ob = rr * 64 + cc * 2; return st * 1024 + (ob ^ (((ob >> 9) & 1) << 5)); }
__host__ __device__ __forceinline__ void stage_rc(int b, int& R, int& C) { const int st = b / 1024, sb = b % 1024, swz = sb ^ (((sb >> 9) & 1) << 5); R = (st >> 1) * 16 + swz / 64; C = (st & 1) * 32 + (swz % 64) / 2; }
__host__ __device__ __forceinline__ int perm32(int rho) { const int n = rho >> 4, i = rho & 15; return 8 * (i >> 2) + 4 * n + (i & 3); }

struct Unit { int pm, pn, z; long aoff, boff; };
struct Gemm { const bf16* A; const bf16* Bt; int K, lda, ldb; };

struct GridOrder {
    int nM, nN, nwg, G, c; long tA, tB;
    __device__ void init(int nM_, int nN_, int G_, int c_, int lda, int ldb) { nM = nM_; nN = nN_; nwg = nM * nN; G = G_; c = c_; tA = (long)BM * lda * 2; tB = (long)BM * ldb * 2; }
    __device__ __forceinline__ bool tile(long L, int& pm, int& pn) const {
        if (L >= nwg) return false;
        int wgid = (int)L; { const int q = nwg / NXCD, r = nwg % NXCD, xcd = wgid % NXCD, off = wgid / NXCD; wgid = (xcd < r ? xcd * (q + 1) : r * (q + 1) + (xcd - r) * q) + off; }
        const int nig = WGM * nN, gid = wgid / nig, fm = gid * WGM, gsz = (nM - fm) < WGM ? (nM - fm) : WGM;
        pm = fm + ((wgid % nig) % gsz); pn = (wgid % nig) / gsz; return true;
    }
    __device__ __forceinline__ bool next(int i, Unit& u) const {
        if (!tile((long)i * G + c, u.pm, u.pn)) return false;
        u.z = 0; u.aoff = u.pm * tA; u.boff = u.pn * tB; return true;
    }
};
struct BatchOrder {
    int nZ, nM, nN, G, c; long tA, tB, zA, zB;
    __device__ __forceinline__ bool next(int i, Unit& u) const {
        const long L = (long)i * G + c; if (L >= (long)nZ * nM * nN) return false;
        const int per = nM * nN; u.z = (int)(L / per); const int r = (int)(L % per); u.pm = r / nN; u.pn = r % nN;
        u.aoff = u.z * zA + u.pm * tA; u.boff = u.z * zB + u.pn * tB; return true;
    }
};
struct ExpertOrder {
    GridOrder g; const LAS unsigned* pend; long eB;
    __device__ __forceinline__ bool next(int i, Unit& u) const {
        if (!g.tile((long)i * g.G + g.c, u.pm, u.pn)) return false;
        int e = 0;
#pragma unroll
        for (int k = 0; k < 15; ++k) e += ((unsigned)u.pm >= pend[k]) ? 1 : 0;
        u.z = e; u.aoff = u.pm * g.tA; u.boff = e * eB + u.pn * g.tB; return true;
    }
};
struct InProj1Order {
    GridOrder g;
    __device__ __forceinline__ bool next(int i, Unit& u) const {
        const long L = (long)i * g.G + g.c;
        if (L < g.nwg) { g.tile(L, u.pm, u.pn); }
        else { const long Lc = L - g.nwg; if (Lc >= 32) return false; u.pm = 128 + (int)(Lc >> 3); u.pn = 4 + (int)(Lc & 7); }
        u.z = 0; u.aoff = u.pm * g.tA; u.boff = u.pn * g.tB; return true;
    }
};

typedef int i32x8 __attribute__((ext_vector_type(8)));
typedef int i32x4 __attribute__((ext_vector_type(4)));
__device__ __forceinline__ i32x8 cat8(bf16x8 a, bf16x8 b) { const i32x4 x = __builtin_bit_cast(i32x4, a), y = __builtin_bit_cast(i32x4, b); return (i32x8){x[0], x[1], x[2], x[3], y[0], y[1], y[2], y[3]}; }
template <bool FP8 = false, class Epi, class Sched>
__device__ __forceinline__ void gemm_phase(LAS unsigned char* lds, const Gemm g, const Sched& S, const Epi& E) {
    const int tid = threadIdx.x, wid = __builtin_amdgcn_readfirstlane(tid >> 6), lane = tid & 63, wr = wid >> 2, wc = wid & 3, fr = lane & 15, fq = lane >> 4;
    const int K = g.K, nt = K / BK;
    unsigned voffA[2], voffB[2];
#pragma unroll
    for (int i = 0; i < 2; ++i) { int R, C; stage_rc(tid * 16 + i * 8192, R, C); const int Rb = Epi::PERM ? ((R & ~31) + perm32(R & 31)) : R;
        voffA[i] = (unsigned)(R * g.lda + C) * 2u; voffB[i] = (unsigned)(Rb * g.ldb + C) * 2u; }
    const size_t kstep = (size_t)(BK * 2);
    const size_t hstepA = (size_t)HALF * g.lda * 2, hstepB = (size_t)HALF * g.ldb * 2;
    const unsigned ldsw = (unsigned)wid * 1024u;
    const int aoff = lds_byte(wr * 64 + fr, fq * 8), boff = lds_byte(wc * 32 + fr, fq * 8);
#define PG8_SA(b, h) (((b) * 2 + (h)) * HTB)
#define PG8_SB(b, h) ((4 + (b) * 2 + (h)) * HTB)
#define PG8_STAGE(bufoff, gbase, voff) do { _Pragma("unroll") for (int _i = 0; _i < 2; ++_i) \
        __builtin_amdgcn_global_load_lds((const unsigned*)((const char*)(gbase) + (voff)[_i]), (LAS unsigned*)(lds + (bufoff) + ldsw + _i * 8192), 16, 0, 0); } while (0)
#define PG8_LDA(dst, b, h) do { _Pragma("unroll") for (int m = 0; m < 4; ++m) dst[m] = cat8(*(const LAS bf16x8*)(lds + PG8_SA(b, h) + aoff + m * 2048), *(const LAS bf16x8*)(lds + PG8_SA(b, h) + aoff + m * 2048 + 1024)); } while (0)
#define PG8_LDB(dst, b, h) do { _Pragma("unroll") for (int n = 0; n < 2; ++n) dst[n] = cat8(*(const LAS bf16x8*)(lds + PG8_SB(b, h) + boff + n * 2048), *(const LAS bf16x8*)(lds + PG8_SB(b, h) + boff + n * 2048 + 1024)); } while (0)
#define PG8_Q(v, q) __builtin_bit_cast(long, __builtin_shufflevector(v, v, 2 * (q), 2 * (q) + 1))
#define PG8_HALF(v, k) __builtin_bit_cast(bf16x8, __builtin_shufflevector(v, v, 4 * (k), 4 * (k) + 1, 4 * (k) + 2, 4 * (k) + 3))
#define PG8_MMA(ai, bj, At, Bt) do { __builtin_amdgcn_s_setprio(1); _Pragma("unroll") for (int m = 0; m < 4; ++m) _Pragma("unroll") for (int n = 0; n < 2; ++n) { \
        if constexpr (FP8 && FP8_WIDE) asm volatile("v_mfma_f32_16x16x128_f8f6f4 %0, %1, %2, %0" : "+v"(acc[ai][bj][m][n]) : "v"(Bt[n]), "v"(At[m])); \
        else if constexpr (FP8) { acc[ai][bj][m][n] = __builtin_amdgcn_mfma_f32_16x16x32_fp8_fp8(PG8_Q(Bt[n], 0), PG8_Q(At[m], 0), acc[ai][bj][m][n], 0, 0, 0); acc[ai][bj][m][n] = __builtin_amdgcn_mfma_f32_16x16x32_fp8_fp8(PG8_Q(Bt[n], 1), PG8_Q(At[m], 1), acc[ai][bj][m][n], 0, 0, 0); \
            acc[ai][bj][m][n] = __builtin_amdgcn_mfma_f32_16x16x32_fp8_fp8(PG8_Q(Bt[n], 2), PG8_Q(At[m], 2), acc[ai][bj][m][n], 0, 0, 0); acc[ai][bj][m][n] = __builtin_amdgcn_mfma_f32_16x16x32_fp8_fp8(PG8_Q(Bt[n], 3), PG8_Q(At[m], 3), acc[ai][bj][m][n], 0, 0, 0); } \
        else { acc[ai][bj][m][n] = __builtin_amdgcn_mfma_f32_16x16x32_bf16(PG8_HALF(Bt[n], 0), PG8_HALF(At[m], 0), acc[ai][bj][m][n], 0, 0, 0); \
               acc[ai][bj][m][n] = __builtin_amdgcn_mfma_f32_16x16x32_bf16(PG8_HALF(Bt[n], 1), PG8_HALF(At[m], 1), acc[ai][bj][m][n], 0, 0, 0); } } __builtin_amdgcn_s_setprio(0); } while (0)
#define PG8_WAIT_V(n) asm volatile("s_waitcnt vmcnt(" #n ")" ::: "memory")
#define PG8_WAIT_L(n) asm volatile("s_waitcnt lgkmcnt(" #n ")" ::: "memory")
#define PG8_BAR __builtin_amdgcn_s_barrier()
#define PG8_SCHED __builtin_amdgcn_sched_barrier(0)
    Unit cur, nxt; int ui = 0;
    if (!S.next(0, cur)) return;
    f32x4 acc[2][2][4][2];
#pragma unroll
    for (int a = 0; a < 2; ++a)
#pragma unroll
        for (int b = 0; b < 2; ++b)
#pragma unroll
            for (int m = 0; m < 4; ++m)
#pragma unroll
                for (int n = 0; n < 2; ++n) acc[a][b][m][n] = (f32x4){0.f, 0.f, 0.f, 0.f};
    i32x8 At[4], B0[2], B1[2];
    const char* cA = (const char*)g.A + cur.aoff; const char* cB = (const char*)g.Bt + cur.boff;
    PG8_STAGE(PG8_SB(0, 0), cB, voffB); PG8_STAGE(PG8_SB(0, 1), cB + hstepB, voffB); PG8_STAGE(PG8_SA(0, 0), cA, voffA); PG8_STAGE(PG8_SA(0, 1), cA + hstepA, voffA);
    if (wr == 1) PG8_BAR;
    PG8_WAIT_V(2); PG8_BAR;
    PG8_STAGE(PG8_SB(1, 0), cB + kstep, voffB); PG8_STAGE(PG8_SA(1, 0), cA + kstep, voffA); PG8_STAGE(PG8_SB(1, 1), cB + hstepB + kstep, voffB);
    PG8_WAIT_V(6); PG8_BAR;
    for (;;) {
        const bool has_next = S.next(ui + 1, nxt);
        const char* nA = has_next ? (const char*)g.A + nxt.aoff : cA; const char* nB = has_next ? (const char*)g.Bt + nxt.boff : cB;
#pragma nounroll
        for (int t = 0; t < nt; t += 2) {
            const bool last = (t == nt - 2);
            const char* a1 = cA + (size_t)(t + 1) * kstep;
            const char* a2 = last ? nA : cA + (size_t)(t + 2) * kstep; const char* b2 = last ? nB : cB + (size_t)(t + 2) * kstep;
            const char* a3 = a2 + kstep; const char* b3 = b2 + kstep;
            PG8_LDB(B0, 0, 0); PG8_LDB(B1, 0, 1); PG8_SCHED; PG8_LDA(At, 0, 0); PG8_STAGE(PG8_SA(1, 1), a1 + hstepA, voffA);
            PG8_WAIT_V(8); PG8_WAIT_L(0); PG8_BAR; PG8_MMA(0, 0, At, B0); PG8_MMA(0, 1, At, B1); PG8_BAR; PG8_SCHED;
            PG8_LDA(At, 0, 1); PG8_STAGE(PG8_SB(0, 0), b2, voffB); PG8_STAGE(PG8_SB(0, 1), b2 + hstepB, voffB); PG8_STAGE(PG8_SA(0, 0), a2, voffA);
            PG8_WAIT_V(8); PG8_WAIT_L(0); PG8_BAR; PG8_MMA(1, 0, At, B0); PG8_MMA(1, 1, At, B1); PG8_BAR; PG8_SCHED;
            PG8_LDB(B0, 1, 0); PG8_LDB(B1, 1, 1); PG8_SCHED; PG8_LDA(At, 1, 0); PG8_STAGE(PG8_SA(0, 1), a2 + hstepA, voffA);
            PG8_WAIT_V(8); PG8_WAIT_L(0); PG8_BAR; PG8_MMA(0, 0, At, B0); PG8_MMA(0, 1, At, B1); PG8_BAR; PG8_SCHED;
            PG8_LDA(At, 1, 1); PG8_STAGE(PG8_SB(1, 0), b3, voffB); PG8_STAGE(PG8_SB(1, 1), b3 + hstepB, voffB); PG8_STAGE(PG8_SA(1, 0), a3, voffA);
            PG8_WAIT_V(8); PG8_WAIT_L(0); PG8_BAR; PG8_MMA(1, 0, At, B0); PG8_MMA(1, 1, At, B1); PG8_BAR; PG8_SCHED;
        }
        if (wr == 0) PG8_BAR;
        if constexpr (FP8 && FP8_WIDE) {
#pragma unroll
            for (int a = 0; a < 2; ++a)
#pragma unroll
                for (int b = 0; b < 2; ++b) asm volatile("s_nop 15" : "+v"(acc[a][b][0][0]), "+v"(acc[a][b][0][1]), "+v"(acc[a][b][1][0]), "+v"(acc[a][b][1][1]), "+v"(acc[a][b][2][0]), "+v"(acc[a][b][2][1]), "+v"(acc[a][b][3][0]), "+v"(acc[a][b][3][1])); }
        E(acc, cur, wr, wc, fr, fq);
        if (!has_next) break;
#pragma unroll
        for (int a = 0; a < 2; ++a)
#pragma unroll
            for (int b = 0; b < 2; ++b)
#pragma unroll
                for (int m = 0; m < 4; ++m)
#pragma unroll
                    for (int n = 0; n < 2; ++n) acc[a][b][m][n] = (f32x4){0.f, 0.f, 0.f, 0.f};
        cur = nxt; cA = nA; cB = nB; ++ui;
        if (wr == 1) PG8_BAR;
    }
    PG8_WAIT_V(0);
    PG8_BAR;
#undef PG8_SA
#undef PG8_SB
#undef PG8_STAGE
#undef PG8_LDA
#undef PG8_LDB
#undef PG8_MMA
#undef PG8_HALF
#undef PG8_Q
#undef PG8_WAIT_V
#undef PG8_WAIT_L
#undef PG8_BAR
#undef PG8_SCHED
}
}
namespace pg8 {
__device__ __forceinline__ u32x4 pack8(const f32x4 a, const f32x4 b) { u32x4 w; w.x = cvt_pk_bf16(a[0], a[1]); w.y = cvt_pk_bf16(a[2], a[3]); w.z = cvt_pk_bf16(b[0], b[1]); w.w = cvt_pk_bf16(b[2], b[3]); return w; }
typedef const f32x4 (&AccRef)[2][2][4][2];
__device__ __forceinline__ float clamp448(float x) { return __builtin_fminf(__builtin_fmaxf(x, -448.f), 448.f); }
__device__ __forceinline__ unsigned pack4_fp8(float a, float b, float c, float d) { int w = __builtin_amdgcn_cvt_pk_fp8_f32(clamp448(a), clamp448(b), 0, false); w = __builtin_amdgcn_cvt_pk_fp8_f32(clamp448(c), clamp448(d), w, true); return (unsigned)w; }
__device__ __forceinline__ unsigned char to_fp8(float x) { return (unsigned char)(__builtin_amdgcn_cvt_pk_fp8_f32(clamp448(x), 0.f, 0, false) & 0xff); }
constexpr float PSC_IN0 = PF_IN0 ? 0.03125f : 1.f, PSC_IN1 = PF_IN1 ? 0.03125f : 1.f, PSC_OUT0 = PF_OUT0 ? 0.03125f : 1.f, PSC_OUT1 = PF_OUT1 ? 0.03125f : 1.f;

struct EpiPlain {
    static constexpr bool PERM = true;
    bf16* O; int ldc;
    __device__ __forceinline__ void operator()(AccRef acc, const Unit& u, int wr, int wc, int fr, int fq) const {
        const int row0 = u.pm * BM + wr * 64 + fr, col0 = u.pn * BM + wc * 32 + 8 * fq;
#pragma unroll
        for (int ai = 0; ai < 2; ++ai)
#pragma unroll
            for (int m = 0; m < 4; ++m) { bf16* rowp = O + (size_t)(row0 + ai * HALF + m * 16) * ldc + col0;
#pragma unroll
                for (int bj = 0; bj < 2; ++bj) *(u32x4*)(rowp + bj * HALF) = pack8(acc[ai][bj][m][0], acc[ai][bj][m][1]); }
    }
};
struct EpiInProj0 {
    static constexpr bool PERM = true;
    bf16 *QK, *V, *G, *UA; const float *rc, *rs;
    __device__ __forceinline__ void operator()(AccRef acc, const Unit& u, int wr, int wc, int fr, int fq) const {
        const int row0 = u.pm * BM + wr * 64 + fr, pn = u.pn;
        if (pn < 3) {
            const int H = 4 * pn + wc;
#pragma unroll
            for (int ai = 0; ai < 2; ++ai)
#pragma unroll
                for (int m = 0; m < 4; ++m) {
                    const int row = row0 + ai * HALF + m * 16;
                    f32x4 c0 = (f32x4){1.f, 1.f, 1.f, 1.f}, c1 = c0, s0 = (f32x4){0.f, 0.f, 0.f, 0.f}, s1 = s0;
                    if (row < NLAT) { const int pos = row & (SEQ - 1); const float* pc = rc + pos * 32 + 8 * fq; const float* ps = rs + pos * 32 + 8 * fq;
                        c0 = *(const f32x4*)pc; c1 = *(const f32x4*)(pc + 4); s0 = *(const f32x4*)ps; s1 = *(const f32x4*)(ps + 4); }
                    const f32x4 a0 = acc[ai][0][m][0] * PSC_IN0, a1 = acc[ai][0][m][1] * PSC_IN0, b0 = acc[ai][1][m][0] * PSC_IN0, b1 = acc[ai][1][m][1] * PSC_IN0;
                    const f32x4 y10 = a0 * c0 - b0 * s0, y11 = a1 * c1 - b1 * s1, y20 = a0 * s0 + b0 * c0, y21 = a1 * s1 + b1 * c1;
                    bf16* rp = QK + (size_t)row * 768 + H * 64 + 8 * fq;
                    *(u32x4*)rp = pack8(y10, y11); *(u32x4*)(rp + 32) = pack8(y20, y21);
                }
        } else if (pn < 9) {
            bf16* base = pn < 6 ? V : G; const int colt = (pn < 6 ? pn - 3 : pn - 6) * BM + wc * 32 + 8 * fq;
#pragma unroll
            for (int ai = 0; ai < 2; ++ai)
#pragma unroll
                for (int m = 0; m < 4; ++m) { bf16* rowp = base + (size_t)(row0 + ai * HALF + m * 16) * 768 + colt;
#pragma unroll
                    for (int bj = 0; bj < 2; ++bj) *(u32x4*)(rowp + bj * HALF) = pack8(acc[ai][bj][m][0] * PSC_IN0, acc[ai][bj][m][1] * PSC_IN0); }
        } else {
#pragma unroll
            for (int ai = 0; ai < 2; ++ai)
#pragma unroll
                for (int m = 0; m < 4; ++m) { const int row = row0 + ai * HALF + m * 16;
#pragma unroll
                    for (int bj = 0; bj < 2; ++bj) { const int c = bj * HALF + wc * 32 + 8 * fq, g = c >> 4, p0 = c & 15;
                        *(u32x4*)(UA + ((size_t)g * S5ROWS + (row >> 5)) * 768 + (row & 31) * 16 + p0) = pack8(acc[ai][bj][m][0] * PSC_IN0, acc[ai][bj][m][1] * PSC_IN0); } }
        }
    }
};
struct EpiS5E {
    static constexpr bool PERM = false;
    float* EO;
    __device__ __forceinline__ void operator()(AccRef acc, const Unit& u, int wr, int wc, int fr, int fq) const {
        const int row0 = u.pm * BM + wr * 64 + fr, col0 = wc * 32 + 4 * fq;
#pragma unroll
        for (int ai = 0; ai < 2; ++ai)
#pragma unroll
            for (int m = 0; m < 4; ++m) { float* rowp = EO + ((size_t)u.z * S5ROWS + row0 + ai * HALF + m * 16) * 256 + col0;
#pragma unroll
                for (int bj = 0; bj < 2; ++bj)
#pragma unroll
                    for (int n = 0; n < 2; ++n) *(f32x4*)(rowp + bj * HALF + n * 16) = acc[ai][bj][m][n]; }
    }
};
struct EpiS5Y {
    static constexpr bool PERM = true;
    bf16* SG;
    __device__ __forceinline__ void operator()(AccRef acc, const Unit& u, int wr, int wc, int fr, int fq) const {
        const int row0 = u.pm * BM + wr * 64 + fr;
#pragma unroll
        for (int ai = 0; ai < 2; ++ai)
#pragma unroll
            for (int m = 0; m < 4; ++m) { const int cr = row0 + ai * HALF + m * 16;
                if (cr < NTOK / S5T) {
#pragma unroll
                    for (int bj = 0; bj < 2; ++bj) { const int cn0 = u.pn * BM + bj * HALF + wc * 32 + 8 * fq, i = cn0 >> 4, p0 = cn0 & 15;
                        f32x4 v0 = acc[ai][bj][m][0], v1 = acc[ai][bj][m][1];
#pragma unroll
                        for (int j = 0; j < 4; ++j) { v0[j] = gelu_tanh(v0[j]); v1[j] = gelu_tanh(v1[j]); }
                        *(u32x4*)(SG + (size_t)(cr * S5T + i) * 256 + u.z * 16 + p0) = pack8(v0, v1); } } }
    }
};
struct EpiGlu {
    static constexpr bool PERM = true;
    bf16* MRG;
    __device__ __forceinline__ void operator()(AccRef acc, const Unit& u, int wr, int wc, int fr, int fq) const {
        const int row0 = u.pm * BM + wr * 64 + fr, col0 = 768 + u.pn * HALF + wc * 32 + 8 * fq;
#pragma unroll
        for (int ai = 0; ai < 2; ++ai)
#pragma unroll
            for (int m = 0; m < 4; ++m) { f32x4 v0, v1;
#pragma unroll
                for (int j = 0; j < 4; ++j) { v0[j] = acc[ai][0][m][0][j] * fast_sigmoid(acc[ai][1][m][0][j]); v1[j] = acc[ai][0][m][1][j] * fast_sigmoid(acc[ai][1][m][1][j]); }
                if (PF_OUT0) { u32x2 w; w.x = pack4_fp8(v0[0], v0[1], v0[2], v0[3]); w.y = pack4_fp8(v1[0], v1[1], v1[2], v1[3]); *(u32x2*)((unsigned char*)MRG + (size_t)(row0 + ai * HALF + m * 16) * 1024 + col0) = w; }
                else *(u32x4*)(MRG + (size_t)(row0 + ai * HALF + m * 16) * 1024 + col0) = pack8(v0, v1); }
    }
};
struct EpiSwiGlu {
    static constexpr bool PERM = true;
    bf16* HID;
    __device__ __forceinline__ void operator()(AccRef acc, const Unit& u, int wr, int wc, int fr, int fq) const {
        const int row0 = u.pm * BM + wr * 64 + fr, col0 = u.pn * HALF + wc * 32 + 8 * fq;
#pragma unroll
        for (int ai = 0; ai < 2; ++ai)
#pragma unroll
            for (int m = 0; m < 4; ++m) { f32x4 v0, v1;
#pragma unroll
                for (int j = 0; j < 4; ++j) { v0[j] = fast_silu(acc[ai][0][m][0][j]) * acc[ai][1][m][0][j]; v1[j] = fast_silu(acc[ai][0][m][1][j]) * acc[ai][1][m][1][j]; }
                *(u32x4*)(HID + (size_t)(row0 + ai * HALF + m * 16) * 1024 + col0) = pack8(v0, v1); }
    }
};
struct EpiSwiGlu8 {
    static constexpr bool PERM = true;
    unsigned char* HID;
    __device__ __forceinline__ void operator()(AccRef acc, const Unit& u, int wr, int wc, int fr, int fq) const {
        const int row0 = u.pm * BM + wr * 64 + fr, col0 = u.pn * HALF + wc * 32 + 8 * fq;
#pragma unroll
        for (int ai = 0; ai < 2; ++ai)
#pragma unroll
            for (int m = 0; m < 4; ++m) { f32x4 v0, v1;
#pragma unroll
                for (int j = 0; j < 4; ++j) { v0[j] = fast_silu(acc[ai][0][m][0][j] * 0.03125f) * (acc[ai][1][m][0][j] * 0.03125f); v1[j] = fast_silu(acc[ai][0][m][1][j] * 0.03125f) * (acc[ai][1][m][1][j] * 0.03125f); }
                u32x2 w; w.x = pack4_fp8(v0[0], v0[1], v0[2], v0[3]); w.y = pack4_fp8(v1[0], v1[1], v1[2], v1[3]);
                *(u32x2*)(HID + (size_t)(row0 + ai * HALF + m * 16) * 1024 + col0) = w; }
    }
};
struct EpiPlainS {
    static constexpr bool PERM = true;
    bf16* O; int ldc; float sc;
    __device__ __forceinline__ void operator()(AccRef acc, const Unit& u, int wr, int wc, int fr, int fq) const {
        const int row0 = u.pm * BM + wr * 64 + fr, col0 = u.pn * BM + wc * 32 + 8 * fq;
#pragma unroll
        for (int ai = 0; ai < 2; ++ai)
#pragma unroll
            for (int m = 0; m < 4; ++m) { bf16* rowp = O + (size_t)(row0 + ai * HALF + m * 16) * ldc + col0;
#pragma unroll
                for (int bj = 0; bj < 2; ++bj) *(u32x4*)(rowp + bj * HALF) = pack8(acc[ai][bj][m][0] * sc, acc[ai][bj][m][1] * sc); }
    }
};
struct EpiInProj1 {
    static constexpr bool PERM = true;
    bf16 *Q, *Kb, *Vb; const float* rope;
    __device__ __forceinline__ void operator()(AccRef acc, const Unit& u, int wr, int wc, int fr, int fq) const {
        const int row0 = u.pm * BM + wr * 64 + fr, pn = u.pn;
#pragma unroll
        for (int ai = 0; ai < 2; ++ai)
#pragma unroll
            for (int m = 0; m < 4; ++m) {
                const int row = row0 + ai * HALF + m * 16;
                const bool lat = row < NLAT;
                const int b = lat ? (row >> 13) : ((row - NLAT) >> 8), t = lat ? (row & (SEQ - 1)) : ((row - NLAT) & 255);
                const size_t krow = (size_t)b * (SEQ + CTXL) + (lat ? t : SEQ + t);
                if (pn < 8) {
                    const int sh = 4 * (pn & 3) + wc;
                    f32x4 c0 = (f32x4){1.f, 1.f, 1.f, 1.f}, c1 = c0, s0 = (f32x4){0.f, 0.f, 0.f, 0.f}, s1 = s0;
                    if (lat) { const int pos = (fq < 2) ? (t >> 6) : (t & 63); const float* pc = rope + pos * 16 + 8 * (fq & 1);
                        c0 = *(const f32x4*)pc; c1 = *(const f32x4*)(pc + 4); s0 = *(const f32x4*)(pc + 2048); s1 = *(const f32x4*)(pc + 2048 + 4); }
                    const f32x4 a0 = acc[ai][0][m][0] * PSC_IN1, a1 = acc[ai][0][m][1] * PSC_IN1, b0 = acc[ai][1][m][0] * PSC_IN1, b1 = acc[ai][1][m][1] * PSC_IN1;
                    const f32x4 y10 = a0 * c0 - b0 * s0, y11 = a1 * c1 - b1 * s1, y20 = a0 * s0 + b0 * c0, y21 = a1 * s1 + b1 * c1;
                    const int dim = (fq < 2 ? 0 : 32) + 8 * (fq & 1);
                    unsigned char* rp = (pn < 4) ? ((unsigned char*)Q + (size_t)row * 1024) : ((unsigned char*)Kb + krow * 1024);
                    rp += sh * 64 + dim;
                    if (pn >= 4 || lat) { u32x2 w1, w2; w1.x = pack4_fp8(y10[0], y10[1], y10[2], y10[3]); w1.y = pack4_fp8(y11[0], y11[1], y11[2], y11[3]); w2.x = pack4_fp8(y20[0], y20[1], y20[2], y20[3]); w2.y = pack4_fp8(y21[0], y21[1], y21[2], y21[3]);
                        *(u32x2*)rp = w1; *(u32x2*)(rp + 16) = w2; }
                } else {
                    bf16* rp = Vb + krow * 1024 + (pn - 8) * BM + wc * 32 + 8 * fq;
#pragma unroll
                    for (int bj = 0; bj < 2; ++bj) *(u32x4*)(rp + bj * HALF) = pack8(acc[ai][bj][m][0] * PSC_IN1, acc[ai][bj][m][1] * PSC_IN1);
                }
            }
    }
};
}
enum InIdx { I_X = 0, I_C, I_CTX, I_CCTX, I_ADAW, I_ADAB, I_LNG, I_WINAB, I_DECAY, I_LAMRE, I_LAMIM, I_LOGDT, I_BRE, I_BIM, I_CRE, I_CIM, I_S5D, I_WGLU,
             I_WOUTAB, I_WINC, I_DLAM, I_SUBLN, I_WOUTC, I_RW, I_RB, I_EG, I_EU, I_ED, N_IN };
struct Params { const float* in[N_IN]; float* out; unsigned char* ws; int ph_lo, ph_hi; };
#if defined(__HIP_DEVICE_COMPILE__)
#define CAS __attribute__((address_space(4)))
#else
#define CAS
#endif
typedef const CAS Params& PR;

struct Frame {
    LAS unsigned char* lds; int tid, lane, wave, G, bid, vcu;
};
#define WSP(T, off) ((T*)(p.ws + (off)))

__device__ __forceinline__ void p0_gemv_item(PR p, Frame& F, int item) {
    LAS float* sc = (LAS float*)F.lds;
    LAS float* red = (LAS float*)(F.lds + 20480);
    const float* c = p.in[I_C]; const float* cctx = p.in[I_CCTX];
    for (int i = F.tid; i < 5120; i += NTHREADS) { const int r = i >> 10, k = i & 1023; const float v = r < 4 ? c[r * 1024 + k] : cctx[k]; sc[i] = v / (1.f + expf(-v)); }
    __syncthreads();
    const int l = item / 96, cb = item % 96, jj = F.tid & 63, kp = F.tid >> 6;
    const float* W = p.in[I_ADAW] + (size_t)l * 1024 * 6144 + cb * 64 + jj;
    float a0 = 0.f, a1 = 0.f, a2 = 0.f, a3 = 0.f, a4 = 0.f;
#pragma unroll 16
    for (int k = kp * 128; k < kp * 128 + 128; ++k) { const float w = W[(size_t)k * 6144]; a0 += sc[k] * w; a1 += sc[1024 + k] * w; a2 += sc[2048 + k] * w; a3 += sc[3072 + k] * w; a4 += sc[4096 + k] * w; }
    red[(kp * 5 + 0) * 64 + jj] = a0; red[(kp * 5 + 1) * 64 + jj] = a1; red[(kp * 5 + 2) * 64 + jj] = a2; red[(kp * 5 + 3) * 64 + jj] = a3; red[(kp * 5 + 4) * 64 + jj] = a4;
    __syncthreads();
    if (F.tid < 320) { const int r = F.tid >> 6, j = F.tid & 63; float s = 0.f;
#pragma unroll
        for (int q = 0; q < 8; ++q) s += red[(q * 5 + r) * 64 + j];
        WSP(float, WS_MOD)[(l * 5 + r) * 6144 + cb * 64 + j] = s + p.in[I_ADAB][l * 6144 + cb * 64 + j]; }
    __syncthreads();
}
__device__ __forceinline__ void p0_s5_item(PR p, Frame& F, int item) {
    const int g = item >> 1, dir = item & 1;
    LAS f32x2* lamp = (LAS f32x2*)F.lds;
    LAS f32x2* coef = lamp + 64 * 33;
    const float dt = expf(p.in[I_LOGDT][dir * 16 + g]);
    for (int i = F.tid; i < 64 * 33; i += NTHREADS) { const int n = i / 33, tau = i % 33;
        const float re = p.in[I_LAMRE][(dir * 16 + g) * 64 + n], im = p.in[I_LAMIM][(dir * 16 + g) * 64 + n];
        const float mag = expf(re * dt * (float)tau); float s, c; sincos_rev((double)im * (double)dt * (double)tau * 0.15915494309189535, s, c);
        const f32x2 v = (f32x2){mag * c, mag * s}; lamp[i] = v; WSP(f32x2, WS_LAMP)[((g * 2 + dir) * 64 + n) * 33 + tau] = v; }
    __syncthreads();
    if (F.tid < 64) { const int n = F.tid; const float re = p.in[I_LAMRE][(dir * 16 + g) * 64 + n], im = p.in[I_LAMIM][(dir * 16 + g) * 64 + n];
        const f32x2 lb = lamp[n * 33 + 1]; const float a = lb.x - 1.f, b = lb.y, den = re * re + im * im;
        const f32x2 v = (f32x2){(a * re + b * im) / den, (b * re - a * im) / den}; coef[n] = v; WSP(f32x2, WS_COEF)[(g * 2 + dir) * 64 + n] = v; }
    __syncthreads();
    const float* bre = p.in[I_BRE] + (size_t)(dir * 16 + g) * 64 * 16; const float* bim = p.in[I_BIM] + (size_t)(dir * 16 + g) * 64 * 16;
    const float* cre = p.in[I_CRE] + (size_t)(dir * 16 + g) * 16 * 64; const float* cim = p.in[I_CIM] + (size_t)(dir * 16 + g) * 16 * 64;
    for (int idx = F.tid; idx < 32 * 256; idx += NTHREADS) { const int tau = idx >> 8, pp = (idx >> 4) & 15, q = idx & 15; float acc = 0.f;
        for (int n = 0; n < 64; ++n) { const f32x2 w = cmul(lamp[n * 33 + tau], coef[n]); const f32x2 bb = cmul(w, (f32x2){bre[n * 16 + q], bim[n * 16 + q]});
            acc += cre[pp * 64 + n] * bb.x - cim[pp * 64 + n] * bb.y; }
        WSP(float, WS_S5K)[((g * 2 + dir) * 32 + tau) * 256 + pp * 16 + q] = acc; }
    __syncthreads();
}
__device__ __forceinline__ int tr_drow(int mode, int n) {
    switch (mode) {
    case 1: if (n < 768) { const int H = n >> 6, half = (n >> 5) & 1, dd = n & 31; return (H >> 2) * 256 + half * 128 + (H & 3) * 32 + dd; } return n;
    case 2: if (n < 2048) { const int base = n & ~1023, c = n & 1023, sh = c >> 6, grp = (c >> 4) & 3; return base + (sh >> 2) * 256 + (grp & 1) * 128 + (sh & 3) * 32 + (grp >> 1) * 16 + (c & 15); } return n;
    case 3: return ((n & 255) >> 7) * 256 + (n >> 8) * 128 + (n & 127);
    case 4: return (n >> 7) * 256 + (n & 127);
    case 5: return (n >> 7) * 256 + 128 + (n & 127);
    default: return n; }
}
__device__ __forceinline__ float tr_scale(int mode, int n) { if (mode == 1) return (n >= 384 && n < 768) ? 0.125f : 1.f; if (mode == 2) return n < 1024 ? 0.5f * 1.4426950408889634f : (n < 2048 ? 0.25f : 1.f); return 1.f; }
struct TrItem { const float* W; bf16* WT; int K, N, mode, item, f8; };
__device__ __forceinline__ void tr_load(const TrItem& d, f32x4 (&t)[8], int lane) {
    const int nblk = d.N / 32, kb = d.item / nblk, nb = d.item % nblk, k0 = 64 * kb, n0 = 32 * nb, kq = lane >> 3, nq = (lane & 7) * 4;
#pragma unroll
    for (int i = 0; i < 8; ++i) t[i] = *(const f32x4*)(d.W + (size_t)(k0 + 8 * i + kq) * d.N + n0 + nq);
}
__device__ __forceinline__ void tr_finish(const TrItem& d, const f32x4 (&t)[8], LAS float* scr, int lane) {
    const int nblk = d.N / 32, kb = d.item / nblk, nb = d.item % nblk, k0 = 64 * kb, n0 = 32 * nb, kq = lane >> 3, nq = (lane & 7) * 4;
    const float sca = tr_scale(d.mode, n0);
#pragma unroll
    for (int i = 0; i < 8; ++i) { LAS float* q = scr + (8 * i + kq) * 33 + nq; q[0] = t[i][0] * sca; q[1] = t[i][1] * sca; q[2] = t[i][2] * sca; q[3] = t[i][3] * sca; }
    asm volatile("s_waitcnt lgkmcnt(0)" ::: "memory");
    const int c = lane & 7;
#pragma unroll
    for (int j = 0; j < 4; ++j) { const int n = (lane >> 3) + 8 * j; const LAS float* s = scr + (8 * c) * 33 + n;
        if (d.f8) { u32x2 o; o.x = pg8::pack4_fp8(s[0 * 33] * 32.f, s[1 * 33] * 32.f, s[2 * 33] * 32.f, s[3 * 33] * 32.f); o.y = pg8::pack4_fp8(s[4 * 33] * 32.f, s[5 * 33] * 32.f, s[6 * 33] * 32.f, s[7 * 33] * 32.f);
            *(u32x2*)((unsigned char*)d.WT + (size_t)tr_drow(d.mode, n0 + n) * d.K + k0 + 8 * c) = o; }
        else { u32x4 o; o.x = cvt_pk_bf16(s[0 * 33], s[1 * 33]); o.y = cvt_pk_bf16(s[2 * 33], s[3 * 33]); o.z = cvt_pk_bf16(s[4 * 33], s[5 * 33]); o.w = cvt_pk_bf16(s[6 * 33], s[7 * 33]);
            *(u32x4*)(d.WT + (size_t)tr_drow(d.mode, n0 + n) * d.K + k0 + 8 * c) = o; } }
    asm volatile("s_waitcnt lgkmcnt(0)" ::: "memory");
}
constexpr int TR_T0 = 1280, TR_T1 = TR_T0 + 64, TR_T2 = TR_T1 + 512, TR_T3 = TR_T2 + 1536, TR_T4 = TR_T3 + 512, TR_T5 = TR_T4 + 49152;
__device__ __forceinline__ TrItem tr_decode(PR p, int it) {
    TrItem d; d.f8 = 0;
    if (it < TR_T0) { d.W = p.in[I_WINAB]; d.WT = WSP(bf16, WS_WIN0); d.K = 1024; d.N = 2560; d.mode = 1; d.item = it; d.f8 = PF_IN0; }
    else if (it < TR_T1) { d.W = p.in[I_WGLU]; d.WT = WSP(bf16, WS_WGLU); d.K = 256; d.N = 512; d.mode = 3; d.item = it - TR_T0; }
    else if (it < TR_T2) { d.W = p.in[I_WOUTAB]; d.WT = WSP(bf16, WS_WOUT0); d.K = 1024; d.N = 1024; d.mode = 0; d.item = it - TR_T1; d.f8 = PF_OUT0; }
    else if (it < TR_T3) { d.W = p.in[I_WINC]; d.WT = WSP(bf16, WS_WIN1); d.K = 1024; d.N = 3072; d.mode = 2; d.item = it - TR_T2; d.f8 = PF_IN1; }
    else if (it < TR_T4) { d.W = p.in[I_WOUTC]; d.WT = WSP(bf16, WS_WOUT1); d.K = 1024; d.N = 1024; d.mode = 0; d.item = it - TR_T3; d.f8 = PF_OUT1; }
    else { const int r = it - TR_T4, le = r / 1536, r1 = r % 1536, which = r1 / 512;
        d.W = p.in[which == 0 ? I_EG : (which == 1 ? I_EU : I_ED)] + (size_t)le * 1024 * 1024;
        d.WT = (bf16*)(p.ws + WS_EXP + (size_t)le * EXP_STRIDE + (which == 2 ? EXP_DN : 0)); d.K = 1024; d.N = 1024; d.mode = which == 0 ? 4 : (which == 1 ? 5 : 0); d.item = r1 % 512; d.f8 = MOE_FP8; }
    return d;
}
__device__ __forceinline__ void p0a_prologue(PR p, Frame& F) {
    for (int it = F.bid; it < 224; it += F.G) { if (it < 192) p0_gemv_item(p, F, it); else p0_s5_item(p, F, it - 192); }
    LAS float* scr = (LAS float*)(F.lds + F.wave * 16384);
    const int gw = F.vcu * NWAVES + F.wave, NGW = F.G * NWAVES;
    { f32x4 ta[8], tb[8]; int it = gw;
      TrItem da = tr_decode(p, it < TR_T5 ? it : 0), db = da;
      if (it < TR_T5) tr_load(da, ta, F.lane);
      while (it < TR_T5) {
          const int nx = it + NGW;
          if (nx < TR_T5) { db = tr_decode(p, nx); tr_load(db, tb, F.lane); }
          tr_finish(da, ta, scr, F.lane);
          it = nx; if (it >= TR_T5) break;
          const int nx2 = it + NGW;
          if (nx2 < TR_T5) { da = tr_decode(p, nx2); tr_load(da, ta, F.lane); }
          tr_finish(db, tb, scr, F.lane);
          it = nx2;
      } }
    const int gt = F.bid * NTHREADS + F.tid, NGT = F.G * NTHREADS;
    for (int i = gt; i < SEQ * 32 + 128 * 16 + 1; i += NGT) {
        if (i < SEQ * 32) { const int pos = i >> 5, k = i & 31; const float inv = powf(10000.f, -(float)(2 * k) / 64.f); const float ang = (float)pos * inv; float s, c; sincos_rev((double)ang * 0.15915494309189535, s, c);
            WSP(float, WS_ROPE0C)[i] = c; WSP(float, WS_ROPE0S)[i] = s; }
        else if (i < SEQ * 32 + 2048) { const int j = i - SEQ * 32, pos = j >> 4, k = j & 15; const float inv = powf(10000.f, -(float)(2 * k) / 32.f); const float ang = (float)pos * inv; float s, c; sincos_rev((double)ang * 0.15915494309189535, s, c);
            WSP(float, WS_ROPE1)[j] = c; WSP(float, WS_ROPE1)[2048 + j] = s; }
        else { const float* dl = p.in[I_DLAM]; float s0 = 0.f, s1 = 0.f; for (int k = 0; k < 64; ++k) { s0 += dl[k] * dl[64 + k]; s1 += dl[128 + k] * dl[192 + k]; }
            WSP(float, WS_SCAL)[0] = expf(s0) - expf(s1) + LAMBDA_INIT; }
    }
}

__device__ __forceinline__ void modulate_row(const float* xrow, const float* shift, const float* scale, bf16* orow, int lane) {
#pragma unroll
    for (int j = 0; j < 4; ++j) { const int c = 4 * lane + 256 * j; const f32x4 x = *(const f32x4*)(xrow + c), sh = *(const f32x4*)(shift + c), sc = *(const f32x4*)(scale + c);
        const f32x4 h = x * (sc + 1.f) + sh; u32x2 w; w.x = cvt_pk_bf16(h[0], h[1]); w.y = cvt_pk_bf16(h[2], h[3]); *(u32x2*)(orow + c) = w; }
}
__device__ __forceinline__ void p0b_phase(PR p, Frame& F) {
    const int gw = F.vcu * NWAVES + F.wave, NGW = F.G * NWAVES;
    const float* mod = WSP(float, WS_MOD);
    bf16* H0 = WSP(bf16, A_H0);
    for (int r0 = gw; r0 < NTOK; r0 += 2 * NGW) {
        const int r1 = r0 + NGW; const bool has1 = r1 < NTOK;
        const bool lat0 = r0 < NLAT, lat1 = r1 < NLAT; const int b0 = lat0 ? (r0 >> 13) : 4, b1 = lat1 ? (r1 >> 13) : 4;
        const float* x0 = lat0 ? p.in[I_X] + (size_t)r0 * DM : p.in[I_CTX] + (size_t)(r0 - NLAT) * DM;
        const float* x1 = has1 ? (lat1 ? p.in[I_X] + (size_t)r1 * DM : p.in[I_CTX] + (size_t)(r1 - NLAT) * DM) : x0;
        f32x4 a[4], c[4];
#pragma unroll
        for (int j = 0; j < 4; ++j) { a[j] = *(const f32x4*)(x0 + 4 * F.lane + 256 * j); c[j] = *(const f32x4*)(x1 + 4 * F.lane + 256 * j); }
#pragma unroll
        for (int j = 0; j < 4; ++j) { const int cc = 4 * F.lane + 256 * j; const f32x4 sh = *(const f32x4*)(mod + b0 * 6144 + cc), sc = *(const f32x4*)(mod + b0 * 6144 + 1024 + cc);
            const f32x4 h = a[j] * (sc + 1.f) + sh;
            if (PF_IN0) *(unsigned*)((unsigned char*)H0 + (size_t)r0 * DM + cc) = pg8::pack4_fp8(h[0], h[1], h[2], h[3]);
            else { u32x2 w; w.x = cvt_pk_bf16(h[0], h[1]); w.y = cvt_pk_bf16(h[2], h[3]); *(u32x2*)(H0 + (size_t)r0 * DM + cc) = w; } }
        if (has1) {
#pragma unroll
            for (int j = 0; j < 4; ++j) { const int cc = 4 * F.lane + 256 * j; const f32x4 sh = *(const f32x4*)(mod + b1 * 6144 + cc), sc = *(const f32x4*)(mod + b1 * 6144 + 1024 + cc);
                const f32x4 h = c[j] * (sc + 1.f) + sh;
                if (PF_IN0) *(unsigned*)((unsigned char*)H0 + (size_t)r1 * DM + cc) = pg8::pack4_fp8(h[0], h[1], h[2], h[3]);
                else { u32x2 w; w.x = cvt_pk_bf16(h[0], h[1]); w.y = cvt_pk_bf16(h[2], h[3]); *(u32x2*)(H0 + (size_t)r1 * DM + cc) = w; } } }
    }
    const int gt = F.bid * NTHREADS + F.tid, NGT = F.G * NTHREADS;
    const float* S5K = WSP(float, WS_S5K); const f32x2* LAMP = WSP(f32x2, WS_LAMP); const f32x2* COEF = WSP(f32x2, WS_COEF);
    bf16* BT2 = WSP(bf16, WS_BT2); bf16* BT1 = WSP(bf16, WS_BT1);
    for (int idx = gt; idx < 16 * 512 * 96; idx += NGT) {
        const int g = idx / (512 * 96), n = (idx / 96) % 512, k0 = (idx % 96) * 8, i = n >> 4, pp = n & 15; float v[8];
        if (k0 < 512) { const int j = k0 >> 4, q0 = k0 & 15;
#pragma unroll
            for (int t = 0; t < 8; ++t) { const int q = q0 + t; float x;
                if (i > j) x = S5K[((g * 2 + 0) * 32 + (i - j)) * 256 + pp * 16 + q];
                else if (i < j) x = S5K[((g * 2 + 1) * 32 + (j - i)) * 256 + pp * 16 + q];
                else x = S5K[((g * 2 + 0) * 32) * 256 + pp * 16 + q] + S5K[((g * 2 + 1) * 32) * 256 + pp * 16 + q] + (pp == q ? p.in[I_S5D][g * 16 + pp] : 0.f);
                v[t] = x; }
        } else { const int kk0 = k0 - 512, dir = kk0 >> 7, ri = (kk0 >> 6) & 1, nn0 = kk0 & 63, pw = dir == 0 ? i + 1 : S5T - i;
#pragma unroll
            for (int t = 0; t < 8; ++t) { const int nn = nn0 + t; const f32x2 cc = (f32x2){p.in[I_CRE][((dir * 16 + g) * 16 + pp) * 64 + nn], p.in[I_CIM][((dir * 16 + g) * 16 + pp) * 64 + nn]};
                const f32x2 w = cmul(cc, LAMP[((g * 2 + dir) * 64 + nn) * 33 + pw]); v[t] = ri == 0 ? w.x : -w.y; }
        }
        u32x4 o; o.x = cvt_pk_bf16(v[0], v[1]); o.y = cvt_pk_bf16(v[2], v[3]); o.z = cvt_pk_bf16(v[4], v[5]); o.w = cvt_pk_bf16(v[6], v[7]);
        *(u32x4*)(BT2 + ((size_t)g * 512 + n) * 768 + k0) = o;
    }
    for (int idx = gt; idx < 16 * 256 * 64; idx += NGT) {
        const int g = idx / (256 * 64), n = (idx / 64) % 256, k0 = (idx % 64) * 8, j = k0 >> 4, q0 = k0 & 15, dir = n >> 7, ri = (n >> 6) & 1, nn = n & 63, pw = dir == 0 ? (S5T - 1 - j) : j;
        const f32x2 w = cmul(LAMP[((g * 2 + dir) * 64 + nn) * 33 + pw], COEF[(g * 2 + dir) * 64 + nn]); float v[8];
#pragma unroll
        for (int t = 0; t < 8; ++t) { const int q = q0 + t; const f32x2 bb = cmul(w, (f32x2){p.in[I_BRE][((dir * 16 + g) * 64 + nn) * 16 + q], p.in[I_BIM][((dir * 16 + g) * 64 + nn) * 16 + q]}); v[t] = ri == 0 ? bb.x : bb.y; }
        u32x4 o; o.x = cvt_pk_bf16(v[0], v[1]); o.y = cvt_pk_bf16(v[2], v[3]); o.z = cvt_pk_bf16(v[4], v[5]); o.w = cvt_pk_bf16(v[6], v[7]);
        *(u32x4*)(BT1 + ((size_t)g * 256 + n) * 512 + k0) = o;
    }
}
__device__ __forceinline__ void ret_unit(int unit, int& bh, int& h, int& r0) {
    const int cch = unit % RNCH; bh = unit / RNCH; h = bh % RH; const int b = bh / RH;
    r0 = cch < 64 ? b * SEQ + cch * RC : NLAT + b * CTXL + (cch - 64) * RC;
}
__device__ __forceinline__ float log_gamma(PR p, int dir, int h) { const float x = p.in[I_DECAY][dir * RH + h]; return -log1pf(expf(-x)); }
struct RetDeal { int u, stride, end; };
__device__ __forceinline__ RetDeal ret_deal(int c, int G, int NG, int a, int total) {
    RetDeal d;
    if (G <= NG) { d.u = c; d.stride = G; d.end = total; }
    else if (c < NG) { d.u = c; d.stride = NG; d.end = NG * a; }
    else { d.u = NG * a + (c - NG); d.stride = G - NG; d.end = total; }
    return d;
}
constexpr int RT_LD = 136;
__device__ __forceinline__ void ret_stage_vt(const bf16* V, int r0, int h, LAS bf16* VT, int tid) {
#pragma unroll
    for (int i = 0; i < 4; ++i) { const int id = tid + 512 * i, j = id >> 4, e0 = (id & 15) * 8;
        const u32x4 raw = *(const u32x4*)(V + (size_t)(r0 + j) * 768 + h * 128 + e0);
        VT[(e0 + 0) * RT_LD + j] = (bf16)(raw.x & 0xffffu); VT[(e0 + 1) * RT_LD + j] = (bf16)(raw.x >> 16);
        VT[(e0 + 2) * RT_LD + j] = (bf16)(raw.y & 0xffffu); VT[(e0 + 3) * RT_LD + j] = (bf16)(raw.y >> 16);
        VT[(e0 + 4) * RT_LD + j] = (bf16)(raw.z & 0xffffu); VT[(e0 + 5) * RT_LD + j] = (bf16)(raw.z >> 16);
        VT[(e0 + 6) * RT_LD + j] = (bf16)(raw.w & 0xffffu); VT[(e0 + 7) * RT_LD + j] = (bf16)(raw.w >> 16); }
}
__device__ __forceinline__ void ret_states_phase(PR p, Frame& F, int NG, int a) {
    LAS bf16* KdTf = (LAS bf16*)F.lds; LAS bf16* KdTb = KdTf + 64 * RT_LD; LAS bf16* VT = KdTb + 64 * RT_LD;
    const bf16* QK = WSP(bf16, A_QK); const bf16* V = WSP(bf16, A_V); float* RT = p.out;
    const int w = F.wave, fr = F.lane & 15, fq = F.lane >> 4;
    const RetDeal dl_ = ret_deal(F.bid, F.G, NG, a, NBATCH * RH * RNCH);
    for (int unit = dl_.u; unit < dl_.end; unit += dl_.stride) {
        int bh, h, r0; ret_unit(unit, bh, h, r0);
        const float lgf = log_gamma(p, 0, h), lgb = log_gamma(p, 1, h);
#pragma unroll
        for (int i = 0; i < 2; ++i) { const int id = F.tid + 512 * i, j = id >> 3, d0 = (id & 7) * 8;
            const u32x4 raw = *(const u32x4*)(QK + (size_t)(r0 + j) * 768 + (RH + h) * 64 + d0);
            const float df = expf(lgf * (float)(RC - 1 - j)), db = expf(lgb * (float)j);
            const unsigned wv[4] = {raw.x, raw.y, raw.z, raw.w};
#pragma unroll
            for (int t = 0; t < 4; ++t) { const float k0 = bflo(wv[t]), k1 = bfhi(wv[t]);
                KdTf[(d0 + 2 * t) * RT_LD + j] = (bf16)f2bf(k0 * df); KdTf[(d0 + 2 * t + 1) * RT_LD + j] = (bf16)f2bf(k1 * df);
                KdTb[(d0 + 2 * t) * RT_LD + j] = (bf16)f2bf(k0 * db); KdTb[(d0 + 2 * t + 1) * RT_LD + j] = (bf16)f2bf(k1 * db); } }
        ret_stage_vt(V, r0, h, VT, F.tid);
        __syncthreads();
        const int dir = w >> 2; const LAS bf16* KdT = dir ? KdTb : KdTf;
        f32x4 acc[2][4];
#pragma unroll
        for (int a = 0; a < 2; ++a)
#pragma unroll
            for (int d = 0; d < 4; ++d) acc[a][d] = (f32x4){0.f, 0.f, 0.f, 0.f};
#pragma unroll
        for (int ks = 0; ks < 4; ++ks) { bf16x8 af[2], bfr[4];
#pragma unroll
            for (int a = 0; a < 2; ++a) af[a] = *(const LAS bf16x8*)(VT + (((w & 3) * 2 + a) * 16 + fr) * RT_LD + 32 * ks + 8 * fq);
#pragma unroll
            for (int d = 0; d < 4; ++d) bfr[d] = *(const LAS bf16x8*)(KdT + (d * 16 + fr) * RT_LD + 32 * ks + 8 * fq);
#pragma unroll
            for (int a = 0; a < 2; ++a)
#pragma unroll
                for (int d = 0; d < 4; ++d) acc[a][d] = __builtin_amdgcn_mfma_f32_16x16x32_bf16(af[a], bfr[d], acc[a][d], 0, 0, 0); }
        float* out = RT + ((size_t)unit * 2 + dir) * 8192;
#pragma unroll
        for (int a = 0; a < 2; ++a)
#pragma unroll
            for (int d = 0; d < 4; ++d)
#pragma unroll
                for (int jj = 0; jj < 4; ++jj) out[(((w & 3) * 2 + a) * 16 + 4 * fq + jj) * 64 + d * 16 + fr] = acc[a][d][jj];
        __syncthreads();
    }
}
__device__ __forceinline__ void ret_scan_phase(PR p, Frame& F) {
    const float* RT = p.out; bf16* TT = WSP(bf16, A_TT);
    const int gt = F.bid * NTHREADS + F.tid, NGT = F.G * NTHREADS;
    for (int e = gt; e < 48 * 8192; e += NGT) {
        const int chain = e >> 13, el = e & 8191, dir = chain & 1, bh = chain >> 1, h = bh % RH;
        const float gC = expf(log_gamma(p, dir, h) * (float)RC);
        float st = 0.f;
        for (int s0 = 0; s0 < RNCH; s0 += 11) {
            float r[11];
#pragma unroll
            for (int k = 0; k < 11; ++k) { const int s = s0 + k, cch = dir == 0 ? (s < 2 ? 64 + s : s - 2) : (65 - s);
                r[k] = RT[((size_t)(bh * RNCH + cch) * 2 + dir) * 8192 + el]; }
#pragma unroll
            for (int k = 0; k < 11; ++k) { const int s = s0 + k, cch = dir == 0 ? (s < 2 ? 64 + s : s - 2) : (65 - s);
                TT[((size_t)(bh * RNCH + cch) * 2 + dir) * 8192 + el] = (bf16)f2bf(st);
                st = st * gC + r[k]; }
        }
    }
}
__device__ __forceinline__ void s5_scan_phase(PR p, Frame& F) {
    const float* EO = WSP(float, A_EO); bf16* UA = WSP(bf16, A_UA); const f32x2* LAMP = WSP(f32x2, WS_LAMP);
    if (F.wave != 0) return;
    for (int it = F.bid; it < 128; it += F.G) {
        const int b = it >> 5, g = (it >> 1) & 15, dir = it & 1, n = F.lane;
        const f32x2 lamT = LAMP[((g * 2 + dir) * 64 + n) * 33 + S5T];
        f32x2 st = (f32x2){0.f, 0.f};
#define S5ROW(s_) (dir == 0 ? ((s_) < 8 ? 1024 + b * 8 + (s_) : b * 256 + ((s_) - 8)) : ((s_) < 8 ? 1024 + b * 8 + (7 - (s_)) : b * 256 + (263 - (s_))))
#define S5LOAD(dst, s0_) do { _Pragma("unroll") for (int k = 0; k < 24; ++k) { const float* er = EO + ((size_t)g * S5ROWS + S5ROW((s0_) + k)) * 256 + dir * 128 + n; dst[k] = (f32x2){er[0], er[64]}; } } while (0)
#define S5STEP(src, s0_) do { _Pragma("unroll") for (int k = 0; k < 24; ++k) { bf16* ur = UA + ((size_t)g * S5ROWS + S5ROW((s0_) + k)) * 768 + 512 + dir * 128 + n; \
            ur[0] = (bf16)f2bf(st.x); ur[64] = (bf16)f2bf(st.y); st = cmul(lamT, st) + src[k]; } } while (0)
        f32x2 ea[24], eb[24];
        S5LOAD(ea, 0);
#pragma unroll 1
        for (int s0 = 0; s0 < 264; s0 += 48) {
            if (s0 + 24 < 264) S5LOAD(eb, s0 + 24);
            S5STEP(ea, s0);
            if (s0 + 24 >= 264) break;
            if (s0 + 48 < 264) S5LOAD(ea, s0 + 48);
            S5STEP(eb, s0 + 24);
        }
#undef S5ROW
#undef S5LOAD
#undef S5STEP
    }
}
__device__ __forceinline__ void ret_out_phase(PR p, Frame& F, int NG, int a) {
    constexpr int KT_LD = 72, GO_LD = 136;
    LAS bf16* VT = (LAS bf16*)F.lds; LAS bf16* Pw = VT + 128 * RT_LD + F.wave * 16 * RT_LD;
    LAS bf16* Kt = VT + 256 * RT_LD;
    LAS bf16* GO = Kt + 128 * KT_LD;
    const bf16* QK = WSP(bf16, A_QK); const bf16* V = WSP(bf16, A_V); const bf16* Gb = WSP(bf16, A_G); const bf16* TT = WSP(bf16, A_TT); bf16* MRG = WSP(bf16, A_MRG);
    const int w = F.wave, fr = F.lane & 15, fq = F.lane >> 4, i0 = 16 * w;
    const RetDeal dl_ = ret_deal(F.bid, F.G, NG, a, NBATCH * RH * RNCH);
    for (int unit = dl_.u; unit < dl_.end; unit += dl_.stride) {
        int bh, h, r0; ret_unit(unit, bh, h, r0);
        const float lgf2 = log_gamma(p, 0, h) * 1.4426950408889634f, lgb2 = log_gamma(p, 1, h) * 1.4426950408889634f;
        ret_stage_vt(V, r0, h, VT, F.tid);
#pragma unroll
        for (int i = 0; i < 2; ++i) { const int id = F.tid + 512 * i, j = id >> 3, c = (id & 7) * 8;
            *(LAS u32x4*)(Kt + j * KT_LD + c) = *(const u32x4*)(QK + (size_t)(r0 + j) * 768 + (RH + h) * 64 + c); }
#pragma unroll
        for (int i = 0; i < 4; ++i) { const int id = F.tid + 512 * i, j = id >> 4, c = (id & 15) * 8;
            *(LAS u32x4*)(GO + j * GO_LD + c) = *(const u32x4*)(Gb + (size_t)(r0 + j) * 768 + h * 128 + c); }
        bf16x8 aq[2];
#pragma unroll
        for (int ks = 0; ks < 2; ++ks) aq[ks] = *(const bf16x8*)(QK + (size_t)(r0 + i0 + fr) * 768 + h * 64 + 32 * ks + 8 * fq);
        __syncthreads();
#pragma unroll
        for (int jt = 0; jt < 8; ++jt) { f32x4 sc = (f32x4){0.f, 0.f, 0.f, 0.f};
#pragma unroll
            for (int ks = 0; ks < 2; ++ks) { const bf16x8 bk = *(const LAS bf16x8*)(Kt + (16 * jt + fr) * KT_LD + 32 * ks + 8 * fq);
                sc = __builtin_amdgcn_mfma_f32_16x16x32_bf16(aq[ks], bk, sc, 0, 0, 0); }
#pragma unroll
            for (int jj = 0; jj < 4; ++jj) { const int dl = (i0 + 4 * fq + jj) - (16 * jt + fr);
                const float dec = __builtin_amdgcn_exp2f(dl >= 0 ? lgf2 * (float)dl : lgb2 * (float)(-dl));
                Pw[(4 * fq + jj) * RT_LD + 16 * jt + fr] = (bf16)f2bf(sc[jj] * dec); } }
        asm volatile("s_waitcnt lgkmcnt(0)" ::: "memory");
        f32x4 o[8];
#pragma unroll
        for (int et = 0; et < 8; ++et) o[et] = (f32x4){0.f, 0.f, 0.f, 0.f};
#pragma unroll
        for (int ks = 0; ks < 4; ++ks) { const bf16x8 ap = *(const LAS bf16x8*)(Pw + fr * RT_LD + 32 * ks + 8 * fq);
#pragma unroll
            for (int et = 0; et < 8; ++et) { const bf16x8 bv = *(const LAS bf16x8*)(VT + (16 * et + fr) * RT_LD + 32 * ks + 8 * fq);
                o[et] = __builtin_amdgcn_mfma_f32_16x16x32_bf16(ap, bv, o[et], 0, 0, 0); } }
#pragma unroll
        for (int dir = 0; dir < 2; ++dir) { const bf16* TTp = TT + ((size_t)unit * 2 + dir) * 8192; float qd[4];
#pragma unroll
            for (int jj = 0; jj < 4; ++jj) { const int i = i0 + 4 * fq + jj; qd[jj] = __builtin_amdgcn_exp2f(dir == 0 ? lgf2 * (float)(i + 1) : lgb2 * (float)(RC - i)); }
#pragma unroll
            for (int et = 0; et < 8; ++et) { f32x4 t = (f32x4){0.f, 0.f, 0.f, 0.f};
#pragma unroll
                for (int ks = 0; ks < 2; ++ks) { const bf16x8 bt = *(const bf16x8*)(TTp + (16 * et + fr) * 64 + 32 * ks + 8 * fq);
                    t = __builtin_amdgcn_mfma_f32_16x16x32_bf16(aq[ks], bt, t, 0, 0, 0); }
#pragma unroll
                for (int jj = 0; jj < 4; ++jj) o[et][jj] += qd[jj] * t[jj]; } }
#pragma unroll
        for (int jj = 0; jj < 4; ++jj) { float s = 0.f;
#pragma unroll
            for (int et = 0; et < 8; ++et) s += o[et][jj];
            s += __shfl_xor(s, 1); s += __shfl_xor(s, 2); s += __shfl_xor(s, 4); s += __shfl_xor(s, 8);
            const float mu = s * (1.f / 128.f); float q = 0.f;
#pragma unroll
            for (int et = 0; et < 8; ++et) { const float d = o[et][jj] - mu; q += d * d; }
            q += __shfl_xor(q, 1); q += __shfl_xor(q, 2); q += __shfl_xor(q, 4); q += __shfl_xor(q, 8);
            const float rstd = 1.f / sqrtf(q * (1.f / 128.f) + GN_EPS);
            LAS bf16* grow = GO + (i0 + 4 * fq + jj) * GO_LD + fr;
#pragma unroll
            for (int et = 0; et < 8; ++et) { const float gv = bf2f(grow[16 * et]); grow[16 * et] = (bf16)f2bf((o[et][jj] - mu) * rstd * (gv * fast_sigmoid(gv))); } }
        __syncthreads();
#pragma unroll
        for (int i = 0; i < 4; ++i) { const int id = F.tid + 512 * i, j = id >> 4, c = (id & 15) * 8; const u32x4 v = *(const LAS u32x4*)(GO + j * GO_LD + c);
            const size_t off = (size_t)(r0 + j) * 1024 + h * 128 + c;
            if (PF_OUT0) { u32x2 q8; q8.x = pg8::pack4_fp8(bflo(v.x), bfhi(v.x), bflo(v.y), bfhi(v.y)); q8.y = pg8::pack4_fp8(bflo(v.z), bfhi(v.z), bflo(v.w), bfhi(v.w)); *(u32x2*)((unsigned char*)MRG + off) = q8; }
            else *(u32x4*)(MRG + off) = v; }
        __syncthreads();
    }
}
struct RouteRec { int e0, e1, rk0, rk1; float w0, w1; int d0, d1; };

__device__ __forceinline__ float* xs_row(PR p, int r) { return r < NLAT ? p.out + (size_t)r * DM : WSP(float, WS_XC) + (size_t)(r - NLAT) * DM; }

template <int LAYER>
__device__ __forceinline__ void ln1_router_phase(PR p, Frame& F, const bf16* O, bf16* H2, int nrows) {
    LAS float* rw = (LAS float*)F.lds;
    LAS unsigned* lcnt = (LAS unsigned*)(F.lds + 65536);
    for (int i = F.tid; i < 1024 * 16 / 4; i += NTHREADS) { const f32x4 w4 = ((const f32x4*)p.in[I_RW])[i]; const int col = i >> 2, e0 = (i & 3) * 4;
        rw[(e0 + 0) * 1024 + col] = w4[0]; rw[(e0 + 1) * 1024 + col] = w4[1]; rw[(e0 + 2) * 1024 + col] = w4[2]; rw[(e0 + 3) * 1024 + col] = w4[3]; }
    if (F.tid < 16) lcnt[F.tid] = 0u;
    __syncthreads();
    const float* mod = WSP(float, WS_MOD) + LAYER * 5 * 6144;
    const float* lng = p.in[I_LNG] + (LAYER * 2 + 0) * DM;
    RouteRec* route = WSP(RouteRec, WS_ROUTE);
    const int rpb = (nrows + F.G - 1) / F.G, rbeg = F.bid * rpb, rend = (rbeg + rpb < nrows) ? rbeg + rpb : nrows;
    const int lane = F.lane;
    f32x4 nx[4]; u32x2 no[4];
#define LN1_LOAD(r_) do { const bool lt_ = (r_) < NLAT; const float* xi_ = (LAYER == 0) ? (lt_ ? p.in[I_X] + (size_t)(r_) * DM : p.in[I_CTX] + (size_t)((r_) - NLAT) * DM) : xs_row(p, (r_)); \
        _Pragma("unroll") for (int j = 0; j < 4; ++j) { const int c = 4 * lane + 256 * j; nx[j] = *(const f32x4*)(xi_ + c); no[j] = *(const u32x2*)(O + (size_t)(r_) * DM + c); } } while (0)
    if (rbeg + F.wave < rend) LN1_LOAD(rbeg + F.wave);
    for (int r = rbeg + F.wave; r < rend; r += NWAVES) {
        const bool lat = r < NLAT; const int b = lat ? (r >> 13) : 4;
        const float* mb = mod + b * 6144;
        f32x4 v[4]; float s = 0.f;
#pragma unroll
        for (int j = 0; j < 4; ++j) { const int c = 4 * lane + 256 * j; const f32x4 g1 = *(const f32x4*)(mb + 2048 + c);
            const f32x4 o = (f32x4){bflo(no[j].x), bfhi(no[j].x), bflo(no[j].y), bfhi(no[j].y)};
            v[j] = nx[j] * ALPHA + g1 * o; s += (v[j][0] + v[j][1]) + (v[j][2] + v[j][3]); }
        if (r + NWAVES < rend) LN1_LOAD(r + NWAVES);
        const float mean = wave_sum(s) * (1.f / DM); float q = 0.f;
#pragma unroll
        for (int j = 0; j < 4; ++j) { v[j] = v[j] - mean; q += (v[j][0] * v[j][0] + v[j][1] * v[j][1]) + (v[j][2] * v[j][2] + v[j][3] * v[j][3]); }
        const float rstd = 1.f / sqrtf(wave_sum(q) * (1.f / DM) + LN_EPS);
        float* xo = xs_row(p, r);
        float lg[16];
#pragma unroll
        for (int e = 0; e < 16; ++e) lg[e] = 0.f;
#pragma unroll
        for (int j = 0; j < 4; ++j) { const int c = 4 * lane + 256 * j; const f32x4 gn = *(const f32x4*)(lng + c), sh = *(const f32x4*)(mb + 3072 + c), sc = *(const f32x4*)(mb + 4096 + c);
            const f32x4 x1 = v[j] * rstd * gn; *(f32x4*)(xo + c) = x1;
            const f32x4 h = x1 * (sc + 1.f) + sh;
            if (MOE_FP8) *(unsigned*)((unsigned char*)H2 + (size_t)r * DM + c) = pg8::pack4_fp8(h[0], h[1], h[2], h[3]);
            else { u32x2 w; w.x = cvt_pk_bf16(h[0], h[1]); w.y = cvt_pk_bf16(h[2], h[3]); *(u32x2*)(H2 + (size_t)r * DM + c) = w; }
#pragma unroll
            for (int e = 0; e < 16; ++e) { const f32x4 wv = *(const LAS f32x4*)(rw + e * 1024 + c); lg[e] = fmaf(h[0], wv[0], fmaf(h[1], wv[1], fmaf(h[2], wv[2], fmaf(h[3], wv[3], lg[e])))); } }
#pragma unroll
        for (int e = 0; e < 16; ++e) lg[e] = wave_sum(lg[e]);
        float sc[16], bs[16];
#pragma unroll
        for (int e = 0; e < 16; ++e) { sc[e] = __builtin_amdgcn_rcpf(1.f + __expf(-lg[e])); bs[e] = sc[e] + p.in[I_RB][e]; }
        float gbest = -INFINITY; int gsel = 0;
#pragma unroll
        for (int gq = 0; gq < 4; ++gq) { const float a = bs[4 * gq], b2 = bs[4 * gq + 1], c2 = bs[4 * gq + 2], d2 = bs[4 * gq + 3];
            const float m1 = fmaxf(fmaxf(a, b2), fmaxf(c2, d2));
            const float m2 = fmaxf(fmaxf(fminf(a, b2), fminf(c2, d2)), fminf(fmaxf(a, b2), fmaxf(c2, d2)));
            const float gs = m1 + m2; if (gs > gbest) { gbest = gs; gsel = gq; } }
        float b4[4], s4[4];
#pragma unroll
        for (int i = 0; i < 4; ++i) { b4[i] = gsel == 0 ? bs[i] : (gsel == 1 ? bs[4 + i] : (gsel == 2 ? bs[8 + i] : bs[12 + i])); s4[i] = gsel == 0 ? sc[i] : (gsel == 1 ? sc[4 + i] : (gsel == 2 ? sc[8 + i] : sc[12 + i])); }
        int i0 = 0; float bv0 = b4[0];
#pragma unroll
        for (int i = 1; i < 4; ++i) if (b4[i] > bv0) { bv0 = b4[i]; i0 = i; }
        int i1 = -1; float bv1 = -INFINITY;
#pragma unroll
        for (int i = 0; i < 4; ++i) if (i != i0 && b4[i] > bv1) { bv1 = b4[i]; i1 = i; }
        const float g0 = i0 == 0 ? s4[0] : (i0 == 1 ? s4[1] : (i0 == 2 ? s4[2] : s4[3]));
        const float g1s = i1 == 0 ? s4[0] : (i1 == 1 ? s4[1] : (i1 == 2 ? s4[2] : s4[3]));
        if (lane == 0) { RouteRec rr; rr.e0 = gsel * 4 + i0; rr.e1 = gsel * 4 + i1; rr.rk0 = (int)atomicAdd((unsigned*)&lcnt[rr.e0], 1u); rr.rk1 = (int)atomicAdd((unsigned*)&lcnt[rr.e1], 1u);
            const float den = g0 + g1s; rr.w0 = g0 / den; rr.w1 = g1s / den; rr.d0 = 0; rr.d1 = 0; route[r] = rr; }
    }
#undef LN1_LOAD
    __syncthreads();
    if (F.tid < 16) WSP(unsigned, WS_CNT)[F.bid * 16 + F.tid] = lcnt[F.tid];
    __syncthreads();
}

struct MoeTabs { LAS unsigned* tot; LAS unsigned* pstart; LAS unsigned* pendb; LAS unsigned* mybase; };
__device__ __forceinline__ MoeTabs moe_tabs(Frame& F) { MoeTabs t; LAS unsigned* m = (LAS unsigned*)(F.lds + MISC_OFF + 256); t.tot = m; t.pstart = m + 16; t.pendb = m + 32; t.mybase = m + 48; return t; }
__device__ __forceinline__ void moe_build_tabs(PR p, Frame& F, const MoeTabs& T) {
    const unsigned* cnt = WSP(unsigned, WS_CNT);
    LAS unsigned* tmp = (LAS unsigned*)(F.lds + MISC_OFF + 1024);
    { const int e = F.tid & 15, part = F.tid >> 4, per = (F.G + 31) / 32, b0 = part * per, b1 = (b0 + per < F.G) ? b0 + per : F.G; unsigned tot = 0, base = 0;
      for (int b = b0; b < b1; ++b) { const unsigned c = cnt[b * 16 + e]; tot += c; base += (b < F.bid) ? c : 0u; }
      tmp[part * 32 + e] = tot; tmp[part * 32 + 16 + e] = base; }
    __syncthreads();
    if (F.tid < 16) { unsigned tot = 0, base = 0;
#pragma unroll
        for (int q = 0; q < 32; ++q) { tot += tmp[q * 32 + F.tid]; base += tmp[q * 32 + 16 + F.tid]; }
        T.tot[F.tid] = tot; T.mybase[F.tid] = base; }
    __syncthreads();
    if (F.tid == 0) { unsigned acc = 0; for (int e = 0; e < 16; ++e) { T.pstart[e] = acc; acc += (T.tot[e] + 255u) & ~255u; T.pendb[e] = acc >> 8; } }
    __syncthreads();
}
__device__ __forceinline__ void moe_scatter_phase(PR p, Frame& F, const bf16* H2, bf16* BUF, int nrows) {
    const MoeTabs T = moe_tabs(F); moe_build_tabs(p, F, T);
    RouteRec* route = WSP(RouteRec, WS_ROUTE);
    const int rpb = (nrows + F.G - 1) / F.G, rbeg = F.bid * rpb, rend = (rbeg + rpb < nrows) ? rbeg + rpb : nrows;
    for (int r = rbeg + F.wave; r < rend; r += NWAVES) {
        const RouteRec rr = route[r];
        const int d0 = (int)(T.pstart[rr.e0] + T.mybase[rr.e0]) + rr.rk0, d1 = (int)(T.pstart[rr.e1] + T.mybase[rr.e1]) + rr.rk1;
        if (MOE_FP8) { const u32x4 a = *((const u32x4*)((const unsigned char*)H2 + (size_t)r * DM) + F.lane);
            *((u32x4*)((unsigned char*)BUF + (size_t)d0 * DM) + F.lane) = a; *((u32x4*)((unsigned char*)BUF + (size_t)d1 * DM) + F.lane) = a; }
        else { const u32x4* src = (const u32x4*)(H2 + (size_t)r * DM) + F.lane; const u32x4 a = src[0], b = src[64];
            u32x4* o0 = (u32x4*)(BUF + (size_t)d0 * DM) + F.lane; u32x4* o1 = (u32x4*)(BUF + (size_t)d1 * DM) + F.lane;
            o0[0] = a; o0[64] = b; o1[0] = a; o1[64] = b; }
        if (F.lane == 0) { route[r].d0 = d0; route[r].d1 = d1; }
    }
    if (F.bid < 16) { const int e = F.bid; const unsigned pb = T.pstart[e] + T.tot[e], pe = T.pstart[e] + ((T.tot[e] + 255u) & ~255u);
        for (unsigned r = pb + F.wave; r < pe; r += NWAVES) { if (MOE_FP8) { *((u32x4*)((unsigned char*)BUF + (size_t)r * DM) + F.lane) = (u32x4){0u, 0u, 0u, 0u}; } else { u32x4* o = (u32x4*)(BUF + (size_t)r * DM) + F.lane; o[0] = (u32x4){0u, 0u, 0u, 0u}; o[64] = (u32x4){0u, 0u, 0u, 0u}; } } }
}

template <int LAYER>
__device__ __forceinline__ void ln2_phase(PR p, Frame& F, const bf16* Y, bf16* H0N, int nrows) {
    const float* mod = WSP(float, WS_MOD) + LAYER * 5 * 6144;
    const float* modn = WSP(float, WS_MOD) + (LAYER + 1) * 5 * 6144;
    const float* lng = p.in[I_LNG] + (LAYER * 2 + 1) * DM;
    const RouteRec* route = WSP(RouteRec, WS_ROUTE);
    const int gw = F.vcu * NWAVES + F.wave, NGW = F.G * NWAVES, lane = F.lane;
    f32x4 nx[4]; u32x2 nya[4], nyb[4]; float nw0 = 0.f, nw1 = 0.f;
#define LN2_LOAD(r_) do { const RouteRec rr_ = route[(r_)]; nw0 = rr_.w0; nw1 = rr_.w1; const float* xr_ = xs_row(p, (r_)); \
        _Pragma("unroll") for (int j = 0; j < 4; ++j) { const int c = 4 * lane + 256 * j; nx[j] = *(const f32x4*)(xr_ + c); nya[j] = *(const u32x2*)(Y + (size_t)rr_.d0 * DM + c); nyb[j] = *(const u32x2*)(Y + (size_t)rr_.d1 * DM + c); } } while (0)
    if (gw < nrows) LN2_LOAD(gw);
    for (int r = gw; r < nrows; r += NGW) {
        const bool lat = r < NLAT; const int b = lat ? (r >> 13) : 4;
        const float* mb = mod + b * 6144; float* xr = xs_row(p, r);
        f32x4 v[4]; float s = 0.f;
#pragma unroll
        for (int j = 0; j < 4; ++j) { const int c = 4 * lane + 256 * j; const f32x4 g2 = *(const f32x4*)(mb + 5120 + c);
            const f32x4 y = (f32x4){bflo(nya[j].x), bfhi(nya[j].x), bflo(nya[j].y), bfhi(nya[j].y)} * nw0 + (f32x4){bflo(nyb[j].x), bfhi(nyb[j].x), bflo(nyb[j].y), bfhi(nyb[j].y)} * nw1;
            v[j] = nx[j] * ALPHA + g2 * y; s += (v[j][0] + v[j][1]) + (v[j][2] + v[j][3]); }
        if (r + NGW < nrows) LN2_LOAD(r + NGW);
        const float mean = wave_sum(s) * (1.f / DM); float q = 0.f;
#pragma unroll
        for (int j = 0; j < 4; ++j) { v[j] = v[j] - mean; q += (v[j][0] * v[j][0] + v[j][1] * v[j][1]) + (v[j][2] * v[j][2] + v[j][3] * v[j][3]); }
        const float rstd = 1.f / sqrtf(wave_sum(q) * (1.f / DM) + LN_EPS);
#pragma unroll
        for (int j = 0; j < 4; ++j) { const int c = 4 * lane + 256 * j; const f32x4 gn = *(const f32x4*)(lng + c); f32x4 x2 = v[j] * rstd * gn;
            *(f32x4*)(xr + c) = x2;
            if (LAYER == 0) { const float* mn = modn + b * 6144; const f32x4 sh = *(const f32x4*)(mn + c), sc = *(const f32x4*)(mn + 1024 + c); const f32x4 h = x2 * (sc + 1.f) + sh;
                if (PF_IN1) *(unsigned*)((unsigned char*)H0N + (size_t)r * DM + c) = pg8::pack4_fp8(h[0], h[1], h[2], h[3]);
                else { u32x2 w; w.x = cvt_pk_bf16(h[0], h[1]); w.y = cvt_pk_bf16(h[2], h[3]); *(u32x2*)(H0N + (size_t)r * DM + c) = w; } } }
    }
#undef LN2_LOAD
}
namespace att {
using pg8::i32x8; using pg8::i32x4;
constexpr int NW = 8, QBLK = 32, KVBLK = 64, LDQ = 1024, LDK = 1024, NKEY = SEQ + CTXL, NT = NKEY / KVBLK;
constexpr size_t SHM_V = KVBLK * 128 * 2, SHM_K = KVBLK * 64 * 2;
constexpr float THR = 8.f;
#define KSWZ64(row, colB) ((row) * 128 + ((colB) ^ ((((row) >> 1) & 7) << 4)))
#define SBAR() __builtin_amdgcn_sched_barrier(0)
__device__ __forceinline__ int crow(int r, int hi) { return (r & 3) + 8 * (r >> 2) + 4 * hi; }
__device__ __forceinline__ unsigned cvtpk(float lo, float hi) { unsigned r; asm volatile("v_cvt_pk_bf16_f32 %0, %1, %2" : "=v"(r) : "v"(lo), "v"(hi)); return r; }
__device__ __forceinline__ void partialSM(f32x16& p0, f32x16& p1, float& m_reg, float& mn, float& alpha) {
    constexpr float C = 1.4426950408889634f;
    float pmax = p0[0];
#pragma unroll
    for (int r = 1; r < 16; ++r) pmax = fmaxf(pmax, p0[r]);
#pragma unroll
    for (int r = 0; r < 16; ++r) pmax = fmaxf(pmax, p1[r]);
    { auto rr = __builtin_amdgcn_permlane32_swap(__float_as_uint(pmax), __float_as_uint(pmax), false, false); pmax = fmaxf(__uint_as_float(rr[0]), __uint_as_float(rr[1])); }
    if (__builtin_expect(__all(pmax - m_reg <= THR), 1)) { mn = m_reg; alpha = 1.f; }
    else { mn = fmaxf(m_reg, pmax); alpha = __builtin_amdgcn_exp2f((m_reg - mn) * C); m_reg = mn; }
    const float mnC = -mn * C;
#pragma unroll
    for (int r = 0; r < 16; ++r) p0[r] = fmaf(p0[r], C, mnC);
#pragma unroll
    for (int r = 0; r < 16; ++r) p1[r] = fmaf(p1[r], C, mnC);
#pragma unroll
    for (int r = 0; r < 16; ++r) p0[r] = __builtin_amdgcn_exp2f(p0[r]);
}
__device__ __forceinline__ void finishSM(f32x16& p0, f32x16& p1, float alpha, float& l_reg, bf16x8& pa0, bf16x8& pa1, bf16x8& pa2, bf16x8& pa3) {
#pragma unroll
    for (int r = 0; r < 16; ++r) p1[r] = __builtin_amdgcn_exp2f(p1[r]);
    float ps = 0;
#pragma unroll
    for (int r = 0; r < 16; ++r) ps += p0[r];
#pragma unroll
    for (int r = 0; r < 16; ++r) ps += p1[r];
    { auto rr = __builtin_amdgcn_permlane32_swap(__float_as_uint(ps), __float_as_uint(ps), false, false); ps = __uint_as_float(rr[0]) + __uint_as_float(rr[1]); }
    l_reg = l_reg * alpha + ps;
#define PK4(P, BASE, OUT) do { unsigned a0 = cvtpk(P[BASE + 0], P[BASE + 1]), a1 = cvtpk(P[BASE + 2], P[BASE + 3]);   \
    unsigned b0 = cvtpk(P[BASE + 4], P[BASE + 5]), b1 = cvtpk(P[BASE + 6], P[BASE + 7]);                              \
    auto r0 = __builtin_amdgcn_permlane32_swap(a0, b0, false, false); auto r1 = __builtin_amdgcn_permlane32_swap(a1, b1, false, false); \
    u32x4 w = {r0[0], r1[0], r0[1], r1[1]}; OUT = __builtin_bit_cast(bf16x8, w); } while (0)
    PK4(p0, 0, pa0); PK4(p0, 8, pa1); PK4(p1, 0, pa2); PK4(p1, 8, pa3);
#undef PK4
}
__device__ __forceinline__ void qkt(f32x16& p0, f32x16& p1, const LAS char* Ks, const bf16x8* qr, int r32, int hi) {
    p0 = f32x16{}; p1 = f32x16{};
#pragma unroll
    for (int d0 = 0; d0 < 4; ++d0) { const int cb = (d0 * 16 + hi * 8) * 2;
        const bf16x8 b0 = *(const LAS bf16x8*)(Ks + KSWZ64(r32, cb));
        const bf16x8 b1 = *(const LAS bf16x8*)(Ks + KSWZ64(32 + r32, cb));
        p0 = __builtin_amdgcn_mfma_f32_32x32x16_bf16(b0, qr[d0], p0, 0, 0, 0);
        p1 = __builtin_amdgcn_mfma_f32_32x32x16_bf16(b1, qr[d0], p1, 0, 0, 0); }
}
__device__ __forceinline__ int v_st(int k, int c) { const int kk = (k & ~0xC) | ((k & 4) << 1) | ((k & 8) >> 1); return ((kk >> 3) * 4 + (c >> 5)) * 512 + ((kk & 7) * 32 + (c & 31)) * 2; }
__device__ __forceinline__ int v_rd_base(int lane) { return ((lane & 3) << 3) | (((lane >> 2) & 3) << 6) | (((lane >> 4) & 1) << 5) | (((lane >> 5) & 1) << 8); }
constexpr int v_rd_off(int d0, int ks, int half) { return d0 * 512 + ks * 4096 + half * 2048; }
template <int OFF> __device__ __forceinline__ s16x4 tr_read(int vb) { s16x4 r; asm volatile("ds_read_b64_tr_b16 %0, %1 offset:%2" : "=&v"(r) : "v"(vb), "i"(OFF) : "memory"); return r; }
template <int D0> __device__ __forceinline__ void pv_one(f32x16& od, int vb, bf16x8 pa0, bf16x8 pa1, bf16x8 pa2, bf16x8 pa3) {
    const s16x4 l0 = tr_read<v_rd_off(D0, 0, 0)>(vb), h0 = tr_read<v_rd_off(D0, 0, 1)>(vb), l1 = tr_read<v_rd_off(D0, 1, 0)>(vb), h1 = tr_read<v_rd_off(D0, 1, 1)>(vb);
    const s16x4 l2 = tr_read<v_rd_off(D0, 2, 0)>(vb), h2 = tr_read<v_rd_off(D0, 2, 1)>(vb), l3 = tr_read<v_rd_off(D0, 3, 0)>(vb), h3 = tr_read<v_rd_off(D0, 3, 1)>(vb);
    asm volatile("s_waitcnt lgkmcnt(0)" ::: "memory"); SBAR();
#define PKV(L, H) (bf16x8){L[0], L[1], L[2], L[3], H[0], H[1], H[2], H[3]}
    od = __builtin_amdgcn_mfma_f32_32x32x16_bf16(pa0, PKV(l0, h0), od, 0, 0, 0);
    od = __builtin_amdgcn_mfma_f32_32x32x16_bf16(pa1, PKV(l1, h1), od, 0, 0, 0);
    od = __builtin_amdgcn_mfma_f32_32x32x16_bf16(pa2, PKV(l2, h2), od, 0, 0, 0);
    od = __builtin_amdgcn_mfma_f32_32x32x16_bf16(pa3, PKV(l3, h3), od, 0, 0, 0);
#undef PKV
}
__device__ __forceinline__ void pv_d0(f32x16* o, int vb, bf16x8 pa0, bf16x8 pa1, bf16x8 pa2, bf16x8 pa3) {
    pv_one<0>(o[0], vb, pa0, pa1, pa2, pa3); pv_one<1>(o[1], vb, pa0, pa1, pa2, pa3); pv_one<2>(o[2], vb, pa0, pa1, pa2, pa3); pv_one<3>(o[3], vb, pa0, pa1, pa2, pa3);
}
template <bool TIE = true> __device__ __forceinline__ void qkt_neg(f32x16& p0, f32x16& p1, int ka0, int ka1, const i32x8& qf, f32x16& negm) {
    const i32x4 a0 = *(const LAS i32x4*)(uintptr_t)(unsigned)ka0, a1 = *(const LAS i32x4*)(uintptr_t)(unsigned)ka1;
    const i32x4 b0 = *(const LAS i32x4*)(uintptr_t)(unsigned)(ka0 + 2048), b1 = *(const LAS i32x4*)(uintptr_t)(unsigned)(ka1 + 2048);
    const i32x8 k0 = (i32x8){a0[0], a0[1], a0[2], a0[3], a1[0], a1[1], a1[2], a1[3]}, k1 = (i32x8){b0[0], b0[1], b0[2], b0[3], b1[0], b1[1], b1[2], b1[3]};
    asm volatile("v_mfma_f32_32x32x64_f8f6f4 %0, %2, %3, %1" : "=&v"(p0), "+v"(negm) : "v"(k0), "v"(qf));
    asm volatile("v_mfma_f32_32x32x64_f8f6f4 %0, %2, %3, %1" : "=&v"(p1), "+v"(negm) : "v"(k1), "v"(qf));
    if (TIE) asm volatile("s_nop 15\n\ts_nop 7" : "+v"(p0), "+v"(p1));
}
constexpr float THR2 = 8.f;
template <bool FIRST> __device__ __forceinline__ void partialSM2(f32x16& p0, f32x16& p1, float& m_reg, f32x16& negm, float& alpha) {
    float pmax = p0[0];
#pragma unroll
    for (int r = 1; r < 16; ++r) pmax = fmaxf(pmax, p0[r]);
#pragma unroll
    for (int r = 0; r < 16; ++r) pmax = fmaxf(pmax, p1[r]);
    { auto rr = __builtin_amdgcn_permlane32_swap(__float_as_uint(pmax), __float_as_uint(pmax), false, false); pmax = fmaxf(__uint_as_float(rr[0]), __uint_as_float(rr[1])); }
    if (!FIRST && __builtin_expect(__all(pmax <= THR2), 1)) { alpha = 1.f; }
    else { const float d = FIRST ? pmax : fmaxf(pmax, 0.f);
        alpha = FIRST ? 1.f : __builtin_amdgcn_exp2f(-d); m_reg += d;
#pragma unroll
        for (int r = 0; r < 16; ++r) { p0[r] -= d; p1[r] -= d; negm[r] = -m_reg; } }
#pragma unroll
    for (int r = 0; r < 16; ++r) p0[r] = __builtin_amdgcn_exp2f(p0[r]);
}
__device__ __forceinline__ void finishSM2(f32x16& p0, f32x16& p1, bf16x8& pa0, bf16x8& pa1, bf16x8& pa2, bf16x8& pa3) {
#pragma unroll
    for (int r = 0; r < 16; ++r) p1[r] = __builtin_amdgcn_exp2f(p1[r]);
#define PK4(P, BASE, OUT) do { unsigned a0 = cvtpk(P[BASE + 0], P[BASE + 1]), a1 = cvtpk(P[BASE + 2], P[BASE + 3]);   \
    unsigned b0 = cvtpk(P[BASE + 4], P[BASE + 5]), b1 = cvtpk(P[BASE + 6], P[BASE + 7]);                              \
    auto r0 = __builtin_amdgcn_permlane32_swap(a0, b0, false, false); auto r1 = __builtin_amdgcn_permlane32_swap(a1, b1, false, false); \
    u32x4 w = {r0[0], r1[0], r0[1], r1[1]}; OUT = __builtin_bit_cast(bf16x8, w); } while (0)
    PK4(p0, 0, pa0); PK4(p0, 8, pa1); PK4(p1, 0, pa2); PK4(p1, 8, pa3);
#undef PK4
}
__device__ __forceinline__ int vimg_off(int d, int key, int perm) {
    const int kk = key & 31, top = key >> 5, hi = (kk >> 2) & 1, r = (kk & 3) + 4 * (kk >> 3), byte = 32 * hi + ((r + 16 * top) ^ perm);
    return d * 64 + ((((byte >> 4) ^ ((d >> 2) & 3))) << 4) + (byte & 15);
}
__device__ __forceinline__ void finishSM8(f32x16& p0, f32x16& p1, i32x8& pP) {
#pragma unroll
    for (int r = 0; r < 16; ++r) p1[r] = __builtin_amdgcn_exp2f(p1[r]);
#pragma unroll
    for (int v = 0; v < 4; ++v) { int w = __builtin_amdgcn_cvt_pk_fp8_f32(p0[4 * v], p0[4 * v + 1], 0, false); pP[v] = __builtin_amdgcn_cvt_pk_fp8_f32(p0[4 * v + 2], p0[4 * v + 3], w, true); }
#pragma unroll
    for (int v = 0; v < 4; ++v) { int w = __builtin_amdgcn_cvt_pk_fp8_f32(p1[4 * v], p1[4 * v + 1], 0, false); pP[4 + v] = __builtin_amdgcn_cvt_pk_fp8_f32(p1[4 * v + 2], p1[4 * v + 3], w, true); }
}
__device__ __forceinline__ void pv8(f32x16 (&o)[4], f32x16& ls, int va0, int va1, const i32x8& pP, const i32x8& ones8) {
    i32x8 vf[4];
#pragma unroll
    for (int d0 = 0; d0 < 4; ++d0) { const i32x4 a = *(const LAS i32x4*)(uintptr_t)(unsigned)(va0 + d0 * 2048), b = *(const LAS i32x4*)(uintptr_t)(unsigned)(va1 + d0 * 2048);
        vf[d0] = (i32x8){a[0], a[1], a[2], a[3], b[0], b[1], b[2], b[3]}; }
    i32x8 pq = pP; asm volatile("s_nop 1" : "+v"(pq));
#pragma unroll
    for (int d0 = 0; d0 < 4; ++d0) asm volatile("v_mfma_f32_32x32x64_f8f6f4 %0, %1, %2, %0" : "+v"(o[d0]) : "v"(pq), "v"(vf[d0]));
    asm volatile("v_mfma_f32_32x32x64_f8f6f4 %0, %1, %2, %0" : "+v"(ls) : "v"(pq), "v"(ones8));
}
__device__ __forceinline__ void mseg7(f32x16& p0, f32x16& p1, f32x16 (&o)[4], f32x16& ls, int ka0, int ka1, int va0, int va1, const i32x8& qf, const f32x16& negm, const i32x8& pP, const i32x8& ones8) {
    const i32x4 a0 = *(const LAS i32x4*)(uintptr_t)(unsigned)ka0, a1 = *(const LAS i32x4*)(uintptr_t)(unsigned)ka1;
    const i32x4 b0 = *(const LAS i32x4*)(uintptr_t)(unsigned)(ka0 + 2048), b1 = *(const LAS i32x4*)(uintptr_t)(unsigned)(ka1 + 2048);
    const i32x8 k0 = (i32x8){a0[0], a0[1], a0[2], a0[3], a1[0], a1[1], a1[2], a1[3]}, k1 = (i32x8){b0[0], b0[1], b0[2], b0[3], b1[0], b1[1], b1[2], b1[3]};
    i32x8 vf[4];
#pragma unroll
    for (int d0 = 0; d0 < 4; ++d0) { const i32x4 a = *(const LAS i32x4*)(uintptr_t)(unsigned)(va0 + d0 * 2048), b = *(const LAS i32x4*)(uintptr_t)(unsigned)(va1 + d0 * 2048);
        vf[d0] = (i32x8){a[0], a[1], a[2], a[3], b[0], b[1], b[2], b[3]}; }
    asm volatile("s_nop 1\n\t"
                 "v_mfma_f32_32x32x64_f8f6f4 %0, %7, %9, %10\n\t"
                 "v_mfma_f32_32x32x64_f8f6f4 %1, %8, %9, %10\n\t"
                 "v_mfma_f32_32x32x64_f8f6f4 %2, %11, %12, %2\n\t"
                 "v_mfma_f32_32x32x64_f8f6f4 %3, %11, %13, %3\n\t"
                 "v_mfma_f32_32x32x64_f8f6f4 %4, %11, %14, %4\n\t"
                 "v_mfma_f32_32x32x64_f8f6f4 %5, %11, %15, %5\n\t"
                 "v_mfma_f32_32x32x64_f8f6f4 %6, %11, %16, %6"
                 : "=&v"(p0), "=&v"(p1), "+v"(o[0]), "+v"(o[1]), "+v"(o[2]), "+v"(o[3]), "+v"(ls)
                 : "v"(k0), "v"(k1), "v"(qf), "v"(negm), "v"(pP), "v"(vf[0]), "v"(vf[1]), "v"(vf[2]), "v"(vf[3]), "v"(ones8));
}
__device__ __forceinline__ void mseg2(f32x16& p0, f32x16& p1, int ka0, int ka1, const i32x8& qf, const f32x16& negm) {
    const i32x4 a0 = *(const LAS i32x4*)(uintptr_t)(unsigned)ka0, a1 = *(const LAS i32x4*)(uintptr_t)(unsigned)ka1;
    const i32x4 b0 = *(const LAS i32x4*)(uintptr_t)(unsigned)(ka0 + 2048), b1 = *(const LAS i32x4*)(uintptr_t)(unsigned)(ka1 + 2048);
    const i32x8 k0 = (i32x8){a0[0], a0[1], a0[2], a0[3], a1[0], a1[1], a1[2], a1[3]}, k1 = (i32x8){b0[0], b0[1], b0[2], b0[3], b1[0], b1[1], b1[2], b1[3]};
    asm volatile("v_mfma_f32_32x32x64_f8f6f4 %0, %2, %4, %5\n\t"
                 "v_mfma_f32_32x32x64_f8f6f4 %1, %3, %4, %5\n\t"
                 "s_nop 15\n\ts_nop 7"
                 : "=&v"(p0), "=&v"(p1) : "v"(k0), "v"(k1), "v"(qf), "v"(negm));
}
template <int LO, int HI> __device__ __forceinline__ void exps(f32x16& a, f32x16& b) {
#pragma unroll
    for (int i = LO; i < HI; ++i) { if (i < 16) a[i & 15] = __builtin_amdgcn_exp2f(a[i & 15]); else b[i & 15] = __builtin_amdgcn_exp2f(b[i & 15]); }
}
template <int LO, int HI> __device__ __forceinline__ void cvts(const f32x16& a, const f32x16& b, i32x8& pP) {
#pragma unroll
    for (int c = LO; c < HI; ++c) { const int e = 2 * c; const float x0 = (e < 16) ? a[e & 15] : b[e & 15], x1 = (e < 16) ? a[(e + 1) & 15] : b[(e + 1) & 15];
        if (c & 1) pP[c >> 1] = __builtin_amdgcn_cvt_pk_fp8_f32(x0, x1, pP[c >> 1], true); else pP[c >> 1] = __builtin_amdgcn_cvt_pk_fp8_f32(x0, x1, 0, false); }
}
__device__ __forceinline__ float rowmax32(const f32x16& a, const f32x16& b) {
    float m0 = fmaxf(fmaxf(a[0], a[1]), a[2]), m1 = fmaxf(fmaxf(b[0], b[1]), b[2]);
#pragma unroll
    for (int r = 3; r < 15; r += 2) { m0 = fmaxf(fmaxf(m0, a[r]), a[r + 1]); m1 = fmaxf(fmaxf(m1, b[r]), b[r + 1]); }
    float pmax = fmaxf(fmaxf(m0, m1), fmaxf(a[15], b[15]));
    { auto rr = __builtin_amdgcn_permlane32_swap(__float_as_uint(pmax), __float_as_uint(pmax), false, false); pmax = fmaxf(__uint_as_float(rr[0]), __uint_as_float(rr[1])); }
    return pmax;
}
__device__ __forceinline__ i32x8 ldfrag(int a0, int a1) { const i32x4 a = *(const LAS i32x4*)(uintptr_t)(unsigned)a0, b = *(const LAS i32x4*)(uintptr_t)(unsigned)a1; return (i32x8){a[0], a[1], a[2], a[3], b[0], b[1], b[2], b[3]}; }
constexpr int SLOT = 12288, NSLOT = 8, WS_OFF = NSLOT * SLOT, QL_OFF = WS_OFF + 2048;
__device__ __forceinline__ void attn_pass(const unsigned char* __restrict__ Qb, const unsigned char* __restrict__ Kh, const unsigned char* __restrict__ VIh, LAS char* lds, f32x16 (&o)[4], f32x16& ls, int tid) {
    const int wid = tid >> 6, lane = tid & 63, r32 = lane & 31, hi = lane >> 5;
    LAS float* ws = (LAS float*)(lds + WS_OFF) + wid * 64; LAS float* al_l = ws + 32;
    float m_reg = 0.f; f32x16 negm = f32x16{}; ls = f32x16{};
    asm volatile("" : "+v"(negm));
    const i32x8 ones8 = (i32x8){0x38383838, 0x38383838, 0x38383838, 0x38383838, 0x38383838, 0x38383838, 0x38383838, 0x38383838};
#pragma unroll
    for (int d = 0; d < 4; ++d) o[d] = f32x16{};
    i32x8 qf; { const unsigned char* Qw = Qb + (long)(wid * QBLK + r32) * 1024 + hi * 32; const i32x4 a = *(const i32x4*)Qw, b = *(const i32x4*)(Qw + 16); qf = (i32x8){a[0], a[1], a[2], a[3], b[0], b[1], b[2], b[3]}; }
    const int wu = __builtin_amdgcn_readfirstlane(wid);
    unsigned goffk;
    { const int q0 = (wu & 3) * 64 + lane, krow = q0 >> 2, g = (q0 & 3) ^ ((krow >> 2) & 3); goffk = (unsigned)(krow * 1024 + g * 16); }
    const int ka0 = (int)(uintptr_t)lds + 8192 + r32 * 64 + (((2 * hi) ^ ((r32 >> 2) & 3)) << 4), ka1 = (int)(uintptr_t)lds + 8192 + r32 * 64 + (((2 * hi + 1) ^ ((r32 >> 2) & 3)) << 4);
    const unsigned goffv = (unsigned)(wu * 1024 + lane * 16);
    const int va0 = (int)(uintptr_t)lds + r32 * 64 + (((2 * hi) ^ ((r32 >> 2) & 3)) << 4), va1 = (int)(uintptr_t)lds + r32 * 64 + (((2 * hi + 1) ^ ((r32 >> 2) & 3)) << 4);
#define SDMA(t_, s_) do { LAS char* sb_ = lds + (s_) * SLOT + wu * 1024; \
        __builtin_amdgcn_global_load_lds((const unsigned*)(VIh + (size_t)(t_) * 8192 + goffv), (LAS unsigned*)(sb_), 16, 0, 0); \
        if (wu < 4) __builtin_amdgcn_global_load_lds((const unsigned*)(Kh + (size_t)(t_) * (KVBLK * 1024) + goffk), (LAS unsigned*)(sb_ + 8192), 16, 0, 0); } while (0)
#define ABAR() do { asm volatile("s_waitcnt lgkmcnt(0)" ::: "memory"); __builtin_amdgcn_s_barrier(); asm volatile("" ::: "memory"); } while (0)
#define DWAIT() do { if (wu < 4) asm volatile("s_waitcnt vmcnt(2)" ::: "memory"); else asm volatile("s_waitcnt vmcnt(1)" ::: "memory"); } while (0)
#define MF_S(dst_, kf_) asm volatile("v_mfma_f32_32x32x64_f8f6f4 %0, %1, %2, %3" : "=&v"(dst_) : "v"(kf_), "v"(qf), "v"(negm))
#define MF_PV(acc_, pin_, vf_) asm volatile("v_mfma_f32_32x32x64_f8f6f4 %0, %1, %2, %0" : "+v"(acc_) : "v"(pin_), "v"(vf_))
#define SLOWPATH(C0, C1, FIRST_) do { const float d_ = (FIRST_) ? pmax : fmaxf(pmax, 0.f); const float a_ = (FIRST_) ? 1.f : __builtin_amdgcn_exp2f(-d_); m_reg += d_; \
        _Pragma("unroll") for (int r = 0; r < 16; ++r) { C0[r] -= d_; C1[r] -= d_; negm[r] = -m_reg; } \
        asm volatile("" : "+v"(negm)); \
        if (__any(a_ < 1.f)) { if (hi == 0) al_l[r32] = a_; \
            asm volatile("s_nop 15\n\ts_nop 15\n\ts_waitcnt lgkmcnt(0)" : "+v"(o[0]), "+v"(o[1]), "+v"(o[2]), "+v"(o[3]), "+v"(ls) :: "memory"); \
            _Pragma("unroll") for (int r = 0; r < 16; ++r) { const float s_ = al_l[crow(r, hi)]; ls[r] *= s_; _Pragma("unroll") for (int d = 0; d < 4; ++d) o[d][r] *= s_; } } } while (0)
#define BODY(C0, C1, PIN, POUT, j_, FIRSTCHK_) do { \
        const int ks_ = ((((j_) + 1 < NT) ? ((j_) + 1) : (NT - 1)) & 7) * SLOT, vs_ = ((((j_) > 0) ? ((j_) - 1) : 0) & 7) * SLOT; \
        const i32x8 v0_ = ldfrag(va0 + vs_, va1 + vs_), v1_ = ldfrag(va0 + vs_ + 2048, va1 + vs_ + 2048); \
        SBAR(); asm volatile("s_nop 11" : "+v"(C0), "+v"(C1));     \
        const float pmax = rowmax32(C0, C1); \
        { const bool first_ = (FIRSTCHK_) && (j_) == 0; if (__builtin_expect(first_ || !__all(pmax <= THR2), 0)) SLOWPATH(C0, C1, first_); } \
        SBAR(); MF_PV(o[0], PIN, v0_); const i32x8 v2_ = ldfrag(va0 + vs_ + 4096, va1 + vs_ + 4096), v3_ = ldfrag(va0 + vs_ + 6144, va1 + vs_ + 6144); exps<0, 5>(C0, C1); \
        SBAR(); MF_PV(o[1], PIN, v1_); { const int tn_ = ((j_) + 3 < NT) ? ((j_) + 3) : (NT - 1); SDMA(tn_, ((j_) + 3) & 7); } exps<5, 10>(C0, C1); cvts<0, 2>(C0, C1, POUT); \
        SBAR(); MF_PV(o[2], PIN, v2_); const i32x8 k0_ = ldfrag(ka0 + ks_, ka1 + ks_), k1_ = ldfrag(ka0 + ks_ + 2048, ka1 + ks_ + 2048); exps<10, 15>(C0, C1); cvts<2, 5>(C0, C1, POUT); \
        SBAR(); MF_PV(o[3], PIN, v3_); exps<15, 20>(C0, C1); cvts<5, 8>(C0, C1, POUT); \
        SBAR(); MF_S(C0, k0_); exps<20, 25>(C0, C1); cvts<8, 10>(C0, C1, POUT); \
        SBAR(); MF_PV(ls, PIN, ones8); exps<25, 30>(C0, C1); cvts<10, 13>(C0, C1, POUT); \
        SBAR(); exps<30, 32>(C0, C1); cvts<13, 16>(C0, C1, POUT); asm volatile("" :: "v"(POUT));     \
        SBAR(); MF_S(C1, k1_); \
        SBAR(); DWAIT(); ABAR(); } while (0)
    f32x16 pX0, pX1; i32x8 pPa = i32x8{}, pPb = i32x8{};
    SDMA(0, 0); SDMA(1, 1); SDMA(2, 2); asm volatile("s_waitcnt vmcnt(0)" ::: "memory"); ABAR();
    { const i32x8 k0_ = ldfrag(ka0, ka1), k1_ = ldfrag(ka0 + 2048, ka1 + 2048); MF_S(pX0, k0_); MF_S(pX1, k1_); asm volatile("s_nop 15\n\ts_nop 7" : "+v"(pX0), "+v"(pX1)); }
    static_assert(NT % 2 == 0, "the loop is unrolled by two");
#pragma nounroll
    for (int j = 0; j < NT; j += 2) {
        BODY(pX0, pX1, pPa, pPb, j, true);
        BODY(pX0, pX1, pPb, pPa, j + 1, false);
    }
    { const int vs_ = ((NT - 1) & 7) * SLOT;
      const i32x8 v0_ = ldfrag(va0 + vs_, va1 + vs_), v1_ = ldfrag(va0 + vs_ + 2048, va1 + vs_ + 2048), v2_ = ldfrag(va0 + vs_ + 4096, va1 + vs_ + 4096), v3_ = ldfrag(va0 + vs_ + 6144, va1 + vs_ + 6144);
      MF_PV(o[0], pPa, v0_); MF_PV(o[1], pPa, v1_); MF_PV(o[2], pPa, v2_); MF_PV(o[3], pPa, v3_); MF_PV(ls, pPa, ones8); }
    asm volatile("s_waitcnt vmcnt(0)" ::: "memory");
    asm volatile("s_nop 15\n\ts_nop 15\n\ts_nop 15\n\ts_nop 15" : "+v"(o[0]), "+v"(o[1]), "+v"(o[2]), "+v"(o[3]), "+v"(ls));
    ABAR();
#undef BODY
#undef SLOWPATH
#undef MF_S
#undef MF_PV
#undef DWAIT
#undef SDMA
#undef ABAR
}
}

__device__ __forceinline__ void vt_image_phase(PR p, Frame& F) {
    const bf16* V = WSP(bf16, B_V); unsigned char* VI = p.ws + B_VI;
    LAS unsigned char* img = (LAS unsigned char*)(F.lds + F.wave * 16384);
    const int gw = F.vcu * NWAVES + F.wave, NGW = F.G * NWAVES, lane = F.lane;
    const unsigned probe = (unsigned)__builtin_amdgcn_cvt_pk_fp8_f32(1.f, 2.f, 0, false);
    const int pshift = (probe & 0xffffu) ? 0 : 16, perm = ((((probe >> pshift) & 0xffu) == 0x38u) ? 0 : 1) | (pshift ? 2 : 0);
    for (int it = gw; it < NBATCH * 8 * att::NT; it += NGW) {
        const int t = it % att::NT, bh = it / att::NT, b = bh >> 3, h = bh & 7;
        const bf16* src = V + ((size_t)b * att::NKEY + t * 64) * 1024 + h * 128;
#pragma unroll 1
        for (int i0 = 0; i0 < 16; i0 += 4) {
            u32x4 x[4];
#pragma unroll
            for (int i = 0; i < 4; ++i) { const int id = lane + 64 * (i0 + i), key = id >> 4, dc = (id & 15) * 8; x[i] = *(const u32x4*)(src + (size_t)key * 1024 + dc); }
#pragma unroll
            for (int i = 0; i < 4; ++i) { const int id = lane + 64 * (i0 + i), key = id >> 4, dc = (id & 15) * 8; const unsigned w[4] = {x[i].x, x[i].y, x[i].z, x[i].w};
#pragma unroll
                for (int e = 0; e < 4; ++e) { const float lo = bflo(w[e]), hi_ = bfhi(w[e]);
                    img[att::vimg_off(dc + 2 * e, key, perm)] = (unsigned char)((__builtin_amdgcn_cvt_pk_fp8_f32(lo, lo, 0, false) >> pshift) & 0xff); img[att::vimg_off(dc + 2 * e + 1, key, perm)] = (unsigned char)((__builtin_amdgcn_cvt_pk_fp8_f32(hi_, hi_, 0, false) >> pshift) & 0xff); } }
        }
        asm volatile("s_waitcnt lgkmcnt(0)" ::: "memory");
        unsigned char* dst = VI + (size_t)it * 8192;
#pragma unroll
        for (int i = 0; i < 8; ++i) *(u32x4*)(dst + (lane + 64 * i) * 16) = *(const LAS u32x4*)(img + (lane + 64 * i) * 16);
        asm volatile("s_waitcnt lgkmcnt(0)" ::: "memory");
    }
}
__device__ __forceinline__ void attn_phase(PR p, Frame& F) {
    using namespace att;
    const unsigned char* Q = p.ws + B_Q; const unsigned char* K = p.ws + B_K; bf16* AO = WSP(bf16, B_AO);
    for (int unit = F.vcu; unit < NBATCH * 8 * 32; unit += F.G) {
        const int bh = unit >> 5, qb = unit & 31, b = bh >> 3, h = bh & 7;
        const unsigned char* Qb = Q + ((size_t)b * SEQ + qb * 256) * 1024 + h * 128;
        const unsigned char* Kh = K + (size_t)b * NKEY * 1024 + h * 128;
        const unsigned char* VIh = p.ws + B_VI + (size_t)(b * 8 + h) * NT * 8192;
        f32x16 o[4]; f32x16 ls;
        int tl = F.tid; asm volatile("" : "+v"(tl));
        attn_pass(Qb, Kh, VIh, (LAS char*)F.lds, o, ls, tl);
        asm volatile("" : "+v"(tl));
        { float* st = WSP(float, B_STASH) + (size_t)F.bid * 64 * NTHREADS + tl;
#pragma unroll
          for (int r = 0; r < 16; ++r) { const float rl = __builtin_amdgcn_rcpf(ls[r]);
#pragma unroll
              for (int d0 = 0; d0 < 4; ++d0) st[(size_t)(d0 * 16 + r) * NTHREADS] = o[d0][r] * rl; } }
        __syncthreads();
        asm volatile("" : "+v"(tl));
        attn_pass(Qb + 64, Kh + 64, VIh, (LAS char*)F.lds, o, ls, tl);
        asm volatile("" : "+v"(tl));
        { const int lane = tl & 63, r32 = lane & 31, hi = lane >> 5, wid = tl >> 6;
          const float* st = WSP(float, B_STASH) + (size_t)F.bid * 64 * NTHREADS + tl;
          const float lam = WSP(float, WS_SCAL)[0];
          float ss[16];
#pragma unroll
          for (int r = 0; r < 16; ++r) { const float rl = __builtin_amdgcn_rcpf(ls[r]); float q = 0.f;
#pragma unroll
              for (int d0 = 0; d0 < 4; ++d0) { const float v = st[(size_t)(d0 * 16 + r) * NTHREADS] - lam * (o[d0][r] * rl); o[d0][r] = v; q += v * v; }
              ss[r] = q; }
#pragma unroll
          for (int r = 0; r < 16; ++r) { float q = ss[r]; q += __shfl_xor(q, 1); q += __shfl_xor(q, 2); q += __shfl_xor(q, 4); q += __shfl_xor(q, 8); q += __shfl_xor(q, 16);
              ss[r] = (1.f / sqrtf(q * (1.f / 128.f) + GN_EPS)) * (1.f - LAMBDA_INIT); }
          bf16* Ow = PF_OUT1 ? (bf16*)((unsigned char*)AO + ((size_t)b * SEQ + qb * 256 + wid * QBLK) * DM + h * 128 + r32) : AO + ((size_t)b * SEQ + qb * 256 + wid * QBLK) * DM + h * 128 + r32;
#pragma unroll
          for (int d0 = 0; d0 < 4; ++d0) { const float gsub = p.in[I_SUBLN][d0 * 32 + r32];
#pragma unroll
              for (int r = 0; r < 16; ++r) { if (PF_OUT1) ((unsigned char*)Ow)[(size_t)crow(r, hi) * DM + d0 * 32] = pg8::to_fp8(o[d0][r] * ss[r] * gsub); else Ow[(size_t)crow(r, hi) * DM + d0 * 32] = (bf16)f2bf(o[d0][r] * ss[r] * gsub); } } }
        __syncthreads();
    }
}
#ifndef MK_MULTI
#define MK_MULTI 0
#endif
constexpr int NPHASE = 22;

template <int LAYER>
__device__ __forceinline__ void moe_gemm1_phase(PR p, Frame& F, const bf16* BUF, bf16* HID) {
    const MoeTabs T = moe_tabs(F); moe_build_tabs(p, F, T);
    const int LD = MOE_FP8 ? 512 : 1024;
    pg8::ExpertOrder S; S.g.init((int)T.pendb[15], 8, F.G, F.bid, LD, LD); S.pend = T.pendb; S.eB = (long)EXP_STRIDE;
    pg8::Gemm g{BUF, (const bf16*)(p.ws + WS_EXP + (size_t)LAYER * 16 * EXP_STRIDE), LD, LD, LD};
    if (MOE_FP8) { pg8::EpiSwiGlu8 E{(unsigned char*)HID}; pg8::gemm_phase<true>(F.lds, g, S, E); }
    else { pg8::EpiSwiGlu E{HID}; pg8::gemm_phase(F.lds, g, S, E); }
}
template <int LAYER>
__device__ __forceinline__ void moe_gemm2_phase(PR p, Frame& F, const bf16* HID, bf16* Y) {
    const MoeTabs T = moe_tabs(F); moe_build_tabs(p, F, T);
    const int LD = MOE_FP8 ? 512 : 1024;
    pg8::ExpertOrder S; S.g.init((int)T.pendb[15], 4, F.G, F.bid, LD, LD); S.pend = T.pendb; S.eB = (long)EXP_STRIDE;
    pg8::Gemm g{HID, (const bf16*)(p.ws + WS_EXP + (size_t)LAYER * 16 * EXP_STRIDE + EXP_DN), LD, LD, LD};
    if (MOE_FP8) { pg8::EpiPlainS E{Y, 1024, 0.03125f}; pg8::gemm_phase<true>(F.lds, g, S, E); }
    else { pg8::EpiPlain E{Y, 1024}; pg8::gemm_phase(F.lds, g, S, E); }
}

#define PHP() const CAS Params* kp_ = (const CAS Params*)__builtin_amdgcn_kernarg_segment_ptr(); asm volatile("" : "+s"(kp_)); PR p = *kp_; Frame F; { int t_ = threadIdx.x; asm volatile("" : "+v"(t_)); int g_ = gridDim.x, b_ = blockIdx.x; asm volatile("" : "+s"(g_), "+s"(b_)); \
    F.lds = lds_base; F.tid = t_; F.lane = t_ & 63; F.wave = __builtin_amdgcn_readfirstlane(t_ >> 6); F.G = g_; F.bid = b_; F.vcu = (g_ % 8 == 0) ? (b_ % 8) * (g_ / 8) + b_ / 8 : b_; }
__global__ void __launch_bounds__(NTHREADS, 2) fwd(Params p_) {
    extern __shared__ __attribute__((aligned(16))) unsigned char lds_raw[];
    LAS unsigned char* const lds_base = (LAS unsigned char*)lds_raw;
    volatile LAS unsigned* misc = (volatile LAS unsigned*)(lds_base + MISC_OFF);
    for (int u = threadIdx.x; u < 64; u += NTHREADS) misc[u] = 0u;
    __syncthreads();
    const int lo = p_.ph_lo, hi = p_.ph_hi;
    XcdBarrier bar; bar.bar = (unsigned*)(p_.ws + WS_CTL) + 4096; bar.x = 0; bar.st = misc;
    if (!MK_MULTI) bar = xcd_barrier_post((unsigned*)(p_.ws + WS_CTL) + 4096, misc);
#ifndef ONLY_PHASE
#define ONLY_PHASE -1
#endif
#ifndef REP_MASK
#define REP_MASK 0
#endif
#define REP(k) for (int rep_ = 0; rep_ < (((REP_MASK) >> (k)) & 1) + 1; ++rep_, __syncthreads())
#define IN(k) ((ONLY_PHASE < 0 || ONLY_PHASE == (k)) && lo <= (k) && (k) < hi)
#define SEAM(k) do { if (IN(k) && IN((k) + 1)) xcd_barrier(bar); } while (0)
#ifdef DIAG_A
#define STAMP(k) do { if ((k) == DIAG_A || (k) == DIAG_B) { if (blockIdx.x == 0 && threadIdx.x == 0) { unsigned long long* st_ = (unsigned long long*)(p_.ws + WS_SCAL + 64) + ((k) == DIAG_B ? 2 : 0); st_[0] = __builtin_amdgcn_s_memtime(); st_[1] = __builtin_amdgcn_s_memrealtime(); } } } while (0)
#define STAMPE(k) do { } while (0)
#else
#define STAMP(k) do { } while (0)
#define STAMPE(k) do { } while (0)
#endif

    STAMP(0); if (IN(0)) REP(0) { PHP(); p0a_prologue(p, F); } STAMPE(0); SEAM(0);
    STAMP(1); if (IN(1)) REP(1) { PHP(); p0b_phase(p, F); } STAMPE(1); SEAM(1);
    STAMP(2); if (IN(2)) REP(2) { PHP();
        constexpr int LD = PF_IN0 ? 512 : 1024; pg8::Gemm g{WSP(bf16, A_H0), WSP(bf16, WS_WIN0), LD, LD, LD}; pg8::GridOrder S; S.init(NTOK / 256, 10, F.G, F.bid, LD, LD);
        pg8::EpiInProj0 E{WSP(bf16, A_QK), WSP(bf16, A_V), WSP(bf16, A_G), WSP(bf16, A_UA), WSP(float, WS_ROPE0C), WSP(float, WS_ROPE0S)};
        pg8::gemm_phase<PF_IN0 != 0>(F.lds, g, S, E);
    } STAMPE(2); SEAM(2);
    STAMP(3); if (IN(3)) REP(3) { PHP();
        pg8::Gemm g{WSP(bf16, A_UA), WSP(bf16, WS_BT1), 512, 768, 512};
        pg8::BatchOrder S; S.nZ = 16; S.nM = 5; S.nN = 1; S.G = F.G; S.c = F.bid; S.tA = 256L * 768 * 2; S.tB = 256L * 512 * 2; S.zA = (long)S5ROWS * 768 * 2; S.zB = 256L * 512 * 2;
        pg8::EpiS5E E{WSP(float, A_EO)};
        pg8::gemm_phase(F.lds, g, S, E);
        ret_states_phase(p, F, 80, 3);
    } STAMPE(3); SEAM(3);
    STAMP(4); if (IN(4)) REP(4) { PHP(); s5_scan_phase(p, F); ret_scan_phase(p, F); } STAMPE(4); SEAM(4);
    STAMP(5); if (IN(5)) REP(5) { PHP();
        pg8::Gemm g{WSP(bf16, A_UA), WSP(bf16, WS_BT2), 768, 768, 768};
        pg8::BatchOrder S; S.nZ = 16; S.nM = 5; S.nN = 2; S.G = F.G; S.c = F.bid; S.tA = 256L * 768 * 2; S.tB = 256L * 768 * 2; S.zA = (long)S5ROWS * 768 * 2; S.zB = 512L * 768 * 2;
        pg8::EpiS5Y E{WSP(bf16, A_SG)};
        pg8::gemm_phase(F.lds, g, S, E);
#ifdef RET_REP
        for (int rr_ = 0; rr_ < RET_REP; ++rr_) { ret_out_phase(p, F, 160, 6); __syncthreads(); }
#endif
        ret_out_phase(p, F, 160, 6);
    } STAMPE(5); SEAM(5);
    STAMP(6); if (IN(6)) REP(6) { PHP();
        pg8::Gemm g{WSP(bf16, A_SG), WSP(bf16, WS_WGLU), 256, 256, 256}; pg8::GridOrder S; S.init(NTOK / 256, 2, F.G, F.bid, 256, 256);
        pg8::EpiGlu E{WSP(bf16, A_MRG)};
        pg8::gemm_phase(F.lds, g, S, E);
    } STAMPE(6); SEAM(6);
    STAMP(7); if (IN(7)) REP(7) { PHP();
        constexpr int LD = PF_OUT0 ? 512 : 1024; pg8::Gemm g{WSP(bf16, A_MRG), WSP(bf16, WS_WOUT0), LD, LD, LD}; pg8::GridOrder S; S.init(NTOK / 256, 4, F.G, F.bid, LD, LD);
        pg8::EpiPlainS E{WSP(bf16, A_O), 1024, pg8::PSC_OUT0};
        pg8::gemm_phase<PF_OUT0 != 0>(F.lds, g, S, E);
    } STAMPE(7); SEAM(7);
    STAMP(8); if (IN(8)) REP(8) { PHP(); ln1_router_phase<0>(p, F, WSP(bf16, A_O), WSP(bf16, A_H2), NTOK); } STAMPE(8); SEAM(8);
    STAMP(9); if (IN(9)) REP(9) { PHP(); moe_scatter_phase(p, F, WSP(bf16, A_H2), WSP(bf16, A_BUF), NTOK); } STAMPE(9); SEAM(9);
    STAMP(10); if (IN(10)) REP(10) { PHP(); moe_gemm1_phase<0>(p, F, WSP(bf16, A_BUF), WSP(bf16, A_HID)); } STAMPE(10); SEAM(10);
    STAMP(11); if (IN(11)) REP(11) { PHP(); moe_gemm2_phase<0>(p, F, WSP(bf16, A_HID), WSP(bf16, A_Y)); } STAMPE(11); SEAM(11);
    STAMP(12); if (IN(12)) REP(12) { PHP(); ln2_phase<0>(p, F, WSP(bf16, A_Y), WSP(bf16, A_H0P), NTOK); } STAMPE(12); SEAM(12);
    STAMP(13); if (IN(13)) REP(13) { PHP();
        constexpr int LD = PF_IN1 ? 512 : 1024; pg8::Gemm g{WSP(bf16, A_H0P), WSP(bf16, WS_WIN1), LD, LD, LD}; pg8::InProj1Order S; S.g.init(NLAT / 256, 12, F.G, F.bid, LD, LD);
        pg8::EpiInProj1 E{WSP(bf16, B_Q), WSP(bf16, B_K), WSP(bf16, B_V), WSP(float, WS_ROPE1)};
        pg8::gemm_phase<PF_IN1 != 0>(F.lds, g, S, E);
    } STAMPE(13); SEAM(13);
    STAMP(14); if (IN(14)) REP(14) { PHP(); vt_image_phase(p, F); } STAMPE(14); SEAM(14);
    STAMP(15); if (IN(15)) REP(15) { PHP(); attn_phase(p, F); } STAMPE(15); SEAM(15);
    STAMP(16); if (IN(16)) REP(16) { PHP();
        constexpr int LD = PF_OUT1 ? 512 : 1024; pg8::Gemm g{WSP(bf16, B_AO), WSP(bf16, WS_WOUT1), LD, LD, LD}; pg8::GridOrder S; S.init(NLAT / 256, 4, F.G, F.bid, LD, LD);
        pg8::EpiPlainS E{WSP(bf16, B_O), 1024, pg8::PSC_OUT1};
        pg8::gemm_phase<PF_OUT1 != 0>(F.lds, g, S, E);
    } STAMPE(16); SEAM(16);
    STAMP(17); if (IN(17)) REP(17) { PHP(); ln1_router_phase<1>(p, F, WSP(bf16, B_O), WSP(bf16, B_H2), NLAT); } STAMPE(17); SEAM(17);
    STAMP(18); if (IN(18)) REP(18) { PHP(); moe_scatter_phase(p, F, WSP(bf16, B_H2), WSP(bf16, B_BUF), NLAT); } STAMPE(18); SEAM(18);
    STAMP(19); if (IN(19)) REP(19) { PHP(); moe_gemm1_phase<1>(p, F, WSP(bf16, B_BUF), WSP(bf16, B_HID)); } STAMPE(19); SEAM(19);
    STAMP(20); if (IN(20)) REP(20) { PHP(); moe_gemm2_phase<1>(p, F, WSP(bf16, B_HID), WSP(bf16, B_Y)); } STAMPE(20); SEAM(20);
    STAMP(21); if (IN(21)) REP(21) { PHP(); ln2_phase<1>(p, F, WSP(bf16, B_Y), nullptr, NLAT); }
#ifdef DIAG_SEG
    if (blockIdx.x == 0 && threadIdx.x == 0) {
        const unsigned long long ticks = *(volatile unsigned long long*)(p_.ws + 65536) / 16ull;
        const unsigned long long t0 = __builtin_amdgcn_s_memrealtime();
        while (__builtin_amdgcn_s_memrealtime() - t0 < ticks) __builtin_amdgcn_s_sleep(8);
    }
#endif
#ifdef DIAG_A
    if (blockIdx.x == 0 && threadIdx.x == 0) {
        unsigned long long* st_ = (unsigned long long*)(p_.ws + WS_SCAL + 64);
        if (DIAG_B == NPHASE) { st_[2] = __builtin_amdgcn_s_memtime(); st_[3] = __builtin_amdgcn_s_memrealtime(); }
        const unsigned long long ticks = 4ull * (st_[3] - st_[1]);
        const unsigned long long t0 = __builtin_amdgcn_s_memrealtime();
        while (__builtin_amdgcn_s_memrealtime() - t0 < ticks) __builtin_amdgcn_s_sleep(8);
    }
#endif
#undef IN
#undef SEAM
}

extern "C" void kernel_launch(void* const* d_in, const int* in_sizes, int n_in, void* d_out, int out_size, void* d_ws, size_t ws_size, hipStream_t stream) {
    static int grid = 0;
    if (grid == 0) {
        if (n_in != N_IN || out_size != NLAT * DM || ws_size < WS_END) { fprintf(stderr, "kernel_launch: unexpected shapes: n_in %d out %d ws %zu (need %zu)\n", n_in, out_size, ws_size, (size_t)WS_END); grid = -1; return; }
        int dev = 0, cus = 0, per_cu = 0;
        if (hipGetDevice(&dev) != hipSuccess || hipDeviceGetAttribute(&cus, hipDeviceAttributeMultiprocessorCount, dev) != hipSuccess) { grid = -1; return; }
        if (hipFuncSetAttribute((const void*)fwd, hipFuncAttributeMaxDynamicSharedMemorySize, LDS_BYTES) != hipSuccess) { fprintf(stderr, "kernel_launch: hipFuncSetAttribute failed\n"); grid = -1; return; }
        if (hipOccupancyMaxActiveBlocksPerMultiprocessor(&per_cu, (const void*)fwd, NTHREADS, LDS_BYTES) != hipSuccess || per_cu < 1) fprintf(stderr, "kernel_launch: occupancy query reports %d\n", per_cu);
        (void)hipGetLastError();
        grid = cus > 256 ? 256 : cus;
    }
    if (grid < 0) return;
    if (hipMemsetAsync((char*)d_ws + WS_CTL, 0, CTL_BYTES, stream) != hipSuccess) return;
    Params prm{};
    for (int i = 0; i < N_IN; ++i) prm.in[i] = (const float*)d_in[i];
    prm.out = (float*)d_out; prm.ws = (unsigned char*)d_ws;
#if MK_MULTI
    for (int ph = 0; ph < NPHASE; ++ph) { prm.ph_lo = ph; prm.ph_hi = ph + 1; hipLaunchKernelGGL(fwd, dim3(grid), dim3(NTHREADS), LDS_BYTES, stream, prm); }
#else
    prm.ph_lo = 0; prm.ph_hi = NPHASE;
    hipLaunchKernelGGL(fwd, dim3(grid), dim3(NTHREADS), LDS_BYTES, stream, prm);
#endif
}
```

```cpp
#include <hip/hip_runtime.h>
#include <cstdio>
#include <cstdint>

#define LAS __attribute__((address_space(3)))
#define GAS __attribute__((address_space(1)))
typedef unsigned short bf16;
typedef short bf16x8 __attribute__((ext_vector_type(8)));
typedef short s16x4 __attribute__((ext_vector_type(4)));
typedef float f32x4 __attribute__((ext_vector_type(4)));
typedef float f32x2 __attribute__((ext_vector_type(2)));
typedef float f32x16 __attribute__((ext_vector_type(16)));
typedef unsigned u32x4 __attribute__((ext_vector_type(4)));
typedef unsigned u32x2 __attribute__((ext_vector_type(2)));

constexpr int DM = 1024, NBATCH = 4, SEQ = 8192, CTXL = 256;
constexpr int NLAT = NBATCH * SEQ, NCTX = NBATCH * CTXL, NTOK = NLAT + NCTX;
constexpr int RH = 6, RDK = 64, RDV = 128, RC = 128, RNCH = 66;
constexpr int S5G = 16, S5P = 16, S5N = 64, S5T = 32, S5ROWS = 1280;
constexpr int NEXP = 16, NB0 = 280, NB1 = 272;
constexpr float ALPHA = 1.4142135623730951f;
constexpr float LN_EPS = 1e-5f, GN_EPS = 1e-6f;
constexpr float LAMBDA_INIT = 0.35550906759096926f;
constexpr int NWAVES = 8, NTHREADS = 512;
#ifndef PROJ_FP8
#define PROJ_FP8 0
#endif
#ifndef PF_IN0
#define PF_IN0 1
#endif
#ifndef PF_OUT0
#define PF_OUT0 1
#endif
#ifndef PF_IN1
#define PF_IN1 1
#endif
#ifndef PF_OUT1
#define PF_OUT1 1
#endif
#ifndef FP8_WIDE
#define FP8_WIDE 1
#endif
#ifndef MOE_FP8
#define MOE_FP8 1
#endif

constexpr size_t MiB = 1u << 20, KiB = 1024;
constexpr size_t WS_CTL = 0, CTL_BYTES = 1 * MiB;
constexpr size_t WS_MOD = 1 * MiB;
constexpr size_t WS_SCAL = 1 * MiB + 256 * KiB;
constexpr size_t WS_LAMP = 1 * MiB + 320 * KiB;
constexpr size_t WS_COEF = 1 * MiB + 896 * KiB;
constexpr size_t WS_ROPE0C = 2 * MiB, WS_ROPE0S = 3 * MiB;
constexpr size_t WS_ROPE1 = 4 * MiB;
constexpr size_t WS_S5K = 4 * MiB + 64 * KiB;
constexpr size_t WS_XC = 6 * MiB;
constexpr size_t WS_CNT = 10 * MiB;
constexpr size_t WS_ROUTE = 10 * MiB + 64 * KiB;
constexpr size_t WS_BT1 = 12 * MiB;
constexpr size_t WS_BT2 = 16 * MiB;
constexpr size_t WS_WIN0 = 28 * MiB;
constexpr size_t WS_WGLU = 33 * MiB;
constexpr size_t WS_WOUT0 = 34 * MiB;
constexpr size_t WS_WIN1 = 36 * MiB;
constexpr size_t WS_WOUT1 = 42 * MiB;
constexpr size_t WS_EXP = 44 * MiB;
constexpr size_t EXP_STRIDE = 6 * MiB, EXP_DN = 4 * MiB;
constexpr size_t WS_ARENA = 236 * MiB;
constexpr size_t AR(double mib) { return WS_ARENA + (size_t)(mib * 1048576.0); }
constexpr size_t A_QK = AR(0), A_V = AR(49.5), A_G = AR(99), A_UA = AR(148.5), A_TT = AR(178.5), A_EO = AR(228), A_H0 = AR(248), A_MRG = AR(248), A_SG = AR(314);
constexpr size_t A_O = AR(140), A_H2 = AR(206), A_BUF = AR(0), A_HID = AR(140), A_Y = AR(0), A_H0P = AR(140);
constexpr size_t B_Q = AR(0), B_K = AR(64), B_V = AR(206), B_STASH = AR(272), B_AO = AR(140), B_O = AR(0), B_H2 = AR(64), B_BUF = AR(140), B_HID = AR(0), B_Y = AR(140);
constexpr size_t WS_XS1 = WS_EXP;
constexpr size_t WS_END = AR(331);
constexpr size_t B_VI = WS_EXP;

constexpr int STAGE_BYTES_LDS = 131072;
constexpr int MISC_OFF = 131072;
constexpr int LDS_BYTES = 147456;

__device__ __forceinline__ unsigned f2bf(float f) { unsigned u = __float_as_uint(f); return (u + 0x7fffu + ((u >> 16) & 1u)) >> 16; }
__device__ __forceinline__ float bf2f(unsigned b) { return __uint_as_float(b << 16); }
__device__ __forceinline__ float bflo(unsigned w) { return __uint_as_float(w << 16); }
__device__ __forceinline__ float bfhi(unsigned w) { return __uint_as_float(w & 0xffff0000u); }
__device__ __forceinline__ unsigned cvt_pk_bf16(float lo, float hi) { unsigned r; asm volatile("v_cvt_pk_bf16_f32 %0, %1, %2" : "=v"(r) : "v"(lo), "v"(hi)); return r; }
template <int CTRL> __device__ __forceinline__ float dpp_f(float v) { return __int_as_float(__builtin_amdgcn_update_dpp(0, __float_as_int(v), CTRL, 0xF, 0xF, true)); }
__device__ __forceinline__ float wave_sum(float v) {
    v += dpp_f<0xB1>(v); v += dpp_f<0x4E>(v); v += dpp_f<0x141>(v); v += dpp_f<0x140>(v);
    { auto r = __builtin_amdgcn_permlane16_swap(__float_as_uint(v), __float_as_uint(v), false, false); v = __uint_as_float(r[0]) + __uint_as_float(r[1]); }
    { auto r = __builtin_amdgcn_permlane32_swap(__float_as_uint(v), __float_as_uint(v), false, false); v = __uint_as_float(r[0]) + __uint_as_float(r[1]); }
    return v;
}
__device__ __forceinline__ float row16_sum(float v) { v += dpp_f<0xB1>(v); v += dpp_f<0x4E>(v); v += dpp_f<0x141>(v); v += dpp_f<0x140>(v); return v; }
__device__ __forceinline__ float fast_sigmoid(float x) { return __builtin_amdgcn_rcpf(1.f + __expf(-x)); }
__device__ __forceinline__ float fast_silu(float x) { return x * fast_sigmoid(x); }
__device__ __forceinline__ float gelu_tanh(float x) { const float z = 0.7978845608028654f * (x + 0.044715f * x * x * x); const float t = 1.f - 2.f * __builtin_amdgcn_rcpf(__expf(2.f * z) + 1.f); return 0.5f * x * (1.f + t); }
__device__ __forceinline__ void sincos_rev(double rev, float& s, float& c) { const double fr = rev - rint(rev); const float y = (float)(fr * 6.283185307179586); s = sinf(y); c = cosf(y); }
__device__ __forceinline__ f32x2 cmul(f32x2 a, f32x2 b) { return (f32x2){a.x * b.x - a.y * b.y, a.x * b.y + a.y * b.x}; }

#define XB_TMO      128
#define XB_XCNT(j)  (256  + 64 * (j))
#define XB_XSUB(j)  (1280 + 64 * (j))
#define XB_XGEN(j)  (2304 + 64 * (j))
#define XB_TOP      3328
#define XB_TOPGEN   3392
#define XCD_BAR_WORDS 3456
#define XB_SPIN_CAP (1u << 22)
__device__ __forceinline__ unsigned xb_ld(unsigned* p)              { return __hip_atomic_load(p, __ATOMIC_RELAXED, __HIP_MEMORY_SCOPE_AGENT); }
__device__ __forceinline__ unsigned xb_add(unsigned* p, unsigned v) { return __hip_atomic_fetch_add(p, v, __ATOMIC_RELAXED, __HIP_MEMORY_SCOPE_AGENT); }
__device__ __forceinline__ unsigned xb_xcc_id() { return (unsigned)__builtin_amdgcn_s_getreg((3 << 11) | 20) & 0xFu; }
#define XB_SPIN(cond, bar) do { unsigned _sp = 0; while (cond) { __builtin_amdgcn_s_sleep(1); \
    if ((++_sp & 255u) == 0u) { if (xb_ld(&(bar)[XB_TMO])) break; if (_sp > XB_SPIN_CAP) { atomicAdd(&(bar)[XB_TMO], 1u); break; } } } } while (0)
struct XcdBarrier { unsigned* bar; unsigned x; volatile LAS unsigned* st; };
__device__ __forceinline__ XcdBarrier xcd_barrier_post(unsigned* bar, volatile LAS unsigned* st) {
    XcdBarrier b; b.bar = bar; b.x = xb_xcc_id(); b.st = st;
    if (threadIdx.x == 0) (void)xb_add(&bar[XB_XCNT(b.x)], 1u);
    return b;
}
__device__ __forceinline__ void xcd_barrier_complete(unsigned* bar, unsigned x, unsigned& nloc, unsigned& nx) {
    const unsigned G = gridDim.x * gridDim.y * gridDim.z;
    unsigned sum, cnt, mine, sp = 0u;
    for (;;) {
        sum = 0u; cnt = 0u; mine = 0u;
#pragma unroll
        for (unsigned j = 0; j < 16; ++j) { const unsigned c = xb_ld(&bar[XB_XCNT(j)]); sum += c; cnt += (c > 0u) ? 1u : 0u; mine = (j == x) ? c : mine; }
        if (sum == G) break;
        __builtin_amdgcn_s_sleep(1);
        if ((++sp & 255u) == 0u) { if (xb_ld(&bar[XB_TMO])) break; if (sp > XB_SPIN_CAP) { atomicAdd(&bar[XB_TMO], 1u); break; } }
    }
    nloc = mine > 0u ? mine : 1u; nx = cnt > 0u ? cnt : 1u;
}
__device__ __forceinline__ void xcd_barrier(const XcdBarrier& b) {
    asm volatile("s_waitcnt vmcnt(0)" ::: "memory");
    __syncthreads();
    if (threadIdx.x == 0) {
        unsigned* bar = b.bar;
        __builtin_amdgcn_s_waitcnt(0);
        unsigned nloc = b.st[0], nx = b.st[1];
        if (nloc == 0u) { xcd_barrier_complete(bar, b.x, nloc, nx); b.st[0] = nloc; b.st[1] = nx; }
        const unsigned old = xb_add(&bar[XB_XSUB(b.x)], 1u);
        const unsigned gen = old / nloc;
        if (old + 1u == (gen + 1u) * nloc) {
            __builtin_amdgcn_fence(__ATOMIC_RELEASE, "agent");
            asm volatile("s_waitcnt vmcnt(0)" ::: "memory");
            const unsigned og = xb_add(&bar[XB_TOP], 1u);
            const unsigned tg = og / nx;
            if (og + 1u == (tg + 1u) * nx) xb_add(&bar[XB_TOPGEN], 1u);
            else XB_SPIN(xb_ld(&bar[XB_TOPGEN]) == tg, bar);
            __builtin_amdgcn_fence(__ATOMIC_ACQUIRE, "agent");
            xb_add(&bar[XB_XGEN(b.x)], 1u);
            asm volatile("s_waitcnt vmcnt(0)" ::: "memory");
        } else {
            XB_SPIN(xb_ld(&bar[XB_XGEN(b.x)]) == gen, bar);
            __builtin_amdgcn_fence(__ATOMIC_ACQUIRE, "agent");
            asm volatile("s_waitcnt vmcnt(0)" ::: "memory");
        }
    }
    __syncthreads();
}

namespace pg8 {
constexpr int BM = 256, BK = 64, HALF = 128, HTB = HALF * BK * 2, NXCD = 8, WGM = 8;
__host__ __device__ __forceinline__ int lds_byte(int r, int c) { const int st = (r >> 4) * 2 + (c >> 5), rr = r & 15, cc = c & 31, ob = rr * 64 + cc * 2; return st * 1024 + (ob ^ (((ob >> 9) & 1) << 5)); }
__host__ __device__ __forceinline__ void stage_rc(int b, int& R, int& C) { const int st = b / 1024, sb = b % 1024, swz = sb ^ (((sb >> 9) & 1) << 5); R = (st >> 1) * 16 + swz / 64; C = (st & 1) * 32 + (swz % 64) / 2; }
__host__ __device__ __forceinline__ int perm32(int rho) { const int n = rho >> 4, i = rho & 15; return 8 * (i >> 2) + 4 * n + (i & 3); }

struct Unit { int pm, pn, z; long aoff, boff; };
struct Gemm { const bf16* A; const bf16* Bt; int K, lda, ldb; };

struct GridOrder {
    int nM, nN, nwg, G, c; long tA, tB;
    __device__ void init(int nM_, int nN_, int G_, int c_, int lda, int ldb) { nM = nM_; nN = nN_; nwg = nM * nN; G = G_; c = c_; tA = (long)BM * lda * 2; tB = (long)BM * ldb * 2; }
    __device__ __forceinline__ bool tile(long L, int& pm, int& pn) const {
        if (L >= nwg) return false;
        int wgid = (int)L; { const int q = nwg / NXCD, r = nwg % NXCD, xcd = wgid % NXCD, off = wgid / NXCD; wgid = (xcd < r ? xcd * (q + 1) : r * (q + 1) + (xcd - r) * q) + off; }
        const int nig = WGM * nN, gid = wgid / nig, fm = gid * WGM, gsz = (nM - fm) < WGM ? (nM - fm) : WGM;
        pm = fm + ((wgid % nig) % gsz); pn = (wgid % nig) / gsz; return true;
    }
    __device__ __forceinline__ bool next(int i, Unit& u) const {
        if (!tile((long)i * G + c, u.pm, u.pn)) return false;
        u.z = 0; u.aoff = u.pm * tA; u.boff = u.pn * tB; return true;
    }
};
struct BatchOrder {
    int nZ, nM, nN, G, c; long tA, tB, zA, zB;
    __device__ __forceinline__ bool next(int i, Unit& u) const {
        const long L = (long)i * G + c; if (L >= (long)nZ * nM * nN) return false;
        const int per = nM * nN; u.z = (int)(L / per); const int r = (int)(L % per); u.pm = r / nN; u.pn = r % nN;
        u.aoff = u.z * zA + u.pm * tA; u.boff = u.z * zB + u.pn * tB; return true;
    }
};
struct ExpertOrder {
    GridOrder g; const LAS unsigned* pend; long eB;
    __device__ __forceinline__ bool next(int i, Unit& u) const {
        if (!g.tile((long)i * g.G + g.c, u.pm, u.pn)) return false;
        int e = 0;
#pragma unroll
        for (int k = 0; k < 15; ++k) e += ((unsigned)u.pm >= pend[k]) ? 1 : 0;
        u.z = e; u.aoff = u.pm * g.tA; u.boff = e * eB + u.pn * g.tB; return true;
    }
};
struct InProj1Order {
    GridOrder g;
    __device__ __forceinline__ bool next(int i, Unit& u) const {
        const long L = (long)i * g.G + g.c;
        if (L < g.nwg) { g.tile(L, u.pm, u.pn); }
        else { const long Lc = L - g.nwg; if (Lc >= 32) return false; u.pm = 128 + (int)(Lc >> 3); u.pn = 4 + (int)(Lc & 7); }
        u.z = 0; u.aoff = u.pm * g.tA; u.boff = u.pn * g.tB; return true;
    }
};

typedef int i32x8 __attribute__((ext_vector_type(8)));
typedef int i32x4 __attribute__((ext_vector_type(4)));
__device__ __forceinline__ i32x8 cat8(bf16x8 a, bf16x8 b) { const i32x4 x = __builtin_bit_cast(i32x4, a), y = __builtin_bit_cast(i32x4, b); return (i32x8){x[0], x[1], x[2], x[3], y[0], y[1], y[2], y[3]}; }
template <bool FP8 = false, class Epi, class Sched>
__device__ __forceinline__ void gemm_phase(LAS unsigned char* lds, const Gemm g, const Sched& S, const Epi& E) {
    const int tid = threadIdx.x, wid = __builtin_amdgcn_readfirstlane(tid >> 6), lane = tid & 63, wr = wid >> 2, wc = wid & 3, fr = lane & 15, fq = lane >> 4;
    const int K = g.K, nt = K / BK;
    unsigned voffA[2], voffB[2];
#pragma unroll
    for (int i = 0; i < 2; ++i) { int R, C; stage_rc(tid * 16 + i * 8192, R, C); const int Rb = Epi::PERM ? ((R & ~31) + perm32(R & 31)) : R;
        voffA[i] = (unsigned)(R * g.lda + C) * 2u; voffB[i] = (unsigned)(Rb * g.ldb + C) * 2u; }
    const size_t kstep = (size_t)(BK * 2);
    const size_t hstepA = (size_t)HALF * g.lda * 2, hstepB = (size_t)HALF * g.ldb * 2;
    const unsigned ldsw = (unsigned)wid * 1024u;
    const int aoff = lds_byte(wr * 64 + fr, fq * 8), boff = lds_byte(wc * 32 + fr, fq * 8);
#define PG8_SA(b, h) (((b) * 2 + (h)) * HTB)
#define PG8_SB(b, h) ((4 + (b) * 2 + (h)) * HTB)
#define PG8_STAGE(bufoff, gbase, voff) do { _Pragma("unroll") for (int _i = 0; _i < 2; ++_i) \
        __builtin_amdgcn_global_load_lds((const unsigned*)((const char*)(gbase) + (voff)[_i]), (LAS unsigned*)(lds + (bufoff) + ldsw + _i * 8192), 16, 0, 0); } while (0)
#define PG8_LDA(dst, b, h) do { _Pragma("unroll") for (int m = 0; m < 4; ++m) dst[m] = cat8(*(const LAS bf16x8*)(lds + PG8_SA(b, h) + aoff + m * 2048), *(const LAS bf16x8*)(lds + PG8_SA(b, h) + aoff + m * 2048 + 1024)); } while (0)
#define PG8_LDB(dst, b, h) do { _Pragma("unroll") for (int n = 0; n < 2; ++n) dst[n] = cat8(*(const LAS bf16x8*)(lds + PG8_SB(b, h) + boff + n * 2048), *(const LAS bf16x8*)(lds + PG8_SB(b, h) + boff + n * 2048 + 1024)); } while (0)
#define PG8_Q(v, q) __builtin_bit_cast(long, __builtin_shufflevector(v, v, 2 * (q), 2 * (q) + 1))
#define PG8_HALF(v, k) __builtin_bit_cast(bf16x8, __builtin_shufflevector(v, v, 4 * (k), 4 * (k) + 1, 4 * (k) + 2, 4 * (k) + 3))
#define PG8_MMA(ai, bj, At, Bt) do { __builtin_amdgcn_s_setprio(1); _Pragma("unroll") for (int m = 0; m < 4; ++m) _Pragma("unroll") for (int n = 0; n < 2; ++n) { \
        if constexpr (FP8 && FP8_WIDE) asm volatile("v_mfma_f32_16x16x128_f8f6f4 %0, %1, %2, %0" : "+v"(acc[ai][bj][m][n]) : "v"(Bt[n]), "v"(At[m])); \
        else if constexpr (FP8) { acc[ai][bj][m][n] = __builtin_amdgcn_mfma_f32_16x16x32_fp8_fp8(PG8_Q(Bt[n], 0), PG8_Q(At[m], 0), acc[ai][bj][m][n], 0, 0, 0); acc[ai][bj][m][n] = __builtin_amdgcn_mfma_f32_16x16x32_fp8_fp8(PG8_Q(Bt[n], 1), PG8_Q(At[m], 1), acc[ai][bj][m][n], 0, 0, 0); \
            acc[ai][bj][m][n] = __builtin_amdgcn_mfma_f32_16x16x32_fp8_fp8(PG8_Q(Bt[n], 2), PG8_Q(At[m], 2), acc[ai][bj][m][n], 0, 0, 0); acc[ai][bj][m][n] = __builtin_amdgcn_mfma_f32_16x16x32_fp8_fp8(PG8_Q(Bt[n], 3), PG8_Q(At[m], 3), acc[ai][bj][m][n], 0, 0, 0); } \
        else { acc[ai][bj][m][n] = __builtin_amdgcn_mfma_f32_16x16x32_bf16(PG8_HALF(Bt[n], 0), PG8_HALF(At[m], 0), acc[ai][bj][m][n], 0, 0, 0); \
               acc[ai][bj][m][n] = __builtin_amdgcn_mfma_f32_16x16x32_bf16(PG8_HALF(Bt[n], 1), PG8_HALF(At[m], 1), acc[ai][bj][m][n], 0, 0, 0); } } __builtin_amdgcn_s_setprio(0); } while (0)
#define PG8_WAIT_V(n) asm volatile("s_waitcnt vmcnt(" #n ")" ::: "memory")
#define PG8_WAIT_L(n) asm volatile("s_waitcnt lgkmcnt(" #n ")" ::: "memory")
#define PG8_BAR __builtin_amdgcn_s_barrier()
#define PG8_SCHED __builtin_amdgcn_sched_barrier(0)
    Unit cur, nxt; int ui = 0;
    if (!S.next(0, cur)) return;
    f32x4 acc[2][2][4][2];
#pragma unroll
    for (int a = 0; a < 2; ++a)
#pragma unroll
        for (int b = 0; b < 2; ++b)
#pragma unroll
            for (int m = 0; m < 4; ++m)
#pragma unroll
                for (int n = 0; n < 2; ++n) acc[a][b][m][n] = (f32x4){0.f, 0.f, 0.f, 0.f};
    i32x8 At[4], B0[2], B1[2];
    const char* cA = (const char*)g.A + cur.aoff; const char* cB = (const char*)g.Bt + cur.boff;
    PG8_STAGE(PG8_SB(0, 0), cB, voffB); PG8_STAGE(PG8_SB(0, 1), cB + hstepB, voffB); PG8_STAGE(PG8_SA(0, 0), cA, voffA); PG8_STAGE(PG8_SA(0, 1), cA + hstepA, voffA);
    if (wr == 1) PG8_BAR;
    PG8_WAIT_V(2); PG8_BAR;
    PG8_STAGE(PG8_SB(1, 0), cB + kstep, voffB); PG8_STAGE(PG8_SA(1, 0), cA + kstep, voffA); PG8_STAGE(PG8_SB(1, 1), cB + hstepB + kstep, voffB);
    PG8_WAIT_V(6); PG8_BAR;
    for (;;) {
        const bool has_next = S.next(ui + 1, nxt);
        const char* nA = has_next ? (const char*)g.A + nxt.aoff : cA; const char* nB = has_next ? (const char*)g.Bt + nxt.boff : cB;
#pragma nounroll
        for (int t = 0; t < nt; t += 2) {
            const bool last = (t == nt - 2);
            const char* a1 = cA + (size_t)(t + 1) * kstep;
            const char* a2 = last ? nA : cA + (size_t)(t + 2) * kstep; const char* b2 = last ? nB : cB + (size_t)(t + 2) * kstep;
            const char* a3 = a2 + kstep; const char* b3 = b2 + kstep;
            PG8_LDB(B0, 0, 0); PG8_LDB(B1, 0, 1); PG8_SCHED; PG8_LDA(At, 0, 0); PG8_STAGE(PG8_SA(1, 1), a1 + hstepA, voffA);
            PG8_WAIT_V(8); PG8_WAIT_L(0); PG8_BAR; PG8_MMA(0, 0, At, B0); PG8_MMA(0, 1, At, B1); PG8_BAR; PG8_SCHED;
            PG8_LDA(At, 0, 1); PG8_STAGE(PG8_SB(0, 0), b2, voffB); PG8_STAGE(PG8_SB(0, 1), b2 + hstepB, voffB); PG8_STAGE(PG8_SA(0, 0), a2, voffA);
            PG8_WAIT_V(8); PG8_WAIT_L(0); PG8_BAR; PG8_MMA(1, 0, At, B0); PG8_MMA(1, 1, At, B1); PG8_BAR; PG8_SCHED;
            PG8_LDB(B0, 1, 0); PG8_LDB(B1, 1, 1); PG8_SCHED; PG8_LDA(At, 1, 0); PG8_STAGE(PG8_SA(0, 1), a2 + hstepA, voffA);
            PG8_WAIT_V(8); PG8_WAIT_L(0); PG8_BAR; PG8_MMA(0, 0, At, B0); PG8_MMA(0, 1, At, B1); PG8_BAR; PG8_SCHED;
            PG8_LDA(At, 1, 1); PG8_STAGE(PG8_SB(1, 0), b3, voffB); PG8_STAGE(PG8_SB(1, 1), b3 + hstepB, voffB); PG8_STAGE(PG8_SA(1, 0), a3, voffA);
            PG8_WAIT_V(8); PG8_WAIT_L(0); PG8_BAR; PG8_MMA(1, 0, At, B0); PG8_MMA(1, 1, At, B1); PG8_BAR; PG8_SCHED;
        }
        if (wr == 0) PG8_BAR;
        if constexpr (FP8 && FP8_WIDE) {
#pragma unroll
            for (int a = 0; a < 2; ++a)
#pragma unroll
                for (int b = 0; b < 2; ++b) asm volatile("s_nop 15" : "+v"(acc[a][b][0][0]), "+v"(acc[a][b][0][1]), "+v"(acc[a][b][1][0]), "+v"(acc[a][b][1][1]), "+v"(acc[a][b][2][0]), "+v"(acc[a][b][2][1]), "+v"(acc[a][b][3][0]), "+v"(acc[a][b][3][1])); }
        E(acc, cur, wr, wc, fr, fq);
        if (!has_next) break;
#pragma unroll
        for (int a = 0; a < 2; ++a)
#pragma unroll
            for (int b = 0; b < 2; ++b)
#pragma unroll
                for (int m = 0; m < 4; ++m)
#pragma unroll
                    for (int n = 0; n < 2; ++n) acc[a][b][m][n] = (f32x4){0.f, 0.f, 0.f, 0.f};
        cur = nxt; cA = nA; cB = nB; ++ui;
        if (wr == 1) PG8_BAR;
    }
    PG8_WAIT_V(0);
    PG8_BAR;
#undef PG8_SA
#undef PG8_SB
#undef PG8_STAGE
#undef PG8_LDA
#undef PG8_LDB
#undef PG8_MMA
#undef PG8_HALF
#undef PG8_Q
#undef PG8_WAIT_V
#undef PG8_WAIT_L
#undef PG8_BAR
#undef PG8_SCHED
}
}
namespace pg8 {
__device__ __forceinline__ u32x4 pack8(const f32x4 a, const f32x4 b) { u32x4 w; w.x = cvt_pk_bf16(a[0], a[1]); w.y = cvt_pk_bf16(a[2], a[3]); w.z = cvt_pk_bf16(b[0], b[1]); w.w = cvt_pk_bf16(b[2], b[3]); return w; }
typedef const f32x4 (&AccRef)[2][2][4][2];
__device__ __forceinline__ float clamp448(float x) { return __builtin_fminf(__builtin_fmaxf(x, -448.f), 448.f); }
__device__ __forceinline__ unsigned pack4_fp8(float a, float b, float c, float d) { int w = __builtin_amdgcn_cvt_pk_fp8_f32(clamp448(a), clamp448(b), 0, false); w = __builtin_amdgcn_cvt_pk_fp8_f32(clamp448(c), clamp448(d), w, true); return (unsigned)w; }
__device__ __forceinline__ unsigned char to_fp8(float x) { return (unsigned char)(__builtin_amdgcn_cvt_pk_fp8_f32(clamp448(x), 0.f, 0, false) & 0xff); }
constexpr float PSC_IN0 = PF_IN0 ? 0.03125f : 1.f, PSC_IN1 = PF_IN1 ? 0.03125f : 1.f, PSC_OUT0 = PF_OUT0 ? 0.03125f : 1.f, PSC_OUT1 = PF_OUT1 ? 0.03125f : 1.f;

struct EpiPlain {
    static constexpr bool PERM = true;
    bf16* O; int ldc;
    __device__ __forceinline__ void operator()(AccRef acc, const Unit& u, int wr, int wc, int fr, int fq) const {
        const int row0 = u.pm * BM + wr * 64 + fr, col0 = u.pn * BM + wc * 32 + 8 * fq;
#pragma unroll
        for (int ai = 0; ai < 2; ++ai)
#pragma unroll
            for (int m = 0; m < 4; ++m) { bf16* rowp = O + (size_t)(row0 + ai * HALF + m * 16) * ldc + col0;
#pragma unroll
                for (int bj = 0; bj < 2; ++bj) *(u32x4*)(rowp + bj * HALF) = pack8(acc[ai][bj][m][0], acc[ai][bj][m][1]); }
    }
};
struct EpiInProj0 {
    static constexpr bool PERM = true;
    bf16 *QK, *V, *G, *UA; const float *rc, *rs;
    __device__ __forceinline__ void operator()(AccRef acc, const Unit& u, int wr, int wc, int fr, int fq) const {
        const int row0 = u.pm * BM + wr * 64 + fr, pn = u.pn;
        if (pn < 3) {
            const int H = 4 * pn + wc;
            f32x4 rr[4]; const bool latu = u.pm * BM < NLAT;
#define ROPE0_LOAD(k_) do { const int row_ = row0 + ((k_) >> 2) * HALF + ((k_) & 3) * 16; f32x4* q_ = rr; \
                q_[0] = (f32x4){1.f, 1.f, 1.f, 1.f}; q_[1] = q_[0]; q_[2] = (f32x4){0.f, 0.f, 0.f, 0.f}; q_[3] = q_[2]; \
                if (latu) { const int pos = row_ & (SEQ - 1); const float* pc = rc + pos * 32 + 8 * fq; const float* ps = rs + pos * 32 + 8 * fq; \
                    q_[0] = *(const f32x4*)pc; q_[1] = *(const f32x4*)(pc + 4); q_[2] = *(const f32x4*)ps; q_[3] = *(const f32x4*)(ps + 4); } } while (0)
            ROPE0_LOAD(0);
#pragma unroll
            for (int k = 0; k < 8; ++k) { const int ai = k >> 2, m = k & 3;
                    const int row = row0 + ai * HALF + m * 16;
                    const f32x4 c0 = rr[0], c1 = rr[1], s0 = rr[2], s1 = rr[3];
                    const f32x4 a0 = acc[ai][0][m][0] * PSC_IN0, a1 = acc[ai][0][m][1] * PSC_IN0, b0 = acc[ai][1][m][0] * PSC_IN0, b1 = acc[ai][1][m][1] * PSC_IN0;
                    const f32x4 y10 = a0 * c0 - b0 * s0, y11 = a1 * c1 - b1 * s1, y20 = a0 * s0 + b0 * c0, y21 = a1 * s1 + b1 * c1;
                    if (k + 1 < 8) ROPE0_LOAD(k + 1);
                    bf16* rp = QK + (size_t)row * 768 + H * 64 + 8 * fq;
                    *(u32x4*)rp = pack8(y10, y11); *(u32x4*)(rp + 32) = pack8(y20, y21);
                }
#undef ROPE0_LOAD
        } else if (pn < 9) {
            bf16* base = pn < 6 ? V : G; const int colt = (pn < 6 ? pn - 3 : pn - 6) * BM + wc * 32 + 8 * fq;
#pragma unroll
            for (int ai = 0; ai < 2; ++ai)
#pragma unroll
                for (int m = 0; m < 4; ++m) { bf16* rowp = base + (size_t)(row0 + ai * HALF + m * 16) * 768 + colt;
#pragma unroll
                    for (int bj = 0; bj < 2; ++bj) *(u32x4*)(rowp + bj * HALF) = pack8(acc[ai][bj][m][0] * PSC_IN0, acc[ai][bj][m][1] * PSC_IN0); }
        } else {
#pragma unroll
            for (int ai = 0; ai < 2; ++ai)
#pragma unroll
                for (int m = 0; m < 4; ++m) { const int row = row0 + ai * HALF + m * 16;
#pragma unroll
                    for (int bj = 0; bj < 2; ++bj) { const int c = bj * HALF + wc * 32 + 8 * fq, g = c >> 4, p0 = c & 15;
                        *(u32x4*)(UA + ((size_t)g * S5ROWS + (row >> 5)) * 768 + (row & 31) * 16 + p0) = pack8(acc[ai][bj][m][0] * PSC_IN0, acc[ai][bj][m][1] * PSC_IN0); } }
        }
    }
};
struct EpiS5E {
    static constexpr bool PERM = false;
    float* EO;
    __device__ __forceinline__ void operator()(AccRef acc, const Unit& u, int wr, int wc, int fr, int fq) const {
        const int row0 = u.pm * BM + wr * 64 + fr, col0 = wc * 32 + 4 * fq;
#pragma unroll
        for (int ai = 0; ai < 2; ++ai)
#pragma unroll
            for (int m = 0; m < 4; ++m) { float* rowp = EO + ((size_t)u.z * S5ROWS + row0 + ai * HALF + m * 16) * 256 + col0;
#pragma unroll
                for (int bj = 0; bj < 2; ++bj)
#pragma unroll
                    for (int n = 0; n < 2; ++n) *(f32x4*)(rowp + bj * HALF + n * 16) = acc[ai][bj][m][n]; }
    }
};
struct EpiS5Y {
    static constexpr bool PERM = true;
    bf16* SG;
    __device__ __forceinline__ void operator()(AccRef acc, const Unit& u, int wr, int wc, int fr, int fq) const {
        const int row0 = u.pm * BM + wr * 64 + fr;
#pragma unroll
        for (int ai = 0; ai < 2; ++ai)
#pragma unroll
            for (int m = 0; m < 4; ++m) { const int cr = row0 + ai * HALF + m * 16;
                if (cr < NTOK / S5T) {
#pragma unroll
                    for (int bj = 0; bj < 2; ++bj) { const int cn0 = u.pn * BM + bj * HALF + wc * 32 + 8 * fq, i = cn0 >> 4, p0 = cn0 & 15;
                        f32x4 v0 = acc[ai][bj][m][0], v1 = acc[ai][bj][m][1];
#pragma unroll
                        for (int j = 0; j < 4; ++j) { v0[j] = gelu_tanh(v0[j]); v1[j] = gelu_tanh(v1[j]); }
                        *(u32x4*)(SG + (size_t)(cr * S5T + i) * 256 + u.z * 16 + p0) = pack8(v0, v1); } } }
    }
};
struct EpiGlu {
    static constexpr bool PERM = true;
    bf16* MRG;
    __device__ __forceinline__ void operator()(AccRef acc, const Unit& u, int wr, int wc, int fr, int fq) const {
        const int row0 = u.pm * BM + wr * 64 + fr, col0 = 768 + u.pn * HALF + wc * 32 + 8 * fq;
#pragma unroll
        for (int ai = 0; ai < 2; ++ai)
#pragma unroll
            for (int m = 0; m < 4; ++m) { f32x4 v0, v1;
#pragma unroll
                for (int j = 0; j < 4; ++j) { v0[j] = acc[ai][0][m][0][j] * fast_sigmoid(acc[ai][1][m][0][j]); v1[j] = acc[ai][0][m][1][j] * fast_sigmoid(acc[ai][1][m][1][j]); }
                if (PF_OUT0) { u32x2 w; w.x = pack4_fp8(v0[0], v0[1], v0[2], v0[3]); w.y = pack4_fp8(v1[0], v1[1], v1[2], v1[3]); *(u32x2*)((unsigned char*)MRG + (size_t)(row0 + ai * HALF + m * 16) * 1024 + col0) = w; }
                else *(u32x4*)(MRG + (size_t)(row0 + ai * HALF + m * 16) * 1024 + col0) = pack8(v0, v1); }
    }
};
struct EpiSwiGlu {
    static constexpr bool PERM = true;
    bf16* HID;
    __device__ __forceinline__ void operator()(AccRef acc, const Unit& u, int wr, int wc, int fr, int fq) const {
        const int row0 = u.pm * BM + wr * 64 + fr, col0 = u.pn * HALF + wc * 32 + 8 * fq;
#pragma unroll
        for (int ai = 0; ai < 2; ++ai)
#pragma unroll
            for (int m = 0; m < 4; ++m) { f32x4 v0, v1;
#pragma unroll
                for (int j = 0; j < 4; ++j) { v0[j] = fast_silu(acc[ai][0][m][0][j]) * acc[ai][1][m][0][j]; v1[j] = fast_silu(acc[ai][0][m][1][j]) * acc[ai][1][m][1][j]; }
                *(u32x4*)(HID + (size_t)(row0 + ai * HALF + m * 16) * 1024 + col0) = pack8(v0, v1); }
    }
};
struct EpiSwiGlu8 {
    static constexpr bool PERM = true;
    unsigned char* HID;
    __device__ __forceinline__ void operator()(AccRef acc, const Unit& u, int wr, int wc, int fr, int fq) const {
        const int row0 = u.pm * BM + wr * 64 + fr, col0 = u.pn * HALF + wc * 32 + 8 * fq;
#pragma unroll
        for (int ai = 0; ai < 2; ++ai)
#pragma unroll
            for (int m = 0; m < 4; ++m) { f32x4 v0, v1;
#pragma unroll
                for (int j = 0; j < 4; ++j) { v0[j] = fast_silu(acc[ai][0][m][0][j] * 0.03125f) * (acc[ai][1][m][0][j] * 0.03125f); v1[j] = fast_silu(acc[ai][0][m][1][j] * 0.03125f) * (acc[ai][1][m][1][j] * 0.03125f); }
                u32x2 w; w.x = pack4_fp8(v0[0], v0[1], v0[2], v0[3]); w.y = pack4_fp8(v1[0], v1[1], v1[2], v1[3]);
                *(u32x2*)(HID + (size_t)(row0 + ai * HALF + m * 16) * 1024 + col0) = w; }
    }
};
struct EpiPlainS {
    static constexpr bool PERM = true;
    bf16* O; int ldc; float sc;
    __device__ __forceinline__ void operator()(AccRef acc, const Unit& u, int wr, int wc, int fr, int fq) const {
        const int row0 = u.pm * BM + wr * 64 + fr, col0 = u.pn * BM + wc * 32 + 8 * fq;
#pragma unroll
        for (int ai = 0; ai < 2; ++ai)
#pragma unroll
            for (int m = 0; m < 4; ++m) { bf16* rowp = O + (size_t)(row0 + ai * HALF + m * 16) * ldc + col0;
#pragma unroll
                for (int bj = 0; bj < 2; ++bj) *(u32x4*)(rowp + bj * HALF) = pack8(acc[ai][bj][m][0] * sc, acc[ai][bj][m][1] * sc); }
    }
};
struct EpiInProj1 {
    static constexpr bool PERM = true;
    bf16 *Q, *Kb, *Vb; const float* rope;
    __device__ __forceinline__ void operator()(AccRef acc, const Unit& u, int wr, int wc, int fr, int fq) const {
        const int row0 = u.pm * BM + wr * 64 + fr, pn = u.pn;
        const bool lat = u.pm * BM < NLAT;
        if (pn < 8) {
            if (!lat && pn < 4) return;
            const int sh = 4 * (pn & 3) + wc, dim = (fq < 2 ? 0 : 32) + 8 * (fq & 1);
            f32x4 rr[4];
#define ROPE1_LOAD(k_) do { const int row_ = row0 + ((k_) >> 2) * HALF + ((k_) & 3) * 16; const int t_ = row_ & (SEQ - 1); const int pos = (fq < 2) ? (t_ >> 6) : (t_ & 63); const float* pc = rope + pos * 16 + 8 * (fq & 1); \
                rr[0] = *(const f32x4*)pc; rr[1] = *(const f32x4*)(pc + 4); rr[2] = *(const f32x4*)(pc + 2048); rr[3] = *(const f32x4*)(pc + 2048 + 4); } while (0)
            if (lat) ROPE1_LOAD(0); else { rr[0] = (f32x4){1.f, 1.f, 1.f, 1.f}; rr[1] = rr[0]; rr[2] = (f32x4){0.f, 0.f, 0.f, 0.f}; rr[3] = rr[2]; }
#pragma unroll
            for (int k = 0; k < 8; ++k) { const int ai = k >> 2, m = k & 3;
                const int row = row0 + ai * HALF + m * 16;
                const int b = lat ? (row >> 13) : ((row - NLAT) >> 8), t = lat ? (row & (SEQ - 1)) : ((row - NLAT) & 255);
                const size_t krow = (size_t)b * (SEQ + CTXL) + (lat ? t : SEQ + t);
                const f32x4 c0 = rr[0], c1 = rr[1], s0 = rr[2], s1 = rr[3];
                const f32x4 a0 = acc[ai][0][m][0] * PSC_IN1, a1 = acc[ai][0][m][1] * PSC_IN1, b0 = acc[ai][1][m][0] * PSC_IN1, b1 = acc[ai][1][m][1] * PSC_IN1;
                const f32x4 y10 = a0 * c0 - b0 * s0, y11 = a1 * c1 - b1 * s1, y20 = a0 * s0 + b0 * c0, y21 = a1 * s1 + b1 * c1;
                if (lat && k + 1 < 8) ROPE1_LOAD(k + 1);
                unsigned char* rp = (pn < 4) ? ((unsigned char*)Q + (size_t)row * 1024) : ((unsigned char*)Kb + krow * 1024);
                rp += sh * 64 + dim;
                u32x2 w1, w2; w1.x = pack4_fp8(y10[0], y10[1], y10[2], y10[3]); w1.y = pack4_fp8(y11[0], y11[1], y11[2], y11[3]); w2.x = pack4_fp8(y20[0], y20[1], y20[2], y20[3]); w2.y = pack4_fp8(y21[0], y21[1], y21[2], y21[3]);
                *(u32x2*)rp = w1; *(u32x2*)(rp + 16) = w2; }
#undef ROPE1_LOAD
        } else {
#pragma unroll
            for (int k = 0; k < 8; ++k) { const int ai = k >> 2, m = k & 3;
                const int row = row0 + ai * HALF + m * 16;
                const int b = lat ? (row >> 13) : ((row - NLAT) >> 8), t = lat ? (row & (SEQ - 1)) : ((row - NLAT) & 255);
                const size_t krow = (size_t)b * (SEQ + CTXL) + (lat ? t : SEQ + t);
                bf16* rp = Vb + krow * 1024 + (pn - 8) * BM + wc * 32 + 8 * fq;
#pragma unroll
                for (int bj = 0; bj < 2; ++bj) *(u32x4*)(rp + bj * HALF) = pack8(acc[ai][bj][m][0] * PSC_IN1, acc[ai][bj][m][1] * PSC_IN1); }
        }
    }
};
}
enum InIdx { I_X = 0, I_C, I_CTX, I_CCTX, I_ADAW, I_ADAB, I_LNG, I_WINAB, I_DECAY, I_LAMRE, I_LAMIM, I_LOGDT, I_BRE, I_BIM, I_CRE, I_CIM, I_S5D, I_WGLU,
             I_WOUTAB, I_WINC, I_DLAM, I_SUBLN, I_WOUTC, I_RW, I_RB, I_EG, I_EU, I_ED, N_IN };
struct Params { const float* in[N_IN]; float* out; unsigned char* ws; int ph_lo, ph_hi; };
#if defined(__HIP_DEVICE_COMPILE__)
#define CAS __attribute__((address_space(4)))
#else
#define CAS
#endif
typedef const CAS Params& PR;

struct Frame {
    LAS unsigned char* lds; int tid, lane, wave, G, bid, vcu;
};
#define WSP(T, off) ((T*)(p.ws + (off)))

__device__ __forceinline__ void p0_gemv_item(PR p, Frame& F, int item) {
    LAS float* sc = (LAS float*)F.lds;
    LAS float* red = (LAS float*)(F.lds + 20480);
    const float* c = p.in[I_C]; const float* cctx = p.in[I_CCTX];
    for (int i = F.tid; i < 5120; i += NTHREADS) { const int r = i >> 10, k = i & 1023; const float v = r < 4 ? c[r * 1024 + k] : cctx[k]; sc[i] = v / (1.f + expf(-v)); }
    __syncthreads();
    const int l = item / 96, cb = item % 96, jj = F.tid & 63, kp = F.tid >> 6;
    const float* W = p.in[I_ADAW] + (size_t)l * 1024 * 6144 + cb * 64 + jj;
    float a0 = 0.f, a1 = 0.f, a2 = 0.f, a3 = 0.f, a4 = 0.f;
#pragma unroll 16
    for (int k = kp * 128; k < kp * 128 + 128; ++k) { const float w = __builtin_nontemporal_load(W + (size_t)k * 6144);     a0 += sc[k] * w; a1 += sc[1024 + k] * w; a2 += sc[2048 + k] * w; a3 += sc[3072 + k] * w; a4 += sc[4096 + k] * w; }
    red[(kp * 5 + 0) * 64 + jj] = a0; red[(kp * 5 + 1) * 64 + jj] = a1; red[(kp * 5 + 2) * 64 + jj] = a2; red[(kp * 5 + 3) * 64 + jj] = a3; red[(kp * 5 + 4) * 64 + jj] = a4;
    __syncthreads();
    if (F.tid < 320) { const int r = F.tid >> 6, j = F.tid & 63; float s = 0.f;
#pragma unroll
        for (int q = 0; q < 8; ++q) s += red[(q * 5 + r) * 64 + j];
        WSP(float, WS_MOD)[(l * 5 + r) * 6144 + cb * 64 + j] = s + p.in[I_ADAB][l * 6144 + cb * 64 + j]; }
    __syncthreads();
}
__device__ __forceinline__ void p0_s5_item(PR p, Frame& F, int item) {
    const int g = item >> 1, dir = item & 1;
    LAS f32x2* lamp = (LAS f32x2*)F.lds;
    LAS f32x2* coef = lamp + 64 * 33;
    const float dt = expf(p.in[I_LOGDT][dir * 16 + g]);
    for (int i = F.tid; i < 64 * 33; i += NTHREADS) { const int n = i / 33, tau = i % 33;
        const float re = p.in[I_LAMRE][(dir * 16 + g) * 64 + n], im = p.in[I_LAMIM][(dir * 16 + g) * 64 + n];
        const float mag = expf(re * dt * (float)tau); float s, c; sincos_rev((double)im * (double)dt * (double)tau * 0.15915494309189535, s, c);
        const f32x2 v = (f32x2){mag * c, mag * s}; lamp[i] = v; WSP(f32x2, WS_LAMP)[((g * 2 + dir) * 64 + n) * 33 + tau] = v; }
    __syncthreads();
    if (F.tid < 64) { const int n = F.tid; const float re = p.in[I_LAMRE][(dir * 16 + g) * 64 + n], im = p.in[I_LAMIM][(dir * 16 + g) * 64 + n];
        const f32x2 lb = lamp[n * 33 + 1]; const float a = lb.x - 1.f, b = lb.y, den = re * re + im * im;
        const f32x2 v = (f32x2){(a * re + b * im) / den, (b * re - a * im) / den}; coef[n] = v; WSP(f32x2, WS_COEF)[(g * 2 + dir) * 64 + n] = v; }
    __syncthreads();
    const float* bre = p.in[I_BRE] + (size_t)(dir * 16 + g) * 64 * 16; const float* bim = p.in[I_BIM] + (size_t)(dir * 16 + g) * 64 * 16;
    const float* cre = p.in[I_CRE] + (size_t)(dir * 16 + g) * 16 * 64; const float* cim = p.in[I_CIM] + (size_t)(dir * 16 + g) * 16 * 64;
    for (int idx = F.tid; idx < 32 * 256; idx += NTHREADS) { const int tau = idx >> 8, pp = (idx >> 4) & 15, q = idx & 15; float acc = 0.f;
        for (int n = 0; n < 64; ++n) { const f32x2 w = cmul(lamp[n * 33 + tau], coef[n]); const f32x2 bb = cmul(w, (f32x2){bre[n * 16 + q], bim[n * 16 + q]});
            acc += cre[pp * 64 + n] * bb.x - cim[pp * 64 + n] * bb.y; }
        WSP(float, WS_S5K)[((g * 2 + dir) * 32 + tau) * 256 + pp * 16 + q] = acc; }
    __syncthreads();
}
__device__ __forceinline__ int tr_drow(int mode, int n) {
    switch (mode) {
    case 1: if (n < 768) { const int H = n >> 6, half = (n >> 5) & 1, dd = n & 31; return (H >> 2) * 256 + half * 128 + (H & 3) * 32 + dd; } return n;
    case 2: if (n < 2048) { const int base = n & ~1023, c = n & 1023, sh = c >> 6, grp = (c >> 4) & 3; return base + (sh >> 2) * 256 + (grp & 1) * 128 + (sh & 3) * 32 + (grp >> 1) * 16 + (c & 15); } return n;
    case 3: return ((n & 255) >> 7) * 256 + (n >> 8) * 128 + (n & 127);
    case 4: return (n >> 7) * 256 + (n & 127);
    case 5: return (n >> 7) * 256 + 128 + (n & 127);
    default: return n; }
}
__device__ __forceinline__ float tr_scale(int mode, int n) { if (mode == 1) return (n >= 384 && n < 768) ? 0.125f : 1.f; if (mode == 2) return n < 1024 ? 0.5f * 1.4426950408889634f : (n < 2048 ? 0.25f : 1.f); return 1.f; }
struct TrItem { const float* W; bf16* WT; int K, N, mode, item, f8; };
__device__ __forceinline__ void tr_load(const TrItem& d, f32x4 (&t)[8], int lane) {
    const int nblk = d.N / 32, kb = d.item / nblk, nb = d.item % nblk, k0 = 64 * kb, n0 = 32 * nb, kq = lane >> 3, nq = (lane & 7) * 4;
#pragma unroll
    for (int i = 0; i < 8; ++i) t[i] = __builtin_nontemporal_load((const f32x4*)(d.W + (size_t)(k0 + 8 * i + kq) * d.N + n0 + nq));
}
__device__ __forceinline__ void tr_finish(const TrItem& d, const f32x4 (&t)[8], LAS float* scr, int lane) {
    const int nblk = d.N / 32, kb = d.item / nblk, nb = d.item % nblk, k0 = 64 * kb, n0 = 32 * nb, kq = lane >> 3, nq = (lane & 7) * 4;
    const float sca = tr_scale(d.mode, n0);
#pragma unroll
    for (int i = 0; i < 8; ++i) { LAS float* q = scr + (8 * i + kq) * 33 + nq; q[0] = t[i][0] * sca; q[1] = t[i][1] * sca; q[2] = t[i][2] * sca; q[3] = t[i][3] * sca; }
    asm volatile("s_waitcnt lgkmcnt(0)" ::: "memory");
    const int c = lane & 7;
#pragma unroll
    for (int j = 0; j < 4; ++j) { const int n = (lane >> 3) + 8 * j; const LAS float* s = scr + (8 * c) * 33 + n;
        if (d.f8) { u32x2 o; o.x = pg8::pack4_fp8(s[0 * 33] * 32.f, s[1 * 33] * 32.f, s[2 * 33] * 32.f, s[3 * 33] * 32.f); o.y = pg8::pack4_fp8(s[4 * 33] * 32.f, s[5 * 33] * 32.f, s[6 * 33] * 32.f, s[7 * 33] * 32.f);
            *(u32x2*)((unsigned char*)d.WT + (size_t)tr_drow(d.mode, n0 + n) * d.K + k0 + 8 * c) = o; }
        else { u32x4 o; o.x = cvt_pk_bf16(s[0 * 33], s[1 * 33]); o.y = cvt_pk_bf16(s[2 * 33], s[3 * 33]); o.z = cvt_pk_bf16(s[4 * 33], s[5 * 33]); o.w = cvt_pk_bf16(s[6 * 33], s[7 * 33]);
            *(u32x4*)(d.WT + (size_t)tr_drow(d.mode, n0 + n) * d.K + k0 + 8 * c) = o; } }
    asm volatile("s_waitcnt lgkmcnt(0)" ::: "memory");
}
constexpr int TR_T0 = 1280, TR_T1 = TR_T0 + 64, TR_T2 = TR_T1 + 512, TR_T3 = TR_T2 + 1536, TR_T4 = TR_T3 + 512, TR_T5 = TR_T4 + 49152;
__device__ __forceinline__ TrItem tr_decode(PR p, int it) {
    TrItem d; d.f8 = 0;
    if (it < TR_T0) { d.W = p.in[I_WINAB]; d.WT = WSP(bf16, WS_WIN0); d.K = 1024; d.N = 2560; d.mode = 1; d.item = it; d.f8 = PF_IN0; }
    else if (it < TR_T1) { d.W = p.in[I_WGLU]; d.WT = WSP(bf16, WS_WGLU); d.K = 256; d.N = 512; d.mode = 3; d.item = it - TR_T0; }
    else if (it < TR_T2) { d.W = p.in[I_WOUTAB]; d.WT = WSP(bf16, WS_WOUT0); d.K = 1024; d.N = 1024; d.mode = 0; d.item = it - TR_T1; d.f8 = PF_OUT0; }
    else if (it < TR_T3) { d.W = p.in[I_WINC]; d.WT = WSP(bf16, WS_WIN1); d.K = 1024; d.N = 3072; d.mode = 2; d.item = it - TR_T2; d.f8 = PF_IN1; }
    else if (it < TR_T4) { d.W = p.in[I_WOUTC]; d.WT = WSP(bf16, WS_WOUT1); d.K = 1024; d.N = 1024; d.mode = 0; d.item = it - TR_T3; d.f8 = PF_OUT1; }
    else { const int r = it - TR_T4, le = r / 1536, r1 = r % 1536, which = r1 / 512;
        d.W = p.in[which == 0 ? I_EG : (which == 1 ? I_EU : I_ED)] + (size_t)le * 1024 * 1024;
        d.WT = (bf16*)(p.ws + WS_EXP + (size_t)le * EXP_STRIDE + (which == 2 ? EXP_DN : 0)); d.K = 1024; d.N = 1024; d.mode = which == 0 ? 4 : (which == 1 ? 5 : 0); d.item = r1 % 512; d.f8 = MOE_FP8; }
    return d;
}
__device__ __forceinline__ void p0a_prologue(PR p, Frame& F) {
    for (int it = F.bid; it < 224; it += F.G) { if (it < 192) p0_gemv_item(p, F, it); else p0_s5_item(p, F, it - 192); }
    LAS float* scr = (LAS float*)(F.lds + F.wave * 16384);
    const int gw = F.vcu * NWAVES + F.wave, NGW = F.G * NWAVES;
    { f32x4 ta[8], tb[8]; int it = gw;
      TrItem da = tr_decode(p, it < TR_T5 ? it : 0), db = da;
      if (it < TR_T5) tr_load(da, ta, F.lane);
      while (it < TR_T5) {
          const int nx = it + NGW;
          if (nx < TR_T5) { db = tr_decode(p, nx); tr_load(db, tb, F.lane); }
          tr_finish(da, ta, scr, F.lane);
          it = nx; if (it >= TR_T5) break;
          const int nx2 = it + NGW;
          if (nx2 < TR_T5) { da = tr_decode(p, nx2); tr_load(da, ta, F.lane); }
          tr_finish(db, tb, scr, F.lane);
          it = nx2;
      } }
    const int gt = F.bid * NTHREADS + F.tid, NGT = F.G * NTHREADS;
    for (int i = gt; i < SEQ * 32 + 128 * 16 + 1; i += NGT) {
        if (i < SEQ * 32) { const int pos = i >> 5, k = i & 31; const float inv = powf(10000.f, -(float)(2 * k) / 64.f); const float ang = (float)pos * inv; float s, c; sincos_rev((double)ang * 0.15915494309189535, s, c);
            WSP(float, WS_ROPE0C)[i] = c; WSP(float, WS_ROPE0S)[i] = s; }
        else if (i < SEQ * 32 + 2048) { const int j = i - SEQ * 32, pos = j >> 4, k = j & 15; const float inv = powf(10000.f, -(float)(2 * k) / 32.f); const float ang = (float)pos * inv; float s, c; sincos_rev((double)ang * 0.15915494309189535, s, c);
            WSP(float, WS_ROPE1)[j] = c; WSP(float, WS_ROPE1)[2048 + j] = s; }
        else { const float* dl = p.in[I_DLAM]; float s0 = 0.f, s1 = 0.f; for (int k = 0; k < 64; ++k) { s0 += dl[k] * dl[64 + k]; s1 += dl[128 + k] * dl[192 + k]; }
            WSP(float, WS_SCAL)[0] = expf(s0) - expf(s1) + LAMBDA_INIT; }
    }
}

__device__ __forceinline__ void modulate_row(const float* xrow, const float* shift, const float* scale, bf16* orow, int lane) {
#pragma unroll
    for (int j = 0; j < 4; ++j) { const int c = 4 * lane + 256 * j; const f32x4 x = *(const f32x4*)(xrow + c), sh = *(const f32x4*)(shift + c), sc = *(const f32x4*)(scale + c);
        const f32x4 h = x * (sc + 1.f) + sh; u32x2 w; w.x = cvt_pk_bf16(h[0], h[1]); w.y = cvt_pk_bf16(h[2], h[3]); *(u32x2*)(orow + c) = w; }
}
__device__ __forceinline__ void p0b_phase(PR p, Frame& F) {
    const int gw = F.vcu * NWAVES + F.wave, NGW = F.G * NWAVES;
    const float* mod = WSP(float, WS_MOD);
    bf16* H0 = WSP(bf16, A_H0);
    f32x4 sh0[4], sc0[4], sh1[4], sc1[4]; int bc0 = -1, bc1 = -1;
    for (int r0 = gw; r0 < NTOK; r0 += 2 * NGW) {
        const int r1 = r0 + NGW; const bool has1 = r1 < NTOK;
        const bool lat0 = r0 < NLAT, lat1 = r1 < NLAT; const int b0 = lat0 ? (r0 >> 13) : 4, b1 = lat1 ? (r1 >> 13) : 4;
        if (b0 != bc0) { bc0 = b0;
#pragma unroll
            for (int j = 0; j < 4; ++j) { const int cc = 4 * F.lane + 256 * j; sh0[j] = *(const f32x4*)(mod + b0 * 6144 + cc); sc0[j] = *(const f32x4*)(mod + b0 * 6144 + 1024 + cc); } }
        if (b1 != bc1) { bc1 = b1;
#pragma unroll
            for (int j = 0; j < 4; ++j) { const int cc = 4 * F.lane + 256 * j; sh1[j] = *(const f32x4*)(mod + b1 * 6144 + cc); sc1[j] = *(const f32x4*)(mod + b1 * 6144 + 1024 + cc); } }
        const float* x0 = lat0 ? p.in[I_X] + (size_t)r0 * DM : p.in[I_CTX] + (size_t)(r0 - NLAT) * DM;
        const float* x1 = has1 ? (lat1 ? p.in[I_X] + (size_t)r1 * DM : p.in[I_CTX] + (size_t)(r1 - NLAT) * DM) : x0;
        f32x4 a[4], c[4];
#pragma unroll
        for (int j = 0; j < 4; ++j) { a[j] = __builtin_nontemporal_load((const f32x4*)(x0 + 4 * F.lane + 256 * j)); c[j] = __builtin_nontemporal_load((const f32x4*)(x1 + 4 * F.lane + 256 * j));     }
#pragma unroll
        for (int j = 0; j < 4; ++j) { const int cc = 4 * F.lane + 256 * j; const f32x4 sh = sh0[j], sc = sc0[j];
            const f32x4 h = a[j] * (sc + 1.f) + sh;
            if (PF_IN0) *(unsigned*)((unsigned char*)H0 + (size_t)r0 * DM + cc) = pg8::pack4_fp8(h[0], h[1], h[2], h[3]);
            else { u32x2 w; w.x = cvt_pk_bf16(h[0], h[1]); w.y = cvt_pk_bf16(h[2], h[3]); *(u32x2*)(H0 + (size_t)r0 * DM + cc) = w; } }
        if (has1) {
#pragma unroll
            for (int j = 0; j < 4; ++j) { const int cc = 4 * F.lane + 256 * j; const f32x4 sh = sh1[j], sc = sc1[j];
                const f32x4 h = c[j] * (sc + 1.f) + sh;
                if (PF_IN0) *(unsigned*)((unsigned char*)H0 + (size_t)r1 * DM + cc) = pg8::pack4_fp8(h[0], h[1], h[2], h[3]);
                else { u32x2 w; w.x = cvt_pk_bf16(h[0], h[1]); w.y = cvt_pk_bf16(h[2], h[3]); *(u32x2*)(H0 + (size_t)r1 * DM + cc) = w; } } }
    }
    const int gt = F.bid * NTHREADS + F.tid, NGT = F.G * NTHREADS;
    const float* S5K = WSP(float, WS_S5K); const f32x2* LAMP = WSP(f32x2, WS_LAMP); const f32x2* COEF = WSP(f32x2, WS_COEF);
    bf16* BT2 = WSP(bf16, WS_BT2); bf16* BT1 = WSP(bf16, WS_BT1);
    for (int idx = gt; idx < 16 * 512 * 96; idx += NGT) {
        const int g = idx / (512 * 96), n = (idx / 96) % 512, k0 = (idx % 96) * 8, i = n >> 4, pp = n & 15; float v[8];
        if (k0 < 512) { const int j = k0 >> 4, q0 = k0 & 15;
            const int dd = i - j, dsel = dd < 0 ? 1 : 0, tau = dd < 0 ? -dd : dd; const bool diag = dd == 0;
            const float* t0 = S5K + ((g * 2 + dsel) * 32 + tau) * 256 + pp * 16 + q0; const float* t1 = S5K + ((g * 2 + 1) * 32) * 256 + pp * 16 + q0;
            float xa[8], xb[8];
#pragma unroll
            for (int t = 0; t < 8; ++t) { xa[t] = t0[t]; xb[t] = t1[t]; }
            const float dv = p.in[I_S5D][g * 16 + pp];
#pragma unroll
            for (int t = 0; t < 8; ++t) v[t] = diag ? (xa[t] + xb[t] + ((pp == q0 + t) ? dv : 0.f)) : xa[t];
        } else { const int kk0 = k0 - 512, dir = kk0 >> 7, ri = (kk0 >> 6) & 1, nn0 = kk0 & 63, pw = dir == 0 ? i + 1 : S5T - i;
#pragma unroll
            for (int t = 0; t < 8; ++t) { const int nn = nn0 + t; const f32x2 cc = (f32x2){p.in[I_CRE][((dir * 16 + g) * 16 + pp) * 64 + nn], p.in[I_CIM][((dir * 16 + g) * 16 + pp) * 64 + nn]};
                const f32x2 w = cmul(cc, LAMP[((g * 2 + dir) * 64 + nn) * 33 + pw]); v[t] = ri == 0 ? w.x : -w.y; }
        }
        u32x4 o; o.x = cvt_pk_bf16(v[0], v[1]); o.y = cvt_pk_bf16(v[2], v[3]); o.z = cvt_pk_bf16(v[4], v[5]); o.w = cvt_pk_bf16(v[6], v[7]);
        *(u32x4*)(BT2 + ((size_t)g * 512 + n) * 768 + k0) = o;
    }
    for (int idx = gt; idx < 16 * 256 * 64; idx += NGT) {
        const int g = idx / (256 * 64), n = (idx / 64) % 256, k0 = (idx % 64) * 8, j = k0 >> 4, q0 = k0 & 15, dir = n >> 7, ri = (n >> 6) & 1, nn = n & 63, pw = dir == 0 ? (S5T - 1 - j) : j;
        const f32x2 w = cmul(LAMP[((g * 2 + dir) * 64 + nn) * 33 + pw], COEF[(g * 2 + dir) * 64 + nn]); float v[8];
#pragma unroll
        for (int t = 0; t < 8; ++t) { const int q = q0 + t; const f32x2 bb = cmul(w, (f32x2){p.in[I_BRE][((dir * 16 + g) * 64 + nn) * 16 + q], p.in[I_BIM][((dir * 16 + g) * 64 + nn) * 16 + q]}); v[t] = ri == 0 ? bb.x : bb.y; }
        u32x4 o; o.x = cvt_pk_bf16(v[0], v[1]); o.y = cvt_pk_bf16(v[2], v[3]); o.z = cvt_pk_bf16(v[4], v[5]); o.w = cvt_pk_bf16(v[6], v[7]);
        *(u32x4*)(BT1 + ((size_t)g * 256 + n) * 512 + k0) = o;
    }
}
__device__ __forceinline__ void ret_unit(int unit, int& bh, int& h, int& r0) {
    const int cch = unit % RNCH; bh = unit / RNCH; h = bh % RH; const int b = bh / RH;
    r0 = cch < 64 ? b * SEQ + cch * RC : NLAT + b * CTXL + (cch - 64) * RC;
}
__device__ __forceinline__ float log_gamma(PR p, int dir, int h) { const float x = p.in[I_DECAY][dir * RH + h]; return -log1pf(expf(-x)); }
struct RetDeal { int u, stride, end; };
__device__ __forceinline__ RetDeal ret_deal(int c, int G, int NG, int a, int total) {
    RetDeal d;
    if (G <= NG) { d.u = c; d.stride = G; d.end = total; }
    else if (c < NG) { d.u = c; d.stride = NG; d.end = NG * a; }
    else { d.u = NG * a + (c - NG); d.stride = G - NG; d.end = total; }
    return d;
}
constexpr int RT_LD = 136;
__device__ __forceinline__ unsigned img_off(unsigned row, unsigned ch) { return 256u * row + 16u * (ch ^ (((row & 3) << 2) | ((row >> 2) & 3))); }
__device__ __forceinline__ unsigned tr16_addr(unsigned lane, unsigned c, unsigned t) { const unsigned g = lane >> 4, q = (lane & 15) >> 2, pp = lane & 3; return img_off(8 * g + 4 * t + q, 2 * c + (pp >> 1)) + 8 * (pp & 1); }
template <int OFF> __device__ __forceinline__ s16x4 tr16_read(unsigned a) { s16x4 r; asm volatile("ds_read_b64_tr_b16 %0, %1 offset:%2" : "=&v"(r) : "v"(a), "i"(OFF) : "memory"); return r; }
#define TR_PK(L, H) ((bf16x8){L[0], L[1], L[2], L[3], H[0], H[1], H[2], H[3]})
__device__ __forceinline__ void ret_stage_v(const bf16* V, int r0, int h, LAS char* img, int tid) {
#pragma unroll
    for (int i = 0; i < 4; ++i) { const int id = tid + 512 * i, j = id >> 4, ch = id & 15;
        *(LAS u32x4*)(img + img_off(j, ch)) = *(const u32x4*)(V + (size_t)(r0 + j) * 768 + h * 128 + 8 * ch); }
}
__device__ __forceinline__ void ret_stage_vt(const bf16* V, int r0, int h, LAS bf16* VT, int tid) {
#pragma unroll
    for (int i = 0; i < 4; ++i) { const int id = tid + 512 * i, j = id >> 4, e0 = (id & 15) * 8;
        const u32x4 raw = *(const u32x4*)(V + (size_t)(r0 + j) * 768 + h * 128 + e0);
        VT[(e0 + 0) * RT_LD + j] = (bf16)(raw.x & 0xffffu); VT[(e0 + 1) * RT_LD + j] = (bf16)(raw.x >> 16);
        VT[(e0 + 2) * RT_LD + j] = (bf16)(raw.y & 0xffffu); VT[(e0 + 3) * RT_LD + j] = (bf16)(raw.y >> 16);
        VT[(e0 + 4) * RT_LD + j] = (bf16)(raw.z & 0xffffu); VT[(e0 + 5) * RT_LD + j] = (bf16)(raw.z >> 16);
        VT[(e0 + 6) * RT_LD + j] = (bf16)(raw.w & 0xffffu); VT[(e0 + 7) * RT_LD + j] = (bf16)(raw.w >> 16); }
}
__device__ __forceinline__ void ret_states_phase(PR p, Frame& F, int NG, int a) {
    LAS char* Kimg = (LAS char*)F.lds; LAS char* Vimg = Kimg + 32768;
    const bf16* QK = WSP(bf16, A_QK); const bf16* V = WSP(bf16, A_V); float* RT = p.out;
    const RetDeal dl_ = ret_deal(F.bid, F.G, NG, a, NBATCH * RH * RNCH);
    for (int unit = dl_.u; unit < dl_.end; unit += dl_.stride) {
        int tl = F.tid; asm volatile("" : "+v"(tl));
        const int lane = tl & 63, w = tl >> 6, fr = lane & 15, fq = lane >> 4, dir = w >> 2;
        unsigned aV[2][2], aK[4][2];
#pragma unroll
        for (int a = 0; a < 2; ++a)
#pragma unroll
            for (int t = 0; t < 2; ++t) aV[a][t] = (unsigned)(uintptr_t)Vimg + tr16_addr(lane, (w & 3) * 2 + a, t);
#pragma unroll
        for (int d = 0; d < 4; ++d)
#pragma unroll
            for (int t = 0; t < 2; ++t) aK[d][t] = (unsigned)(uintptr_t)Kimg + tr16_addr(lane, 4 * dir + d, t);
        int bh, h, r0; ret_unit(unit, bh, h, r0);
        const float lgf = log_gamma(p, 0, h), lgb = log_gamma(p, 1, h);
        u32x4 kraw[2], vraw[4];
#pragma unroll
        for (int i = 0; i < 2; ++i) { const int id = tl + 512 * i, j = id >> 3, cd = id & 7; kraw[i] = *(const u32x4*)(QK + (size_t)(r0 + j) * 768 + (RH + h) * 64 + 8 * cd); }
#pragma unroll
        for (int i = 0; i < 4; ++i) { const int id = tl + 512 * i, j = id >> 4, ch = id & 15; vraw[i] = *(const u32x4*)(V + (size_t)(r0 + j) * 768 + h * 128 + 8 * ch); }
        const float lgf2 = lgf * 1.4426950408889634f, lgb2 = lgb * 1.4426950408889634f;
#pragma unroll
        for (int i = 0; i < 2; ++i) { const int id = tl + 512 * i, j = id >> 3, cd = id & 7;
            const u32x4 raw = kraw[i];
            const float df = __builtin_amdgcn_exp2f(lgf2 * (float)(RC - 1 - j)), db = __builtin_amdgcn_exp2f(lgb2 * (float)j);
            const unsigned wv[4] = {raw.x, raw.y, raw.z, raw.w}; u32x4 pf, pb;
            pf.x = cvt_pk_bf16(bflo(wv[0]) * df, bfhi(wv[0]) * df); pf.y = cvt_pk_bf16(bflo(wv[1]) * df, bfhi(wv[1]) * df); pf.z = cvt_pk_bf16(bflo(wv[2]) * df, bfhi(wv[2]) * df); pf.w = cvt_pk_bf16(bflo(wv[3]) * df, bfhi(wv[3]) * df);
            pb.x = cvt_pk_bf16(bflo(wv[0]) * db, bfhi(wv[0]) * db); pb.y = cvt_pk_bf16(bflo(wv[1]) * db, bfhi(wv[1]) * db); pb.z = cvt_pk_bf16(bflo(wv[2]) * db, bfhi(wv[2]) * db); pb.w = cvt_pk_bf16(bflo(wv[3]) * db, bfhi(wv[3]) * db);
            *(LAS u32x4*)(Kimg + img_off(j, cd)) = pf; *(LAS u32x4*)(Kimg + img_off(j, 8 + cd)) = pb; }
#pragma unroll
        for (int i = 0; i < 4; ++i) { const int id = tl + 512 * i, j = id >> 4, ch = id & 15; *(LAS u32x4*)(Vimg + img_off(j, ch)) = vraw[i]; }
        __syncthreads();
        f32x4 acc[2][4];
#pragma unroll
        for (int a = 0; a < 2; ++a)
#pragma unroll
            for (int d = 0; d < 4; ++d) acc[a][d] = (f32x4){0.f, 0.f, 0.f, 0.f};
#define R1_STEP(KS) do { \
            s16x4 va0 = tr16_read<8192 * KS>(aV[0][0]), va1 = tr16_read<8192 * KS>(aV[0][1]), vb0 = tr16_read<8192 * KS>(aV[1][0]), vb1 = tr16_read<8192 * KS>(aV[1][1]); \
            s16x4 k00 = tr16_read<8192 * KS>(aK[0][0]), k01 = tr16_read<8192 * KS>(aK[0][1]), k10 = tr16_read<8192 * KS>(aK[1][0]), k11 = tr16_read<8192 * KS>(aK[1][1]); \
            s16x4 k20 = tr16_read<8192 * KS>(aK[2][0]), k21 = tr16_read<8192 * KS>(aK[2][1]), k30 = tr16_read<8192 * KS>(aK[3][0]), k31 = tr16_read<8192 * KS>(aK[3][1]); \
            asm volatile("s_waitcnt lgkmcnt(0)" : "+v"(va0), "+v"(va1), "+v"(vb0), "+v"(vb1), "+v"(k00), "+v"(k01), "+v"(k10), "+v"(k11), "+v"(k20), "+v"(k21), "+v"(k30), "+v"(k31) :: "memory"); \
            const bf16x8 af0 = TR_PK(va0, va1), af1 = TR_PK(vb0, vb1), b0 = TR_PK(k00, k01), b1 = TR_PK(k10, k11), b2 = TR_PK(k20, k21), b3 = TR_PK(k30, k31); \
            acc[0][0] = __builtin_amdgcn_mfma_f32_16x16x32_bf16(af0, b0, acc[0][0], 0, 0, 0); acc[0][1] = __builtin_amdgcn_mfma_f32_16x16x32_bf16(af0, b1, acc[0][1], 0, 0, 0); \
            acc[0][2] = __builtin_amdgcn_mfma_f32_16x16x32_bf16(af0, b2, acc[0][2], 0, 0, 0); acc[0][3] = __builtin_amdgcn_mfma_f32_16x16x32_bf16(af0, b3, acc[0][3], 0, 0, 0); \
            acc[1][0] = __builtin_amdgcn_mfma_f32_16x16x32_bf16(af1, b0, acc[1][0], 0, 0, 0); acc[1][1] = __builtin_amdgcn_mfma_f32_16x16x32_bf16(af1, b1, acc[1][1], 0, 0, 0); \
            acc[1][2] = __builtin_amdgcn_mfma_f32_16x16x32_bf16(af1, b2, acc[1][2], 0, 0, 0); acc[1][3] = __builtin_amdgcn_mfma_f32_16x16x32_bf16(af1, b3, acc[1][3], 0, 0, 0); } while (0)
        R1_STEP(0); R1_STEP(1); R1_STEP(2); R1_STEP(3);
#undef R1_STEP
        float* out = RT + ((size_t)unit * 2 + dir) * 8192;
#pragma unroll
        for (int a = 0; a < 2; ++a)
#pragma unroll
            for (int d = 0; d < 4; ++d)
#pragma unroll
                for (int jj = 0; jj < 4; ++jj) out[(((w & 3) * 2 + a) * 16 + 4 * fq + jj) * 64 + d * 16 + fr] = acc[a][d][jj];
        __syncthreads();
    }
}
__device__ __forceinline__ void ret_scan_phase(PR p, Frame& F) {
    const float* RT = p.out; bf16* TT = WSP(bf16, A_TT);
    const int ns5 = F.G < 128 ? F.G : 128;
    if (F.bid < ns5 && F.wave == 0) return;
    const int gt = F.bid < ns5 ? F.bid * (NTHREADS - 64) + (F.tid - 64) : ns5 * (NTHREADS - 64) + (F.bid - ns5) * NTHREADS + F.tid, NGT = ns5 * (NTHREADS - 64) + (F.G - ns5) * NTHREADS;
    for (int e = gt; e < 48 * 8192; e += NGT) {
        const int chain = e >> 13, el = e & 8191, dir = chain & 1, bh = chain >> 1, h = bh % RH;
        const float gC = expf(log_gamma(p, dir, h) * (float)RC);
        float st = 0.f;
        for (int s0 = 0; s0 < RNCH; s0 += 11) {
            float r[11];
#pragma unroll
            for (int k = 0; k < 11; ++k) { const int s = s0 + k, cch = dir == 0 ? (s < 2 ? 64 + s : s - 2) : (65 - s);
                r[k] = RT[((size_t)(bh * RNCH + cch) * 2 + dir) * 8192 + el]; }
#pragma unroll
            for (int k = 0; k < 11; ++k) { const int s = s0 + k, cch = dir == 0 ? (s < 2 ? 64 + s : s - 2) : (65 - s);
                TT[((size_t)(bh * RNCH + cch) * 2 + dir) * 8192 + el] = (bf16)f2bf(st);
                st = st * gC + r[k]; }
        }
    }
}
__device__ __forceinline__ void s5_scan_phase(PR p, Frame& F) {
    const float* EO = WSP(float, A_EO); bf16* UA = WSP(bf16, A_UA); const f32x2* LAMP = WSP(f32x2, WS_LAMP);
    if (F.wave != 0) return;
    for (int it = F.bid; it < 128; it += F.G) {
        const int b = it >> 5, g = (it >> 1) & 15, dir = it & 1, n = F.lane;
        const f32x2 lamT = LAMP[((g * 2 + dir) * 64 + n) * 33 + S5T];
        f32x2 st = (f32x2){0.f, 0.f};
#define S5ROW(s_) (dir == 0 ? ((s_) < 8 ? 1024 + b * 8 + (s_) : b * 256 + ((s_) - 8)) : ((s_) < 8 ? 1024 + b * 8 + (7 - (s_)) : b * 256 + (263 - (s_))))
#define S5LOAD(dst, s0_) do { _Pragma("unroll") for (int k = 0; k < 24; ++k) { const float* er = EO + ((size_t)g * S5ROWS + S5ROW((s0_) + k)) * 256 + dir * 128 + n; dst[k] = (f32x2){er[0], er[64]}; } } while (0)
#define S5STEP(src, s0_) do { _Pragma("unroll") for (int k = 0; k < 24; ++k) { bf16* ur = UA + ((size_t)g * S5ROWS + S5ROW((s0_) + k)) * 768 + 512 + dir * 128 + n; \
            ur[0] = (bf16)f2bf(st.x); ur[64] = (bf16)f2bf(st.y); st = cmul(lamT, st) + src[k]; } } while (0)
        f32x2 ea[24], eb[24];
        S5LOAD(ea, 0);
#pragma unroll 1
        for (int s0 = 0; s0 < 264; s0 += 48) {
            if (s0 + 24 < 264) S5LOAD(eb, s0 + 24);
            S5STEP(ea, s0);
            if (s0 + 24 >= 264) break;
            if (s0 + 48 < 264) S5LOAD(ea, s0 + 48);
            S5STEP(eb, s0 + 24);
        }
#undef S5ROW
#undef S5LOAD
#undef S5STEP
    }
}
__device__ __forceinline__ void ret_out_phase(PR p, Frame& F, int NG, int a) {
    constexpr int KT_LD = 72, GO_LD = 136;
    LAS bf16* VT = (LAS bf16*)F.lds;
    LAS char* Vimg = (LAS char*)F.lds;
    LAS bf16* Kt = VT + 256 * RT_LD;
    LAS bf16* GO = Kt + 128 * KT_LD;
    const bf16* QK = WSP(bf16, A_QK); const bf16* V = WSP(bf16, A_V); const bf16* Gb = WSP(bf16, A_G); const bf16* TT = WSP(bf16, A_TT); bf16* MRG = WSP(bf16, A_MRG);
    const RetDeal dl_ = ret_deal(F.bid, F.G, NG, a, NBATCH * RH * RNCH);
    for (int unit = dl_.u; unit < dl_.end; unit += dl_.stride) {
        int tl = F.tid; asm volatile("" : "+v"(tl));
        const int lane = tl & 63, w = tl >> 6, fr = lane & 15, fq = lane >> 4, i0 = 16 * w;
        LAS bf16* Pw = VT + 128 * RT_LD + w * 16 * RT_LD;
        unsigned av[8][2];
#pragma unroll
        for (int et = 0; et < 8; ++et)
#pragma unroll
            for (int t = 0; t < 2; ++t) av[et][t] = (unsigned)(uintptr_t)Vimg + tr16_addr(lane, et, t);
        int bh, h, r0; ret_unit(unit, bh, h, r0);
        const float lgf2 = log_gamma(p, 0, h) * 1.4426950408889634f, lgb2 = log_gamma(p, 1, h) * 1.4426950408889634f;
        ret_stage_v(V, r0, h, Vimg, tl);
#pragma unroll
        for (int i = 0; i < 2; ++i) { const int id = tl + 512 * i, j = id >> 3, c = (id & 7) * 8;
            *(LAS u32x4*)(Kt + j * KT_LD + c) = *(const u32x4*)(QK + (size_t)(r0 + j) * 768 + (RH + h) * 64 + c); }
#pragma unroll
        for (int i = 0; i < 4; ++i) { const int id = tl + 512 * i, j = id >> 4, c = (id & 15) * 8;
            *(LAS u32x4*)(GO + j * GO_LD + c) = *(const u32x4*)(Gb + (size_t)(r0 + j) * 768 + h * 128 + c); }
        bf16x8 aq[2];
#pragma unroll
        for (int ks = 0; ks < 2; ++ks) aq[ks] = *(const bf16x8*)(QK + (size_t)(r0 + i0 + fr) * 768 + h * 64 + 32 * ks + 8 * fq);
        u32x4 tfr[2], tbr[2];
        { const bf16* TTf = TT + ((size_t)unit * 2 + 0) * 8192; const bf16* TTb = TT + ((size_t)unit * 2 + 1) * 8192;
#pragma unroll
          for (int i = 0; i < 2; ++i) { const int id = tl + 512 * i, e = id >> 3, c = (id & 7) * 8; tfr[i] = *(const u32x4*)(TTf + e * 64 + c); tbr[i] = *(const u32x4*)(TTb + e * 64 + c); } }
        __syncthreads();
#pragma unroll
        for (int jt = 0; jt < 8; ++jt) { f32x4 sc = (f32x4){0.f, 0.f, 0.f, 0.f};
#pragma unroll
            for (int ks = 0; ks < 2; ++ks) { const bf16x8 bk = *(const LAS bf16x8*)(Kt + (16 * jt + fr) * KT_LD + 32 * ks + 8 * fq);
                sc = __builtin_amdgcn_mfma_f32_16x16x32_bf16(aq[ks], bk, sc, 0, 0, 0); }
#pragma unroll
            for (int jj = 0; jj < 4; ++jj) { const int dl = (i0 + 4 * fq + jj) - (16 * jt + fr);
                const float dec = __builtin_amdgcn_exp2f(dl >= 0 ? lgf2 * (float)dl : lgb2 * (float)(-dl));
                Pw[(4 * fq + jj) * RT_LD + 16 * jt + fr] = (bf16)f2bf(sc[jj] * dec); } }
        asm volatile("s_waitcnt lgkmcnt(0)" ::: "memory");
        f32x4 o[8];
#pragma unroll
        for (int et = 0; et < 8; ++et) o[et] = (f32x4){0.f, 0.f, 0.f, 0.f};
#define R3_PV(KS) do { const bf16x8 ap = *(const LAS bf16x8*)(Pw + fr * RT_LD + 32 * KS + 8 * fq); \
            s16x4 l0 = tr16_read<8192 * KS>(av[0][0]), h0 = tr16_read<8192 * KS>(av[0][1]), l1 = tr16_read<8192 * KS>(av[1][0]), h1 = tr16_read<8192 * KS>(av[1][1]); \
            s16x4 l2 = tr16_read<8192 * KS>(av[2][0]), h2 = tr16_read<8192 * KS>(av[2][1]), l3 = tr16_read<8192 * KS>(av[3][0]), h3 = tr16_read<8192 * KS>(av[3][1]); \
            s16x4 l4 = tr16_read<8192 * KS>(av[4][0]), h4 = tr16_read<8192 * KS>(av[4][1]), l5 = tr16_read<8192 * KS>(av[5][0]), h5 = tr16_read<8192 * KS>(av[5][1]); \
            s16x4 l6 = tr16_read<8192 * KS>(av[6][0]), h6 = tr16_read<8192 * KS>(av[6][1]), l7 = tr16_read<8192 * KS>(av[7][0]), h7 = tr16_read<8192 * KS>(av[7][1]); \
            asm volatile("s_waitcnt lgkmcnt(0)" : "+v"(l0), "+v"(h0), "+v"(l1), "+v"(h1), "+v"(l2), "+v"(h2), "+v"(l3), "+v"(h3), "+v"(l4), "+v"(h4), "+v"(l5), "+v"(h5), "+v"(l6), "+v"(h6), "+v"(l7), "+v"(h7) :: "memory"); \
            o[0] = __builtin_amdgcn_mfma_f32_16x16x32_bf16(ap, TR_PK(l0, h0), o[0], 0, 0, 0); o[1] = __builtin_amdgcn_mfma_f32_16x16x32_bf16(ap, TR_PK(l1, h1), o[1], 0, 0, 0); \
            o[2] = __builtin_amdgcn_mfma_f32_16x16x32_bf16(ap, TR_PK(l2, h2), o[2], 0, 0, 0); o[3] = __builtin_amdgcn_mfma_f32_16x16x32_bf16(ap, TR_PK(l3, h3), o[3], 0, 0, 0); \
            o[4] = __builtin_amdgcn_mfma_f32_16x16x32_bf16(ap, TR_PK(l4, h4), o[4], 0, 0, 0); o[5] = __builtin_amdgcn_mfma_f32_16x16x32_bf16(ap, TR_PK(l5, h5), o[5], 0, 0, 0); \
            o[6] = __builtin_amdgcn_mfma_f32_16x16x32_bf16(ap, TR_PK(l6, h6), o[6], 0, 0, 0); o[7] = __builtin_amdgcn_mfma_f32_16x16x32_bf16(ap, TR_PK(l7, h7), o[7], 0, 0, 0); } while (0)
        R3_PV(0); R3_PV(1); R3_PV(2); R3_PV(3);
#undef R3_PV
        __syncthreads();
        LAS bf16* Tb = (LAS bf16*)Vimg;
#pragma unroll
        for (int i = 0; i < 2; ++i) { const int id = tl + 512 * i, e = id >> 3, c = (id & 7) * 8; *(LAS u32x4*)(Kt + e * KT_LD + c) = tfr[i]; *(LAS u32x4*)(Tb + e * KT_LD + c) = tbr[i]; }
        __syncthreads();
#pragma unroll
        for (int dir = 0; dir < 2; ++dir) { const LAS bf16* Timg = dir == 0 ? Kt : Tb; float qd[4];
#pragma unroll
            for (int jj = 0; jj < 4; ++jj) { const int i = i0 + 4 * fq + jj; qd[jj] = __builtin_amdgcn_exp2f(dir == 0 ? lgf2 * (float)(i + 1) : lgb2 * (float)(RC - i)); }
#pragma unroll
            for (int et = 0; et < 8; ++et) { f32x4 t = (f32x4){0.f, 0.f, 0.f, 0.f};
#pragma unroll
                for (int ks = 0; ks < 2; ++ks) { const bf16x8 bt = *(const LAS bf16x8*)(Timg + (16 * et + fr) * KT_LD + 32 * ks + 8 * fq);
                    t = __builtin_amdgcn_mfma_f32_16x16x32_bf16(aq[ks], bt, t, 0, 0, 0); }
#pragma unroll
                for (int jj = 0; jj < 4; ++jj) o[et][jj] += qd[jj] * t[jj]; } }
#pragma unroll
        for (int jj = 0; jj < 4; ++jj) { float s = 0.f;
#pragma unroll
            for (int et = 0; et < 8; ++et) s += o[et][jj];
            s = row16_sum(s);
            const float mu = s * (1.f / 128.f); float q = 0.f;
#pragma unroll
            for (int et = 0; et < 8; ++et) { const float d = o[et][jj] - mu; q += d * d; }
            q = row16_sum(q);
            const float rstd = 1.f / sqrtf(q * (1.f / 128.f) + GN_EPS);
            LAS bf16* grow = GO + (i0 + 4 * fq + jj) * GO_LD + fr;
#pragma unroll
            for (int et = 0; et < 8; ++et) { const float gv = bf2f(grow[16 * et]); grow[16 * et] = (bf16)f2bf((o[et][jj] - mu) * rstd * (gv * fast_sigmoid(gv))); } }
        __syncthreads();
#pragma unroll
        for (int i = 0; i < 4; ++i) { const int id = tl + 512 * i, j = id >> 4, c = (id & 15) * 8; const u32x4 v = *(const LAS u32x4*)(GO + j * GO_LD + c);
            const size_t off = (size_t)(r0 + j) * 1024 + h * 128 + c;
            if (PF_OUT0) { u32x2 q8; q8.x = pg8::pack4_fp8(bflo(v.x), bfhi(v.x), bflo(v.y), bfhi(v.y)); q8.y = pg8::pack4_fp8(bflo(v.z), bfhi(v.z), bflo(v.w), bfhi(v.w)); *(u32x2*)((unsigned char*)MRG + off) = q8; }
            else *(u32x4*)(MRG + off) = v; }
        __syncthreads();
    }
}
struct RouteRec { int e0, e1, rk0, rk1; float w0, w1; int d0, d1; };

__device__ __forceinline__ bf16* xs_row(PR p, int r) { return (bf16*)p.out + (size_t)r * DM; }
__device__ __forceinline__ bf16* xs1_row(PR p, int r) { return WSP(bf16, WS_XS1) + (size_t)r * DM; }

template <int LAYER>
__device__ __forceinline__ void ln1_router_phase(PR p, Frame& F, const bf16* O, bf16* H2, int nrows) {
    LAS float* rw = (LAS float*)F.lds;
    LAS unsigned* lcnt = (LAS unsigned*)(F.lds + 65536);
    { f32x4 w8[8];
#pragma unroll
      for (int k = 0; k < 8; ++k) w8[k] = ((const f32x4*)p.in[I_RW])[F.tid + NTHREADS * k];
#pragma unroll
      for (int k = 0; k < 8; ++k) { const int i = F.tid + NTHREADS * k, col = i >> 2, e0 = (i & 3) * 4;
          rw[(e0 + 0) * 1024 + col] = w8[k][0]; rw[(e0 + 1) * 1024 + col] = w8[k][1]; rw[(e0 + 2) * 1024 + col] = w8[k][2]; rw[(e0 + 3) * 1024 + col] = w8[k][3]; } }
    if (F.tid < 16) lcnt[F.tid] = 0u;
    __syncthreads();
    const float* mod = WSP(float, WS_MOD) + LAYER * 5 * 6144;
    const float* lng = p.in[I_LNG] + (LAYER * 2 + 0) * DM;
    RouteRec* route = WSP(RouteRec, WS_ROUTE);
    const int rpb = (nrows + F.G - 1) / F.G, rbeg = F.bid * rpb, rend = (rbeg + rpb < nrows) ? rbeg + rpb : nrows;
    const int lane = F.lane;
    f32x4 gnv[4], g1v[4], shv[4], scv[4]; int bcur = -1;
#pragma unroll
    for (int j = 0; j < 4; ++j) gnv[j] = *(const f32x4*)(lng + 4 * lane + 256 * j);
    f32x4 nx[4]; u32x2 nxb[4]; u32x2 no[4];
#define LN1_LOAD(r_) do { const bool lt_ = (r_) < NLAT; const float* xi_ = lt_ ? p.in[I_X] + (size_t)(r_) * DM : p.in[I_CTX] + (size_t)((r_) - NLAT) * DM; const bf16* xb_ = xs_row(p, (r_)); \
        _Pragma("unroll") for (int j = 0; j < 4; ++j) { const int c = 4 * lane + 256 * j; if (LAYER == 0) nx[j] = *(const f32x4*)(xi_ + c); else nxb[j] = *(const u32x2*)(xb_ + c); no[j] = *(const u32x2*)(O + (size_t)(r_) * DM + c); } } while (0)
    if (rbeg + F.wave < rend) LN1_LOAD(rbeg + F.wave);
    for (int r = rbeg + F.wave; r < rend; r += NWAVES) {
        const bool lat = r < NLAT; const int b = lat ? (r >> 13) : 4;
        const float* mb = mod + b * 6144;
        if (b != bcur) { bcur = b;
#pragma unroll
            for (int j = 0; j < 4; ++j) { const int c = 4 * lane + 256 * j; g1v[j] = *(const f32x4*)(mb + 2048 + c); shv[j] = *(const f32x4*)(mb + 3072 + c); scv[j] = *(const f32x4*)(mb + 4096 + c); } }
        f32x4 v[4]; float s = 0.f;
#pragma unroll
        for (int j = 0; j < 4; ++j) { const int c = 4 * lane + 256 * j; const f32x4 g1 = g1v[j];
            const f32x4 o = (f32x4){bflo(no[j].x), bfhi(no[j].x), bflo(no[j].y), bfhi(no[j].y)};
            const f32x4 xin = (LAYER == 0) ? nx[j] : (f32x4){bflo(nxb[j].x), bfhi(nxb[j].x), bflo(nxb[j].y), bfhi(nxb[j].y)};
            v[j] = xin * ALPHA + g1 * o; s += (v[j][0] + v[j][1]) + (v[j][2] + v[j][3]); }
        if (r + NWAVES < rend) LN1_LOAD(r + NWAVES);
        const float mean = wave_sum(s) * (1.f / DM); float q = 0.f;
#pragma unroll
        for (int j = 0; j < 4; ++j) { v[j] = v[j] - mean; q += (v[j][0] * v[j][0] + v[j][1] * v[j][1]) + (v[j][2] * v[j][2] + v[j][3] * v[j][3]); }
        const float rstd = 1.f / sqrtf(wave_sum(q) * (1.f / DM) + LN_EPS);
        bf16* xo = (LAYER == 0) ? xs_row(p, r) : xs1_row(p, r);
        float lg[16];
#pragma unroll
        for (int e = 0; e < 16; ++e) lg[e] = 0.f;
#pragma unroll
        for (int j = 0; j < 4; ++j) { const int c = 4 * lane + 256 * j; const f32x4 gn = gnv[j], sh = shv[j], sc = scv[j];
            const f32x4 x1 = v[j] * rstd * gn; { u32x2 xw; xw.x = cvt_pk_bf16(x1[0], x1[1]); xw.y = cvt_pk_bf16(x1[2], x1[3]); *(u32x2*)(xo + c) = xw; }
            const f32x4 h = x1 * (sc + 1.f) + sh;
            if (MOE_FP8) *(unsigned*)((unsigned char*)H2 + (size_t)r * DM + c) = pg8::pack4_fp8(h[0], h[1], h[2], h[3]);
            else { u32x2 w; w.x = cvt_pk_bf16(h[0], h[1]); w.y = cvt_pk_bf16(h[2], h[3]); *(u32x2*)(H2 + (size_t)r * DM + c) = w; }
#pragma unroll
            for (int e = 0; e < 16; ++e) { const f32x4 wv = *(const LAS f32x4*)(rw + e * 1024 + c); lg[e] = fmaf(h[0], wv[0], fmaf(h[1], wv[1], fmaf(h[2], wv[2], fmaf(h[3], wv[3], lg[e])))); } }
#pragma unroll
        for (int e = 0; e < 16; ++e) lg[e] = wave_sum(lg[e]);
        float sc[16], bs[16];
#pragma unroll
        for (int e = 0; e < 16; ++e) { sc[e] = __builtin_amdgcn_rcpf(1.f + __expf(-lg[e])); bs[e] = sc[e] + p.in[I_RB][e]; }
        float gbest = -INFINITY; int gsel = 0;
#pragma unroll
        for (int gq = 0; gq < 4; ++gq) { const float a = bs[4 * gq], b2 = bs[4 * gq + 1], c2 = bs[4 * gq + 2], d2 = bs[4 * gq + 3];
            const float m1 = fmaxf(fmaxf(a, b2), fmaxf(c2, d2));
            const float m2 = fmaxf(fmaxf(fminf(a, b2), fminf(c2, d2)), fminf(fmaxf(a, b2), fmaxf(c2, d2)));
            const float gs = m1 + m2; if (gs > gbest) { gbest = gs; gsel = gq; } }
        float b4[4], s4[4];
#pragma unroll
        for (int i = 0; i < 4; ++i) { b4[i] = gsel == 0 ? bs[i] : (gsel == 1 ? bs[4 + i] : (gsel == 2 ? bs[8 + i] : bs[12 + i])); s4[i] = gsel == 0 ? sc[i] : (gsel == 1 ? sc[4 + i] : (gsel == 2 ? sc[8 + i] : sc[12 + i])); }
        int i0 = 0; float bv0 = b4[0];
#pragma unroll
        for (int i = 1; i < 4; ++i) if (b4[i] > bv0) { bv0 = b4[i]; i0 = i; }
        int i1 = -1; float bv1 = -INFINITY;
#pragma unroll
        for (int i = 0; i < 4; ++i) if (i != i0 && b4[i] > bv1) { bv1 = b4[i]; i1 = i; }
        const float g0 = i0 == 0 ? s4[0] : (i0 == 1 ? s4[1] : (i0 == 2 ? s4[2] : s4[3]));
        const float g1s = i1 == 0 ? s4[0] : (i1 == 1 ? s4[1] : (i1 == 2 ? s4[2] : s4[3]));
        if (lane == 0) { RouteRec rr; rr.e0 = gsel * 4 + i0; rr.e1 = gsel * 4 + i1; rr.rk0 = (int)atomicAdd((unsigned*)&lcnt[rr.e0], 1u); rr.rk1 = (int)atomicAdd((unsigned*)&lcnt[rr.e1], 1u);
            const float den = g0 + g1s; rr.w0 = g0 / den; rr.w1 = g1s / den; rr.d0 = 0; rr.d1 = 0; route[r] = rr; }
    }
#undef LN1_LOAD
    __syncthreads();
    if (F.tid < 16) WSP(unsigned, WS_CNT)[F.bid * 16 + F.tid] = lcnt[F.tid];
    __syncthreads();
}

struct MoeTabs { LAS unsigned* tot; LAS unsigned* pstart; LAS unsigned* pendb; LAS unsigned* mybase; };
__device__ __forceinline__ MoeTabs moe_tabs(Frame& F) { MoeTabs t; LAS unsigned* m = (LAS unsigned*)(F.lds + MISC_OFF + 256); t.tot = m; t.pstart = m + 16; t.pendb = m + 32; t.mybase = m + 48; return t; }
__device__ __forceinline__ void moe_build_tabs(PR p, Frame& F, const MoeTabs& T) {
    const unsigned* cnt = WSP(unsigned, WS_CNT);
    LAS unsigned* tmp = (LAS unsigned*)(F.lds + MISC_OFF + 1024);
    { const int e = F.tid & 15, part = F.tid >> 4, per = (F.G + 31) / 32, b0 = part * per, b1 = (b0 + per < F.G) ? b0 + per : F.G; unsigned tot = 0, base = 0;
      for (int b = b0; b < b1; ++b) { const unsigned c = cnt[b * 16 + e]; tot += c; base += (b < F.bid) ? c : 0u; }
      tmp[part * 32 + e] = tot; tmp[part * 32 + 16 + e] = base; }
    __syncthreads();
    if (F.tid < 16) { unsigned tot = 0, base = 0;
#pragma unroll
        for (int q = 0; q < 32; ++q) { tot += tmp[q * 32 + F.tid]; base += tmp[q * 32 + 16 + F.tid]; }
        T.tot[F.tid] = tot; T.mybase[F.tid] = base; }
    __syncthreads();
    if (F.tid == 0) { unsigned acc = 0; for (int e = 0; e < 16; ++e) { T.pstart[e] = acc; acc += (T.tot[e] + 255u) & ~255u; T.pendb[e] = acc >> 8; } }
    __syncthreads();
}
__device__ __forceinline__ void moe_scatter_phase(PR p, Frame& F, const bf16* H2, bf16* BUF, int nrows) {
    const MoeTabs T = moe_tabs(F); moe_build_tabs(p, F, T);
    RouteRec* route = WSP(RouteRec, WS_ROUTE);
    const int rpb = (nrows + F.G - 1) / F.G, rbeg = F.bid * rpb, rend = (rbeg + rpb < nrows) ? rbeg + rpb : nrows;
    for (int r = rbeg + F.wave; r < rend; r += NWAVES) {
        const RouteRec rr = route[r];
        const int d0 = (int)(T.pstart[rr.e0] + T.mybase[rr.e0]) + rr.rk0, d1 = (int)(T.pstart[rr.e1] + T.mybase[rr.e1]) + rr.rk1;
        if (MOE_FP8) { const u32x4 a = *((const u32x4*)((const unsigned char*)H2 + (size_t)r * DM) + F.lane);
            *((u32x4*)((unsigned char*)BUF + (size_t)d0 * DM) + F.lane) = a; *((u32x4*)((unsigned char*)BUF + (size_t)d1 * DM) + F.lane) = a; }
        else { const u32x4* src = (const u32x4*)(H2 + (size_t)r * DM) + F.lane; const u32x4 a = src[0], b = src[64];
            u32x4* o0 = (u32x4*)(BUF + (size_t)d0 * DM) + F.lane; u32x4* o1 = (u32x4*)(BUF + (size_t)d1 * DM) + F.lane;
            o0[0] = a; o0[64] = b; o1[0] = a; o1[64] = b; }
        if (F.lane == 0) { route[r].d0 = d0; route[r].d1 = d1; }
    }
    if (F.bid < 16) { const int e = F.bid; const unsigned pb = T.pstart[e] + T.tot[e], pe = T.pstart[e] + ((T.tot[e] + 255u) & ~255u);
        for (unsigned r = pb + F.wave; r < pe; r += NWAVES) { if (MOE_FP8) { *((u32x4*)((unsigned char*)BUF + (size_t)r * DM) + F.lane) = (u32x4){0u, 0u, 0u, 0u}; } else { u32x4* o = (u32x4*)(BUF + (size_t)r * DM) + F.lane; o[0] = (u32x4){0u, 0u, 0u, 0u}; o[64] = (u32x4){0u, 0u, 0u, 0u}; } } }
}

template <int LAYER>
__device__ __forceinline__ void ln2_phase(PR p, Frame& F, const bf16* Y, bf16* H0N, int nrows) {
    const float* mod = WSP(float, WS_MOD) + LAYER * 5 * 6144;
    const float* modn = WSP(float, WS_MOD) + (LAYER + 1) * 5 * 6144;
    const float* lng = p.in[I_LNG] + (LAYER * 2 + 1) * DM;
    const RouteRec* route = WSP(RouteRec, WS_ROUTE);
    const int gw = F.vcu * NWAVES + F.wave, NGW = F.G * NWAVES, lane = F.lane;
    f32x4 gnv[4], g2v[4], shv[4], scv[4]; int bcur = -1;
#pragma unroll
    for (int j = 0; j < 4; ++j) gnv[j] = *(const f32x4*)(lng + 4 * lane + 256 * j);
    u32x2 nx[4]; u32x2 nya[4], nyb[4]; float nw0 = 0.f, nw1 = 0.f;
#define LN2_LOAD(r_) do { const RouteRec rr_ = route[(r_)]; nw0 = rr_.w0; nw1 = rr_.w1; const bf16* xr_ = (LAYER == 0) ? xs_row(p, (r_)) : xs1_row(p, (r_)); \
        _Pragma("unroll") for (int j = 0; j < 4; ++j) { const int c = 4 * lane + 256 * j; nx[j] = *(const u32x2*)(xr_ + c); nya[j] = *(const u32x2*)(Y + (size_t)rr_.d0 * DM + c); nyb[j] = *(const u32x2*)(Y + (size_t)rr_.d1 * DM + c); } } while (0)
    if (gw < nrows) LN2_LOAD(gw);
    for (int r = gw; r < nrows; r += NGW) {
        const bool lat = r < NLAT; const int b = lat ? (r >> 13) : 4;
        const float* mb = mod + b * 6144; bf16* xr = xs_row(p, r);
        if (b != bcur) { bcur = b; const float* mn = modn + b * 6144;
#pragma unroll
            for (int j = 0; j < 4; ++j) { const int c = 4 * lane + 256 * j; g2v[j] = *(const f32x4*)(mb + 5120 + c); if (LAYER == 0) { shv[j] = *(const f32x4*)(mn + c); scv[j] = *(const f32x4*)(mn + 1024 + c); } } }
        f32x4 v[4]; float s = 0.f;
#pragma unroll
        for (int j = 0; j < 4; ++j) { const int c = 4 * lane + 256 * j; const f32x4 g2 = g2v[j];
            const f32x4 y = (f32x4){bflo(nya[j].x), bfhi(nya[j].x), bflo(nya[j].y), bfhi(nya[j].y)} * nw0 + (f32x4){bflo(nyb[j].x), bfhi(nyb[j].x), bflo(nyb[j].y), bfhi(nyb[j].y)} * nw1;
            v[j] = (f32x4){bflo(nx[j].x), bfhi(nx[j].x), bflo(nx[j].y), bfhi(nx[j].y)} * ALPHA + g2 * y; s += (v[j][0] + v[j][1]) + (v[j][2] + v[j][3]); }
        if (r + NGW < nrows) LN2_LOAD(r + NGW);
        const float mean = wave_sum(s) * (1.f / DM); float q = 0.f;
#pragma unroll
        for (int j = 0; j < 4; ++j) { v[j] = v[j] - mean; q += (v[j][0] * v[j][0] + v[j][1] * v[j][1]) + (v[j][2] * v[j][2] + v[j][3] * v[j][3]); }
        const float rstd = 1.f / sqrtf(wave_sum(q) * (1.f / DM) + LN_EPS);
#pragma unroll
        for (int j = 0; j < 4; ++j) { const int c = 4 * lane + 256 * j; const f32x4 gn = gnv[j]; f32x4 x2 = v[j] * rstd * gn;
            if (LAYER == 0) { u32x2 xw; xw.x = cvt_pk_bf16(x2[0], x2[1]); xw.y = cvt_pk_bf16(x2[2], x2[3]); *(u32x2*)(xr + c) = xw; }
            else if (lat) *(f32x4*)(p.out + (size_t)r * DM + c) = x2;
            if (LAYER == 0) { const f32x4 sh = shv[j], sc = scv[j]; const f32x4 h = x2 * (sc + 1.f) + sh;
                if (PF_IN1) *(unsigned*)((unsigned char*)H0N + (size_t)r * DM + c) = pg8::pack4_fp8(h[0], h[1], h[2], h[3]);
                else { u32x2 w; w.x = cvt_pk_bf16(h[0], h[1]); w.y = cvt_pk_bf16(h[2], h[3]); *(u32x2*)(H0N + (size_t)r * DM + c) = w; } } }
    }
#undef LN2_LOAD
}
namespace att {
using pg8::i32x8; using pg8::i32x4;
constexpr int NW = 8, QBLK = 32, KVBLK = 64, LDQ = 1024, LDK = 1024, NKEY = SEQ + CTXL, NT = NKEY / KVBLK;
constexpr size_t SHM_V = KVBLK * 128 * 2, SHM_K = KVBLK * 64 * 2;
constexpr float THR = 8.f;
#define KSWZ64(row, colB) ((row) * 128 + ((colB) ^ ((((row) >> 1) & 7) << 4)))
#define SBAR() __builtin_amdgcn_sched_barrier(0)
__device__ __forceinline__ int crow(int r, int hi) { return (r & 3) + 8 * (r >> 2) + 4 * hi; }
__device__ __forceinline__ unsigned cvtpk(float lo, float hi) { unsigned r; asm volatile("v_cvt_pk_bf16_f32 %0, %1, %2" : "=v"(r) : "v"(lo), "v"(hi)); return r; }
__device__ __forceinline__ void partialSM(f32x16& p0, f32x16& p1, float& m_reg, float& mn, float& alpha) {
    constexpr float C = 1.4426950408889634f;
    float pmax = p0[0];
#pragma unroll
    for (int r = 1; r < 16; ++r) pmax = fmaxf(pmax, p0[r]);
#pragma unroll
    for (int r = 0; r < 16; ++r) pmax = fmaxf(pmax, p1[r]);
    { auto rr = __builtin_amdgcn_permlane32_swap(__float_as_uint(pmax), __float_as_uint(pmax), false, false); pmax = fmaxf(__uint_as_float(rr[0]), __uint_as_float(rr[1])); }
    if (__builtin_expect(__all(pmax - m_reg <= THR), 1)) { mn = m_reg; alpha = 1.f; }
    else { mn = fmaxf(m_reg, pmax); alpha = __builtin_amdgcn_exp2f((m_reg - mn) * C); m_reg = mn; }
    const float mnC = -mn * C;
#pragma unroll
    for (int r = 0; r < 16; ++r) p0[r] = fmaf(p0[r], C, mnC);
#pragma unroll
    for (int r = 0; r < 16; ++r) p1[r] = fmaf(p1[r], C, mnC);
#pragma unroll
    for (int r = 0; r < 16; ++r) p0[r] = __builtin_amdgcn_exp2f(p0[r]);
}
__device__ __forceinline__ void finishSM(f32x16& p0, f32x16& p1, float alpha, float& l_reg, bf16x8& pa0, bf16x8& pa1, bf16x8& pa2, bf16x8& pa3) {
#pragma unroll
    for (int r = 0; r < 16; ++r) p1[r] = __builtin_amdgcn_exp2f(p1[r]);
    float ps = 0;
#pragma unroll
    for (int r = 0; r < 16; ++r) ps += p0[r];
#pragma unroll
    for (int r = 0; r < 16; ++r) ps += p1[r];
    { auto rr = __builtin_amdgcn_permlane32_swap(__float_as_uint(ps), __float_as_uint(ps), false, false); ps = __uint_as_float(rr[0]) + __uint_as_float(rr[1]); }
    l_reg = l_reg * alpha + ps;
#define PK4(P, BASE, OUT) do { unsigned a0 = cvtpk(P[BASE + 0], P[BASE + 1]), a1 = cvtpk(P[BASE + 2], P[BASE + 3]);   \
    unsigned b0 = cvtpk(P[BASE + 4], P[BASE + 5]), b1 = cvtpk(P[BASE + 6], P[BASE + 7]);                              \
    auto r0 = __builtin_amdgcn_permlane32_swap(a0, b0, false, false); auto r1 = __builtin_amdgcn_permlane32_swap(a1, b1, false, false); \
    u32x4 w = {r0[0], r1[0], r0[1], r1[1]}; OUT = __builtin_bit_cast(bf16x8, w); } while (0)
    PK4(p0, 0, pa0); PK4(p0, 8, pa1); PK4(p1, 0, pa2); PK4(p1, 8, pa3);
#undef PK4
}
__device__ __forceinline__ void qkt(f32x16& p0, f32x16& p1, const LAS char* Ks, const bf16x8* qr, int r32, int hi) {
    p0 = f32x16{}; p1 = f32x16{};
#pragma unroll
    for (int d0 = 0; d0 < 4; ++d0) { const int cb = (d0 * 16 + hi * 8) * 2;
        const bf16x8 b0 = *(const LAS bf16x8*)(Ks + KSWZ64(r32, cb));
        const bf16x8 b1 = *(const LAS bf16x8*)(Ks + KSWZ64(32 + r32, cb));
        p0 = __builtin_amdgcn_mfma_f32_32x32x16_bf16(b0, qr[d0], p0, 0, 0, 0);
        p1 = __builtin_amdgcn_mfma_f32_32x32x16_bf16(b1, qr[d0], p1, 0, 0, 0); }
}
__device__ __forceinline__ int v_st(int k, int c) { const int kk = (k & ~0xC) | ((k & 4) << 1) | ((k & 8) >> 1); return ((kk >> 3) * 4 + (c >> 5)) * 512 + ((kk & 7) * 32 + (c & 31)) * 2; }
__device__ __forceinline__ int v_rd_base(int lane) { return ((lane & 3) << 3) | (((lane >> 2) & 3) << 6) | (((lane >> 4) & 1) << 5) | (((lane >> 5) & 1) << 8); }
constexpr int v_rd_off(int d0, int ks, int half) { return d0 * 512 + ks * 4096 + half * 2048; }
template <int OFF> __device__ __forceinline__ s16x4 tr_read(int vb) { s16x4 r; asm volatile("ds_read_b64_tr_b16 %0, %1 offset:%2" : "=&v"(r) : "v"(vb), "i"(OFF) : "memory"); return r; }
template <int D0> __device__ __forceinline__ void pv_one(f32x16& od, int vb, bf16x8 pa0, bf16x8 pa1, bf16x8 pa2, bf16x8 pa3) {
    const s16x4 l0 = tr_read<v_rd_off(D0, 0, 0)>(vb), h0 = tr_read<v_rd_off(D0, 0, 1)>(vb), l1 = tr_read<v_rd_off(D0, 1, 0)>(vb), h1 = tr_read<v_rd_off(D0, 1, 1)>(vb);
    const s16x4 l2 = tr_read<v_rd_off(D0, 2, 0)>(vb), h2 = tr_read<v_rd_off(D0, 2, 1)>(vb), l3 = tr_read<v_rd_off(D0, 3, 0)>(vb), h3 = tr_read<v_rd_off(D0, 3, 1)>(vb);
    asm volatile("s_waitcnt lgkmcnt(0)" ::: "memory"); SBAR();
#define PKV(L, H) (bf16x8){L[0], L[1], L[2], L[3], H[0], H[1], H[2], H[3]}
    od = __builtin_amdgcn_mfma_f32_32x32x16_bf16(pa0, PKV(l0, h0), od, 0, 0, 0);
    od = __builtin_amdgcn_mfma_f32_32x32x16_bf16(pa1, PKV(l1, h1), od, 0, 0, 0);
    od = __builtin_amdgcn_mfma_f32_32x32x16_bf16(pa2, PKV(l2, h2), od, 0, 0, 0);
    od = __builtin_amdgcn_mfma_f32_32x32x16_bf16(pa3, PKV(l3, h3), od, 0, 0, 0);
#undef PKV
}
__device__ __forceinline__ void pv_d0(f32x16* o, int vb, bf16x8 pa0, bf16x8 pa1, bf16x8 pa2, bf16x8 pa3) {
    pv_one<0>(o[0], vb, pa0, pa1, pa2, pa3); pv_one<1>(o[1], vb, pa0, pa1, pa2, pa3); pv_one<2>(o[2], vb, pa0, pa1, pa2, pa3); pv_one<3>(o[3], vb, pa0, pa1, pa2, pa3);
}
template <bool TIE = true> __device__ __forceinline__ void qkt_neg(f32x16& p0, f32x16& p1, int ka0, int ka1, const i32x8& qf, f32x16& negm) {
    const i32x4 a0 = *(const LAS i32x4*)(uintptr_t)(unsigned)ka0, a1 = *(const LAS i32x4*)(uintptr_t)(unsigned)ka1;
    const i32x4 b0 = *(const LAS i32x4*)(uintptr_t)(unsigned)(ka0 + 2048), b1 = *(const LAS i32x4*)(uintptr_t)(unsigned)(ka1 + 2048);
    const i32x8 k0 = (i32x8){a0[0], a0[1], a0[2], a0[3], a1[0], a1[1], a1[2], a1[3]}, k1 = (i32x8){b0[0], b0[1], b0[2], b0[3], b1[0], b1[1], b1[2], b1[3]};
    asm volatile("v_mfma_f32_32x32x64_f8f6f4 %0, %2, %3, %1" : "=&v"(p0), "+v"(negm) : "v"(k0), "v"(qf));
    asm volatile("v_mfma_f32_32x32x64_f8f6f4 %0, %2, %3, %1" : "=&v"(p1), "+v"(negm) : "v"(k1), "v"(qf));
    if (TIE) asm volatile("s_nop 15\n\ts_nop 7" : "+v"(p0), "+v"(p1));
}
constexpr float THR2 = 8.f;
template <bool FIRST> __device__ __forceinline__ void partialSM2(f32x16& p0, f32x16& p1, float& m_reg, f32x16& negm, float& alpha) {
    float pmax = p0[0];
#pragma unroll
    for (int r = 1; r < 16; ++r) pmax = fmaxf(pmax, p0[r]);
#pragma unroll
    for (int r = 0; r < 16; ++r) pmax = fmaxf(pmax, p1[r]);
    { auto rr = __builtin_amdgcn_permlane32_swap(__float_as_uint(pmax), __float_as_uint(pmax), false, false); pmax = fmaxf(__uint_as_float(rr[0]), __uint_as_float(rr[1])); }
    if (!FIRST && __builtin_expect(__all(pmax <= THR2), 1)) { alpha = 1.f; }
    else { const float d = FIRST ? pmax : fmaxf(pmax, 0.f);
        alpha = FIRST ? 1.f : __builtin_amdgcn_exp2f(-d); m_reg += d;
#pragma unroll
        for (int r = 0; r < 16; ++r) { p0[r] -= d; p1[r] -= d; negm[r] = -m_reg; } }
#pragma unroll
    for (int r = 0; r < 16; ++r) p0[r] = __builtin_amdgcn_exp2f(p0[r]);
}
__device__ __forceinline__ void finishSM2(f32x16& p0, f32x16& p1, bf16x8& pa0, bf16x8& pa1, bf16x8& pa2, bf16x8& pa3) {
#pragma unroll
    for (int r = 0; r < 16; ++r) p1[r] = __builtin_amdgcn_exp2f(p1[r]);
#define PK4(P, BASE, OUT) do { unsigned a0 = cvtpk(P[BASE + 0], P[BASE + 1]), a1 = cvtpk(P[BASE + 2], P[BASE + 3]);   \
    unsigned b0 = cvtpk(P[BASE + 4], P[BASE + 5]), b1 = cvtpk(P[BASE + 6], P[BASE + 7]);                              \
    auto r0 = __builtin_amdgcn_permlane32_swap(a0, b0, false, false); auto r1 = __builtin_amdgcn_permlane32_swap(a1, b1, false, false); \
    u32x4 w = {r0[0], r1[0], r0[1], r1[1]}; OUT = __builtin_bit_cast(bf16x8, w); } while (0)
    PK4(p0, 0, pa0); PK4(p0, 8, pa1); PK4(p1, 0, pa2); PK4(p1, 8, pa3);
#undef PK4
}
__device__ __forceinline__ int vimg_off(int d, int key, int perm) {
    const int kk = key & 31, top = key >> 5, hi = (kk >> 2) & 1, r = (kk & 3) + 4 * (kk >> 3), byte = 32 * hi + ((r + 16 * top) ^ perm);
    return d * 64 + ((((byte >> 4) ^ ((d >> 2) & 3))) << 4) + (byte & 15);
}
__device__ __forceinline__ void finishSM8(f32x16& p0, f32x16& p1, i32x8& pP) {
#pragma unroll
    for (int r = 0; r < 16; ++r) p1[r] = __builtin_amdgcn_exp2f(p1[r]);
#pragma unroll
    for (int v = 0; v < 4; ++v) { int w = __builtin_amdgcn_cvt_pk_fp8_f32(p0[4 * v], p0[4 * v + 1], 0, false); pP[v] = __builtin_amdgcn_cvt_pk_fp8_f32(p0[4 * v + 2], p0[4 * v + 3], w, true); }
#pragma unroll
    for (int v = 0; v < 4; ++v) { int w = __builtin_amdgcn_cvt_pk_fp8_f32(p1[4 * v], p1[4 * v + 1], 0, false); pP[4 + v] = __builtin_amdgcn_cvt_pk_fp8_f32(p1[4 * v + 2], p1[4 * v + 3], w, true); }
}
__device__ __forceinline__ void pv8(f32x16 (&o)[4], f32x16& ls, int va0, int va1, const i32x8& pP, const i32x8& ones8) {
    i32x8 vf[4];
#pragma unroll
    for (int d0 = 0; d0 < 4; ++d0) { const i32x4 a = *(const LAS i32x4*)(uintptr_t)(unsigned)(va0 + d0 * 2048), b = *(const LAS i32x4*)(uintptr_t)(unsigned)(va1 + d0 * 2048);
        vf[d0] = (i32x8){a[0], a[1], a[2], a[3], b[0], b[1], b[2], b[3]}; }
    i32x8 pq = pP; asm volatile("s_nop 1" : "+v"(pq));
#pragma unroll
    for (int d0 = 0; d0 < 4; ++d0) asm volatile("v_mfma_f32_32x32x64_f8f6f4 %0, %1, %2, %0" : "+v"(o[d0]) : "v"(pq), "v"(vf[d0]));
    asm volatile("v_mfma_f32_32x32x64_f8f6f4 %0, %1, %2, %0" : "+v"(ls) : "v"(pq), "v"(ones8));
}
__device__ __forceinline__ void mseg7(f32x16& p0, f32x16& p1, f32x16 (&o)[4], f32x16& ls, int ka0, int ka1, int va0, int va1, const i32x8& qf, const f32x16& negm, const i32x8& pP, const i32x8& ones8) {
    const i32x4 a0 = *(const LAS i32x4*)(uintptr_t)(unsigned)ka0, a1 = *(const LAS i32x4*)(uintptr_t)(unsigned)ka1;
    const i32x4 b0 = *(const LAS i32x4*)(uintptr_t)(unsigned)(ka0 + 2048), b1 = *(const LAS i32x4*)(uintptr_t)(unsigned)(ka1 + 2048);
    const i32x8 k0 = (i32x8){a0[0], a0[1], a0[2], a0[3], a1[0], a1[1], a1[2], a1[3]}, k1 = (i32x8){b0[0], b0[1], b0[2], b0[3], b1[0], b1[1], b1[2], b1[3]};
    i32x8 vf[4];
#pragma unroll
    for (int d0 = 0; d0 < 4; ++d0) { const i32x4 a = *(const LAS i32x4*)(uintptr_t)(unsigned)(va0 + d0 * 2048), b = *(const LAS i32x4*)(uintptr_t)(unsigned)(va1 + d0 * 2048);
        vf[d0] = (i32x8){a[0], a[1], a[2], a[3], b[0], b[1], b[2], b[3]}; }
    asm volatile("s_nop 1\n\t"
                 "v_mfma_f32_32x32x64_f8f6f4 %0, %7, %9, %10\n\t"
                 "v_mfma_f32_32x32x64_f8f6f4 %1, %8, %9, %10\n\t"
                 "v_mfma_f32_32x32x64_f8f6f4 %2, %11, %12, %2\n\t"
                 "v_mfma_f32_32x32x64_f8f6f4 %3, %11, %13, %3\n\t"
                 "v_mfma_f32_32x32x64_f8f6f4 %4, %11, %14, %4\n\t"
                 "v_mfma_f32_32x32x64_f8f6f4 %5, %11, %15, %5\n\t"
                 "v_mfma_f32_32x32x64_f8f6f4 %6, %11, %16, %6"
                 : "=&v"(p0), "=&v"(p1), "+v"(o[0]), "+v"(o[1]), "+v"(o[2]), "+v"(o[3]), "+v"(ls)
                 : "v"(k0), "v"(k1), "v"(qf), "v"(negm), "v"(pP), "v"(vf[0]), "v"(vf[1]), "v"(vf[2]), "v"(vf[3]), "v"(ones8));
}
__device__ __forceinline__ void mseg2(f32x16& p0, f32x16& p1, int ka0, int ka1, const i32x8& qf, const f32x16& negm) {
    const i32x4 a0 = *(const LAS i32x4*)(uintptr_t)(unsigned)ka0, a1 = *(const LAS i32x4*)(uintptr_t)(unsigned)ka1;
    const i32x4 b0 = *(const LAS i32x4*)(uintptr_t)(unsigned)(ka0 + 2048), b1 = *(const LAS i32x4*)(uintptr_t)(unsigned)(ka1 + 2048);
    const i32x8 k0 = (i32x8){a0[0], a0[1], a0[2], a0[3], a1[0], a1[1], a1[2], a1[3]}, k1 = (i32x8){b0[0], b0[1], b0[2], b0[3], b1[0], b1[1], b1[2], b1[3]};
    asm volatile("v_mfma_f32_32x32x64_f8f6f4 %0, %2, %4, %5\n\t"
                 "v_mfma_f32_32x32x64_f8f6f4 %1, %3, %4, %5\n\t"
                 "s_nop 15\n\ts_nop 7"
                 : "=&v"(p0), "=&v"(p1) : "v"(k0), "v"(k1), "v"(qf), "v"(negm));
}
template <int LO, int HI> __device__ __forceinline__ void exps(f32x16& a, f32x16& b) {
#pragma unroll
    for (int i = LO; i < HI; ++i) { if (i < 16) a[i & 15] = __builtin_amdgcn_exp2f(a[i & 15]); else b[i & 15] = __builtin_amdgcn_exp2f(b[i & 15]); }
}
template <int LO, int HI> __device__ __forceinline__ void cvts(const f32x16& a, const f32x16& b, i32x8& pP) {
#pragma unroll
    for (int c = LO; c < HI; ++c) { const int e = 2 * c; const float x0 = (e < 16) ? a[e & 15] : b[e & 15], x1 = (e < 16) ? a[(e + 1) & 15] : b[(e + 1) & 15];
        if (c & 1) pP[c >> 1] = __builtin_amdgcn_cvt_pk_fp8_f32(x0, x1, pP[c >> 1], true); else pP[c >> 1] = __builtin_amdgcn_cvt_pk_fp8_f32(x0, x1, pP[c >> 1], false); }
}
__device__ __forceinline__ float rowmax32(const f32x16& a, const f32x16& b) {
    float m0 = fmaxf(fmaxf(a[0], a[1]), a[2]), m1 = fmaxf(fmaxf(b[0], b[1]), b[2]);
#pragma unroll
    for (int r = 3; r < 15; r += 2) { m0 = fmaxf(fmaxf(m0, a[r]), a[r + 1]); m1 = fmaxf(fmaxf(m1, b[r]), b[r + 1]); }
    float pmax = fmaxf(fmaxf(m0, m1), fmaxf(a[15], b[15]));
    { auto rr = __builtin_amdgcn_permlane32_swap(__float_as_uint(pmax), __float_as_uint(pmax), false, false); pmax = fmaxf(__uint_as_float(rr[0]), __uint_as_float(rr[1])); }
    return pmax;
}
__device__ __forceinline__ i32x8 ldfrag(int a0, int a1) { const i32x4 a = *(const LAS i32x4*)(uintptr_t)(unsigned)a0, b = *(const LAS i32x4*)(uintptr_t)(unsigned)a1; return (i32x8){a[0], a[1], a[2], a[3], b[0], b[1], b[2], b[3]}; }
constexpr int NSLOT = 6, KIMG = 4096, VIMG = 8192, VREG = NSLOT * KIMG, WS_OFF = 98304, QL_OFF = WS_OFF + 2048;
__device__ __forceinline__ i32x8 attn_issue(const unsigned char* __restrict__ Qb, const unsigned char* __restrict__ Kh, const unsigned char* __restrict__ VIh, LAS char* lds, int tid) {
    const int wid = tid >> 6, lane = tid & 63, r32 = lane & 31, hi = lane >> 5;
    i32x8 qf; { const unsigned char* Qw = Qb + (long)(wid * QBLK + r32) * 1024 + hi * 32; const i32x4 a = *(const i32x4*)Qw, b = *(const i32x4*)(Qw + 16); qf = (i32x8){a[0], a[1], a[2], a[3], b[0], b[1], b[2], b[3]}; }
    const int wu = __builtin_amdgcn_readfirstlane(wid);
    unsigned goffk; { const int q0 = (wu & 3) * 64 + lane, krow = q0 >> 2, g = (q0 & 3) ^ ((krow >> 2) & 3); goffk = (unsigned)(krow * 1024 + g * 16); }
    const unsigned goffv = (unsigned)(wu * 1024 + lane * 16);
    const __amdgpu_buffer_rsrc_t rsV = __builtin_amdgcn_make_buffer_rsrc((void*)VIh, 0, 0x7fffffff, 0x00020000), rsK = __builtin_amdgcn_make_buffer_rsrc((void*)Kh, 0, 0x7fffffff, 0x00020000);
    int lowh = ((wu - 4) >> 31) & 1; asm volatile("" : "+s"(lowh));
#define SDMA0(t_, s_) do { \
        __builtin_amdgcn_raw_ptr_buffer_load_lds(rsV, (LAS void*)(lds + VREG + (s_) * VIMG + wu * 1024), 16, (int)goffv, (t_) * 8192, 0, 0); \
        if (lowh) __builtin_amdgcn_raw_ptr_buffer_load_lds(rsK, (LAS void*)(lds + (s_) * KIMG + wu * 1024), 16, (int)goffk, (t_) * (KVBLK * 1024), 0, 0); } while (0)
    SDMA0(0, 0); SDMA0(1, 1); SDMA0(2, 2); SDMA0(0, 5);
#undef SDMA0
    return qf;
}
__device__ __forceinline__ void attn_pass(const unsigned char* __restrict__ Qb, const unsigned char* __restrict__ Kh, const unsigned char* __restrict__ VIh, LAS char* lds, f32x16 (&o)[4], f32x16& ls, int tid, i32x8 qf) {
    const int wid = tid >> 6, lane = tid & 63, r32 = lane & 31, hi = lane >> 5;
    LAS float* ws = (LAS float*)(lds + WS_OFF) + wid * 64; LAS float* al_l = ws + 32;
    float m_reg = 0.f; f32x16 negm = f32x16{}; ls = f32x16{};
    asm volatile("" : "+v"(negm));
    i32x8 ones8 = (i32x8){0x38383838, 0x38383838, 0x38383838, 0x38383838, 0x38383838, 0x38383838, 0x38383838, 0x38383838};
    asm volatile("" : "+v"(ones8));
#pragma unroll
    for (int d = 0; d < 4; ++d) o[d] = f32x16{};
    const int wu = __builtin_amdgcn_readfirstlane(wid);
    unsigned goffk;
    { const int q0 = (wu & 3) * 64 + lane, krow = q0 >> 2, g = (q0 & 3) ^ ((krow >> 2) & 3); goffk = (unsigned)(krow * 1024 + g * 16); }
    int ka0 = (int)(uintptr_t)lds + r32 * 64 + (((2 * hi) ^ ((r32 >> 2) & 3)) << 4), ka1 = (int)(uintptr_t)lds + r32 * 64 + (((2 * hi + 1) ^ ((r32 >> 2) & 3)) << 4);
    const unsigned goffv = (unsigned)(wu * 1024 + lane * 16);
    int va0 = (int)(uintptr_t)lds + VREG + r32 * 64 + (((2 * hi) ^ ((r32 >> 2) & 3)) << 4), va1 = (int)(uintptr_t)lds + VREG + r32 * 64 + (((2 * hi + 1) ^ ((r32 >> 2) & 3)) << 4);
    asm volatile("" : "+v"(ka0), "+v"(ka1), "+v"(va0), "+v"(va1));
    const __amdgpu_buffer_rsrc_t rsV = __builtin_amdgcn_make_buffer_rsrc((void*)VIh, 0, 0x7fffffff, 0x00020000), rsK = __builtin_amdgcn_make_buffer_rsrc((void*)Kh, 0, 0x7fffffff, 0x00020000);
    int lowh = ((wu - 4) >> 31) & 1; asm volatile("" : "+s"(lowh));
#define SDMA(t_, s_) do { \
        __builtin_amdgcn_raw_ptr_buffer_load_lds(rsV, (LAS void*)(lds + VREG + (s_) * VIMG + wu * 1024), 16, (int)goffv, (t_) * 8192, 0, 0); \
        if (lowh) __builtin_amdgcn_raw_ptr_buffer_load_lds(rsK, (LAS void*)(lds + (s_) * KIMG + wu * 1024), 16, (int)goffk, (t_) * (KVBLK * 1024), 0, 0); } while (0)
#define ABAR() do { asm volatile("s_waitcnt lgkmcnt(0)" ::: "memory"); __builtin_amdgcn_s_barrier(); asm volatile("" ::: "memory"); } while (0)
#define DWAIT() do { if (lowh) asm volatile("s_waitcnt vmcnt(2)" ::: "memory"); else asm volatile("s_waitcnt vmcnt(1)" ::: "memory"); } while (0)
#define MF_S(dst_, kf_) asm volatile("v_mfma_f32_32x32x64_f8f6f4 %0, %1, %2, %3" : "=&v"(dst_) : "v"(kf_), "v"(qf), "v"(negm))
#define MF_PV(acc_, pin_, vf_) asm volatile("v_mfma_f32_32x32x64_f8f6f4 %0, %1, %2, %0" : "+v"(acc_) : "v"(pin_), "v"(vf_))
#define SLOWPATH(C0, C1, FIRST_) do { const float d_ = (FIRST_) ? pmax : fmaxf(pmax, 0.f); const float a_ = (FIRST_) ? 1.f : __builtin_amdgcn_exp2f(-d_); m_reg += d_; \
        _Pragma("unroll") for (int r = 0; r < 16; ++r) { C0[r] -= d_; C1[r] -= d_; negm[r] = -m_reg; } \
        asm volatile("" : "+v"(negm)); \
        if (__any(a_ < 1.f)) { if (hi == 0) al_l[r32] = a_; \
            asm volatile("s_nop 15\n\ts_nop 15\n\ts_waitcnt lgkmcnt(0)" : "+v"(o[0]), "+v"(o[1]), "+v"(o[2]), "+v"(o[3]), "+v"(ls) :: "memory"); \
            _Pragma("unroll") for (int r = 0; r < 16; ++r) { const float s_ = al_l[crow(r, hi)]; ls[r] *= s_; _Pragma("unroll") for (int d = 0; d < 4; ++d) o[d][r] *= s_; } } } while (0)
#define BODY(C0, C1, PIN, POUT, j_, I_, FIRSTCHK_) do {     \
        constexpr int ks_ = (((I_) + 1) % 6) * KIMG, vs_ = (((I_) + 5) % 6) * VIMG; \
        const i32x8 v0_ = ldfrag(va0 + vs_, va1 + vs_), v1_ = ldfrag(va0 + vs_ + 2048, va1 + vs_ + 2048); \
        SBAR(); asm volatile("s_nop 11" : "+v"(C0), "+v"(C1));     \
        const float pmax = rowmax32(C0, C1); \
        { const bool first_ = (FIRSTCHK_) && (j_) == 0; if (__builtin_expect(first_ || !__all(pmax <= THR2), 0)) SLOWPATH(C0, C1, first_); } \
        SBAR(); MF_PV(o[0], PIN, v0_); const i32x8 v2_ = ldfrag(va0 + vs_ + 4096, va1 + vs_ + 4096), v3_ = ldfrag(va0 + vs_ + 6144, va1 + vs_ + 6144); exps<0, 5>(C0, C1); \
        SBAR(); MF_PV(o[1], PIN, v1_); { const int tn_ = ((j_) + 3 < NT) ? ((j_) + 3) : (NT - 1); SDMA(tn_, ((I_) + 3) % 6); } exps<5, 10>(C0, C1); cvts<0, 2>(C0, C1, POUT); \
        SBAR(); MF_PV(o[2], PIN, v2_); const i32x8 k0_ = ldfrag(ka0 + ks_, ka1 + ks_), k1_ = ldfrag(ka0 + ks_ + 2048, ka1 + ks_ + 2048); exps<10, 15>(C0, C1); cvts<2, 5>(C0, C1, POUT); \
        SBAR(); MF_PV(o[3], PIN, v3_); exps<15, 20>(C0, C1); cvts<5, 8>(C0, C1, POUT); \
        SBAR(); MF_S(C0, k0_); exps<20, 25>(C0, C1); cvts<8, 10>(C0, C1, POUT); \
        SBAR(); MF_PV(ls, PIN, ones8); exps<25, 30>(C0, C1); cvts<10, 13>(C0, C1, POUT); \
        SBAR(); exps<30, 32>(C0, C1); cvts<13, 16>(C0, C1, POUT); asm volatile("" :: "v"(POUT));     \
        SBAR(); MF_S(C1, k1_); \
        SBAR(); DWAIT(); ABAR(); } while (0)
    f32x16 pX0, pX1; i32x8 pPa = i32x8{}, pPb = i32x8{};
    asm volatile("s_waitcnt vmcnt(0)" ::: "memory"); ABAR();
    { const i32x8 k0_ = ldfrag(ka0, ka1), k1_ = ldfrag(ka0 + 2048, ka1 + 2048); MF_S(pX0, k0_); MF_S(pX1, k1_); asm volatile("s_nop 15\n\ts_nop 7" : "+v"(pX0), "+v"(pX1)); }
    static_assert(NT % 6 == 0, "the loop is unrolled by six (ring slots as immediates; the packed-P buffers alternate)");
#pragma nounroll
    for (int j = 0; j < NT; j += 6) {
        BODY(pX0, pX1, pPa, pPb, j, 0, true);
        BODY(pX0, pX1, pPb, pPa, j + 1, 1, false);
        BODY(pX0, pX1, pPa, pPb, j + 2, 2, false);
        BODY(pX0, pX1, pPb, pPa, j + 3, 3, false);
        BODY(pX0, pX1, pPa, pPb, j + 4, 4, false);
        BODY(pX0, pX1, pPb, pPa, j + 5, 5, false);
    }
    { constexpr int vs_ = ((NT - 1) % 6) * VIMG;
      const i32x8 v0_ = ldfrag(va0 + vs_, va1 + vs_), v1_ = ldfrag(va0 + vs_ + 2048, va1 + vs_ + 2048), v2_ = ldfrag(va0 + vs_ + 4096, va1 + vs_ + 4096), v3_ = ldfrag(va0 + vs_ + 6144, va1 + vs_ + 6144);
      MF_PV(o[0], pPa, v0_); MF_PV(o[1], pPa, v1_); MF_PV(o[2], pPa, v2_); MF_PV(o[3], pPa, v3_); MF_PV(ls, pPa, ones8); }
    asm volatile("s_waitcnt vmcnt(0)" ::: "memory");
    asm volatile("s_nop 15\n\ts_nop 15\n\ts_nop 15\n\ts_nop 15" : "+v"(o[0]), "+v"(o[1]), "+v"(o[2]), "+v"(o[3]), "+v"(ls));
    ABAR();
#undef BODY
#undef SLOWPATH
#undef MF_S
#undef MF_PV
#undef DWAIT
#undef SDMA
#undef ABAR
}
}

__device__ __forceinline__ void vt_image_phase(PR p, Frame& F) {
    const bf16* V = WSP(bf16, B_V); unsigned char* VI = p.ws + B_VI;
    LAS unsigned char* img = (LAS unsigned char*)(F.lds + F.wave * 16384);
    const int gw = F.vcu * NWAVES + F.wave, NGW = F.G * NWAVES, lane = F.lane;
    const unsigned probe = (unsigned)__builtin_amdgcn_cvt_pk_fp8_f32(1.f, 2.f, 0, false);
    const int pshift = (probe & 0xffffu) ? 0 : 16, perm = ((((probe >> pshift) & 0xffu) == 0x38u) ? 0 : 1) | (pshift ? 2 : 0);
    for (int it2 = gw; it2 < 2 * NBATCH * 8 * att::NT; it2 += NGW) {
        const int it = it2 >> 1, half = it2 & 1;
        const int t = it % att::NT, bh = it / att::NT, b = bh >> 3, h = bh & 7;
        const bf16* src = V + ((size_t)b * att::NKEY + t * 64) * 1024 + h * 128;
        u32x4 xn[4];
#define VT_LOAD(i0_) do { _Pragma("unroll") for (int i = 0; i < 4; ++i) { const int id = lane + 64 * ((i0_) + i), key = id >> 4, dc = (id & 15) * 8; xn[i] = *(const u32x4*)(src + (size_t)key * 1024 + dc); } } while (0)
        VT_LOAD(8 * half);
#pragma unroll 1
        for (int i0 = 8 * half; i0 < 8 * half + 8; i0 += 4) {
            u32x4 x[4];
#pragma unroll
            for (int i = 0; i < 4; ++i) x[i] = xn[i];
            if (i0 + 4 < 8 * half + 8) VT_LOAD(i0 + 4);
#pragma unroll
            for (int i = 0; i < 4; ++i) { const int id = lane + 64 * (i0 + i), key = id >> 4, dc = (id & 15) * 8; const unsigned w[4] = {x[i].x, x[i].y, x[i].z, x[i].w};
#pragma unroll
                for (int e = 0; e < 4; ++e) { const float lo = bflo(w[e]), hi_ = bfhi(w[e]);
                    const int d0_ = dc + 2 * e, d1_ = d0_ + 1;
                    img[att::vimg_off(d0_, key, perm) + 4 * d0_] = (unsigned char)((__builtin_amdgcn_cvt_pk_fp8_f32(lo, lo, 0, false) >> pshift) & 0xff);
                    img[att::vimg_off(d1_, key, perm) + 4 * d1_] = (unsigned char)((__builtin_amdgcn_cvt_pk_fp8_f32(hi_, hi_, 0, false) >> pshift) & 0xff); } }
        }
#undef VT_LOAD
        asm volatile("s_waitcnt lgkmcnt(0)" ::: "memory");
        unsigned char* dst = VI + (size_t)it * 8192;
#pragma unroll
        for (int i = 0; i < 8; ++i) { const int pc = lane + 64 * i, row = pc >> 2; const LAS unsigned* q = (const LAS unsigned*)(img + row * 68 + (pc & 3) * 16);
            if ((((pc & 3) ^ ((row >> 2) & 3)) & 1) == half) *(u32x4*)(dst + pc * 16) = (u32x4){q[0], q[1], q[2], q[3]}; }
        asm volatile("s_waitcnt lgkmcnt(0)" ::: "memory");
    }
}
__device__ __forceinline__ void attn_phase(PR p, Frame& F) {
    using namespace att;
    const unsigned char* Q = p.ws + B_Q; const unsigned char* K = p.ws + B_K; bf16* AO = WSP(bf16, B_AO);
    i32x8 qn = i32x8{};
    if (F.vcu < NBATCH * 8 * 32) { const int un = F.vcu, bhn = un >> 5, qbn = un & 31, bn = bhn >> 3, hn = bhn & 7; int t0 = F.tid; asm volatile("" : "+v"(t0));
        qn = attn_issue(Q + ((size_t)bn * SEQ + qbn * 256) * 1024 + hn * 128, K + (size_t)bn * NKEY * 1024 + hn * 128, p.ws + B_VI + (size_t)(bn * 8 + hn) * NT * 8192, (LAS char*)F.lds, t0); }
    for (int unit = F.vcu; unit < NBATCH * 8 * 32; unit += F.G) {
        const int bh = unit >> 5, qb = unit & 31, b = bh >> 3, h = bh & 7;
        const unsigned char* Qb = Q + ((size_t)b * SEQ + qb * 256) * 1024 + h * 128;
        const unsigned char* Kh = K + (size_t)b * NKEY * 1024 + h * 128;
        const unsigned char* VIh = p.ws + B_VI + (size_t)(b * 8 + h) * NT * 8192;
        f32x16 o[4]; f32x16 ls;
        int tl = F.tid; asm volatile("" : "+v"(tl));
        attn_pass(Qb, Kh, VIh, (LAS char*)F.lds, o, ls, tl, qn);
        asm volatile("" : "+v"(tl));
        qn = attn_issue(Qb + 64, Kh + 64, VIh, (LAS char*)F.lds, tl);
        asm volatile("" : "+v"(tl));
        { float* st = WSP(float, B_STASH) + (size_t)F.bid * 64 * NTHREADS + tl;
#pragma unroll
          for (int r = 0; r < 16; ++r) { const float rl = __builtin_amdgcn_rcpf(ls[r]);
#pragma unroll
              for (int d0 = 0; d0 < 4; ++d0) st[(size_t)(d0 * 16 + r) * NTHREADS] = o[d0][r] * rl; } }
        __syncthreads();
        asm volatile("" : "+v"(tl));
        attn_pass(Qb + 64, Kh + 64, VIh, (LAS char*)F.lds, o, ls, tl, qn);
        asm volatile("" : "+v"(tl));
        if (unit + F.G < NBATCH * 8 * 32) { const int un = unit + F.G, bhn = un >> 5, qbn = un & 31, bn = bhn >> 3, hn = bhn & 7;
            qn = attn_issue(Q + ((size_t)bn * SEQ + qbn * 256) * 1024 + hn * 128, K + (size_t)bn * NKEY * 1024 + hn * 128, p.ws + B_VI + (size_t)(bn * 8 + hn) * NT * 8192, (LAS char*)F.lds, tl); }
        asm volatile("" : "+v"(tl));
        { const int lane = tl & 63, r32 = lane & 31, hi = lane >> 5, wid = tl >> 6;
          const float* st = WSP(float, B_STASH) + (size_t)F.bid * 64 * NTHREADS + tl;
          const float lam = WSP(float, WS_SCAL)[0];
          float ss[16];
#pragma unroll
          for (int r = 0; r < 16; ++r) { const float rl = __builtin_amdgcn_rcpf(ls[r]); float q = 0.f;
#pragma unroll
              for (int d0 = 0; d0 < 4; ++d0) { const float v = st[(size_t)(d0 * 16 + r) * NTHREADS] - lam * (o[d0][r] * rl); o[d0][r] = v; q += v * v; }
              ss[r] = q; }
#pragma unroll
          for (int r = 0; r < 16; ++r) { float q = ss[r]; q += __shfl_xor(q, 1); q += __shfl_xor(q, 2); q += __shfl_xor(q, 4); q += __shfl_xor(q, 8); q += __shfl_xor(q, 16);
              ss[r] = (1.f / sqrtf(q * (1.f / 128.f) + GN_EPS)) * (1.f - LAMBDA_INIT); }
          bf16* Ow = PF_OUT1 ? (bf16*)((unsigned char*)AO + ((size_t)b * SEQ + qb * 256 + wid * QBLK) * DM + h * 128 + r32) : AO + ((size_t)b * SEQ + qb * 256 + wid * QBLK) * DM + h * 128 + r32;
#pragma unroll
          for (int d0 = 0; d0 < 4; ++d0) { const float gsub = p.in[I_SUBLN][d0 * 32 + r32];
#pragma unroll
              for (int r = 0; r < 16; ++r) { if (PF_OUT1) ((unsigned char*)Ow)[(size_t)crow(r, hi) * DM + d0 * 32] = pg8::to_fp8(o[d0][r] * ss[r] * gsub); else Ow[(size_t)crow(r, hi) * DM + d0 * 32] = (bf16)f2bf(o[d0][r] * ss[r] * gsub); } } }
        __syncthreads();
    }
}
#ifndef MK_MULTI
#define MK_MULTI 0
#endif
constexpr int NPHASE = 22;

template <int LAYER>
__device__ __forceinline__ void moe_gemm1_phase(PR p, Frame& F, const bf16* BUF, bf16* HID) {
    const MoeTabs T = moe_tabs(F); moe_build_tabs(p, F, T);
    const int LD = MOE_FP8 ? 512 : 1024;
    pg8::ExpertOrder S; S.g.init((int)T.pendb[15], 8, F.G, F.bid, LD, LD); S.pend = T.pendb; S.eB = (long)EXP_STRIDE;
    pg8::Gemm g{BUF, (const bf16*)(p.ws + WS_EXP + (size_t)LAYER * 16 * EXP_STRIDE), LD, LD, LD};
    if (MOE_FP8) { pg8::EpiSwiGlu8 E{(unsigned char*)HID}; pg8::gemm_phase<true>(F.lds, g, S, E); }
    else { pg8::EpiSwiGlu E{HID}; pg8::gemm_phase(F.lds, g, S, E); }
}
template <int LAYER>
__device__ __forceinline__ void moe_gemm2_phase(PR p, Frame& F, const bf16* HID, bf16* Y) {
    const MoeTabs T = moe_tabs(F); moe_build_tabs(p, F, T);
    const int LD = MOE_FP8 ? 512 : 1024;
    pg8::ExpertOrder S; S.g.init((int)T.pendb[15], 4, F.G, F.bid, LD, LD); S.pend = T.pendb; S.eB = (long)EXP_STRIDE;
    pg8::Gemm g{HID, (const bf16*)(p.ws + WS_EXP + (size_t)LAYER * 16 * EXP_STRIDE + EXP_DN), LD, LD, LD};
    if (MOE_FP8) { pg8::EpiPlainS E{Y, 1024, 0.03125f}; pg8::gemm_phase<true>(F.lds, g, S, E); }
    else { pg8::EpiPlain E{Y, 1024}; pg8::gemm_phase(F.lds, g, S, E); }
}

#define PHP() const CAS Params* kp_ = (const CAS Params*)__builtin_amdgcn_kernarg_segment_ptr(); asm volatile("" : "+s"(kp_)); PR p = *kp_; Frame F; { int t_ = threadIdx.x; asm volatile("" : "+v"(t_)); int g_ = gridDim.x, b_ = blockIdx.x; asm volatile("" : "+s"(g_), "+s"(b_)); \
    F.lds = lds_base; F.tid = t_; F.lane = t_ & 63; F.wave = __builtin_amdgcn_readfirstlane(t_ >> 6); F.G = g_; F.bid = b_; F.vcu = (g_ % 8 == 0) ? (b_ % 8) * (g_ / 8) + b_ / 8 : b_; }
__global__ void __launch_bounds__(NTHREADS, 2) fwd(Params p_) {
    extern __shared__ __attribute__((aligned(16))) unsigned char lds_raw[];
    LAS unsigned char* const lds_base = (LAS unsigned char*)lds_raw;
    volatile LAS unsigned* misc = (volatile LAS unsigned*)(lds_base + MISC_OFF);
    for (int u = threadIdx.x; u < 64; u += NTHREADS) misc[u] = 0u;
    __syncthreads();
    const int lo = p_.ph_lo, hi = p_.ph_hi;
    XcdBarrier bar; bar.bar = (unsigned*)(p_.ws + WS_CTL) + 4096; bar.x = 0; bar.st = misc;
    if (!MK_MULTI) bar = xcd_barrier_post((unsigned*)(p_.ws + WS_CTL) + 4096, misc);
#ifndef ONLY_PHASE
#define ONLY_PHASE -1
#endif
#ifndef REP_MASK
#define REP_MASK 0
#endif
#define REP(k) for (int rep_ = 0; rep_ < (((REP_MASK) >> (k)) & 1) + 1; ++rep_, __syncthreads())
#define IN(k) ((ONLY_PHASE < 0 || ONLY_PHASE == (k)) && lo <= (k) && (k) < hi)
#define SEAM(k) do { if (IN(k) && IN((k) + 1)) xcd_barrier(bar); } while (0)
#ifdef DIAG_A
#define STAMP(k) do { if ((k) == DIAG_A || (k) == DIAG_B) { if (blockIdx.x == 0 && threadIdx.x == 0) { unsigned long long* st_ = (unsigned long long*)(p_.ws + WS_SCAL + 64) + ((k) == DIAG_B ? 2 : 0); st_[0] = __builtin_amdgcn_s_memtime(); st_[1] = __builtin_amdgcn_s_memrealtime(); } } } while (0)
#define STAMPE(k) do { } while (0)
#else
#define STAMP(k) do { } while (0)
#define STAMPE(k) do { } while (0)
#endif

    STAMP(0); if (IN(0)) REP(0) { PHP(); p0a_prologue(p, F); } STAMPE(0); SEAM(0);
    STAMP(1); if (IN(1)) REP(1) { PHP(); p0b_phase(p, F); } STAMPE(1); SEAM(1);
    STAMP(2); if (IN(2)) REP(2) { PHP();
        constexpr int LD = PF_IN0 ? 512 : 1024; pg8::Gemm g{WSP(bf16, A_H0), WSP(bf16, WS_WIN0), LD, LD, LD}; pg8::GridOrder S; S.init(NTOK / 256, 10, F.G, F.bid, LD, LD);
        pg8::EpiInProj0 E{WSP(bf16, A_QK), WSP(bf16, A_V), WSP(bf16, A_G), WSP(bf16, A_UA), WSP(float, WS_ROPE0C), WSP(float, WS_ROPE0S)};
        pg8::gemm_phase<PF_IN0 != 0>(F.lds, g, S, E);
    } STAMPE(2); SEAM(2);
    STAMP(3); if (IN(3)) REP(3) { PHP();
        pg8::Gemm g{WSP(bf16, A_UA), WSP(bf16, WS_BT1), 512, 768, 512};
        pg8::BatchOrder S; S.nZ = 16; S.nM = 5; S.nN = 1; S.G = F.G; S.c = F.bid; S.tA = 256L * 768 * 2; S.tB = 256L * 512 * 2; S.zA = (long)S5ROWS * 768 * 2; S.zB = 256L * 512 * 2;
        pg8::EpiS5E E{WSP(float, A_EO)};
        pg8::gemm_phase(F.lds, g, S, E);
        ret_states_phase(p, F, 80, 3);
    } STAMPE(3); SEAM(3);
    STAMP(4); if (IN(4)) REP(4) { PHP(); s5_scan_phase(p, F); ret_scan_phase(p, F); } STAMPE(4); SEAM(4);
    STAMP(5); if (IN(5)) REP(5) { PHP();
        pg8::Gemm g{WSP(bf16, A_UA), WSP(bf16, WS_BT2), 768, 768, 768};
        pg8::BatchOrder S; S.nZ = 16; S.nM = 5; S.nN = 2; S.G = F.G; S.c = F.bid; S.tA = 256L * 768 * 2; S.tB = 256L * 768 * 2; S.zA = (long)S5ROWS * 768 * 2; S.zB = 512L * 768 * 2;
        pg8::EpiS5Y E{WSP(bf16, A_SG)};
        pg8::gemm_phase(F.lds, g, S, E);
#ifdef RET_REP
        for (int rr_ = 0; rr_ < RET_REP; ++rr_) { ret_out_phase(p, F, 160, 6); __syncthreads(); }
#endif
        ret_out_phase(p, F, 160, 6);
    } STAMPE(5); SEAM(5);
    STAMP(6); if (IN(6)) REP(6) { PHP();
        pg8::Gemm g{WSP(bf16, A_SG), WSP(bf16, WS_WGLU), 256, 256, 256}; pg8::GridOrder S; S.init(NTOK / 256, 2, F.G, F.bid, 256, 256);
        pg8::EpiGlu E{WSP(bf16, A_MRG)};
        pg8::gemm_phase(F.lds, g, S, E);
    } STAMPE(6); SEAM(6);
    STAMP(7); if (IN(7)) REP(7) { PHP();
        constexpr int LD = PF_OUT0 ? 512 : 1024; pg8::Gemm g{WSP(bf16, A_MRG), WSP(bf16, WS_WOUT0), LD, LD, LD}; pg8::GridOrder S; S.init(NTOK / 256, 4, F.G, F.bid, LD, LD);
        pg8::EpiPlainS E{WSP(bf16, A_O), 1024, pg8::PSC_OUT0};
        pg8::gemm_phase<PF_OUT0 != 0>(F.lds, g, S, E);
    } STAMPE(7); SEAM(7);
    STAMP(8); if (IN(8)) REP(8) { PHP(); ln1_router_phase<0>(p, F, WSP(bf16, A_O), WSP(bf16, A_H2), NTOK); } STAMPE(8); SEAM(8);
    STAMP(9); if (IN(9)) REP(9) { PHP(); moe_scatter_phase(p, F, WSP(bf16, A_H2), WSP(bf16, A_BUF), NTOK); } STAMPE(9); SEAM(9);
    STAMP(10); if (IN(10)) REP(10) { PHP(); moe_gemm1_phase<0>(p, F, WSP(bf16, A_BUF), WSP(bf16, A_HID)); } STAMPE(10); SEAM(10);
    STAMP(11); if (IN(11)) REP(11) { PHP(); moe_gemm2_phase<0>(p, F, WSP(bf16, A_HID), WSP(bf16, A_Y)); } STAMPE(11); SEAM(11);
    STAMP(12); if (IN(12)) REP(12) { PHP(); ln2_phase<0>(p, F, WSP(bf16, A_Y), WSP(bf16, A_H0P), NTOK); } STAMPE(12); SEAM(12);
    STAMP(13); if (IN(13)) REP(13) { PHP();
        constexpr int LD = PF_IN1 ? 512 : 1024; pg8::Gemm g{WSP(bf16, A_H0P), WSP(bf16, WS_WIN1), LD, LD, LD}; pg8::InProj1Order S; S.g.init(NLAT / 256, 12, F.G, F.bid, LD, LD);
        pg8::EpiInProj1 E{WSP(bf16, B_Q), WSP(bf16, B_K), WSP(bf16, B_V), WSP(float, WS_ROPE1)};
        pg8::gemm_phase<PF_IN1 != 0>(F.lds, g, S, E);
    } STAMPE(13); SEAM(13);
    STAMP(14); if (IN(14)) REP(14) { PHP(); vt_image_phase(p, F); } STAMPE(14); SEAM(14);
    STAMP(15); if (IN(15)) REP(15) { PHP(); attn_phase(p, F); } STAMPE(15); SEAM(15);
    STAMP(16); if (IN(16)) REP(16) { PHP();
        constexpr int LD = PF_OUT1 ? 512 : 1024; pg8::Gemm g{WSP(bf16, B_AO), WSP(bf16, WS_WOUT1), LD, LD, LD}; pg8::GridOrder S; S.init(NLAT / 256, 4, F.G, F.bid, LD, LD);
        pg8::EpiPlainS E{WSP(bf16, B_O), 1024, pg8::PSC_OUT1};
        pg8::gemm_phase<PF_OUT1 != 0>(F.lds, g, S, E);
    } STAMPE(16); SEAM(16);
    STAMP(17); if (IN(17)) REP(17) { PHP(); ln1_router_phase<1>(p, F, WSP(bf16, B_O), WSP(bf16, B_H2), NLAT); } STAMPE(17); SEAM(17);
    STAMP(18); if (IN(18)) REP(18) { PHP(); moe_scatter_phase(p, F, WSP(bf16, B_H2), WSP(bf16, B_BUF), NLAT); } STAMPE(18); SEAM(18);
    STAMP(19); if (IN(19)) REP(19) { PHP(); moe_gemm1_phase<1>(p, F, WSP(bf16, B_BUF), WSP(bf16, B_HID)); } STAMPE(19); SEAM(19);
    STAMP(20); if (IN(20)) REP(20) { PHP(); moe_gemm2_phase<1>(p, F, WSP(bf16, B_HID), WSP(bf16, B_Y)); } STAMPE(20); SEAM(20);
    STAMP(21); if (IN(21)) REP(21) { PHP(); ln2_phase<1>(p, F, WSP(bf16, B_Y), nullptr, NLAT); }
#ifdef DIAG_SEG
    if (blockIdx.x == 0 && threadIdx.x == 0) {
        const unsigned long long ticks = *(volatile unsigned long long*)(p_.ws + 65536) / 16ull;
        const unsigned long long t0 = __builtin_amdgcn_s_memrealtime();
        while (__builtin_amdgcn_s_memrealtime() - t0 < ticks) __builtin_amdgcn_s_sleep(8);
    }
#endif
#ifdef DIAG_A
    if (blockIdx.x == 0 && threadIdx.x == 0) {
        unsigned long long* st_ = (unsigned long long*)(p_.ws + WS_SCAL + 64);
        if (DIAG_B == NPHASE) { st_[2] = __builtin_amdgcn_s_memtime(); st_[3] = __builtin_amdgcn_s_memrealtime(); }
        const unsigned long long ticks = 4ull * (st_[3] - st_[1]);
        const unsigned long long t0 = __builtin_amdgcn_s_memrealtime();
        while (__builtin_amdgcn_s_memrealtime() - t0 < ticks) __builtin_amdgcn_s_sleep(8);
    }
#endif
#undef IN
#undef SEAM
}

extern "C" void kernel_launch(void* const* d_in, const int* in_sizes, int n_in, void* d_out, int out_size, void* d_ws, size_t ws_size, hipStream_t stream) {
    static int grid = 0;
    if (grid == 0) {
        if (n_in != N_IN || out_size != NLAT * DM || ws_size < WS_END) { fprintf(stderr, "kernel_launch: unexpected shapes: n_in %d out %d ws %zu (need %zu)\n", n_in, out_size, ws_size, (size_t)WS_END); grid = -1; return; }
        int dev = 0, cus = 0, per_cu = 0;
        if (hipGetDevice(&dev) != hipSuccess || hipDeviceGetAttribute(&cus, hipDeviceAttributeMultiprocessorCount, dev) != hipSuccess) { grid = -1; return; }
        if (hipFuncSetAttribute((const void*)fwd, hipFuncAttributeMaxDynamicSharedMemorySize, LDS_BYTES) != hipSuccess) { fprintf(stderr, "kernel_launch: hipFuncSetAttribute failed\n"); grid = -1; return; }
        if (hipOccupancyMaxActiveBlocksPerMultiprocessor(&per_cu, (const void*)fwd, NTHREADS, LDS_BYTES) != hipSuccess || per_cu < 1) fprintf(stderr, "kernel_launch: occupancy query reports %d\n", per_cu);
        (void)hipGetLastError();
        grid = cus > 256 ? 256 : cus;
    }
    if (grid < 0) return;
    if (hipMemsetAsync((char*)d_ws + WS_CTL, 0, CTL_BYTES, stream) != hipSuccess) return;
    Params prm{};
    for (int i = 0; i < N_IN; ++i) prm.in[i] = (const float*)d_in[i];
    prm.out = (float*)d_out; prm.ws = (unsigned char*)d_ws;
#if MK_MULTI
    for (int ph = 0; ph < NPHASE; ++ph) { prm.ph_lo = ph; prm.ph_hi = ph + 1; hipLaunchKernelGGL(fwd, dim3(grid), dim3(NTHREADS), LDS_BYTES, stream, prm); }
#else
    prm.ph_lo = 0; prm.ph_hi = NPHASE;
    hipLaunchKernelGGL(fwd, dim3(grid), dim3(NTHREADS), LDS_BYTES, stream, prm);
#endif
}
```
